# Optimizing an MI355X kernel written in HIP

```python
import math
import jax
import jax.numpy as jnp
from jax import lax
import numpy as np

D_MODEL = 1024
BATCH = 8
SEQ = 2048
DEPTH = 1
DEC_BATCH = 8
DEC_SEQ = 16
PAST_LEN = 4096

CHUNK = 64
CONV_W = 4
LRU_WIDTH = 1024
LRU_HEADS = 8
LRU_BLOCK = LRU_WIDTH // LRU_HEADS
LRU_C = 8.0
D_INNER = 2 * D_MODEL
SSD_HEAD_DIM = 64
SSD_HEADS = D_INNER // SSD_HEAD_DIM
SSD_GROUPS = 4
HEADS_PER_GROUP = SSD_HEADS // SSD_GROUPS
D_STATE = 128
SSD_CONV_DIM = D_INNER + 2 * SSD_GROUPS * D_STATE
N_BRANCH = 2
FFN_DIM = 2816
EPS = 1e-6
IN_COLS = 2 * LRU_WIDTH + D_INNER + SSD_CONV_DIM + SSD_HEADS + N_BRANCH * D_MODEL

kernel_name = 'hybrid_rglru_ssd_macaron_stream_step'


def _rmsnorm(x, g):
    xf = x.astype(jnp.float32)
    inv = lax.rsqrt(jnp.mean(xf * xf, axis=-1, keepdims=True) + EPS)
    return (xf * inv).astype(x.dtype) * g


def _swiglu(x, w_up, w_down):
    gate, up = jnp.split(x @ w_up, 2, axis=-1)
    return (jax.nn.silu(gate) * up) @ w_down


def _causal_conv(x, buf, w, b):
    L = x.shape[1]
    xp = jnp.concatenate([buf, x], axis=1)
    y = b + xp[:, 0:L, :] * w[0]
    for k in range(1, CONV_W):
        y = y + xp[:, k:k + L, :] * w[k]
    return y, xp[:, L:, :]


def _rglru(x, h0, w_rg, b_rg, w_ig, b_ig, lam):
    nb, L, _ = x.shape
    xb = x.reshape(nb, L, LRU_HEADS, LRU_BLOCK)
    r = jax.nn.sigmoid(jnp.einsum('blhi,hij->blhj', xb, w_rg).reshape(nb, L, LRU_WIDTH) + b_rg)
    i = jax.nn.sigmoid(jnp.einsum('blhi,hij->blhj', xb, w_ig).reshape(nb, L, LRU_WIDTH) + b_ig)
    log_a = -LRU_C * r.astype(jnp.float32) * jax.nn.softplus(-lam.astype(jnp.float32))
    a = jnp.exp(log_a)
    u = jnp.sqrt(-jnp.expm1(2.0 * log_a)) * (i * x).astype(jnp.float32)
    u = u.at[:, 0].add(a[:, 0] * h0.astype(jnp.float32))

    def combine(left, right):
        a1, b1 = left
        a2, b2 = right
        return a1 * a2, a2 * b1 + b2

    _, h = lax.associative_scan(combine, (a, u), axis=1)
    return h.astype(x.dtype), h[:, -1].astype(x.dtype)


def _segsum(x):
    T = x.shape[-1]
    xr = jnp.broadcast_to(x[..., :, None], x.shape + (T,))
    strict = jnp.tril(jnp.ones((T, T), dtype=bool), -1)
    cs = jnp.cumsum(jnp.where(strict, xr, 0.0), axis=-2)
    return jnp.where(jnp.tril(jnp.ones((T, T), dtype=bool)), cs, -jnp.inf)


def _ssd_scan(x, dt, A, Bm, Cm, h0):
    nb, L = x.shape[0], x.shape[1]
    cs = min(CHUNK, L)
    nc = L // cs
    G, E, P, N = SSD_GROUPS, HEADS_PER_GROUP, SSD_HEAD_DIM, D_STATE
    x = x.reshape(nb, nc, cs, G, E, P)
    dt = dt.reshape(nb, nc, cs, G, E)
    Bm = Bm.reshape(nb, nc, cs, G, N)
    Cm = Cm.reshape(nb, nc, cs, G, N)
    dA = jnp.moveaxis(dt * A.reshape(G, E), 2, -1)
    xd = x * dt[..., None]
    A_cs = jnp.cumsum(dA, axis=-1)
    Lmat = jnp.exp(_segsum(dA))
    CB = jnp.einsum('bclgn,bcsgn->bcgls', Cm, Bm)
    y_diag = jnp.einsum('bcgls,bcgels,bcsgep->bclgep', CB, Lmat, xd)
    decay_states = jnp.exp(A_cs[..., -1:] - A_cs)
    states = jnp.einsum('bcsgn,bcges,bcsgep->bcgepn', Bm, decay_states, xd)
    states = jnp.concatenate([h0.reshape(nb, G, E, P, N)[:, None], states], axis=1)
    chunk_decay = jnp.pad(A_cs[..., -1], ((0, 0), (1, 0), (0, 0), (0, 0)))
    decay_chunk = jnp.exp(_segsum(jnp.moveaxis(chunk_decay, 1, -1)))
    new_states = jnp.einsum('bgezc,bcgepn->bzgepn', decay_chunk, states)
    states_in, final = new_states[:, :-1], new_states[:, -1]
    y_off = jnp.einsum('bclgn,bcgepn,bcgel->bclgep', Cm, states_in, jnp.exp(A_cs))
    y = (y_diag + y_off).reshape(nb, L, SSD_HEADS, P)
    return y, final.reshape(nb, SSD_HEADS, P, N)


def _mixer(u, lru_conv_buf, lru_h0, ssd_conv_buf, ssd_h0, p):
    nb, L, _ = u.shape
    proj = u @ p['w_in']
    sizes = [LRU_WIDTH, LRU_WIDTH, D_INNER, SSD_CONV_DIM, SSD_HEADS, N_BRANCH * D_MODEL]
    offs = np.cumsum(sizes)[:-1].tolist()
    lru_x, lru_gate, z, xbc, dt_raw, gate_logits = jnp.split(proj, offs, axis=-1)

    xc, lru_conv_new = _causal_conv(lru_x, lru_conv_buf, p['lru_conv_w'], p['lru_conv_b'])
    h, lru_h_new = _rglru(xc, lru_h0, p['lru_w_rg'], p['lru_b_rg'], p['lru_w_ig'], p['lru_b_ig'], p['lru_lambda'])
    y_lru = jax.nn.gelu(lru_gate) * h

    xbc_c, ssd_conv_new = _causal_conv(xbc, ssd_conv_buf, p['ssd_conv_w'], p['ssd_conv_b'])
    xbc_c = jax.nn.silu(xbc_c)
    xs, Bm, Cm = jnp.split(xbc_c, [D_INNER, D_INNER + SSD_GROUPS * D_STATE], axis=-1)
    xs_h = xs.reshape(nb, L, SSD_HEADS, SSD_HEAD_DIM).astype(jnp.float32)
    dt = jax.nn.softplus(dt_raw.astype(jnp.float32) + p['ssd_dt_bias'].astype(jnp.float32))
    A = -jnp.exp(p['ssd_A_log'].astype(jnp.float32))
    y, ssd_h_new = _ssd_scan(
        xs_h, dt, A,
        Bm.reshape(nb, L, SSD_GROUPS, D_STATE).astype(jnp.float32),
        Cm.reshape(nb, L, SSD_GROUPS, D_STATE).astype(jnp.float32),
        ssd_h0.astype(jnp.float32))
    y = y + p['ssd_D'].astype(jnp.float32)[:, None] * xs_h
    y = y.reshape(nb, L, D_INNER).astype(u.dtype) * jax.nn.silu(z)
    y = _rmsnorm(y.reshape(nb, L, SSD_GROUPS, D_INNER // SSD_GROUPS),
                 p['ssd_norm_g'].reshape(SSD_GROUPS, D_INNER // SSD_GROUPS)).reshape(nb, L, D_INNER)

    g_lru, g_ssd = jnp.split(jax.nn.sigmoid(gate_logits + p['b_gate']), 2, axis=-1)
    m = g_lru * (y_lru @ p['w_br_lru']) + g_ssd * (y @ p['w_br_ssd'])
    out = m @ p['w_out']
    return out, lru_conv_new, lru_h_new, ssd_conv_new, ssd_h_new.astype(u.dtype)


def _layer(x, lru_conv_buf, lru_h0, ssd_conv_buf, ssd_h0, p):
    x = x + 0.5 * _swiglu(_rmsnorm(x, p['norm_ffn1_g']), p['ffn1_w_up'], p['ffn1_w_down'])
    mix, lcv, lh, scv, sh = _mixer(_rmsnorm(x, p['norm_mix_g']), lru_conv_buf, lru_h0, ssd_conv_buf, ssd_h0, p)
    x = x + mix
    x = x + 0.5 * _swiglu(_rmsnorm(x, p['norm_ffn2_g']), p['ffn2_w_up'], p['ffn2_w_down'])
    return x, (lcv, lh, scv, sh)


def setup_inputs(seed: int = 0) -> dict:
    key = jax.random.key(seed)
    ks = jax.random.split(key, 40)
    f32 = jnp.float32

    def nrm(k, shape, scale):
        return jax.random.normal(k, shape, f32) * scale

    u_lam = jax.random.uniform(ks[10], (DEPTH, LRU_WIDTH), f32, minval=0.9, maxval=0.999)
    dt0 = jnp.exp(jax.random.uniform(ks[14], (DEPTH, SSD_HEADS), f32,
                                     minval=math.log(1e-3), maxval=math.log(1e-1)))
    return {
        'x_prompt': nrm(ks[0], (BATCH, SEQ, D_MODEL), 1.0),
        'x_sample': nrm(ks[1], (DEC_BATCH, DEC_SEQ, D_MODEL), 1.0),
        'state_lru_conv': nrm(ks[2], (DEPTH, DEC_BATCH, CONV_W - 1, LRU_WIDTH), 1.0),
        'state_lru_h': nrm(ks[3], (DEPTH, DEC_BATCH, LRU_WIDTH), 0.5),
        'state_ssd_conv': nrm(ks[4], (DEPTH, DEC_BATCH, CONV_W - 1, SSD_CONV_DIM), 1.0),
        'state_ssd_h': nrm(ks[5], (DEPTH, DEC_BATCH, SSD_HEADS, SSD_HEAD_DIM, D_STATE), 0.1),
        'norm_ffn1_g': 1.0 + nrm(ks[6], (DEPTH, D_MODEL), 0.02),
        'ffn1_w_up': nrm(ks[7], (DEPTH, D_MODEL, 2 * FFN_DIM), D_MODEL ** -0.5),
        'ffn1_w_down': nrm(ks[8], (DEPTH, FFN_DIM, D_MODEL), FFN_DIM ** -0.5),
        'norm_mix_g': 1.0 + nrm(ks[9], (DEPTH, D_MODEL), 0.02),
        'w_in': nrm(ks[11], (DEPTH, D_MODEL, IN_COLS), D_MODEL ** -0.5),
        'b_gate': nrm(ks[12], (DEPTH, N_BRANCH * D_MODEL), 0.01),
        'lru_conv_w': nrm(ks[13], (DEPTH, CONV_W, LRU_WIDTH), CONV_W ** -0.5),
        'lru_conv_b': nrm(ks[15], (DEPTH, LRU_WIDTH), 0.01),
        'lru_w_rg': nrm(ks[16], (DEPTH, LRU_HEADS, LRU_BLOCK, LRU_BLOCK), LRU_BLOCK ** -0.5),
        'lru_b_rg': nrm(ks[17], (DEPTH, LRU_WIDTH), 0.01),
        'lru_w_ig': nrm(ks[18], (DEPTH, LRU_HEADS, LRU_BLOCK, LRU_BLOCK), LRU_BLOCK ** -0.5),
        'lru_b_ig': nrm(ks[19], (DEPTH, LRU_WIDTH), 0.01),
        'lru_lambda': jnp.log(u_lam) - jnp.log1p(-u_lam),
        'ssd_conv_w': nrm(ks[20], (DEPTH, CONV_W, SSD_CONV_DIM), CONV_W ** -0.5),
        'ssd_conv_b': nrm(ks[21], (DEPTH, SSD_CONV_DIM), 0.01),
        'ssd_dt_bias': dt0 + jnp.log(-jnp.expm1(-dt0)),
        'ssd_A_log': jnp.log(jax.random.uniform(ks[22], (DEPTH, SSD_HEADS), f32, minval=1.0, maxval=16.0)),
        'ssd_D': 1.0 + nrm(ks[23], (DEPTH, SSD_HEADS), 0.02),
        'ssd_norm_g': 1.0 + nrm(ks[24], (DEPTH, D_INNER), 0.02),
        'w_br_lru': nrm(ks[25], (DEPTH, LRU_WIDTH, D_MODEL), LRU_WIDTH ** -0.5),
        'w_br_ssd': nrm(ks[26], (DEPTH, D_INNER, D_MODEL), D_INNER ** -0.5),
        'w_out': nrm(ks[27], (DEPTH, D_MODEL, D_MODEL), D_MODEL ** -0.5),
        'norm_ffn2_g': 1.0 + nrm(ks[28], (DEPTH, D_MODEL), 0.02),
        'ffn2_w_up': nrm(ks[29], (DEPTH, D_MODEL, 2 * FFN_DIM), D_MODEL ** -0.5),
        'ffn2_w_down': nrm(ks[30], (DEPTH, FFN_DIM, D_MODEL), FFN_DIM ** -0.5),
        'norm_final_g': 1.0 + nrm(ks[31], (D_MODEL,), 0.02),
    }


def reference(x_prompt, x_sample, state_lru_conv, state_lru_h, state_ssd_conv, state_ssd_h,
              norm_ffn1_g, ffn1_w_up, ffn1_w_down, norm_mix_g, w_in, b_gate,
              lru_conv_w, lru_conv_b, lru_w_rg, lru_b_rg, lru_w_ig, lru_b_ig, lru_lambda,
              ssd_conv_w, ssd_conv_b, ssd_dt_bias, ssd_A_log, ssd_D, ssd_norm_g,
              w_br_lru, w_br_ssd, w_out, norm_ffn2_g, ffn2_w_up, ffn2_w_down, norm_final_g):
    nbp = x_prompt.shape[0]
    dtype = x_prompt.dtype
    xp, xs = x_prompt, x_sample
    new_p, new_s = [], []
    for l in range(DEPTH):
        p = {
            'norm_ffn1_g': norm_ffn1_g[l], 'ffn1_w_up': ffn1_w_up[l], 'ffn1_w_down': ffn1_w_down[l],
            'norm_mix_g': norm_mix_g[l], 'w_in': w_in[l], 'b_gate': b_gate[l],
            'lru_conv_w': lru_conv_w[l], 'lru_conv_b': lru_conv_b[l],
            'lru_w_rg': lru_w_rg[l], 'lru_b_rg': lru_b_rg[l],
            'lru_w_ig': lru_w_ig[l], 'lru_b_ig': lru_b_ig[l], 'lru_lambda': lru_lambda[l],
            'ssd_conv_w': ssd_conv_w[l], 'ssd_conv_b': ssd_conv_b[l],
            'ssd_dt_bias': ssd_dt_bias[l], 'ssd_A_log': ssd_A_log[l], 'ssd_D': ssd_D[l],
            'ssd_norm_g': ssd_norm_g[l], 'w_br_lru': w_br_lru[l], 'w_br_ssd': w_br_ssd[l],
            'w_out': w_out[l], 'norm_ffn2_g': norm_ffn2_g[l],
            'ffn2_w_up': ffn2_w_up[l], 'ffn2_w_down': ffn2_w_down[l],
        }
        xp, st_p = _layer(
            xp,
            jnp.zeros((nbp, CONV_W - 1, LRU_WIDTH), dtype),
            jnp.zeros((nbp, LRU_WIDTH), dtype),
            jnp.zeros((nbp, CONV_W - 1, SSD_CONV_DIM), dtype),
            jnp.zeros((nbp, SSD_HEADS, SSD_HEAD_DIM, D_STATE), dtype),
            p)
        xs, st_s = _layer(xs, state_lru_conv[l], state_lru_h[l], state_ssd_conv[l], state_ssd_h[l], p)
        new_p.append(st_p)
        new_s.append(st_s)
    y_prompt = _rmsnorm(xp, norm_final_g)
    y_sample = _rmsnorm(xs, norm_final_g)
    lru_conv_p = jnp.stack([s[0] for s in new_p])
    lru_h_p = jnp.stack([s[1] for s in new_p])
    ssd_conv_p = jnp.stack([s[2] for s in new_p])
    ssd_h_p = jnp.stack([s[3] for s in new_p])
    lru_conv_s = jnp.stack([s[0] for s in new_s])
    lru_h_s = jnp.stack([s[1] for s in new_s])
    ssd_conv_s = jnp.stack([s[2] for s in new_s])
    ssd_h_s = jnp.stack([s[3] for s in new_s])
    return (y_prompt, y_sample, lru_conv_p, lru_h_p, ssd_conv_p, ssd_h_p,
            lru_conv_s, lru_h_s, ssd_conv_s, ssd_h_s)
```

```cpp
#include <hip/hip_runtime.h>
#include <hip/hip_cooperative_groups.h>
#include <cstdio>
namespace cg = cooperative_groups;

#define LAS __attribute__((address_space(3)))
typedef unsigned short bf16_t;
typedef short bf16x8 __attribute__((ext_vector_type(8)));
typedef float f32x4 __attribute__((ext_vector_type(4)));
typedef unsigned u32x4 __attribute__((ext_vector_type(4)));

constexpr int T = 16384, TS = 128, D = 1024, FF = 2816, NPP = 4096, SEQ = 2048, NCH = 32;
constexpr float EPS = 1e-6f;
constexpr size_t OFF_WUP1 = 0, OFF_WDN1 = 11534336;
constexpr size_t OFF_DT = 0, OFF_SUMM = 2097152, OFF_HALO = 4194304, OFF_GSSQ = 5767168, OFF_PS = 7864320,
                 OFF_DTS = 12582912, OFF_YGS = 12599296, OFF_ABRS = 13647872, OFF_M1S = 14434304, OFF_MS = 14958592;
constexpr size_t OFF_WIN = 17301504, OFF_WDT = 36175872, OFF_WBR = 36241408, OFF_WOUT = 42532864, OFF_WUP2 = 44630016,
                 OFF_WDN2 = 56164352, OFF_WRG = 61931520, OFF_WIG = 62193664, OFF_XB = 62455808, OFF_XN = 96010240,
                 OFF_PP = 129564672, OFF_SSQ = 263782400, OFF_XNS = 264830976, OFF_HS = 265093120, WS_END = 265814016;
constexpr size_t O_YP = 0, O_YS = 16777216, O_LCP = 16908288, O_LHP = 16932864, O_SCP = 16941056, O_SHP = 17014784,
                 O_LCS = 19111936, O_LHS = 19136512, O_SCS = 19144704, O_SHS = 19218432;
constexpr int LDS_BYTES = 135168;

struct Params { const float* in[32]; float* out; unsigned char* ws; int ph_lo, ph_hi; };

#ifdef DIAG
#define SZ(x) 0.0f
#ifndef DIAG_TOL
#define DIAG_TOL 0.01f
#endif
#else
#define SZ(x) (x)
#endif
__device__ __forceinline__ int otid() { int t = threadIdx.x; asm volatile("" : "+v"(t)); return t; }
__device__ __forceinline__ unsigned cvt_pk_bf16(float lo, float hi) { unsigned r; asm volatile("v_cvt_pk_bf16_f32 %0, %1, %2" : "=v"(r) : "v"(lo), "v"(hi)); return r; }
__device__ __forceinline__ bf16_t f2bf(float f) { return (bf16_t)(cvt_pk_bf16(f, 0.f) & 0xffffu); }
__device__ __forceinline__ float bf2f(bf16_t b) { return __uint_as_float(((unsigned)b) << 16); }
__device__ __forceinline__ float bflo(unsigned w) { return __uint_as_float(w << 16); }
__device__ __forceinline__ float bfhi(unsigned w) { return __uint_as_float(w & 0xffff0000u); }
__device__ __forceinline__ float sigmoidf_(float x) { return __builtin_amdgcn_rcpf(1.0f + __expf(-x)); }
__device__ __forceinline__ float siluf_(float x) { return x * sigmoidf_(x); }
__device__ __forceinline__ float gelu_tanh(float x) { const float u = 0.7978845608028654f * (x + 0.044715f * x * x * x); return x * sigmoidf_(2.0f * u); }
__device__ __forceinline__ float softplusf_(float x) { return x > 20.f ? x : log1pf(__expf(x)); }
__device__ __forceinline__ u32x4 pack8(const f32x4 a, const f32x4 b) { u32x4 w; w.x = cvt_pk_bf16(a[0], a[1]); w.y = cvt_pk_bf16(a[2], a[3]); w.z = cvt_pk_bf16(b[0], b[1]); w.w = cvt_pk_bf16(b[2], b[3]); return w; }
__device__ __forceinline__ void unpack8(const u32x4 w, f32x4& a, f32x4& b) { a[0] = bflo(w.x); a[1] = bfhi(w.x); a[2] = bflo(w.y); a[3] = bfhi(w.y); b[0] = bflo(w.z); b[1] = bfhi(w.z); b[2] = bflo(w.w); b[3] = bfhi(w.w); }
__device__ __forceinline__ float rowinv16(const float* ssq, int row) {
    const f32x4* p = (const f32x4*)(ssq + (size_t)row * 16); const f32x4 a = p[0], b = p[1], c = p[2], d = p[3];
    const float s = ((a[0] + a[1]) + (a[2] + a[3])) + ((b[0] + b[1]) + (b[2] + b[3])) + ((c[0] + c[1]) + (c[2] + c[3])) + ((d[0] + d[1]) + (d[2] + d[3]));
    return rsqrtf(s * (1.0f / 1024.0f) + EPS);
}

namespace pg8 {
constexpr int BM = 256, BK = 64, HALF = 128, HTB = HALF * BK * 2, STAGE_BYTES = 8 * HTB, NXCD = 8, WGM = 8;
__device__ __forceinline__ int lds_byte(int r, int c) { const int st = (r >> 4) * 2 + (c >> 5), rr = r & 15, cc = c & 31, ob = rr * 64 + cc * 2; return st * 1024 + (ob ^ (((ob >> 9) & 1) << 5)); }
__device__ __forceinline__ void stage_rc(int b, int& R, int& C) { const int st = b / 1024, sb = b % 1024, swz = sb ^ (((sb >> 9) & 1) << 5); R = (st >> 1) * 16 + swz / 64; C = (st & 1) * 32 + (swz % 64) / 2; }
__device__ __forceinline__ int perm32(int rho) { const int n = rho >> 4, i = rho & 15; return 8 * (i >> 2) + 4 * n + (i & 3); }
struct Unit { int pm, pn; };
struct Gemm { const bf16_t* A; int lda; const bf16_t* Bt; int ldb; int M, N, K; };
struct StaticOrder {
    int nM, nN, nwg, G, c;
    __device__ __forceinline__ void init(int M, int N, int G_, int c_) { nM = M / BM; nN = N / BM; nwg = nM * nN; G = G_; c = c_; }
    __device__ __forceinline__ bool next(int i, Unit& u) const {
        const long L = (long)i * G + c; if (L >= nwg) return false;
        int wgid = (int)L; { const int q = nwg / NXCD, r = nwg % NXCD, xcd = wgid % NXCD, off = wgid / NXCD; wgid = (xcd < r ? xcd * (q + 1) : r * (q + 1) + (xcd - r) * q) + off; }
        const int nig = WGM * nN, gid = wgid / nig, fm = gid * WGM, gsz = (nM - fm) < WGM ? (nM - fm) : WGM;
        u.pm = fm + ((wgid % nig) % gsz); u.pn = (wgid % nig) / gsz; return true;
    }
};
template <class Epi>
__device__ __forceinline__ void gemm_phase(LAS unsigned char* lds, const Gemm g, const StaticOrder& S, const Epi& E) {
    const int tid = otid(), wid = __builtin_amdgcn_readfirstlane(tid >> 6), lane = tid & 63, wr = wid >> 2, wc = wid & 3, fr = lane & 15, fq = lane >> 4;
    const int K = g.K, nt = K / BK;
    unsigned voffA[2], voffB[2];
#pragma unroll
    for (int i = 0; i < 2; ++i) { int R, C; stage_rc(tid * 16 + i * 8192, R, C); const int Rb = (R & ~31) + perm32(R & 31);
        voffA[i] = (unsigned)(R * g.lda + C) * 2u; voffB[i] = (unsigned)(Rb * g.ldb + C) * 2u; }
    const size_t kstep = (size_t)(BK * 2);
    const size_t hstepA = (size_t)HALF * g.lda * 2, hstepB = (size_t)HALF * g.ldb * 2;
    const size_t tstepA = 2 * hstepA, tstepB = 2 * hstepB;
    const unsigned ldsw = (unsigned)wid * 1024u;
    const int aoff = lds_byte(wr * 64 + fr, fq * 8), boff = lds_byte(wc * 32 + fr, fq * 8);
#define PG8_SA(b, h) (((b) * 2 + (h)) * HTB)
#define PG8_SB(b, h) ((4 + (b) * 2 + (h)) * HTB)
#define PG8_STAGE(bufoff, gbase, voff) do { _Pragma("unroll") for (int _i = 0; _i < 2; ++_i) \
        __builtin_amdgcn_global_load_lds((const unsigned*)((const char*)(gbase) + (voff)[_i]), (LAS unsigned*)(lds + (bufoff) + ldsw + _i * 8192), 16, 0, 0); } while (0)
#define PG8_LDA(dst, b, h) do { _Pragma("unroll") for (int m = 0; m < 4; ++m) _Pragma("unroll") for (int k = 0; k < 2; ++k) dst[m][k] = *(const LAS bf16x8*)(lds + PG8_SA(b, h) + aoff + m * 2048 + k * 1024); } while (0)
#define PG8_LDB(dst, b, h) do { _Pragma("unroll") for (int n = 0; n < 2; ++n) _Pragma("unroll") for (int k = 0; k < 2; ++k) dst[n][k] = *(const LAS bf16x8*)(lds + PG8_SB(b, h) + boff + n * 2048 + k * 1024); } while (0)
#define PG8_MMA(ai, bj, At, Bt) do { __builtin_amdgcn_s_setprio(1); _Pragma("unroll") for (int m = 0; m < 4; ++m) _Pragma("unroll") for (int n = 0; n < 2; ++n) _Pragma("unroll") for (int k = 0; k < 2; ++k) \
        acc[ai][bj][m][n] = __builtin_amdgcn_mfma_f32_16x16x32_bf16(Bt[n][k], At[m][k], acc[ai][bj][m][n], 0, 0, 0); __builtin_amdgcn_s_setprio(0); } while (0)
#define PG8_WAIT_V(n) asm volatile("s_waitcnt vmcnt(" #n ")" ::: "memory")
#define PG8_WAIT_L(n) asm volatile("s_waitcnt lgkmcnt(" #n ")" ::: "memory")
#define PG8_BAR __builtin_amdgcn_s_barrier()
#define PG8_SCHED __builtin_amdgcn_sched_barrier(0)
    Unit cur, nxt; int ui = 0;
    if (!S.next(0, cur)) return;
    f32x4 acc[2][2][4][2];
#pragma unroll
    for (int a = 0; a < 2; ++a)
#pragma unroll
        for (int b = 0; b < 2; ++b)
#pragma unroll
            for (int m = 0; m < 4; ++m)
#pragma unroll
                for (int n = 0; n < 2; ++n) acc[a][b][m][n] = (f32x4){0.f, 0.f, 0.f, 0.f};
    bf16x8 At[4][2], B0[2][2], B1[2][2];
    const char* cA = (const char*)g.A + (size_t)cur.pm * tstepA; const char* cB = (const char*)g.Bt + (size_t)cur.pn * tstepB;
    PG8_STAGE(PG8_SB(0, 0), cB, voffB); PG8_STAGE(PG8_SA(0, 0), cA, voffA); PG8_STAGE(PG8_SB(0, 1), cB + hstepB, voffB); PG8_STAGE(PG8_SA(0, 1), cA + hstepA, voffA);
    if (wr == 1) PG8_BAR;
    PG8_WAIT_V(4); PG8_BAR;
    PG8_STAGE(PG8_SB(1, 0), cB + kstep, voffB); PG8_STAGE(PG8_SA(1, 0), cA + kstep, voffA); PG8_STAGE(PG8_SB(1, 1), cB + hstepB + kstep, voffB);
    PG8_WAIT_V(6); PG8_BAR;
    for (;;) {
        const bool has_next = S.next(ui + 1, nxt);
        const char* nA = has_next ? (const char*)g.A + (size_t)nxt.pm * tstepA : cA; const char* nB = has_next ? (const char*)g.Bt + (size_t)nxt.pn * tstepB : cB;
        for (int t = 0; t < nt; t += 2) {
            const bool last = (t == nt - 2);
            const char* a1 = cA + (size_t)(t + 1) * kstep;
            const char* a2 = last ? nA : cA + (size_t)(t + 2) * kstep; const char* b2 = last ? nB : cB + (size_t)(t + 2) * kstep;
            const char* a3 = a2 + kstep; const char* b3 = b2 + kstep;
            PG8_LDB(B0, 0, 0); PG8_SCHED; PG8_LDA(At, 0, 0); PG8_STAGE(PG8_SA(1, 1), a1 + hstepA, voffA);
            PG8_WAIT_L(8); PG8_BAR; PG8_WAIT_L(0); PG8_MMA(0, 0, At, B0); PG8_BAR; PG8_SCHED;
            PG8_LDB(B1, 0, 1); PG8_STAGE(PG8_SB(0, 0), b2, voffB);
            PG8_BAR; PG8_WAIT_L(0); PG8_MMA(0, 1, At, B1); PG8_BAR;
            PG8_LDA(At, 0, 1); PG8_STAGE(PG8_SA(0, 0), a2, voffA);
            PG8_BAR; PG8_WAIT_L(0); PG8_MMA(1, 0, At, B0); PG8_BAR; PG8_SCHED;
            PG8_STAGE(PG8_SB(0, 1), b2 + hstepB, voffB);
            PG8_WAIT_V(6); PG8_BAR; PG8_MMA(1, 1, At, B1); PG8_BAR;
            PG8_LDB(B0, 1, 0); PG8_SCHED; PG8_LDA(At, 1, 0); PG8_STAGE(PG8_SA(0, 1), a2 + hstepA, voffA);
            PG8_WAIT_L(8); PG8_BAR; PG8_WAIT_L(0); PG8_MMA(0, 0, At, B0); PG8_BAR; PG8_SCHED;
            PG8_LDB(B1, 1, 1); PG8_STAGE(PG8_SB(1, 0), b3, voffB);
            PG8_BAR; PG8_WAIT_L(0); PG8_MMA(0, 1, At, B1); PG8_BAR;
            PG8_LDA(At, 1, 1); PG8_STAGE(PG8_SA(1, 0), a3, voffA);
            PG8_BAR; PG8_WAIT_L(0); PG8_MMA(1, 0, At, B0); PG8_BAR; PG8_SCHED;
            PG8_STAGE(PG8_SB(1, 1), b3 + hstepB, voffB);
            PG8_WAIT_V(6); PG8_BAR; PG8_MMA(1, 1, At, B1); PG8_BAR;
        }
        E(acc, cur, wr, wc, fr, fq);
        if (!has_next) break;
#pragma unroll
        for (int a = 0; a < 2; ++a)
#pragma unroll
            for (int b = 0; b < 2; ++b)
#pragma unroll
                for (int m = 0; m < 4; ++m)
#pragma unroll
                    for (int n = 0; n < 2; ++n) acc[a][b][m][n] = (f32x4){0.f, 0.f, 0.f, 0.f};
        cur = nxt; cA = nA; cB = nB; ++ui;
    }
    PG8_WAIT_V(0);
    if (wr == 0) PG8_BAR;
    PG8_BAR;
#undef PG8_SA
#undef PG8_SB
#undef PG8_STAGE
#undef PG8_LDA
#undef PG8_LDB
#undef PG8_MMA
#undef PG8_WAIT_V
#undef PG8_WAIT_L
#undef PG8_BAR
#undef PG8_SCHED
}
}
typedef f32x4 Acc[2][2][4][2];

struct EpiSwiglu {
    bf16_t* H; const float* ssq;
    __device__ __forceinline__ void operator()(const Acc& acc, const pg8::Unit& u, int wr, int wc, int fr, int fq) const {
        const int row0 = u.pm * 256 + wr * 64 + fr, col = u.pn * 128 + wc * 32 + 8 * fq;
#pragma unroll
        for (int ai = 0; ai < 2; ++ai)
#pragma unroll
            for (int m = 0; m < 4; ++m) {
                const int row = row0 + ai * 128 + m * 16; const float inv = ssq ? rowinv16(ssq, row) : 1.0f;
                f32x4 h0, h1;
#pragma unroll
                for (int j = 0; j < 4; ++j) { h0[j] = siluf_(acc[ai][0][m][0][j] * inv) * (acc[ai][1][m][0][j] * inv); h1[j] = siluf_(acc[ai][0][m][1][j] * inv) * (acc[ai][1][m][1][j] * inv); }
                *(u32x4*)(H + (size_t)row * FF + col) = pack8(h0, h1);
            }
    }
};
struct EpiResid {
    const float* xin; float* xout; bf16_t* xb; float* ssq; float alpha;
    __device__ __forceinline__ void operator()(const Acc& acc, const pg8::Unit& u, int wr, int wc, int fr, int fq) const {
        const int row0 = u.pm * 256 + wr * 64 + fr, col0 = u.pn * 256 + wc * 32 + 8 * fq;
#pragma unroll
        for (int ai = 0; ai < 2; ++ai)
#pragma unroll
            for (int m = 0; m < 4; ++m) {
                const int row = row0 + ai * 128 + m * 16; float ss = 0.f;
#pragma unroll
                for (int bj = 0; bj < 2; ++bj) {
                    const size_t o = (size_t)row * D + col0 + bj * 128;
                    f32x4 v0 = *(const f32x4*)(xin + o) + alpha * acc[ai][bj][m][0], v1 = *(const f32x4*)(xin + o + 4) + alpha * acc[ai][bj][m][1];
                    *(f32x4*)(xout + o) = v0; *(f32x4*)(xout + o + 4) = v1;
                    ss += (v0[0] * v0[0] + v0[1] * v0[1]) + (v0[2] * v0[2] + v0[3] * v0[3]) + (v1[0] * v1[0] + v1[1] * v1[1]) + (v1[2] * v1[2] + v1[3] * v1[3]);
                    if (xb) *(u32x4*)(xb + o) = pack8(v0, v1);
                }
                ss += __shfl_xor(ss, 16); ss += __shfl_xor(ss, 32);
                if (fq == 0) ssq[(size_t)row * 16 + u.pn * 4 + wc] = ss;
            }
    }
};
struct EpiScaleBf16 {
    bf16_t* O; const float* ssq;
    __device__ __forceinline__ void operator()(const Acc& acc, const pg8::Unit& u, int wr, int wc, int fr, int fq) const {
        const int row0 = u.pm * 256 + wr * 64 + fr, col0 = u.pn * 256 + wc * 32 + 8 * fq;
#pragma unroll
        for (int ai = 0; ai < 2; ++ai)
#pragma unroll
            for (int m = 0; m < 4; ++m) {
                const int row = row0 + ai * 128 + m * 16; const float inv = rowinv16(ssq, row);
#pragma unroll
                for (int bj = 0; bj < 2; ++bj) *(u32x4*)(O + (size_t)row * NPP + col0 + bj * 128) = pack8(acc[ai][bj][m][0] * inv, acc[ai][bj][m][1] * inv);
            }
    }
};
struct EpiGatesA {
    bf16_t* PP; const float* ssq; float* gssq;
    __device__ __forceinline__ void operator()(const Acc& acc, const pg8::Unit& u, int wr, int wc, int fr, int fq) const {
        const int row0 = u.pm * 256 + wr * 64 + fr, cw = wc * 32 + 8 * fq; const int pn = u.pn;
#pragma unroll
        for (int ai = 0; ai < 2; ++ai)
#pragma unroll
            for (int m = 0; m < 4; ++m) {
                const int row = row0 + ai * 128 + m * 16; const float inv = rowinv16(ssq, row); float ss = 0.f;
#pragma unroll
                for (int bj = 0; bj < 2; ++bj) {
                    const f32x4 a0 = acc[ai][bj][m][0] * inv, a1 = acc[ai][bj][m][1] * inv; f32x4 o0, o1;
                    bf16_t* p = PP + (size_t)row * NPP + pn * 256 + bj * 128 + cw; f32x4 s0, s1; unpack8(*(const u32x4*)p, s0, s1);
                    if (pn < 4) {
#pragma unroll
                        for (int j = 0; j < 4; ++j) { o0[j] = gelu_tanh(a0[j]) * s0[j]; o1[j] = gelu_tanh(a1[j]) * s1[j]; }
                    } else {
#pragma unroll
                        for (int j = 0; j < 4; ++j) { o0[j] = siluf_(a0[j]) * s0[j]; o1[j] = siluf_(a1[j]) * s1[j]; ss += o0[j] * o0[j] + o1[j] * o1[j]; }
                    }
                    *(u32x4*)p = pack8(o0, o1);
                }
                if (pn >= 4) { ss += __shfl_xor(ss, 16); ss += __shfl_xor(ss, 32); if (fq == 0) gssq[(size_t)row * 32 + (pn - 4) * 4 + wc] = ss; }
            }
    }
};
struct EpiSigmoid {
    bf16_t* O; int ldo; const float* ssq; const float* bias;
    __device__ __forceinline__ void operator()(const Acc& acc, const pg8::Unit& u, int wr, int wc, int fr, int fq) const {
        const int row0 = u.pm * 256 + wr * 64 + fr, col0 = u.pn * 256 + wc * 32 + 8 * fq;
#pragma unroll
        for (int ai = 0; ai < 2; ++ai)
#pragma unroll
            for (int m = 0; m < 4; ++m) {
                const int row = row0 + ai * 128 + m * 16; const float inv = rowinv16(ssq, row);
#pragma unroll
                for (int bj = 0; bj < 2; ++bj) {
                    const int gc = col0 + bj * 128;
                    const f32x4 a0 = acc[ai][bj][m][0] * inv, a1 = acc[ai][bj][m][1] * inv; f32x4 o0, o1;
                    const f32x4 b0 = *(const f32x4*)(bias + gc), b1 = *(const f32x4*)(bias + gc + 4);
#pragma unroll
                    for (int j = 0; j < 4; ++j) { o0[j] = sigmoidf_(a0[j] + b0[j]); o1[j] = sigmoidf_(a1[j] + b1[j]); }
                    *(u32x4*)(O + (size_t)row * ldo + gc) = pack8(o0, o1);
                }
            }
    }
};
struct EpiBr {
    bf16_t* GA; const bf16_t* PP; int mode;
    __device__ __forceinline__ void operator()(const Acc& acc, const pg8::Unit& u, int wr, int wc, int fr, int fq) const {
        const int row0 = u.pm * 256 + wr * 64 + fr, col0 = u.pn * 256 + wc * 32 + 8 * fq;
#pragma unroll
        for (int ai = 0; ai < 2; ++ai)
#pragma unroll
            for (int m = 0; m < 4; ++m) {
                const int row = row0 + ai * 128 + m * 16;
#pragma unroll
                for (int bj = 0; bj < 2; ++bj) {
                    bf16_t* p = GA + (size_t)row * D + col0 + bj * 128; f32x4 g0, g1; unpack8(*(const u32x4*)p, g0, g1);
                    if (mode == 0) { *(u32x4*)p = pack8(g0 * acc[ai][bj][m][0], g1 * acc[ai][bj][m][1]); }
                    else { f32x4 h0, h1; unpack8(*(const u32x4*)(PP + (size_t)row * NPP + 3072 + col0 + bj * 128), h0, h1);
                        *(u32x4*)p = pack8(g0 + h0 * acc[ai][bj][m][0], g1 + h1 * acc[ai][bj][m][1]); }
                }
            }
    }
};

template <int NC, int NB, class RM, class F>
__device__ __forceinline__ void small_gemm(LAS unsigned char* lds, const bf16_t* A, int lda, int M, const bf16_t* Bt, int ldb, int K, int N,
                                           const float* rs_src, int rs_mode, RM rm, F f) {
    const int tid = otid(), wid = tid >> 6, lane = tid & 63, lr = lane & 15, kg = lane >> 4;
    LAS float* red = (LAS float*)lds;
    LAS float* invs = (LAS float*)(lds + 131072);
    const int nct = N / NC, items = (M / 16) * nct, kw = K / 8;
    constexpr int CT = NC / 16;
    for (int it = blockIdx.x; it < items; it += gridDim.x) {
        const int rt = it / nct, ct = it % nct, row0 = rt * 16, col0 = ct * NC;
        if (rs_mode == 1) { const int r = tid >> 5, q = tid & 31; const float* p = rs_src + (size_t)(row0 + r) * D + q * 32; float s = 0.f;
            for (int j = 0; j < 32; j += 4) { const f32x4 v = *(const f32x4*)(p + j); s += v[0] * v[0] + v[1] * v[1] + v[2] * v[2] + v[3] * v[3]; }
            s += __shfl_xor(s, 1); s += __shfl_xor(s, 2); s += __shfl_xor(s, 4); s += __shfl_xor(s, 8); s += __shfl_xor(s, 16);
            if (q == 0) invs[r] = rsqrtf(s * (1.0f / 1024.0f) + EPS); }
        else if (rs_mode == 2) { if (tid < 16) invs[tid] = rowinv16(rs_src, row0 + tid); }
        else { if (tid < 16) invs[tid] = 1.0f; }
        f32x4 acc[NB][CT];
#pragma unroll
        for (int p = 0; p < NB; ++p)
#pragma unroll
            for (int c = 0; c < CT; ++c) acc[p][c] = (f32x4){0.f, 0.f, 0.f, 0.f};
        const bf16_t* ap = A + (size_t)(row0 + lr) * lda + wid * kw + 8 * kg;
        const bf16_t* bp0 = Bt + (size_t)(rm(col0, 0) + lr) * ldb + wid * kw + 8 * kg;
        const bf16_t* bp1 = NB > 1 ? Bt + (size_t)(rm(col0, 1) + lr) * ldb + wid * kw + 8 * kg : bp0;
        for (int k = 0; k < kw; k += 32) {
            const bf16x8 a = *(const bf16x8*)(ap + k);
#pragma unroll
            for (int c = 0; c < CT; ++c) {
                const bf16x8 b = *(const bf16x8*)(bp0 + (size_t)c * 16 * ldb + k);
                acc[0][c] = __builtin_amdgcn_mfma_f32_16x16x32_bf16(a, b, acc[0][c], 0, 0, 0);
                if (NB > 1) { const bf16x8 b1 = *(const bf16x8*)(bp1 + (size_t)c * 16 * ldb + k); acc[NB - 1][c] = __builtin_amdgcn_mfma_f32_16x16x32_bf16(a, b1, acc[NB - 1][c], 0, 0, 0); }
            }
        }
#pragma unroll
        for (int p = 0; p < NB; ++p)
#pragma unroll
            for (int c = 0; c < CT; ++c)
#pragma unroll
                for (int r = 0; r < 4; ++r) red[((wid * NB + p) * 16 + 4 * kg + r) * NC + 16 * c + lr] = acc[p][c][r];
        __syncthreads();
        for (int e = tid; e < 16 * NC; e += 512) {
            float v0 = 0.f, v1 = 0.f;
#pragma unroll
            for (int w = 0; w < 8; ++w) { v0 += red[(w * NB) * 16 * NC + e]; if (NB > 1) v1 += red[(w * NB + 1) * 16 * NC + e]; }
            const int r = e / NC, c = e % NC;
            f(row0 + r, col0 + c, v0, v1, invs[r]);
        }
        __syncthreads();
    }
}

struct Ctx { const float* const* in; float* out; unsigned char* ws; LAS unsigned char* lds; };

__device__ __forceinline__ void tp_tile(LAS float* tile, const float* src, int sld, int sc0, int k0, bf16_t* dst, int dld, int dr0, int dk0, const float* scale, int ncv) {
    const int tid = otid();
#pragma unroll
    for (int i = 0; i < 8; ++i) { const int e = tid + 512 * i, kk = e >> 6, cc = e & 63; float v = 0.f;
        if (cc < ncv) { v = src[(size_t)(k0 + kk) * sld + sc0 + cc]; if (scale) v *= scale[k0 + kk]; }
        tile[kk * 65 + cc] = v; }
    __syncthreads();
#pragma unroll
    for (int i = 0; i < 8; ++i) { const int e = tid + 512 * i, cc = e >> 6, kk = e & 63;
        if (cc < ncv) dst[(size_t)(dr0 + cc) * dld + dk0 + kk] = f2bf(tile[kk * 65 + cc]); }
    __syncthreads();
}
__device__ __forceinline__ void prep_weights(const Ctx& c) {
    LAS float* tile = (LAS float*)c.lds; unsigned char* ws = c.ws;
    constexpr int N_UP = 1408, N_DN = 704, N_IN = 2304, N_DT = 16, N_BRL = 256, N_BRS = 512, N_OUT = 256, N_RG = 32;
    constexpr int TOT = 2 * N_UP + 2 * N_DN + N_IN + N_DT + N_BRL + N_BRS + N_OUT + 2 * N_RG;
    for (int ti0 = blockIdx.x; ti0 < TOT; ti0 += gridDim.x) {
        int ti = ti0;
        if (ti < 2 * N_UP) { const int l = ti >= N_UP; if (l) ti -= N_UP;
            const int j = ti >> 5, r = ti & 31, pn = j >> 1, panel = j & 1, ct = r >> 4, kt = r & 15;
            tp_tile(tile, c.in[l ? 29 : 7], 2 * FF, panel * FF + 128 * pn + 64 * ct, 64 * kt, (bf16_t*)(ws + (l ? OFF_WUP2 : OFF_WUP1)), D, 256 * pn + 128 * panel + 64 * ct, 64 * kt, l ? c.in[28] : nullptr, 64);
            continue; }
        ti -= 2 * N_UP;
        if (ti < 2 * N_DN) { const int l = ti >= N_DN; if (l) ti -= N_DN;
            const int nt = ti / 44, kt = ti % 44;
            tp_tile(tile, c.in[l ? 30 : 8], D, 64 * nt, 64 * kt, (bf16_t*)(ws + (l ? OFF_WDN2 : OFF_WDN1)), FF, 64 * nt, 64 * kt, nullptr, 64);
            continue; }
        ti -= 2 * N_DN;
        if (ti < N_IN) { const int nt = ti >> 4, kt = ti & 15, n0 = 64 * nt;
            const int sc = n0 < 1024 ? n0 : (n0 < 4096 ? n0 + 3072 : (n0 < 7168 ? n0 - 3072 : n0 + 32));
            tp_tile(tile, c.in[10], 9248, sc, 64 * kt, (bf16_t*)(ws + OFF_WIN), D, n0, 64 * kt, c.in[9], 64);
            continue; }
        ti -= N_IN;
        if (ti < N_DT) { tp_tile(tile, c.in[10], 9248, 7168, 64 * ti, (bf16_t*)(ws + OFF_WDT), D, 0, 64 * ti, c.in[9], 32); continue; }
        ti -= N_DT;
        if (ti < N_BRL) { const int nt = ti >> 4, kt = ti & 15; tp_tile(tile, c.in[25], D, 64 * nt, 64 * kt, (bf16_t*)(ws + OFF_WBR), 3072, 64 * nt, 64 * kt, nullptr, 64); continue; }
        ti -= N_BRL;
        if (ti < N_BRS) { const int nt = ti >> 5, kt = ti & 31; tp_tile(tile, c.in[26], D, 64 * nt, 64 * kt, (bf16_t*)(ws + OFF_WBR), 3072, 64 * nt, 1024 + 64 * kt, c.in[24], 64); continue; }
        ti -= N_BRS;
        if (ti < N_OUT) { const int nt = ti >> 4, kt = ti & 15; tp_tile(tile, c.in[27], D, 64 * nt, 64 * kt, (bf16_t*)(ws + OFF_WOUT), D, 64 * nt, 64 * kt, nullptr, 64); continue; }
        ti -= N_OUT;
        { const int l = ti >= N_RG; if (l) ti -= N_RG; const int h = ti >> 2, nt = (ti >> 1) & 1, kt = ti & 1;
          tp_tile(tile, c.in[l ? 16 : 14] + h * 16384, 128, 64 * nt, 64 * kt, (bf16_t*)(ws + (l ? OFF_WIG : OFF_WRG)) + h * 16384, 128, 64 * nt, 64 * kt, nullptr, 64); }
    }
}
__device__ __forceinline__ void rmsnorm_rows_bf16(const float* x, int nrows, const float* g, bf16_t* dst) {
    const int t_ = otid(), lane = t_ & 63, gw = blockIdx.x * 8 + (t_ >> 6), nw = gridDim.x * 8;
    for (int r = gw; r < nrows; r += nw) {
        const float* p = x + (size_t)r * D; f32x4 v[4]; float s = 0.f;
#pragma unroll
        for (int i = 0; i < 4; ++i) { v[i] = *(const f32x4*)(p + (i * 64 + lane) * 4); s += v[i][0] * v[i][0] + v[i][1] * v[i][1] + v[i][2] * v[i][2] + v[i][3] * v[i][3]; }
#pragma unroll
        for (int o = 1; o < 64; o <<= 1) s += __shfl_xor(s, o);
        const float inv = rsqrtf(s * (1.0f / 1024.0f) + EPS);
#pragma unroll
        for (int i = 0; i < 4; ++i) { const int cc = (i * 64 + lane) * 4; const f32x4 gg = *(const f32x4*)(g + cc); const f32x4 o = v[i] * inv * gg;
            unsigned* q = (unsigned*)(dst + (size_t)r * D + cc); q[0] = cvt_pk_bf16(o[0], o[1]); q[1] = cvt_pk_bf16(o[2], o[3]); }
    }
}
__device__ __forceinline__ void rmsnorm_rows_f32(float* x, int nrows, const float* g) {
    const int t_ = otid(), lane = t_ & 63, gw = blockIdx.x * 8 + (t_ >> 6), nw = gridDim.x * 8;
    for (int r = gw; r < nrows; r += nw) {
        float* p = x + (size_t)r * D; f32x4 v[4]; float s = 0.f;
#pragma unroll
        for (int i = 0; i < 4; ++i) { v[i] = *(const f32x4*)(p + (i * 64 + lane) * 4); s += v[i][0] * v[i][0] + v[i][1] * v[i][1] + v[i][2] * v[i][2] + v[i][3] * v[i][3]; }
#pragma unroll
        for (int o = 1; o < 64; o <<= 1) s += __shfl_xor(s, o);
        const float inv = rsqrtf(s * (1.0f / 1024.0f) + EPS);
#pragma unroll
        for (int i = 0; i < 4; ++i) { const int cc = (i * 64 + lane) * 4; const f32x4 gg = *(const f32x4*)(g + cc); *(f32x4*)(p + cc) = v[i] * inv * gg; }
    }
}

template <bool FINAL>
__device__ __forceinline__ void lru_chunk(const Ctx& c, int b, int ch) {
    const int tid = otid(), wid = tid >> 6, lane = tid & 63, lr = lane & 15, kg = lane >> 4;
    LAS float* XC = (LAS float*)c.lds; LAS float* AA = (LAS float*)(c.lds + 32768); LAS float* UU = (LAS float*)(c.lds + 65536); LAS unsigned char* XCb = c.lds + 98304;
    bf16_t* PP = (bf16_t*)(c.ws + OFF_PP); bf16_t* HALO = (bf16_t*)(c.ws + OFF_HALO); float* SUMM = (float*)(c.ws + OFF_SUMM);
    const bf16_t* WRG = (const bf16_t*)(c.ws + OFF_WRG); const bf16_t* WIG = (const bf16_t*)(c.ws + OFF_WIG);
    const float* cw = c.in[12]; const float* cb = c.in[13]; const float* brg = c.in[15]; const float* big = c.in[17]; const float* lam = c.in[18];
    const int t0 = b * SEQ + 64 * ch;
    for (int head = 0; head < 8; ++head) {
        const int ch0 = 128 * head;
        if (!FINAL) { if (tid < 48) { const int row = tid >> 4, cg8 = tid & 15;
            *(u32x4*)(HALO + ((size_t)((b * NCH + ch) * 3 + row)) * D + ch0 + 8 * cg8) = *(const u32x4*)(PP + (size_t)(t0 + 61 + row) * NPP + ch0 + 8 * cg8); } }
        {
            const int cg8 = tid & 15, tk = (tid >> 4) * 2, cc0 = ch0 + 8 * cg8;
            f32x4 raw[5][2];
#pragma unroll
            for (int i = 0; i < 5; ++i) { const int tt = tk - 3 + i; u32x4 w = (u32x4){0u, 0u, 0u, 0u};
                if (tt >= 0) w = *(const u32x4*)(PP + (size_t)(t0 + tt) * NPP + cc0);
                else if (ch > 0) { if (FINAL) w = *(const u32x4*)(HALO + ((size_t)((b * NCH + ch - 1) * 3 + (tt + 3))) * D + cc0); else w = *(const u32x4*)(PP + (size_t)(t0 + tt) * NPP + cc0); }
                unpack8(w, raw[i][0], raw[i][1]); }
            f32x4 wk[4][2], bb[2];
#pragma unroll
            for (int k = 0; k < 4; ++k) { wk[k][0] = *(const f32x4*)(cw + k * D + cc0); wk[k][1] = *(const f32x4*)(cw + k * D + cc0 + 4); }
            bb[0] = *(const f32x4*)(cb + cc0); bb[1] = *(const f32x4*)(cb + cc0 + 4);
#pragma unroll
            for (int q = 0; q < 2; ++q) { f32x4 o0 = bb[0], o1 = bb[1];
#pragma unroll
                for (int k = 0; k < 4; ++k) { o0 += wk[k][0] * raw[q + k][0]; o1 += wk[k][1] * raw[q + k][1]; }
                *(LAS f32x4*)(XC + (tk + q) * 128 + 8 * cg8) = o0; *(LAS f32x4*)(XC + (tk + q) * 128 + 8 * cg8 + 4) = o1;
                *(LAS u32x4*)(XCb + (tk + q) * 272 + 16 * cg8) = pack8(o0, o1); }
        }
        __syncthreads();
        {
            f32x4 ar[4], ai_[4];
#pragma unroll
            for (int m = 0; m < 4; ++m) { ar[m] = (f32x4){0.f, 0.f, 0.f, 0.f}; ai_[m] = (f32x4){0.f, 0.f, 0.f, 0.f}; }
            const bf16_t* wr_ = WRG + (size_t)(ch0 + 16 * wid + lr) * 128 + 8 * kg; const bf16_t* wi_ = WIG + (size_t)(ch0 + 16 * wid + lr) * 128 + 8 * kg;
#pragma unroll
            for (int ks = 0; ks < 4; ++ks) { const bf16x8 br = *(const bf16x8*)(wr_ + 32 * ks), bi = *(const bf16x8*)(wi_ + 32 * ks);
#pragma unroll
                for (int m = 0; m < 4; ++m) { const bf16x8 a = *(const LAS bf16x8*)(XCb + (16 * m + lr) * 272 + (32 * ks + 8 * kg) * 2);
                    ar[m] = __builtin_amdgcn_mfma_f32_16x16x32_bf16(a, br, ar[m], 0, 0, 0); ai_[m] = __builtin_amdgcn_mfma_f32_16x16x32_bf16(a, bi, ai_[m], 0, 0, 0); } }
            const int cl = 16 * wid + lr, cgl = ch0 + cl; const float b1 = brg[cgl], b2 = big[cgl], sp = softplusf_(-lam[cgl]);
#pragma unroll
            for (int m = 0; m < 4; ++m)
#pragma unroll
                for (int r = 0; r < 4; ++r) { const int tk = 16 * m + 4 * kg + r; const float rg = sigmoidf_(ar[m][r] + b1), ig = sigmoidf_(ai_[m][r] + b2);
                    const float la = -8.0f * rg * sp; const float a = __expf(la); const float u = sqrtf(-expm1f(2.0f * la)) * ig * XC[tk * 128 + cl];
                    AA[tk * 128 + cl] = a; UU[tk * 128 + cl] = u; }
        }
        __syncthreads();
        if (tid < 128) { const int cgl = ch0 + tid;
            if (!FINAL) { float A = 1.f, H = 0.f; for (int tk = 0; tk < 64; ++tk) { const float a = AA[tk * 128 + tid], u = UU[tk * 128 + tid]; H = a * H + u; A *= a; }
                float* s = SUMM + ((size_t)(b * NCH + ch) * D + cgl) * 2; s[0] = A; s[1] = H; }
            else { float h = 0.f; for (int cp = 0; cp < ch; ++cp) { const float* s = SUMM + ((size_t)(b * NCH + cp) * D + cgl) * 2; h = s[0] * h + s[1]; }
                for (int tk = 0; tk < 64; ++tk) { h = AA[tk * 128 + tid] * h + UU[tk * 128 + tid]; UU[tk * 128 + tid] = h; }
                if (ch == NCH - 1) c.out[O_LHP + b * D + cgl] = h; } }
        __syncthreads();
        if (FINAL) { const int cg8 = tid & 15, tk = (tid >> 4) * 2;
#pragma unroll
            for (int q = 0; q < 2; ++q) { const f32x4 o0 = *(const LAS f32x4*)(UU + (tk + q) * 128 + 8 * cg8), o1 = *(const LAS f32x4*)(UU + (tk + q) * 128 + 8 * cg8 + 4);
                *(u32x4*)(PP + (size_t)(t0 + tk + q) * NPP + ch0 + 8 * cg8) = pack8(o0, o1); }
            __syncthreads(); }
    }
}

__device__ __forceinline__ void ssd_seq(const Ctx& c, int b, int h) {
    const int tid = otid(), wid = tid >> 6, lane = tid & 63, lr = lane & 15, kg = lane >> 4;
    LAS unsigned char* L = c.lds;
    LAS unsigned char* Cm = L; LAS unsigned char* Bm = L + 17408; LAS unsigned char* BT = L + 34816; LAS unsigned char* Sb = L + 53248;
    LAS unsigned char* XdT = L + 70656; LAS unsigned char* XdTd = L + 79872; LAS unsigned char* Xr = L + 89088; LAS unsigned char* Mm = L + 98304;
    LAS float* dts = (LAS float*)(L + 107520); LAS float* css = (LAS float*)(L + 107776); LAS bf16_t* halo = (LAS bf16_t*)(L + 108032);
    bf16_t* PP = (bf16_t*)(c.ws + OFF_PP); const float* DT = (const float*)(c.ws + OFF_DT);
    const float* cw = c.in[19]; const float* cb = c.in[20];
    const int g = h >> 3;
    const float Ah = -__expf(c.in[22][h]), Dh = c.in[23][h], dtb = c.in[21][h];
    f32x4 accS[4];
#pragma unroll
    for (int m = 0; m < 4; ++m) accS[m] = (f32x4){0.f, 0.f, 0.f, 0.f};
    for (int e = tid; e < 64 * 136; e += 512) ((LAS bf16_t*)Sb)[e] = 0;
    for (int ch = 0; ch < NCH; ++ch) {
        const int t0 = b * SEQ + 64 * ch;
        if (wid == 0) {
            const float d = softplusf_(DT[(size_t)(t0 + lane) * 32 + h] + dtb); float s = d * Ah;
#pragma unroll
            for (int o = 1; o < 64; o <<= 1) { const float v = __shfl_up(s, o); if (lane >= o) s += v; }
            dts[lane] = d; css[lane] = s;
        }
        __syncthreads();
#pragma unroll 1
        for (int item = tid; item < 640; item += 512) {
            const int cgp = item % 40, st = item / 40;
            int gcol, ccol;
            if (cgp < 8) { gcol = 1024 + 64 * h + 8 * cgp; ccol = 64 * h + 8 * cgp; }
            else if (cgp < 24) { gcol = 3072 + 128 * g + 8 * (cgp - 8); ccol = 2048 + 128 * g + 8 * (cgp - 8); }
            else { gcol = 3584 + 128 * g + 8 * (cgp - 24); ccol = 2560 + 128 * g + 8 * (cgp - 24); }
            f32x4 raw[7][2];
#pragma unroll
            for (int i = 0; i < 7; ++i) { const int tt = 4 * st - 3 + i; u32x4 w = (u32x4){0u, 0u, 0u, 0u};
                if (tt >= 0) w = *(const u32x4*)(PP + (size_t)(t0 + tt) * NPP + gcol);
                else if (ch > 0) { if (cgp < 8) w = *(const LAS u32x4*)(halo + (tt + 3) * 64 + 8 * cgp); else w = *(const u32x4*)(PP + (size_t)(t0 + tt) * NPP + gcol); }
                unpack8(w, raw[i][0], raw[i][1]); }
            if (ch == NCH - 1 && cgp < 8 && st == 15) {
#pragma unroll
                for (int r = 0; r < 3; ++r) { float* o = c.out + O_SCP + (size_t)(b * 3 + r) * 3072 + ccol; *(f32x4*)o = raw[4 + r][0]; *(f32x4*)(o + 4) = raw[4 + r][1]; } }
            const float cse = css[63];
#pragma unroll
            for (int q = 0; q < 4; ++q) { f32x4 o0 = *(const f32x4*)(cb + ccol), o1 = *(const f32x4*)(cb + ccol + 4);
#pragma unroll
                for (int k = 0; k < 4; ++k) { o0 += *(const f32x4*)(cw + k * 3072 + ccol) * raw[q + k][0]; o1 += *(const f32x4*)(cw + k * 3072 + ccol + 4) * raw[q + k][1]; }
#pragma unroll
                for (int j = 0; j < 4; ++j) { o0[j] = siluf_(o0[j]); o1[j] = siluf_(o1[j]); }
                const int l = 4 * st + q;
                if (cgp < 8) { const float d = dts[l], dd = d * __expf(cse - css[l]);
                    *(LAS u32x4*)(Xr + l * 144 + 16 * cgp) = pack8(o0, o1);
#pragma unroll
                    for (int j = 0; j < 4; ++j) { const int p0 = 8 * cgp + j, p1 = p0 + 4;
                        *(LAS bf16_t*)(XdT + p0 * 144 + 2 * l) = f2bf(o0[j] * d); *(LAS bf16_t*)(XdT + p1 * 144 + 2 * l) = f2bf(o1[j] * d);
                        *(LAS bf16_t*)(XdTd + p0 * 144 + 2 * l) = f2bf(o0[j] * dd); *(LAS bf16_t*)(XdTd + p1 * 144 + 2 * l) = f2bf(o1[j] * dd); } }
                else if (cgp < 24) { const int n0 = 8 * (cgp - 8);
                    *(LAS u32x4*)(Bm + l * 272 + 2 * n0) = pack8(o0, o1);
#pragma unroll
                    for (int j = 0; j < 4; ++j) { *(LAS bf16_t*)(BT + (n0 + j) * 144 + 2 * l) = f2bf(o0[j]); *(LAS bf16_t*)(BT + (n0 + 4 + j) * 144 + 2 * l) = f2bf(o1[j]); } }
                else { const int n0 = 8 * (cgp - 24); *(LAS u32x4*)(Cm + l * 272 + 2 * n0) = pack8(o0, o1); }
            }
        }
        __syncthreads();
        if (tid < 24) { const int r = tid >> 3, q = tid & 7; *(LAS u32x4*)(halo + r * 64 + 8 * q) = *(const u32x4*)(PP + (size_t)(t0 + 61 + r) * NPP + 1024 + 64 * h + 8 * q); }
#pragma unroll
        for (int q = 0; q < 2; ++q) { const int ti = 2 * wid + q, mt = ti >> 2, nt = ti & 3; f32x4 a4 = (f32x4){0.f, 0.f, 0.f, 0.f};
            if (nt <= mt) {
#pragma unroll
                for (int ks = 0; ks < 4; ++ks) { const bf16x8 a = *(const LAS bf16x8*)(Cm + (16 * mt + lr) * 272 + (32 * ks + 8 * kg) * 2), bq = *(const LAS bf16x8*)(Bm + (16 * nt + lr) * 272 + (32 * ks + 8 * kg) * 2);
                    a4 = __builtin_amdgcn_mfma_f32_16x16x32_bf16(a, bq, a4, 0, 0, 0); } }
            const int s = 16 * nt + lr; const float css_s = css[s];
#pragma unroll
            for (int r = 0; r < 4; ++r) { const int l = 16 * mt + 4 * kg + r; const float v = (s <= l) ? a4[r] * __expf(css[l] - css_s) : 0.f; *(LAS bf16_t*)(Mm + l * 144 + 2 * s) = f2bf(v); } }
        __syncthreads();
#pragma unroll
        for (int q = 0; q < 2; ++q) { const int ti = 2 * wid + q, mt = ti >> 2, nt = ti & 3; f32x4 a4 = (f32x4){0.f, 0.f, 0.f, 0.f};
#pragma unroll
            for (int ks = 0; ks < 4; ++ks) { const bf16x8 a = *(const LAS bf16x8*)(Cm + (16 * mt + lr) * 272 + (32 * ks + 8 * kg) * 2), bq = *(const LAS bf16x8*)(Sb + (16 * nt + lr) * 272 + (32 * ks + 8 * kg) * 2);
                a4 = __builtin_amdgcn_mfma_f32_16x16x32_bf16(a, bq, a4, 0, 0, 0); }
#pragma unroll
            for (int r = 0; r < 4; ++r) a4[r] *= __expf(css[16 * mt + 4 * kg + r]);
#pragma unroll
            for (int ks = 0; ks < 2; ++ks) { const bf16x8 a = *(const LAS bf16x8*)(Mm + (16 * mt + lr) * 144 + (32 * ks + 8 * kg) * 2), bq = *(const LAS bf16x8*)(XdT + (16 * nt + lr) * 144 + (32 * ks + 8 * kg) * 2);
                a4 = __builtin_amdgcn_mfma_f32_16x16x32_bf16(a, bq, a4, 0, 0, 0); }
            const int p = 16 * nt + lr;
#pragma unroll
            for (int r = 0; r < 4; ++r) { const int l = 16 * mt + 4 * kg + r; const float y = a4[r] + Dh * bf2f(*(const LAS bf16_t*)(Xr + l * 144 + 2 * p));
                PP[(size_t)(t0 + l) * NPP + 1024 + 64 * h + p] = f2bf(y); } }
        { const float ce = __expf(css[63]);
#pragma unroll
          for (int m = 0; m < 4; ++m) { accS[m] *= ce;
#pragma unroll
            for (int ks = 0; ks < 2; ++ks) { const bf16x8 a = *(const LAS bf16x8*)(XdTd + (16 * m + lr) * 144 + (32 * ks + 8 * kg) * 2), bq = *(const LAS bf16x8*)(BT + (16 * wid + lr) * 144 + (32 * ks + 8 * kg) * 2);
                accS[m] = __builtin_amdgcn_mfma_f32_16x16x32_bf16(a, bq, accS[m], 0, 0, 0); } } }
        __syncthreads();
#pragma unroll
        for (int m = 0; m < 4; ++m)
#pragma unroll
            for (int r = 0; r < 4; ++r) *(LAS bf16_t*)(Sb + (16 * m + 4 * kg + r) * 272 + 2 * (16 * wid + lr)) = f2bf(accS[m][r]);
    }
#pragma unroll
    for (int m = 0; m < 4; ++m)
#pragma unroll
        for (int r = 0; r < 4; ++r) c.out[O_SHP + ((size_t)(b * 32 + h) * 64 + 16 * m + 4 * kg + r) * 128 + 16 * wid + lr] = accS[m][r];
    __syncthreads();
}

__device__ __forceinline__ void lru_sample(const Ctx& c, int b, int head) {
    const int tid = otid(); LAS float* XC = (LAS float*)c.lds; LAS float* RG = XC + 2048; LAS float* IG = RG + 2048;
    const float* PS = (const float*)(c.ws + OFF_PS); bf16_t* ABRS = (bf16_t*)(c.ws + OFF_ABRS);
    const float* cw = c.in[12]; const float* cb = c.in[13]; const int ch0 = 128 * head;
    for (int e = tid; e < 2048; e += 512) { const int tk = e >> 7, cl = e & 127, cgl = ch0 + cl; float o = cb[cgl];
#pragma unroll
        for (int k = 0; k < 4; ++k) { const int tt = tk - 3 + k; const float v = tt >= 0 ? PS[(size_t)(b * 16 + tt) * 9216 + cgl] : SZ(c.in[2][(size_t)(b * 3 + tt + 3) * D + cgl]); o += cw[k * D + cgl] * v; }
        XC[e] = o; }
    if (tid < 384) { const int r = tid >> 7, cl = tid & 127; c.out[O_LCS + (size_t)(b * 3 + r) * D + ch0 + cl] = PS[(size_t)(b * 16 + 13 + r) * 9216 + ch0 + cl]; }
    __syncthreads();
    { const int j = tid & 255, tg = tid >> 8; const bool isi = j >= 128; const int jj = j & 127; const float* W = (isi ? c.in[16] : c.in[14]) + (size_t)head * 16384 + jj; float acc[8];
#pragma unroll
      for (int q = 0; q < 8; ++q) acc[q] = 0.f;
      for (int i = 0; i < 128; ++i) { const float w = W[i * 128];
#pragma unroll
          for (int q = 0; q < 8; ++q) acc[q] += XC[(8 * tg + q) * 128 + i] * w; }
      const float bias = (isi ? c.in[17] : c.in[15])[ch0 + jj];
#pragma unroll
      for (int q = 0; q < 8; ++q) (isi ? IG : RG)[(8 * tg + q) * 128 + jj] = sigmoidf_(acc[q] + bias); }
    __syncthreads();
    if (tid < 128) { const int cgl = ch0 + tid; const float sp = softplusf_(-c.in[18][cgl]); float h = SZ(c.in[3][b * D + cgl]);
        for (int tk = 0; tk < 16; ++tk) { const float la = -8.0f * RG[tk * 128 + tid] * sp, a = __expf(la), u = sqrtf(-expm1f(2.0f * la)) * IG[tk * 128 + tid] * XC[tk * 128 + tid];
            h = a * h + u; ABRS[(size_t)(b * 16 + tk) * 3072 + cgl] = f2bf(gelu_tanh(PS[(size_t)(b * 16 + tk) * 9216 + 4096 + cgl]) * h); }
        c.out[O_LHS + b * D + cgl] = h; }
    __syncthreads();
}
__device__ __forceinline__ void ssd_sample(const Ctx& c, int b, int h) {
    const int tid = otid(); LAS float* XS = (LAS float*)c.lds; LAS float* BS = XS + 1024; LAS float* CS = BS + 2048; LAS float* DTL = CS + 2048;
    const float* PS = (const float*)(c.ws + OFF_PS); const float* DTS = (const float*)(c.ws + OFF_DTS); float* YGS = (float*)(c.ws + OFF_YGS);
    const float* cw = c.in[19]; const float* cb = c.in[20]; const int g = h >> 3;
    for (int e = tid; e < 16 * 320; e += 512) { const int tk = e / 320, q = e % 320; int cc; LAS float* dst;
        if (q < 64) { cc = 64 * h + q; dst = XS + tk * 64 + q; } else if (q < 192) { cc = 2048 + 128 * g + (q - 64); dst = BS + tk * 128 + (q - 64); } else { cc = 2560 + 128 * g + (q - 192); dst = CS + tk * 128 + (q - 192); }
        float o = cb[cc];
#pragma unroll
        for (int k = 0; k < 4; ++k) { const int tt = tk - 3 + k; const float v = tt >= 0 ? PS[(size_t)(b * 16 + tt) * 9216 + 1024 + cc] : SZ(c.in[4][(size_t)(b * 3 + tt + 3) * 3072 + cc]); o += cw[k * 3072 + cc] * v; }
        *dst = siluf_(o);
        if (tk >= 13 && (q < 64 || (h & 7) == 0)) c.out[O_SCS + (size_t)(b * 3 + tk - 13) * 3072 + cc] = PS[(size_t)(b * 16 + tk) * 9216 + 1024 + cc]; }
    if (tid < 16) DTL[tid] = softplusf_(DTS[(b * 16 + tid) * 32 + h] + c.in[21][h]);
    __syncthreads();
    const float Ah = -__expf(c.in[22][h]), Dh = c.in[23][h];
    const int p = tid >> 3, n0 = (tid & 7) * 16; float hs[16];
    const float* h0 = c.in[5] + ((size_t)(b * 32 + h) * 64 + p) * 128 + n0;
#pragma unroll
    for (int j = 0; j < 16; ++j) hs[j] = SZ(h0[j]);
    for (int tk = 0; tk < 16; ++tk) { const float d = DTL[tk], ea = __expf(d * Ah), xv = XS[tk * 64 + p], dx = d * xv; float y = 0.f;
#pragma unroll
        for (int j = 0; j < 16; ++j) { hs[j] = ea * hs[j] + dx * BS[tk * 128 + n0 + j]; y += CS[tk * 128 + n0 + j] * hs[j]; }
        y += __shfl_xor(y, 1); y += __shfl_xor(y, 2); y += __shfl_xor(y, 4);
        if ((tid & 7) == 0) { const int row = b * 16 + tk; YGS[(size_t)row * 2048 + 64 * h + p] = (y + Dh * xv) * siluf_(PS[(size_t)row * 9216 + 5120 + 64 * h + p]); } }
    float* ho = c.out + O_SHS + ((size_t)(b * 32 + h) * 64 + p) * 128 + n0;
#pragma unroll
    for (int j = 0; j < 16; ++j) ho[j] = hs[j];
    __syncthreads();
}

#ifdef DIAG
constexpr size_t OFF_DIAG = 266338304;
__device__ __forceinline__ int prow(int r) { return (r >> 4) * SEQ + (r & 15); }
template <class FA, class FB>
__device__ __forceinline__ void diag_rel(LAS float* red, float* dst, int ncols, FA fa, FB fb) {
    const int tid = threadIdx.x; float num = 0.f, den = 0.f;
    for (int e = tid; e < TS * ncols; e += 512) { const int r = e / ncols, cc = e % ncols; const float a = fa(r, cc), b = fb(r, cc); num += (a - b) * (a - b); den += b * b; }
    red[tid] = num; red[512 + tid] = den; __syncthreads();
    if (tid == 0) { float n = 0.f, d = 0.f; for (int i = 0; i < 512; ++i) { n += red[i]; d += red[512 + i]; } *dst = n / (d + 1e-30f); }
    __syncthreads();
}
#endif
__global__ void __launch_bounds__(512, 2) fwd_kernel(Params prm) {
    extern __shared__ __attribute__((aligned(16))) unsigned char lds_raw[];
    Ctx c; c.in = prm.in; c.out = prm.out; c.ws = prm.ws; c.lds = (LAS unsigned char*)lds_raw;
    unsigned char* ws = prm.ws; float* out = prm.out;
    const int tid = threadIdx.x, G = gridDim.x, bid = blockIdx.x;
    bf16_t* XB = (bf16_t*)(ws + OFF_XB); bf16_t* XN = (bf16_t*)(ws + OFF_XN); bf16_t* PP = (bf16_t*)(ws + OFF_PP); float* SSQ = (float*)(ws + OFF_SSQ);
    bf16_t* XNS = (bf16_t*)(ws + OFF_XNS); bf16_t* HS = (bf16_t*)(ws + OFF_HS); float* PS = (float*)(ws + OFF_PS); float* GSSQ = (float*)(ws + OFF_GSSQ);
    float* YS = out + O_YS;
    const int lo = prm.ph_lo, hi = prm.ph_hi;
#ifdef DIAG
    if (lo >= 100) {
        if (bid != 0) return;
        float* DG = (float*)(ws + OFF_DIAG); LAS float* red = (LAS float*)c.lds; const int st = lo - 100;
        const float* DTp = (const float*)(ws + OFF_DT); const float* DTs = (const float*)(ws + OFF_DTS); const bf16_t* ABRS = (const bf16_t*)(ws + OFF_ABRS); const bf16_t* MS = (const bf16_t*)(ws + OFF_MS); const float* bg = prm.in[11];
        if (st == 0 || st == 6 || st == 7) diag_rel(red, DG + st, D, [=](int r, int cc) { return out[O_YP + (size_t)prow(r) * D + cc]; }, [=](int r, int cc) { return YS[(size_t)r * D + cc]; });
        if (st == 1) { diag_rel(red, DG + 1, NPP, [=](int r, int cc) { return bf2f(PP[(size_t)prow(r) * NPP + cc]); }, [=](int r, int cc) { return PS[(size_t)r * 9216 + cc]; });
                       diag_rel(red, DG + 2, 32, [=](int r, int cc) { return DTp[(size_t)prow(r) * 32 + cc]; }, [=](int r, int cc) { return DTs[(size_t)r * 32 + cc]; }); }
        if (st == 8) { diag_rel(red, DG + 8, D, [=](int r, int cc) { return bf2f(XN[(size_t)prow(r) * D + cc]); }, [=](int r, int cc) { return sigmoidf_(PS[(size_t)r * 9216 + 7168 + cc] + bg[cc]); });
                       diag_rel(red, DG + 9, D, [=](int r, int cc) { return bf2f(PP[(size_t)prow(r) * NPP + 3072 + cc]); }, [=](int r, int cc) { return sigmoidf_(PS[(size_t)r * 9216 + 8192 + cc] + bg[1024 + cc]); }); }
        if (st == 3) { diag_rel(red, DG + 3, D, [=](int r, int cc) { return bf2f(PP[(size_t)prow(r) * NPP + cc]); }, [=](int r, int cc) { return bf2f(ABRS[(size_t)r * 3072 + cc]); });
                       diag_rel(red, DG + 4, 2048, [=](int r, int cc) { return bf2f(PP[(size_t)prow(r) * NPP + 1024 + cc]); }, [=](int r, int cc) { return bf2f(ABRS[(size_t)r * 3072 + 1024 + cc]); }); }
        if (st == 5) diag_rel(red, DG + 5, D, [=](int r, int cc) { return bf2f(XN[(size_t)prow(r) * D + cc]); }, [=](int r, int cc) { return bf2f(MS[(size_t)r * D + cc]); });
        if (st == 20) {
            int mask = 0; if (!(DG[8] < DIAG_TOL)) mask |= 1; if (!(DG[9] < DIAG_TOL)) mask |= 2; if (!(DG[3] < DIAG_TOL)) mask |= 4; if (!(DG[4] < DIAG_TOL)) mask |= 8; if (!(DG[5] < DIAG_TOL)) mask |= 16;
            if (mask == 0) { if (!(DG[6] < DIAG_TOL)) mask |= 32; if (!(DG[7] < DIAG_TOL)) mask |= 64; }
            float code = mask ? 100.f * (1 + mask) : 0.f;
            if (code > 0.f) for (int e = tid; e < TS * D; e += 512) YS[e] = code;
        }
        return;
    }
#endif
#ifndef PHMASK
#define PHMASK 0x1fff
#endif
#define IN(k) (((PHMASK >> (k)) & 1) && lo <= (k) && (k) < hi)
#define SEAM(k) do { if (IN(k) && IN((k) + 1)) { __threadfence(); cg::this_grid().sync(); } } while (0)
    auto rm_id = [](int col0, int) { return col0; };
    auto rm_up = [](int col0, int panel) { return (col0 >> 7) * 256 + panel * 128 + (col0 & 127); };

    if (IN(0)) {
        prep_weights(c);
        rmsnorm_rows_bf16(prm.in[0], T, prm.in[6], XN);
#ifdef DIAG
        { const int t_ = otid(), lane = t_ & 63; for (int r = bid * 8 + (t_ >> 6); r < TS; r += G * 8) { const float* p = prm.in[0] + (size_t)prow(r) * D; float v[16]; float s = 0.f;
            for (int i = 0; i < 16; ++i) { v[i] = p[lane + 64 * i]; s += v[i] * v[i]; }
            for (int o = 1; o < 64; o <<= 1) s += __shfl_xor(s, o);
            const float inv = rsqrtf(s * (1.0f / 1024.0f) + EPS);
            for (int i = 0; i < 16; ++i) XNS[(size_t)r * D + lane + 64 * i] = f2bf(v[i] * inv * prm.in[6][lane + 64 * i]); } }
#else
        rmsnorm_rows_bf16(prm.in[1], TS, prm.in[6], XNS);
#endif
    }
    SEAM(0);
    if (IN(1)) {
        pg8::Gemm g{XN, D, (const bf16_t*)(ws + OFF_WUP1), D, T, 2 * FF, D}; pg8::StaticOrder S; S.init(T, 2 * FF, G, bid);
        pg8::gemm_phase(c.lds, g, S, EpiSwiglu{PP, nullptr});
        small_gemm<64, 2>(c.lds, XNS, D, TS, (const bf16_t*)(ws + OFF_WUP1), D, D, FF, nullptr, 0, rm_up,
            [=](int r, int cc, float v0, float v1, float) { HS[(size_t)r * FF + cc] = f2bf(siluf_(v0) * v1); });
    }
    SEAM(1);
    if (IN(2)) {
        pg8::Gemm g{PP, FF, (const bf16_t*)(ws + OFF_WDN1), FF, T, D, FF}; pg8::StaticOrder S; S.init(T, D, G, bid);
        pg8::gemm_phase(c.lds, g, S, EpiResid{prm.in[0], out + O_YP, XB, SSQ, 0.5f});
        const float* xs_in = prm.in[1];
        small_gemm<64, 1>(c.lds, HS, FF, TS, (const bf16_t*)(ws + OFF_WDN1), FF, FF, D, nullptr, 0, rm_id,
            [=](int r, int cc, float v0, float, float) {
#ifdef DIAG
            const float x = prm.in[0][(size_t)prow(r) * D + cc] + 0.5f * v0;
#else
            const float x = xs_in[(size_t)r * D + cc] + 0.5f * v0;
#endif
            YS[(size_t)r * D + cc] = x; XNS[(size_t)r * D + cc] = f2bf(x); });
    }
    SEAM(2);
    if (IN(3)) {
        pg8::Gemm g{XB, D, (const bf16_t*)(ws + OFF_WIN), D, T, NPP, D}; pg8::StaticOrder S; S.init(T, NPP, G, bid);
        pg8::gemm_phase(c.lds, g, S, EpiScaleBf16{PP, SSQ});
        float* DTp = (float*)(ws + OFF_DT); float* DTs = (float*)(ws + OFF_DTS);
        small_gemm<32, 1>(c.lds, XB, D, T, (const bf16_t*)(ws + OFF_WDT), D, D, 32, SSQ, 2, rm_id,
            [=](int r, int cc, float v0, float, float inv) { DTp[(size_t)r * 32 + cc] = v0 * inv; });
        small_gemm<64, 1>(c.lds, XNS, D, TS, (const bf16_t*)(ws + OFF_WIN), D, D, 9216, YS, 1, rm_id,
            [=](int r, int cc, float v0, float, float inv) { PS[(size_t)r * 9216 + cc] = v0 * inv; });
        small_gemm<32, 1>(c.lds, XNS, D, TS, (const bf16_t*)(ws + OFF_WDT), D, D, 32, YS, 1, rm_id,
            [=](int r, int cc, float v0, float, float inv) { DTs[(size_t)r * 32 + cc] = v0 * inv; });
    }
    SEAM(3);
    if (IN(4)) {
        for (int e = bid * 512 + tid; e < 8 * 3 * 2048; e += G * 512) {
            const int cc = e & 2047, r = (e >> 11) % 3, b = e / (3 * 2048); const size_t row = (size_t)b * SEQ + 2045 + r;
            if (cc < 1024) out[O_LCP + (size_t)(b * 3 + r) * D + cc] = bf2f(PP[row * NPP + cc]);
            else out[O_SCP + (size_t)(b * 3 + r) * 3072 + 2048 + (cc - 1024)] = bf2f(PP[row * NPP + 3072 + (cc - 1024)]); }
        for (int it = bid; it < 256; it += G) lru_chunk<false>(c, it >> 5, it & 31);
        for (int it = bid; it < 256; it += G) ssd_seq(c, it >> 5, it & 31);
        for (int it = bid; it < 64; it += G) lru_sample(c, it >> 3, it & 7);
        for (int it = bid; it < 256; it += G) ssd_sample(c, it >> 5, it & 31);
    }
    SEAM(4);
    if (IN(5)) {
        for (int it = bid; it < 256; it += G) lru_chunk<true>(c, it >> 5, it & 31);
        const float* YGS = (const float*)(ws + OFF_YGS); bf16_t* ABRS = (bf16_t*)(ws + OFF_ABRS);
        const int lane = tid & 63;
        for (int w = bid * 8 + (tid >> 6); w < TS * 4; w += G * 8) { const int r = w >> 2, gq = w & 3; const float* p = YGS + (size_t)r * 2048 + 512 * gq; float v[8]; float s = 0.f;
#pragma unroll
            for (int j = 0; j < 8; ++j) { v[j] = p[lane + 64 * j]; s += v[j] * v[j]; }
#pragma unroll
            for (int o = 1; o < 64; o <<= 1) s += __shfl_xor(s, o);
            const float inv = rsqrtf(s * (1.0f / 512.0f) + EPS);
#pragma unroll
            for (int j = 0; j < 8; ++j) ABRS[(size_t)r * 3072 + 1024 + 512 * gq + lane + 64 * j] = f2bf(v[j] * inv); }
    }
    SEAM(5);
    if (IN(6)) {
        { pg8::Gemm g{XB, D, (const bf16_t*)(ws + OFF_WIN) + (size_t)4096 * D, D, T, 3072, D}; pg8::StaticOrder S; S.init(T, 3072, G, bid);
          pg8::gemm_phase(c.lds, g, S, EpiGatesA{PP, SSQ, GSSQ}); }
        { pg8::Gemm g{XB, D, (const bf16_t*)(ws + OFF_WIN) + (size_t)7168 * D, D, T, D, D}; pg8::StaticOrder S; S.init(T, D, G, bid);
          pg8::gemm_phase(c.lds, g, S, EpiSigmoid{XN, D, SSQ, prm.in[11]}); }
        { pg8::Gemm g{XB, D, (const bf16_t*)(ws + OFF_WIN) + (size_t)8192 * D, D, T, D, D}; pg8::StaticOrder S; S.init(T, D, G, bid);
          pg8::gemm_phase(c.lds, g, S, EpiSigmoid{PP + 3072, NPP, SSQ, prm.in[11] + 1024}); }
    }
    SEAM(6);
    if (IN(7)) {
        const int lane = tid & 63;
        for (int r = bid * 8 + (tid >> 6); r < T; r += G * 8) {
            float s = (lane < 32) ? GSSQ[(size_t)r * 32 + lane] : 0.f;
            s += __shfl_xor(s, 1); s += __shfl_xor(s, 2); s += __shfl_xor(s, 4);
            const float i0 = rsqrtf(__shfl(s, 0) * (1.0f / 512.0f) + EPS), i1 = rsqrtf(__shfl(s, 8) * (1.0f / 512.0f) + EPS), i2 = rsqrtf(__shfl(s, 16) * (1.0f / 512.0f) + EPS), i3 = rsqrtf(__shfl(s, 24) * (1.0f / 512.0f) + EPS);
#pragma unroll
            for (int i = 0; i < 4; ++i) { const float inv = i == 0 ? i0 : (i == 1 ? i1 : (i == 2 ? i2 : i3));
                bf16_t* p = PP + (size_t)r * NPP + 1024 + 512 * i + 8 * lane; f32x4 a, bq; unpack8(*(const u32x4*)p, a, bq); *(u32x4*)p = pack8(a * inv, bq * inv); }
        }
    }
    SEAM(7);
    if (IN(8)) {
        { pg8::Gemm g{PP, NPP, (const bf16_t*)(ws + OFF_WBR), 3072, T, D, D}; pg8::StaticOrder S; S.init(T, D, G, bid); pg8::gemm_phase(c.lds, g, S, EpiBr{XN, PP, 0}); }
        { pg8::Gemm g{PP + 1024, NPP, (const bf16_t*)(ws + OFF_WBR) + 1024, 3072, T, D, 2048}; pg8::StaticOrder S; S.init(T, D, G, bid); pg8::gemm_phase(c.lds, g, S, EpiBr{XN, PP, 1}); }
        const bf16_t* ABRS = (const bf16_t*)(ws + OFF_ABRS); float* M1S = (float*)(ws + OFF_M1S); bf16_t* MS = (bf16_t*)(ws + OFF_MS); const float* bg = prm.in[11];
        small_gemm<64, 1>(c.lds, ABRS, 3072, TS, (const bf16_t*)(ws + OFF_WBR), 3072, D, D, nullptr, 0, rm_id,
            [=](int r, int cc, float v0, float, float) { M1S[(size_t)r * D + cc] = sigmoidf_(PS[(size_t)r * 9216 + 7168 + cc] + bg[cc]) * v0; });
        small_gemm<64, 1>(c.lds, ABRS + 1024, 3072, TS, (const bf16_t*)(ws + OFF_WBR) + 1024, 3072, 2048, D, nullptr, 0, rm_id,
            [=](int r, int cc, float v0, float, float) { MS[(size_t)r * D + cc] = f2bf(M1S[(size_t)r * D + cc] + sigmoidf_(PS[(size_t)r * 9216 + 8192 + cc] + bg[1024 + cc]) * v0); });
    }
    SEAM(8);
    if (IN(9)) {
        pg8::Gemm g{XN, D, (const bf16_t*)(ws + OFF_WOUT), D, T, D, D}; pg8::StaticOrder S; S.init(T, D, G, bid);
        pg8::gemm_phase(c.lds, g, S, EpiResid{out + O_YP, out + O_YP, XB, SSQ, 1.0f});
        const bf16_t* MS = (const bf16_t*)(ws + OFF_MS);
        small_gemm<64, 1>(c.lds, MS, D, TS, (const bf16_t*)(ws + OFF_WOUT), D, D, D, nullptr, 0, rm_id,
            [=](int r, int cc, float v0, float, float) { const float x = YS[(size_t)r * D + cc] + v0; YS[(size_t)r * D + cc] = x; XNS[(size_t)r * D + cc] = f2bf(x); });
    }
    SEAM(9);
    if (IN(10)) {
        pg8::Gemm g{XB, D, (const bf16_t*)(ws + OFF_WUP2), D, T, 2 * FF, D}; pg8::StaticOrder S; S.init(T, 2 * FF, G, bid);
        pg8::gemm_phase(c.lds, g, S, EpiSwiglu{PP, SSQ});
        small_gemm<64, 2>(c.lds, XNS, D, TS, (const bf16_t*)(ws + OFF_WUP2), D, D, FF, YS, 1, rm_up,
            [=](int r, int cc, float v0, float v1, float inv) { HS[(size_t)r * FF + cc] = f2bf(siluf_(v0 * inv) * (v1 * inv)); });
    }
    SEAM(10);
    if (IN(11)) {
        pg8::Gemm g{PP, FF, (const bf16_t*)(ws + OFF_WDN2), FF, T, D, FF}; pg8::StaticOrder S; S.init(T, D, G, bid);
        pg8::gemm_phase(c.lds, g, S, EpiResid{out + O_YP, out + O_YP, nullptr, SSQ, 0.5f});
        small_gemm<64, 1>(c.lds, HS, FF, TS, (const bf16_t*)(ws + OFF_WDN2), FF, FF, D, nullptr, 0, rm_id,
            [=](int r, int cc, float v0, float, float) { YS[(size_t)r * D + cc] += 0.5f * v0; });
    }
    SEAM(11);
    if (IN(12)) {
        rmsnorm_rows_f32(out + O_YP, T + TS, prm.in[31]);
    }
#undef IN
#undef SEAM
}

#ifndef N_LAUNCH_MODE
#define N_LAUNCH_MODE 1
#endif
extern "C" void kernel_launch(void* const* d_in, const int* in_sizes, int n_in, void* d_out, int out_size, void* d_ws, size_t ws_size, hipStream_t stream) {
    static int grid = 0;
    if (grid == 0) {
        if (n_in != 32 || ws_size < WS_END) { fprintf(stderr, "kernel_launch: unexpected n_in %d or ws_size %zu (< %zu)\n", n_in, ws_size, (size_t)WS_END); grid = -1; return; }
        int dev = 0, cus = 0, per_cu = 0;
        hipGetDevice(&dev); hipDeviceGetAttribute(&cus, hipDeviceAttributeMultiprocessorCount, dev);
        if (hipFuncSetAttribute((const void*)fwd_kernel, hipFuncAttributeMaxDynamicSharedMemorySize, LDS_BYTES) != hipSuccess) { fprintf(stderr, "kernel_launch: hipFuncSetAttribute failed\n"); grid = -1; return; }
        hipOccupancyMaxActiveBlocksPerMultiprocessor(&per_cu, (const void*)fwd_kernel, 512, LDS_BYTES);
        if (per_cu < 1) { fprintf(stderr, "kernel_launch: occupancy query says %d blocks per CU\n", per_cu); per_cu = 1; }
        grid = cus * 1;
        (void)hipGetLastError();
    }
    if (grid < 0) return;
    Params p{};
    for (int i = 0; i < 32; ++i) p.in[i] = (const float*)d_in[i];
    p.out = (float*)d_out; p.ws = (unsigned char*)d_ws;
#if N_LAUNCH_MODE == 0
    for (int ph = 0; ph < 13; ++ph) { p.ph_lo = ph; p.ph_hi = ph + 1; hipLaunchKernelGGL(fwd_kernel, dim3(grid), dim3(512), LDS_BYTES, stream, p);
#ifdef DIAG
        int st = -1; if (ph == 2) st = 0; if (ph == 3) st = 1; if (ph == 6) st = 8; if (ph == 7) st = 3; if (ph == 8) st = 5; if (ph == 9) st = 6; if (ph == 11) st = 7; if (ph == 12) st = 20;
        if (st >= 0) { p.ph_lo = 100 + st; p.ph_hi = 0; hipLaunchKernelGGL(fwd_kernel, dim3(grid), dim3(512), LDS_BYTES, stream, p); }
#endif
    }
#else
    p.ph_lo = 0; p.ph_hi = 13;
    void* args[] = {&p};
    hipError_t e = hipLaunchCooperativeKernel((const void*)fwd_kernel, dim3(grid), dim3(512), args, LDS_BYTES, stream);
    if (e != hipSuccess) fprintf(stderr, "cooperative launch failed: %s (grid %d)\n", hipGetErrorString(e), grid);
#endif
}
```

```cpp
#include <hip/hip_runtime.h>
#include <hip/hip_cooperative_groups.h>
#include <cstdio>
namespace cg = cooperative_groups;

#define LAS __attribute__((address_space(3)))
typedef unsigned short bf16_t;
typedef short bf16x8 __attribute__((ext_vector_type(8)));
typedef float f32x4 __attribute__((ext_vector_type(4)));
typedef unsigned u32x4 __attribute__((ext_vector_type(4)));

constexpr int T = 16384, TS = 128, D = 1024, FF = 2816, NPP = 4096, SEQ = 2048, NCH = 32;
constexpr float EPS = 1e-6f;
constexpr size_t OFF_WUP1 = 0, OFF_WDN1 = 11534336;
constexpr size_t OFF_DT = 0, OFF_SUMM = 2097152, OFF_HALO = 4194304, OFF_GSSQ = 5767168, OFF_PS = 7864320,
                 OFF_DTS = 12582912, OFF_YGS = 12599296, OFF_ABRS = 13647872, OFF_M1S = 14434304, OFF_MS = 14958592;
constexpr size_t OFF_WIN = 17301504, OFF_WDT = 36175872, OFF_WBR = 36241408, OFF_WOUT = 42532864, OFF_WUP2 = 44630016,
                 OFF_WDN2 = 56164352, OFF_WRG = 61931520, OFF_WIG = 62193664, OFF_XB = 62455808, OFF_XN = 96010240,
                 OFF_PP = 129564672, OFF_SSQ = 263782400, OFF_XNS = 264830976, OFF_HS = 265093120, WS_END = 265814016;
constexpr size_t O_YP = 0, O_YS = 16777216, O_LCP = 16908288, O_LHP = 16932864, O_SCP = 16941056, O_SHP = 17014784,
                 O_LCS = 19111936, O_LHS = 19136512, O_SCS = 19144704, O_SHS = 19218432;
constexpr int LDS_BYTES = 143360;
constexpr int LDS_INV = 131072;

struct Params { const float* in[32]; float* out; unsigned char* ws; int ph_lo, ph_hi; };

#ifdef DIAG
#define SZ(x) 0.0f
#ifndef DIAG_TOL
#define DIAG_TOL 0.01f
#endif
#else
#define SZ(x) (x)
#endif
__device__ __forceinline__ int otid() { int t = threadIdx.x; asm volatile("" : "+v"(t)); return t; }
__device__ __forceinline__ unsigned cvt_pk_bf16(float lo, float hi) { unsigned r; asm volatile("v_cvt_pk_bf16_f32 %0, %1, %2" : "=v"(r) : "v"(lo), "v"(hi)); return r; }
__device__ __forceinline__ bf16_t f2bf(float f) { return (bf16_t)(cvt_pk_bf16(f, 0.f) & 0xffffu); }
__device__ __forceinline__ float bf2f(bf16_t b) { return __uint_as_float(((unsigned)b) << 16); }
__device__ __forceinline__ float bflo(unsigned w) { return __uint_as_float(w << 16); }
__device__ __forceinline__ float bfhi(unsigned w) { return __uint_as_float(w & 0xffff0000u); }
__device__ __forceinline__ float sigmoidf_(float x) { return __builtin_amdgcn_rcpf(1.0f + __expf(-x)); }
__device__ __forceinline__ float siluf_(float x) { return x * sigmoidf_(x); }
__device__ __forceinline__ float gelu_tanh(float x) { const float u = 0.7978845608028654f * (x + 0.044715f * x * x * x); return x * sigmoidf_(2.0f * u); }
__device__ __forceinline__ float softplusf_(float x) { return x > 20.f ? x : log1pf(__expf(x)); }
__device__ __forceinline__ u32x4 pack8(const f32x4 a, const f32x4 b) { u32x4 w; w.x = cvt_pk_bf16(a[0], a[1]); w.y = cvt_pk_bf16(a[2], a[3]); w.z = cvt_pk_bf16(b[0], b[1]); w.w = cvt_pk_bf16(b[2], b[3]); return w; }
__device__ __forceinline__ void unpack8(const u32x4 w, f32x4& a, f32x4& b) { a[0] = bflo(w.x); a[1] = bfhi(w.x); a[2] = bflo(w.y); a[3] = bfhi(w.y); b[0] = bflo(w.z); b[1] = bfhi(w.z); b[2] = bflo(w.w); b[3] = bfhi(w.w); }
__device__ __forceinline__ float rowinv16(const float* ssq, int row) {
    const f32x4* p = (const f32x4*)(ssq + (size_t)row * 16); const f32x4 a = p[0], b = p[1], c = p[2], d = p[3];
    const float s = ((a[0] + a[1]) + (a[2] + a[3])) + ((b[0] + b[1]) + (b[2] + b[3])) + ((c[0] + c[1]) + (c[2] + c[3])) + ((d[0] + d[1]) + (d[2] + d[3]));
    return rsqrtf(s * (1.0f / 1024.0f) + EPS);
}

namespace pg8 {
constexpr int BM = 256, BK = 64, HALF = 128, HTB = HALF * BK * 2, STAGE_BYTES = 8 * HTB, NXCD = 8, WGM = 8;
__device__ __forceinline__ int lds_byte(int r, int c) { const int st = (r >> 4) * 2 + (c >> 5), rr = r & 15, cc = c & 31, ob = rr * 64 + cc * 2; return st * 1024 + (ob ^ (((ob >> 9) & 1) << 5)); }
__device__ __forceinline__ void stage_rc(int b, int& R, int& C) { const int st = b / 1024, sb = b % 1024, swz = sb ^ (((sb >> 9) & 1) << 5); R = (st >> 1) * 16 + swz / 64; C = (st & 1) * 32 + (swz % 64) / 2; }
__device__ __forceinline__ int perm32(int rho) { const int n = rho >> 4, i = rho & 15; return 8 * (i >> 2) + 4 * n + (i & 3); }
struct Unit { int pm, pn; };
struct Gemm { const bf16_t* A; int lda; const bf16_t* Bt; int ldb; int M, N, K; };
struct StaticOrder {
    int nM, nN, nwg, G, c;
    __device__ __forceinline__ void init(int M, int N, int G_, int c_) { nM = M / BM; nN = N / BM; nwg = nM * nN; G = G_; c = c_; }
    __device__ __forceinline__ bool next(int i, Unit& u) const {
        const long L = (long)i * G + c; if (L >= nwg) return false;
        int wgid = (int)L; { const int q = nwg / NXCD, r = nwg % NXCD, xcd = wgid % NXCD, off = wgid / NXCD; wgid = (xcd < r ? xcd * (q + 1) : r * (q + 1) + (xcd - r) * q) + off; }
        const int nig = WGM * nN, gid = wgid / nig, fm = gid * WGM, gsz = (nM - fm) < WGM ? (nM - fm) : WGM;
        u.pm = fm + ((wgid % nig) % gsz); u.pn = (wgid % nig) / gsz; return true;
    }
};
template <class Epi>
__device__ __forceinline__ void gemm_phase(LAS unsigned char* lds, const Gemm g, const StaticOrder& S, const Epi& E) {
    const int tid = otid(), wid = __builtin_amdgcn_readfirstlane(tid >> 6), lane = tid & 63, wr = wid >> 2, wc = wid & 3, fr = lane & 15, fq = lane >> 4;
    const int K = g.K, nt = K / BK;
    unsigned voffA[2], voffB[2];
#pragma unroll
    for (int i = 0; i < 2; ++i) { int R, C; stage_rc(tid * 16 + i * 8192, R, C); const int Rb = (R & ~31) + perm32(R & 31);
        voffA[i] = (unsigned)(R * g.lda + C) * 2u; voffB[i] = (unsigned)(Rb * g.ldb + C) * 2u; }
    const size_t kstep = (size_t)(BK * 2);
    const size_t hstepA = (size_t)HALF * g.lda * 2, hstepB = (size_t)HALF * g.ldb * 2;
    const size_t tstepA = 2 * hstepA, tstepB = 2 * hstepB;
    const unsigned ldsw = (unsigned)wid * 1024u;
    const int aoff = lds_byte(wr * 64 + fr, fq * 8), boff = lds_byte(wc * 32 + fr, fq * 8);
#define PG8_SA(b, h) (((b) * 2 + (h)) * HTB)
#define PG8_SB(b, h) ((4 + (b) * 2 + (h)) * HTB)
#define PG8_STAGE(bufoff, gbase, voff) do { _Pragma("unroll") for (int _i = 0; _i < 2; ++_i) \
        __builtin_amdgcn_global_load_lds((const unsigned*)((const char*)(gbase) + (voff)[_i]), (LAS unsigned*)(lds + (bufoff) + ldsw + _i * 8192), 16, 0, 0); } while (0)
#define PG8_LDA(dst, b, h) do { _Pragma("unroll") for (int m = 0; m < 4; ++m) _Pragma("unroll") for (int k = 0; k < 2; ++k) dst[m][k] = *(const LAS bf16x8*)(lds + PG8_SA(b, h) + aoff + m * 2048 + k * 1024); } while (0)
#define PG8_LDB(dst, b, h) do { _Pragma("unroll") for (int n = 0; n < 2; ++n) _Pragma("unroll") for (int k = 0; k < 2; ++k) dst[n][k] = *(const LAS bf16x8*)(lds + PG8_SB(b, h) + boff + n * 2048 + k * 1024); } while (0)
#define PG8_MMA(ai, bj, At, Bt) do { __builtin_amdgcn_s_setprio(1); _Pragma("unroll") for (int m = 0; m < 4; ++m) _Pragma("unroll") for (int n = 0; n < 2; ++n) _Pragma("unroll") for (int k = 0; k < 2; ++k) \
        acc[ai][bj][m][n] = __builtin_amdgcn_mfma_f32_16x16x32_bf16(Bt[n][k], At[m][k], acc[ai][bj][m][n], 0, 0, 0); __builtin_amdgcn_s_setprio(0); } while (0)
#define PG8_WAIT_V(n) asm volatile("s_waitcnt vmcnt(" #n ")" ::: "memory")
#define PG8_WAIT_L(n) asm volatile("s_waitcnt lgkmcnt(" #n ")" ::: "memory")
#define PG8_BAR __builtin_amdgcn_s_barrier()
#define PG8_SCHED __builtin_amdgcn_sched_barrier(0)
    Unit cur, nxt; int ui = 0;
    if (!S.next(0, cur)) return;
    f32x4 acc[2][2][4][2];
#pragma unroll
    for (int a = 0; a < 2; ++a)
#pragma unroll
        for (int b = 0; b < 2; ++b)
#pragma unroll
            for (int m = 0; m < 4; ++m)
#pragma unroll
                for (int n = 0; n < 2; ++n) acc[a][b][m][n] = (f32x4){0.f, 0.f, 0.f, 0.f};
    bf16x8 At[4][2], B0[2][2], B1[2][2];
    const char* cA = (const char*)g.A + (size_t)cur.pm * tstepA; const char* cB = (const char*)g.Bt + (size_t)cur.pn * tstepB;
    PG8_STAGE(PG8_SB(0, 0), cB, voffB); PG8_STAGE(PG8_SA(0, 0), cA, voffA); PG8_STAGE(PG8_SB(0, 1), cB + hstepB, voffB); PG8_STAGE(PG8_SA(0, 1), cA + hstepA, voffA);
    if (wr == 1) PG8_BAR;
    PG8_WAIT_V(4); PG8_BAR;
    PG8_STAGE(PG8_SB(1, 0), cB + kstep, voffB); PG8_STAGE(PG8_SA(1, 0), cA + kstep, voffA); PG8_STAGE(PG8_SB(1, 1), cB + hstepB + kstep, voffB);
    PG8_WAIT_V(6); PG8_BAR;
    for (;;) {
        const bool has_next = S.next(ui + 1, nxt);
        const char* nA = has_next ? (const char*)g.A + (size_t)nxt.pm * tstepA : cA; const char* nB = has_next ? (const char*)g.Bt + (size_t)nxt.pn * tstepB : cB;
        for (int t = 0; t < nt; t += 2) {
            const bool last = (t == nt - 2);
            const char* a1 = cA + (size_t)(t + 1) * kstep;
            const char* a2 = last ? nA : cA + (size_t)(t + 2) * kstep; const char* b2 = last ? nB : cB + (size_t)(t + 2) * kstep;
            const char* a3 = a2 + kstep; const char* b3 = b2 + kstep;
            PG8_LDB(B0, 0, 0); PG8_SCHED; PG8_LDA(At, 0, 0); PG8_STAGE(PG8_SA(1, 1), a1 + hstepA, voffA);
            PG8_WAIT_L(8); PG8_BAR; PG8_WAIT_L(0); PG8_MMA(0, 0, At, B0); PG8_BAR; PG8_SCHED;
            PG8_LDB(B1, 0, 1); PG8_STAGE(PG8_SB(0, 0), b2, voffB);
            PG8_BAR; PG8_WAIT_L(0); PG8_MMA(0, 1, At, B1); PG8_BAR;
            PG8_LDA(At, 0, 1); PG8_STAGE(PG8_SA(0, 0), a2, voffA);
            PG8_BAR; PG8_WAIT_L(0); PG8_MMA(1, 0, At, B0); PG8_BAR; PG8_SCHED;
            PG8_STAGE(PG8_SB(0, 1), b2 + hstepB, voffB);
            PG8_WAIT_V(6); PG8_BAR; PG8_MMA(1, 1, At, B1); PG8_BAR;
            PG8_LDB(B0, 1, 0); PG8_SCHED; PG8_LDA(At, 1, 0); PG8_STAGE(PG8_SA(0, 1), a2 + hstepA, voffA);
            PG8_WAIT_L(8); PG8_BAR; PG8_WAIT_L(0); PG8_MMA(0, 0, At, B0); PG8_BAR; PG8_SCHED;
            PG8_LDB(B1, 1, 1); PG8_STAGE(PG8_SB(1, 0), b3, voffB);
            PG8_BAR; PG8_WAIT_L(0); PG8_MMA(0, 1, At, B1); PG8_BAR;
            PG8_LDA(At, 1, 1); PG8_STAGE(PG8_SA(1, 0), a3, voffA);
            PG8_BAR; PG8_WAIT_L(0); PG8_MMA(1, 0, At, B0); PG8_BAR; PG8_SCHED;
            PG8_STAGE(PG8_SB(1, 1), b3 + hstepB, voffB);
            PG8_WAIT_V(6); PG8_BAR; PG8_MMA(1, 1, At, B1); PG8_BAR;
        }
        E(acc, cur, wr, wc, fr, fq);
        if (!has_next) break;
#pragma unroll
        for (int a = 0; a < 2; ++a)
#pragma unroll
            for (int b = 0; b < 2; ++b)
#pragma unroll
                for (int m = 0; m < 4; ++m)
#pragma unroll
                    for (int n = 0; n < 2; ++n) acc[a][b][m][n] = (f32x4){0.f, 0.f, 0.f, 0.f};
        cur = nxt; cA = nA; cB = nB; ++ui;
    }
    PG8_WAIT_V(0);
    if (wr == 0) PG8_BAR;
    PG8_BAR;
#undef PG8_SA
#undef PG8_SB
#undef PG8_STAGE
#undef PG8_LDA
#undef PG8_LDB
#undef PG8_MMA
#undef PG8_WAIT_V
#undef PG8_WAIT_L
#undef PG8_BAR
#undef PG8_SCHED
}
}
typedef f32x4 Acc[2][2][4][2];

__device__ __forceinline__ LAS const float* fill_inv(LAS unsigned char* lds, const float* ssq) {
    LAS float* t = (LAS float*)(lds + LDS_INV); const int base = 2048 * (blockIdx.x & 7);
    for (int r = otid(); r < 2048; r += 512) t[r] = rowinv16(ssq, base + r);
    __syncthreads();
    return t;
}
struct EpiSwiglu {
    bf16_t* H; LAS const float* linv;
    __device__ __forceinline__ void operator()(const Acc& acc, const pg8::Unit& u, int wr, int wc, int fr, int fq) const {
        const int row0 = u.pm * 256 + wr * 64 + fr, col = u.pn * 128 + wc * 32 + 8 * fq;
#pragma unroll
        for (int ai = 0; ai < 2; ++ai)
#pragma unroll
            for (int m = 0; m < 4; ++m) {
                const int row = row0 + ai * 128 + m * 16; const float inv = linv ? linv[row & 2047] : 1.0f;
                f32x4 h0, h1;
#pragma unroll
                for (int j = 0; j < 4; ++j) { h0[j] = siluf_(acc[ai][0][m][0][j] * inv) * (acc[ai][1][m][0][j] * inv); h1[j] = siluf_(acc[ai][0][m][1][j] * inv) * (acc[ai][1][m][1][j] * inv); }
                *(u32x4*)(H + (size_t)row * FF + col) = pack8(h0, h1);
            }
    }
};
struct EpiResid {
    const float* xin; float* xout; bf16_t* xb; float* ssq; float alpha;
    __device__ __forceinline__ void operator()(const Acc& acc, const pg8::Unit& u, int wr, int wc, int fr, int fq) const {
        const int row0 = u.pm * 256 + wr * 64 + fr, col0 = u.pn * 256 + wc * 32 + 8 * fq;
#pragma unroll
        for (int ai = 0; ai < 2; ++ai) {
            f32x4 xv[4][2][2];
#pragma unroll
            for (int m = 0; m < 4; ++m)
#pragma unroll
                for (int bj = 0; bj < 2; ++bj) { const size_t o = (size_t)(row0 + ai * 128 + m * 16) * D + col0 + bj * 128; xv[m][bj][0] = *(const f32x4*)(xin + o); xv[m][bj][1] = *(const f32x4*)(xin + o + 4); }
#pragma unroll
            for (int m = 0; m < 4; ++m) {
                const int row = row0 + ai * 128 + m * 16; float ss = 0.f;
#pragma unroll
                for (int bj = 0; bj < 2; ++bj) {
                    const size_t o = (size_t)row * D + col0 + bj * 128;
                    const f32x4 v0 = xv[m][bj][0] + alpha * acc[ai][bj][m][0], v1 = xv[m][bj][1] + alpha * acc[ai][bj][m][1];
                    *(f32x4*)(xout + o) = v0; *(f32x4*)(xout + o + 4) = v1;
                    ss += (v0[0] * v0[0] + v0[1] * v0[1]) + (v0[2] * v0[2] + v0[3] * v0[3]) + (v1[0] * v1[0] + v1[1] * v1[1]) + (v1[2] * v1[2] + v1[3] * v1[3]);
                    if (xb) *(u32x4*)(xb + o) = pack8(v0, v1);
                }
                ss += __shfl_xor(ss, 16); ss += __shfl_xor(ss, 32);
                if (fq == 0) ssq[(size_t)row * 16 + u.pn * 4 + wc] = ss;
            }
        }
    }
};
struct EpiScaleBf16 {
    bf16_t* O; LAS const float* linv;
    __device__ __forceinline__ void operator()(const Acc& acc, const pg8::Unit& u, int wr, int wc, int fr, int fq) const {
        const int row0 = u.pm * 256 + wr * 64 + fr, col0 = u.pn * 256 + wc * 32 + 8 * fq;
#pragma unroll
        for (int ai = 0; ai < 2; ++ai)
#pragma unroll
            for (int m = 0; m < 4; ++m) {
                const int row = row0 + ai * 128 + m * 16; const float inv = linv[row & 2047];
#pragma unroll
                for (int bj = 0; bj < 2; ++bj) *(u32x4*)(O + (size_t)row * NPP + col0 + bj * 128) = pack8(acc[ai][bj][m][0] * inv, acc[ai][bj][m][1] * inv);
            }
    }
};
struct EpiGatesA {
    bf16_t* PP; LAS const float* linv; float* gssq;
    __device__ __forceinline__ void operator()(const Acc& acc, const pg8::Unit& u, int wr, int wc, int fr, int fq) const {
        const int row0 = u.pm * 256 + wr * 64 + fr, cw = wc * 32 + 8 * fq; const int pn = u.pn;
#pragma unroll
        for (int ai = 0; ai < 2; ++ai) {
            u32x4 sv[4][2];
#pragma unroll
            for (int m = 0; m < 4; ++m)
#pragma unroll
                for (int bj = 0; bj < 2; ++bj) sv[m][bj] = *(const u32x4*)(PP + (size_t)(row0 + ai * 128 + m * 16) * NPP + pn * 256 + bj * 128 + cw);
#pragma unroll
            for (int m = 0; m < 4; ++m) {
                const int row = row0 + ai * 128 + m * 16; const float inv = linv[row & 2047]; float ss = 0.f;
#pragma unroll
                for (int bj = 0; bj < 2; ++bj) {
                    const f32x4 a0 = acc[ai][bj][m][0] * inv, a1 = acc[ai][bj][m][1] * inv; f32x4 o0, o1;
                    bf16_t* p = PP + (size_t)row * NPP + pn * 256 + bj * 128 + cw; f32x4 s0, s1; unpack8(sv[m][bj], s0, s1);
                    if (pn < 4) {
#pragma unroll
                        for (int j = 0; j < 4; ++j) { o0[j] = gelu_tanh(a0[j]) * s0[j]; o1[j] = gelu_tanh(a1[j]) * s1[j]; }
                    } else {
#pragma unroll
                        for (int j = 0; j < 4; ++j) { o0[j] = siluf_(a0[j]) * s0[j]; o1[j] = siluf_(a1[j]) * s1[j]; ss += o0[j] * o0[j] + o1[j] * o1[j]; }
                    }
                    *(u32x4*)p = pack8(o0, o1);
                }
                if (pn >= 4) { ss += __shfl_xor(ss, 16); ss += __shfl_xor(ss, 32); if (fq == 0) gssq[(size_t)row * 32 + (pn - 4) * 4 + wc] = ss; }
            }
        }
    }
};
struct EpiSigmoid {
    bf16_t* O; int ldo; LAS const float* linv; const float* bias;
    __device__ __forceinline__ void operator()(const Acc& acc, const pg8::Unit& u, int wr, int wc, int fr, int fq) const {
        const int row0 = u.pm * 256 + wr * 64 + fr, col0 = u.pn * 256 + wc * 32 + 8 * fq;
#pragma unroll
        for (int ai = 0; ai < 2; ++ai)
#pragma unroll
            for (int m = 0; m < 4; ++m) {
                const int row = row0 + ai * 128 + m * 16; const float inv = linv[row & 2047];
#pragma unroll
                for (int bj = 0; bj < 2; ++bj) {
                    const int gc = col0 + bj * 128;
                    const f32x4 a0 = acc[ai][bj][m][0] * inv, a1 = acc[ai][bj][m][1] * inv; f32x4 o0, o1;
                    const f32x4 b0 = *(const f32x4*)(bias + gc), b1 = *(const f32x4*)(bias + gc + 4);
#pragma unroll
                    for (int j = 0; j < 4; ++j) { o0[j] = sigmoidf_(a0[j] + b0[j]); o1[j] = sigmoidf_(a1[j] + b1[j]); }
                    *(u32x4*)(O + (size_t)row * ldo + gc) = pack8(o0, o1);
                }
            }
    }
};
struct EpiBr {
    bf16_t* GA; const bf16_t* PP; int mode;
    __device__ __forceinline__ void operator()(const Acc& acc, const pg8::Unit& u, int wr, int wc, int fr, int fq) const {
        const int row0 = u.pm * 256 + wr * 64 + fr, col0 = u.pn * 256 + wc * 32 + 8 * fq;
#pragma unroll
        for (int ai = 0; ai < 2; ++ai) {
            u32x4 gv[4][2], hv[4][2];
#pragma unroll
            for (int m = 0; m < 4; ++m)
#pragma unroll
                for (int bj = 0; bj < 2; ++bj) { const int row = row0 + ai * 128 + m * 16; gv[m][bj] = *(const u32x4*)(GA + (size_t)row * D + col0 + bj * 128);
                    hv[m][bj] = (mode == 0) ? (u32x4){0u, 0u, 0u, 0u} : *(const u32x4*)(PP + (size_t)row * NPP + 3072 + col0 + bj * 128); }
#pragma unroll
            for (int m = 0; m < 4; ++m) {
                const int row = row0 + ai * 128 + m * 16;
#pragma unroll
                for (int bj = 0; bj < 2; ++bj) {
                    bf16_t* p = GA + (size_t)row * D + col0 + bj * 128; f32x4 g0, g1; unpack8(gv[m][bj], g0, g1);
                    if (mode == 0) { *(u32x4*)p = pack8(g0 * acc[ai][bj][m][0], g1 * acc[ai][bj][m][1]); }
                    else { f32x4 h0, h1; unpack8(hv[m][bj], h0, h1); *(u32x4*)p = pack8(g0 + h0 * acc[ai][bj][m][0], g1 + h1 * acc[ai][bj][m][1]); }
                }
            }
        }
    }
};

template <int NC, int NB, int K, class RM, class F>
__device__ __forceinline__ void small_gemm(LAS unsigned char* lds, const bf16_t* A, int lda, int M, const bf16_t* Bt, int ldb, int N,
                                           const float* rs_src, int rs_mode, RM rm, F f) {
    const int tid = otid(), wid = tid >> 6, lane = tid & 63, lr = lane & 15, kg = lane >> 4;
    LAS float* red = (LAS float*)lds;
    LAS float* invs = (LAS float*)(lds + 131072);
    const int nct = N / NC, items = (M / 16) * nct; constexpr int kw = K / 8;
    constexpr int CT = NC / 16;
    const int nrt = M / 16; const bool hoist = (rs_mode == 1) && (gridDim.x % nrt == 0); const int bix = gridDim.x - 1 - blockIdx.x;
    for (int it = bix; it < items; it += gridDim.x) {
        const int rt = it % nrt, ct = it / nrt, row0 = rt * 16, col0 = ct * NC;
        if (rs_mode == 1) { if (!(hoist && it != bix)) { const int r = tid >> 5, q = tid & 31; const float* p = rs_src + (size_t)(row0 + r) * D + q * 32; float s = 0.f;
            for (int j = 0; j < 32; j += 4) { const f32x4 v = *(const f32x4*)(p + j); s += v[0] * v[0] + v[1] * v[1] + v[2] * v[2] + v[3] * v[3]; }
            s += __shfl_xor(s, 1); s += __shfl_xor(s, 2); s += __shfl_xor(s, 4); s += __shfl_xor(s, 8); s += __shfl_xor(s, 16);
            if (q == 0) invs[r] = rsqrtf(s * (1.0f / 1024.0f) + EPS); } }
        else if (rs_mode == 2) { if (tid < 16) invs[tid] = rowinv16(rs_src, row0 + tid); }
        else { if (tid < 16) invs[tid] = 1.0f; }
        f32x4 acc[NB][CT];
#pragma unroll
        for (int p = 0; p < NB; ++p)
#pragma unroll
            for (int c = 0; c < CT; ++c) acc[p][c] = (f32x4){0.f, 0.f, 0.f, 0.f};
        const bf16_t* ap = A + (size_t)(row0 + lr) * lda + wid * kw + 8 * kg;
        const bf16_t* bp0 = Bt + (size_t)(rm(col0, 0) + lr) * ldb + wid * kw + 8 * kg;
        const bf16_t* bp1 = NB > 1 ? Bt + (size_t)(rm(col0, 1) + lr) * ldb + wid * kw + 8 * kg : bp0;
#pragma unroll
        for (int k = 0; k < kw; k += 32) {
            const bf16x8 a = *(const bf16x8*)(ap + k);
#pragma unroll
            for (int c = 0; c < CT; ++c) {
                const bf16x8 b = *(const bf16x8*)(bp0 + (size_t)c * 16 * ldb + k);
                acc[0][c] = __builtin_amdgcn_mfma_f32_16x16x32_bf16(a, b, acc[0][c], 0, 0, 0);
                if (NB > 1) { const bf16x8 b1 = *(const bf16x8*)(bp1 + (size_t)c * 16 * ldb + k); acc[NB - 1][c] = __builtin_amdgcn_mfma_f32_16x16x32_bf16(a, b1, acc[NB - 1][c], 0, 0, 0); }
            }
        }
#pragma unroll
        for (int p = 0; p < NB; ++p)
#pragma unroll
            for (int c = 0; c < CT; ++c)
#pragma unroll
                for (int r = 0; r < 4; ++r) red[((wid * NB + p) * 16 + 4 * kg + r) * NC + 16 * c + lr] = acc[p][c][r];
        __syncthreads();
        for (int e = tid; e < 16 * NC; e += 512) {
            float v0 = 0.f, v1 = 0.f;
#pragma unroll
            for (int w = 0; w < 8; ++w) { v0 += red[(w * NB) * 16 * NC + e]; if (NB > 1) v1 += red[(w * NB + 1) * 16 * NC + e]; }
            const int r = e / NC, c = e % NC;
            f(row0 + r, col0 + c, v0, v1, invs[r]);
        }
        __syncthreads();
    }
}

template <int NC, int NB, int K, class RM, class F>
__device__ __forceinline__ void sgemm(LAS unsigned char* lds, const bf16_t* A, int lda, const bf16_t* Bt, int ldb, int N, const float* ssq_src, float* ssq_out, RM rm, F f, int nblk = 0) {
    const int tid = otid(), wid = tid >> 6, lane = tid & 63, lr = lane & 15, kg = lane >> 4;
    constexpr int CT = NC / 16, KW = K / 8;
    LAS float* red = (LAS float*)lds;
    const int items = N / NC, bix = gridDim.x - 1 - blockIdx.x; if (nblk == 0) nblk = gridDim.x;
    LAS float* invs = (LAS float*)(lds + LDS_INV);
    if (bix < items && bix < nblk) {
        if (ssq_src) { const int row = tid >> 2, q = tid & 3; float sm = 0.f;
#pragma unroll
            for (int j = 0; j < 16; j += 4) { const f32x4 v = *(const f32x4*)(ssq_src + row * 64 + q * 16 + j); sm += (v[0] + v[1]) + (v[2] + v[3]); }
            sm += __shfl_xor(sm, 1); sm += __shfl_xor(sm, 2);
            if (q == 0) invs[row] = rsqrtf(sm * (1.0f / 1024.0f) + EPS); }
        else if (tid < 128) invs[tid] = 1.0f;
        __syncthreads();
    }
    for (int it = bix; it < items && bix < nblk; it += nblk) {
        const int col0 = it * NC;
        f32x4 acc[8][NB][CT];
#pragma unroll
        for (int t = 0; t < 8; ++t)
#pragma unroll
            for (int p = 0; p < NB; ++p)
#pragma unroll
                for (int c = 0; c < CT; ++c) acc[t][p][c] = (f32x4){0.f, 0.f, 0.f, 0.f};
        const bf16_t* ap = A + (size_t)lr * lda + wid * KW + 8 * kg;
        const bf16_t* bp0 = Bt + (size_t)(rm(col0, 0) + lr) * ldb + wid * KW + 8 * kg;
        const bf16_t* bp1 = NB > 1 ? Bt + (size_t)(rm(col0, 1) + lr) * ldb + wid * KW + 8 * kg : bp0;
#pragma unroll 4
        for (int k = 0; k < KW; k += 32) {
            bf16x8 bf[NB][CT];
#pragma unroll
            for (int c = 0; c < CT; ++c) { bf[0][c] = *(const bf16x8*)(bp0 + (size_t)c * 16 * ldb + k); if (NB > 1) bf[NB - 1][c] = *(const bf16x8*)(bp1 + (size_t)c * 16 * ldb + k); }
#pragma unroll
            for (int t = 0; t < 8; ++t) { const bf16x8 a = *(const bf16x8*)(ap + (size_t)t * 16 * lda + k);
#pragma unroll
                for (int p = 0; p < NB; ++p)
#pragma unroll
                    for (int c = 0; c < CT; ++c) acc[t][p][c] = __builtin_amdgcn_mfma_f32_16x16x32_bf16(a, bf[p][c], acc[t][p][c], 0, 0, 0); }
        }
#pragma unroll
        for (int t = 0; t < 8; ++t)
#pragma unroll
            for (int p = 0; p < NB; ++p)
#pragma unroll
                for (int c = 0; c < CT; ++c)
#pragma unroll
                    for (int r = 0; r < 4; ++r) red[((((wid * 8 + t) * NB + p) * CT + c) * 16 + 4 * kg + r) * 16 + lr] = acc[t][p][c][r];
        __syncthreads();
        for (int e = tid; e < 128 * NC; e += 512) {
            const int row = e / NC, col = e % NC, t = row >> 4, rr = row & 15, c = col >> 4, cl = col & 15;
            float v0 = 0.f, v1 = 0.f;
#pragma unroll
            for (int w = 0; w < 8; ++w) { v0 += red[((((w * 8 + t) * NB + 0) * CT + c) * 16 + rr) * 16 + cl]; if (NB > 1) v1 += red[((((w * 8 + t) * NB + (NB - 1)) * CT + c) * 16 + rr) * 16 + cl]; }
            float sq = f(row, col0 + col, v0, v1, invs[row]);
            if (ssq_out) { sq *= sq; sq += __shfl_xor(sq, 1); sq += __shfl_xor(sq, 2); sq += __shfl_xor(sq, 4); sq += __shfl_xor(sq, 8); if (NC > 16) sq += __shfl_xor(sq, 16);
                if ((col & (NC - 1)) == 0) ssq_out[row * 64 + it] = sq; }
        }
        __syncthreads();
    }
}

template <int CT, int NB, int K, class RM, class F>
__device__ __forceinline__ void wave_gemm(LAS unsigned char* lds, const bf16_t* A, int lda, const bf16_t* Bt, int ldb, int N, const float* rs_src, RM rm, F f) {
    const int tid = otid(), wid = tid >> 6, lane = tid & 63, lr = lane & 15, kg = lane >> 4;
    const int bix = gridDim.x - 1 - blockIdx.x, rt = bix & 7, row0 = rt * 16, nct = N / (16 * CT);
    LAS float* invs = (LAS float*)(lds + LDS_INV);
    if (rs_src) { const int r = tid >> 5, q = tid & 31; const float* p = rs_src + (size_t)(row0 + r) * D + q * 32; float s = 0.f;
        for (int j = 0; j < 32; j += 4) { const f32x4 v = *(const f32x4*)(p + j); s += v[0] * v[0] + v[1] * v[1] + v[2] * v[2] + v[3] * v[3]; }
        s += __shfl_xor(s, 1); s += __shfl_xor(s, 2); s += __shfl_xor(s, 4); s += __shfl_xor(s, 8); s += __shfl_xor(s, 16);
        if (q == 0) invs[r] = rsqrtf(s * (1.0f / 1024.0f) + EPS); }
    else if (tid < 16) invs[tid] = 1.0f;
    __syncthreads();
    for (int ct = (bix >> 3) * 8 + wid; ct < nct; ct += (gridDim.x >> 3) * 8) {
        const int col0 = ct * 16 * CT;
        f32x4 acc[NB][CT];
#pragma unroll
        for (int p = 0; p < NB; ++p)
#pragma unroll
            for (int c = 0; c < CT; ++c) acc[p][c] = (f32x4){0.f, 0.f, 0.f, 0.f};
        const bf16_t* ap = A + (size_t)(row0 + lr) * lda + 8 * kg;
        const bf16_t* bp0 = Bt + (size_t)(rm(col0, 0) + lr) * ldb + 8 * kg;
        const bf16_t* bp1 = NB > 1 ? Bt + (size_t)(rm(col0, 1) + lr) * ldb + 8 * kg : bp0;
#pragma unroll 4
        for (int k = 0; k < K; k += 32) {
            const bf16x8 a = *(const bf16x8*)(ap + k);
#pragma unroll
            for (int c = 0; c < CT; ++c) {
                const bf16x8 b = *(const bf16x8*)(bp0 + (size_t)c * 16 * ldb + k);
                acc[0][c] = __builtin_amdgcn_mfma_f32_16x16x32_bf16(a, b, acc[0][c], 0, 0, 0);
                if (NB > 1) { const bf16x8 b1 = *(const bf16x8*)(bp1 + (size_t)c * 16 * ldb + k); acc[NB - 1][c] = __builtin_amdgcn_mfma_f32_16x16x32_bf16(a, b1, acc[NB - 1][c], 0, 0, 0); }
            }
        }
#pragma unroll
        for (int c = 0; c < CT; ++c)
#pragma unroll
            for (int r = 0; r < 4; ++r) f(row0 + 4 * kg + r, col0 + 16 * c + lr, acc[0][c][r], NB > 1 ? acc[NB - 1][c][r] : 0.f, invs[4 * kg + r]);
    }
    __syncthreads();
}

struct Ctx { const float* const* in; float* out; unsigned char* ws; LAS unsigned char* lds; };

__device__ __forceinline__ void tp_tile(LAS float* tile, const float* src, int sld, int sc0, int k0, bf16_t* dst, int dld, int dr0, int dk0, const float* scale, int ncv) {
    const int lane = otid() & 63;
    float v[64];
    const float* sp = src + (size_t)k0 * sld + sc0 + lane;
#pragma unroll
    for (int kk = 0; kk < 64; ++kk) v[kk] = (lane < ncv) ? sp[(size_t)kk * sld] : 0.f;
    if (scale) {
#pragma unroll
        for (int kk = 0; kk < 64; ++kk) v[kk] *= scale[k0 + kk];
    }
#pragma unroll
    for (int kk = 0; kk < 64; ++kk) tile[kk * 65 + lane] = v[kk];
    const int j = lane & 7;
#pragma unroll
    for (int ps = 0; ps < 8; ++ps) { const int cc = (lane >> 3) + 8 * ps;
        float x[8];
#pragma unroll
        for (int i = 0; i < 8; ++i) x[i] = tile[(8 * j + i) * 65 + cc];
        u32x4 w; w.x = cvt_pk_bf16(x[0], x[1]); w.y = cvt_pk_bf16(x[2], x[3]); w.z = cvt_pk_bf16(x[4], x[5]); w.w = cvt_pk_bf16(x[6], x[7]);
        if (cc < ncv) *(u32x4*)(dst + (size_t)(dr0 + cc) * dld + dk0 + 8 * j) = w; }
}
__device__ __forceinline__ void prep_weights(const Ctx& c) {
    const int wv_ = __builtin_amdgcn_readfirstlane(otid() >> 6); LAS float* tile = (LAS float*)c.lds + wv_ * (64 * 65); unsigned char* ws = c.ws;
    constexpr int N_UP = 1408, N_DN = 704, N_IN = 2304, N_DT = 16, N_BRL = 256, N_BRS = 512, N_OUT = 256, N_RG = 32;
    constexpr int TOT = 2 * N_UP + 2 * N_DN + N_IN + N_DT + N_BRL + N_BRS + N_OUT + 2 * N_RG;
    for (int ti0 = blockIdx.x * 8 + wv_; ti0 < TOT; ti0 += gridDim.x * 8) {
        int ti = ti0;
        if (ti < 2 * N_UP) { const int l = ti >= N_UP; if (l) ti -= N_UP;
            const int j = ti >> 5, r = ti & 31, pn = j >> 1, panel = j & 1, ct = r >> 4, kt = r & 15;
            tp_tile(tile, c.in[l ? 29 : 7], 2 * FF, panel * FF + 128 * pn + 64 * ct, 64 * kt, (bf16_t*)(ws + (l ? OFF_WUP2 : OFF_WUP1)), D, 256 * pn + 128 * panel + 64 * ct, 64 * kt, l ? c.in[28] : nullptr, 64);
            continue; }
        ti -= 2 * N_UP;
        if (ti < 2 * N_DN) { const int l = ti >= N_DN; if (l) ti -= N_DN;
            const int nt = ti / 44, kt = ti % 44;
            tp_tile(tile, c.in[l ? 30 : 8], D, 64 * nt, 64 * kt, (bf16_t*)(ws + (l ? OFF_WDN2 : OFF_WDN1)), FF, 64 * nt, 64 * kt, nullptr, 64);
            continue; }
        ti -= 2 * N_DN;
        if (ti < N_IN) { const int nt = ti >> 4, kt = ti & 15, n0 = 64 * nt;
            const int sc = n0 < 1024 ? n0 : (n0 < 4096 ? n0 + 3072 : (n0 < 7168 ? n0 - 3072 : n0 + 32));
            tp_tile(tile, c.in[10], 9248, sc, 64 * kt, (bf16_t*)(ws + OFF_WIN), D, n0, 64 * kt, c.in[9], 64);
            continue; }
        ti -= N_IN;
        if (ti < N_DT) { tp_tile(tile, c.in[10], 9248, 7168, 64 * ti, (bf16_t*)(ws + OFF_WDT), D, 0, 64 * ti, c.in[9], 32); continue; }
        ti -= N_DT;
        if (ti < N_BRL) { const int nt = ti >> 4, kt = ti & 15; tp_tile(tile, c.in[25], D, 64 * nt, 64 * kt, (bf16_t*)(ws + OFF_WBR), 3072, 64 * nt, 64 * kt, nullptr, 64); continue; }
        ti -= N_BRL;
        if (ti < N_BRS) { const int nt = ti >> 5, kt = ti & 31; tp_tile(tile, c.in[26], D, 64 * nt, 64 * kt, (bf16_t*)(ws + OFF_WBR), 3072, 64 * nt, 1024 + 64 * kt, c.in[24], 64); continue; }
        ti -= N_BRS;
        if (ti < N_OUT) { const int nt = ti >> 4, kt = ti & 15; tp_tile(tile, c.in[27], D, 64 * nt, 64 * kt, (bf16_t*)(ws + OFF_WOUT), D, 64 * nt, 64 * kt, nullptr, 64); continue; }
        ti -= N_OUT;
        { const int l = ti >= N_RG; if (l) ti -= N_RG; const int h = ti >> 2, nt = (ti >> 1) & 1, kt = ti & 1;
          tp_tile(tile, c.in[l ? 16 : 14] + h * 16384, 128, 64 * nt, 64 * kt, (bf16_t*)(ws + (l ? OFF_WIG : OFF_WRG)) + h * 16384, 128, 64 * nt, 64 * kt, nullptr, 64); }
    }
}
__device__ __forceinline__ void rmsnorm_rows_bf16(const float* x, int nrows, const float* g, bf16_t* dst) {
    const int t_ = otid(), lane = t_ & 63, gw = blockIdx.x * 8 + (t_ >> 6), nw = gridDim.x * 8;
    f32x4 gg[4];
#pragma unroll
    for (int i = 0; i < 4; ++i) gg[i] = *(const f32x4*)(g + (i * 64 + lane) * 4);
    for (int r = gw; r < nrows; r += 2 * nw) {
        const int r2 = r + nw; const bool two = r2 < nrows;
        const float* p = x + (size_t)r * D; const float* p2 = x + (size_t)(two ? r2 : r) * D; f32x4 v[4], w[4]; float s = 0.f, s2 = 0.f;
#pragma unroll
        for (int i = 0; i < 4; ++i) { v[i] = *(const f32x4*)(p + (i * 64 + lane) * 4); w[i] = *(const f32x4*)(p2 + (i * 64 + lane) * 4); }
#pragma unroll
        for (int i = 0; i < 4; ++i) { s += v[i][0] * v[i][0] + v[i][1] * v[i][1] + v[i][2] * v[i][2] + v[i][3] * v[i][3]; s2 += w[i][0] * w[i][0] + w[i][1] * w[i][1] + w[i][2] * w[i][2] + w[i][3] * w[i][3]; }
#pragma unroll
        for (int o = 1; o < 64; o <<= 1) { s += __shfl_xor(s, o); s2 += __shfl_xor(s2, o); }
        const float inv = rsqrtf(s * (1.0f / 1024.0f) + EPS), inv2 = rsqrtf(s2 * (1.0f / 1024.0f) + EPS);
#pragma unroll
        for (int i = 0; i < 4; ++i) { const int cc = (i * 64 + lane) * 4; const f32x4 o = v[i] * inv * gg[i];
            unsigned* q = (unsigned*)(dst + (size_t)r * D + cc); q[0] = cvt_pk_bf16(o[0], o[1]); q[1] = cvt_pk_bf16(o[2], o[3]);
            if (two) { const f32x4 o2 = w[i] * inv2 * gg[i]; unsigned* q2 = (unsigned*)(dst + (size_t)r2 * D + cc); q2[0] = cvt_pk_bf16(o2[0], o2[1]); q2[1] = cvt_pk_bf16(o2[2], o2[3]); } }
    }
}
__device__ __forceinline__ void rmsnorm_rows_f32(float* x, int nrows, const float* g) {
    const int t_ = otid(), lane = t_ & 63, gw = blockIdx.x * 8 + (t_ >> 6), nw = gridDim.x * 8;
    f32x4 gg[4];
#pragma unroll
    for (int i = 0; i < 4; ++i) gg[i] = *(const f32x4*)(g + (i * 64 + lane) * 4);
    for (int r = gw; r < nrows; r += 2 * nw) {
        const int r2 = r + nw; const bool two = r2 < nrows;
        float* p = x + (size_t)r * D; float* p2 = x + (size_t)(two ? r2 : r) * D; f32x4 v[4], w[4]; float s = 0.f, s2 = 0.f;
#pragma unroll
        for (int i = 0; i < 4; ++i) { v[i] = *(const f32x4*)(p + (i * 64 + lane) * 4); w[i] = *(const f32x4*)(p2 + (i * 64 + lane) * 4); }
#pragma unroll
        for (int i = 0; i < 4; ++i) { s += v[i][0] * v[i][0] + v[i][1] * v[i][1] + v[i][2] * v[i][2] + v[i][3] * v[i][3]; s2 += w[i][0] * w[i][0] + w[i][1] * w[i][1] + w[i][2] * w[i][2] + w[i][3] * w[i][3]; }
#pragma unroll
        for (int o = 1; o < 64; o <<= 1) { s += __shfl_xor(s, o); s2 += __shfl_xor(s2, o); }
        const float inv = rsqrtf(s * (1.0f / 1024.0f) + EPS), inv2 = rsqrtf(s2 * (1.0f / 1024.0f) + EPS);
#pragma unroll
        for (int i = 0; i < 4; ++i) { const int cc = (i * 64 + lane) * 4; *(f32x4*)(p + cc) = v[i] * inv * gg[i]; if (two) *(f32x4*)(p2 + cc) = w[i] * inv2 * gg[i]; }
    }
}

template <bool FINAL>
__device__ __forceinline__ void lru_chunk(const Ctx& c, int b, int ch, bool dry = false) {
    const int tid = otid(), wid = tid >> 6, lane = tid & 63, lr = lane & 15, kg = lane >> 4;
    LAS float* XC = (LAS float*)c.lds; LAS float* AA = (LAS float*)(c.lds + 32768); LAS float* UU = (LAS float*)(c.lds + 65536); LAS unsigned char* XCb = c.lds + 98304;
    bf16_t* PP = (bf16_t*)(c.ws + OFF_PP); bf16_t* HALO = (bf16_t*)(c.ws + OFF_HALO); float* SUMM = (float*)(c.ws + OFF_SUMM);
    const bf16_t* WRG = (const bf16_t*)(c.ws + OFF_WRG); const bf16_t* WIG = (const bf16_t*)(c.ws + OFF_WIG);
    const float* cw = c.in[12]; const float* cb = c.in[13]; const float* brg = c.in[15]; const float* big = c.in[17]; const float* lam = c.in[18];
    const int t0 = b * SEQ + 64 * ch;
    LAS float* CARRY = (LAS float*)(c.lds + 115712);
    if (FINAL) {
        float h0 = 0.f, h1 = 0.f;
        for (int cp = 0; cp < ch; cp += 8) {
            float a0[8], b0[8], a1[8], b1[8];
#pragma unroll
            for (int i = 0; i < 8; ++i) { a0[i] = 1.f; b0[i] = 0.f; a1[i] = 1.f; b1[i] = 0.f;
                if (cp + i < ch) { const float* sp = SUMM + ((size_t)(b * NCH + cp + i) * D + tid) * 2; a0[i] = sp[0]; b0[i] = sp[1]; a1[i] = sp[1024]; b1[i] = sp[1025]; } }
#pragma unroll
            for (int i = 0; i < 8; ++i) { h0 = a0[i] * h0 + b0[i]; h1 = a1[i] * h1 + b1[i]; }
        }
        CARRY[tid] = h0; CARRY[tid + 512] = h1;
    }
    const int cg8 = tid & 15, tk = (tid >> 4) * 2;
    u32x4 rawp[5]; f32x4 wk[4][2], bb[2]; bf16x8 wrf[4], wif[4]; float pb1 = 0.f, pb2 = 0.f, plam = 0.f;
#define LRU_FETCH(hd) do { const int cc0_ = 128 * (hd) + 8 * cg8; \
        _Pragma("unroll") for (int i = 0; i < 5; ++i) { const int tt = tk - 3 + i; rawp[i] = (u32x4){0u, 0u, 0u, 0u}; \
            if (tt >= 0) rawp[i] = *(const u32x4*)(PP + (size_t)(t0 + tt) * NPP + cc0_); \
            else if (ch > 0) { if (FINAL) rawp[i] = *(const u32x4*)(HALO + ((size_t)((b * NCH + ch - 1) * 3 + (tt + 3))) * D + cc0_); else rawp[i] = *(const u32x4*)(PP + (size_t)(t0 + tt) * NPP + cc0_); } } \
        _Pragma("unroll") for (int k = 0; k < 4; ++k) { wk[k][0] = *(const f32x4*)(cw + k * D + cc0_); wk[k][1] = *(const f32x4*)(cw + k * D + cc0_ + 4); } \
        bb[0] = *(const f32x4*)(cb + cc0_); bb[1] = *(const f32x4*)(cb + cc0_ + 4); } while (0)
#define LRU_FETCHW(hd) do { \
        { const int cgl_ = 128 * (hd) + 16 * wid + lr; const bf16_t* wr__ = WRG + (size_t)cgl_ * 128 + 8 * kg; const bf16_t* wi__ = WIG + (size_t)cgl_ * 128 + 8 * kg; \
          _Pragma("unroll") for (int ks = 0; ks < 4; ++ks) { wrf[ks] = *(const bf16x8*)(wr__ + 32 * ks); wif[ks] = *(const bf16x8*)(wi__ + 32 * ks); } \
          pb1 = brg[cgl_]; pb2 = big[cgl_]; plam = lam[cgl_]; } } while (0)
    LRU_FETCH(0); LRU_FETCHW(0);
    for (int head = 0; head < 8; ++head) {
        const int ch0 = 128 * head;
        if (!FINAL) { if (tid < 48) { const int row = tid >> 4, cg8_ = tid & 15;
            *(u32x4*)(HALO + ((size_t)((b * NCH + ch) * 3 + row)) * D + ch0 + 8 * cg8_) = *(const u32x4*)(PP + (size_t)(t0 + 61 + row) * NPP + ch0 + 8 * cg8_); } }
        {
            f32x4 raw[5][2];
#pragma unroll
            for (int i = 0; i < 5; ++i) unpack8(rawp[i], raw[i][0], raw[i][1]);
#pragma unroll
            for (int q = 0; q < 2; ++q) { f32x4 o0 = bb[0], o1 = bb[1];
#pragma unroll
                for (int k = 0; k < 4; ++k) { o0 += wk[k][0] * raw[q + k][0]; o1 += wk[k][1] * raw[q + k][1]; }
                *(LAS f32x4*)(XC + (tk + q) * 128 + 8 * cg8) = o0; *(LAS f32x4*)(XC + (tk + q) * 128 + 8 * cg8 + 4) = o1;
                *(LAS u32x4*)(XCb + (tk + q) * 272 + 16 * cg8) = pack8(o0, o1); }
            if (head < 7) LRU_FETCH(head + 1);
        }
        __syncthreads();
        {
            f32x4 ar[4], ai_[4];
#pragma unroll
            for (int m = 0; m < 4; ++m) { ar[m] = (f32x4){0.f, 0.f, 0.f, 0.f}; ai_[m] = (f32x4){0.f, 0.f, 0.f, 0.f}; }
#pragma unroll
            for (int ks = 0; ks < 4; ++ks) { const bf16x8 br = wrf[ks], bi = wif[ks];
#pragma unroll
                for (int m = 0; m < 4; ++m) { const bf16x8 a = *(const LAS bf16x8*)(XCb + (16 * m + lr) * 272 + (32 * ks + 8 * kg) * 2);
                    ar[m] = __builtin_amdgcn_mfma_f32_16x16x32_bf16(a, br, ar[m], 0, 0, 0); ai_[m] = __builtin_amdgcn_mfma_f32_16x16x32_bf16(a, bi, ai_[m], 0, 0, 0); } }
            const int cl = 16 * wid + lr; const float b1 = pb1, b2 = pb2, sp = softplusf_(-plam);
            if (head < 7) LRU_FETCHW(head + 1);
#pragma unroll
            for (int m = 0; m < 4; ++m)
#pragma unroll
                for (int r = 0; r < 4; ++r) { const int tk = 16 * m + 4 * kg + r; const float rg = sigmoidf_(ar[m][r] + b1), ig = sigmoidf_(ai_[m][r] + b2);
                    const float la = -8.0f * rg * sp; const float a = __expf(la); const float u = sqrtf(-expm1f(2.0f * la)) * ig * XC[tk * 128 + cl];
                    AA[tk * 128 + cl] = a; UU[tk * 128 + cl] = u; }
        }
        __syncthreads();
        if (tid < 128) { const int cgl = ch0 + tid;
            if (!FINAL) { float A = 1.f, H = 0.f;
                for (int t8 = 0; t8 < 64; t8 += 16) { float av[16], uv[16];
#pragma unroll
                    for (int i = 0; i < 16; ++i) { av[i] = AA[(t8 + i) * 128 + tid]; uv[i] = UU[(t8 + i) * 128 + tid]; }
#pragma unroll
                    for (int i = 0; i < 16; ++i) { H = av[i] * H + uv[i]; A *= av[i]; } }
                float* s = SUMM + ((size_t)(b * NCH + ch) * D + cgl) * 2; s[0] = A; s[1] = H; }
            else { float h = CARRY[cgl];
                for (int t8 = 0; t8 < 64; t8 += 16) { float av[16], uv[16];
#pragma unroll
                    for (int i = 0; i < 16; ++i) { av[i] = AA[(t8 + i) * 128 + tid]; uv[i] = UU[(t8 + i) * 128 + tid]; }
#pragma unroll
                    for (int i = 0; i < 16; ++i) { h = av[i] * h + uv[i]; UU[(t8 + i) * 128 + tid] = h; } }
                if (ch == NCH - 1) c.out[O_LHP + b * D + cgl] = h; } }
        __syncthreads();
        if (FINAL) { const int cg8 = tid & 15, tk = (tid >> 4) * 2;
#pragma unroll
            for (int q = 0; q < 2; ++q) { const f32x4 o0 = *(const LAS f32x4*)(UU + (tk + q) * 128 + 8 * cg8), o1 = *(const LAS f32x4*)(UU + (tk + q) * 128 + 8 * cg8 + 4);
                if (!dry) *(u32x4*)(PP + (size_t)(t0 + tk + q) * NPP + ch0 + 8 * cg8) = pack8(o0, o1); }
            __syncthreads(); }
    }
}

__device__ __forceinline__ void bc_conv(const Ctx& c, int b, int ch) {
    const int tid = otid(); const bf16_t* PP = (const bf16_t*)(c.ws + OFF_PP); bf16_t* BCc = (bf16_t*)(c.ws + OFF_XN);
    const float* cw = c.in[19]; const float* cb = c.in[20]; const int t0 = b * SEQ + 64 * ch;
#pragma unroll 1
    for (int item = tid; item < 1024; item += 512) {
        const int cgq = item & 127, st = item >> 7, gcol = 3072 + 8 * cgq, ccol = 2048 + 8 * cgq;
        u32x4 raw[11];
#pragma unroll
        for (int i = 0; i < 11; ++i) { const int tt = 8 * st - 3 + i; raw[i] = (u32x4){0u, 0u, 0u, 0u}; if (tt >= 0 || ch > 0) raw[i] = *(const u32x4*)(PP + (size_t)(t0 + tt) * NPP + gcol); }
#pragma unroll
        for (int hf = 0; hf < 2; ++hf) {
            f32x4 wk[4]; const f32x4 bb = *(const f32x4*)(cb + ccol + 4 * hf);
#pragma unroll
            for (int k = 0; k < 4; ++k) wk[k] = *(const f32x4*)(cw + k * 3072 + ccol + 4 * hf);
#pragma unroll
            for (int q = 0; q < 8; ++q) { f32x4 o = bb;
#pragma unroll
                for (int k = 0; k < 4; ++k) { const unsigned w0 = raw[q + k][2 * hf], w1 = raw[q + k][2 * hf + 1]; const f32x4 r = (f32x4){bflo(w0), bfhi(w0), bflo(w1), bfhi(w1)}; o += wk[k] * r; }
#pragma unroll
                for (int j = 0; j < 4; ++j) o[j] = siluf_(o[j]);
                unsigned* op = (unsigned*)(BCc + (size_t)(t0 + 8 * st + q) * 1024 + 8 * cgq + 4 * hf); op[0] = cvt_pk_bf16(o[0], o[1]); op[1] = cvt_pk_bf16(o[2], o[3]); }
        }
    }
}

__device__ __forceinline__ void ssd_seq(const Ctx& c, int b, int h, bool dry = false) {
    const int tid = otid(), wid = tid >> 6, lane = tid & 63, lr = lane & 15, kg = lane >> 4;
    LAS unsigned char* L = c.lds;
    LAS unsigned char* Cm = L; LAS unsigned char* Bm = L + 17408; LAS unsigned char* BdT = L + 34816; LAS unsigned char* Sb = L + 53248;
    LAS unsigned char* XdT = L + 70656; LAS unsigned char* Xr = L + 79872; LAS unsigned char* Mm = L + 89088;
    LAS float* dts = (LAS float*)(L + 98304); LAS float* css = (LAS float*)(L + 98560); LAS float* dec = (LAS float*)(L + 98816); LAS bf16_t* halo = (LAS bf16_t*)(L + 99072);
    bf16_t* PP = (bf16_t*)(c.ws + OFF_PP); const float* DT = (const float*)(c.ws + OFF_DT);
    const float* cw = c.in[19]; const float* cb = c.in[20];
    const int g = h >> 3;
    const float Ah = -__expf(c.in[22][h]), Dh = c.in[23][h], dtb = c.in[21][h];
    f32x4 accS[4];
#pragma unroll
    for (int m = 0; m < 4; ++m) accS[m] = (f32x4){0.f, 0.f, 0.f, 0.f};
    for (int e = tid; e < 64 * 136; e += 512) ((LAS bf16_t*)Sb)[e] = 0;
    const bf16_t* BCc = (const bf16_t*)(c.ws + OFF_XN);
    const int role = tid >> 7, rt = tid & 127;
    const int xg = rt & 7, xst = rt >> 3;
    const int bg8 = rt & 15, bst = rt >> 4;
    const int gcol = 1024 + 64 * h + 8 * xg, ccol = 64 * h + 8 * xg;
    const int bcol = (role == 2 ? 512 : 0) + 128 * g + 8 * bg8;
    u32x4 raw[8]; float dtv = 0.f;
    f32x4 wkk[2][4], bbb[2];
#pragma unroll
    for (int hf = 0; hf < 2; ++hf) { bbb[hf] = *(const f32x4*)(cb + ccol + 4 * hf);
#pragma unroll
        for (int k = 0; k < 4; ++k) wkk[hf][k] = *(const f32x4*)(cw + k * 3072 + ccol + 4 * hf); }
    {
        const int t0 = b * SEQ;
        if (role == 0) {
#pragma unroll
            for (int i = 0; i < 7; ++i) { const int tt = 4 * xst - 3 + i; raw[i] = (u32x4){0u, 0u, 0u, 0u}; if (tt >= 0) raw[i] = *(const u32x4*)(PP + (size_t)(t0 + tt) * NPP + gcol); } }
        else if (role < 3) {
#pragma unroll
            for (int i = 0; i < 8; ++i) raw[i] = *(const u32x4*)(BCc + (size_t)(t0 + 8 * bst + i) * 1024 + bcol); }
        if (wid == 0) dtv = DT[(size_t)(t0 + lane) * 32 + h];
    }
    for (int ch = 0; ch < NCH; ++ch) {
        const int t0 = b * SEQ + 64 * ch;
        if (wid == 0) {
            const float d = softplusf_(dtv + dtb); float sc = d * Ah;
#pragma unroll
            for (int o = 1; o < 64; o <<= 1) { const float v = __shfl_up(sc, o); if (lane >= o) sc += v; }
            const float ce = __shfl(sc, 63);
            dts[lane] = d; css[lane] = sc; dec[lane] = __expf(ce - sc);
        }
        __syncthreads();
        if (role == 0) {
            if (xst == 0 && ch > 0) {
#pragma unroll
                for (int i = 0; i < 3; ++i) raw[i] = *(const LAS u32x4*)(halo + ((ch - 1) & 1) * 192 + i * 64 + 8 * xg); }
            if (xst == 15) {
#pragma unroll
                for (int i = 0; i < 3; ++i) *(LAS u32x4*)(halo + (ch & 1) * 192 + i * 64 + 8 * xg) = raw[4 + i];
                if (ch == NCH - 1 && !dry) {
#pragma unroll
                    for (int r = 0; r < 3; ++r) { f32x4 v0, v1; unpack8(raw[4 + r], v0, v1); float* o = c.out + O_SCP + (size_t)(b * 3 + r) * 3072 + ccol; *(f32x4*)o = v0; *(f32x4*)(o + 4) = v1; } } }
            const int chunk = (xst >> 1) ^ xg;
#pragma unroll
            for (int hf = 0; hf < 2; ++hf) {
                unsigned tq[4][2];
#pragma unroll
                for (int q = 0; q < 4; ++q) { f32x4 o = bbb[hf];
#pragma unroll
                    for (int k = 0; k < 4; ++k) { const unsigned w0 = raw[q + k][2 * hf], w1 = raw[q + k][2 * hf + 1]; const f32x4 r = (f32x4){bflo(w0), bfhi(w0), bflo(w1), bfhi(w1)}; o += wkk[hf][k] * r; }
#pragma unroll
                    for (int j = 0; j < 4; ++j) o[j] = siluf_(o[j]);
                    const int l = 4 * xst + q;
                    LAS unsigned* rp = (LAS unsigned*)(Xr + l * 144 + 16 * xg + 8 * hf); rp[0] = cvt_pk_bf16(o[0], o[1]); rp[1] = cvt_pk_bf16(o[2], o[3]);
                    const float d = dts[l]; tq[q][0] = cvt_pk_bf16(o[0] * d, o[1] * d); tq[q][1] = cvt_pk_bf16(o[2] * d, o[3] * d);
                }
#pragma unroll
                for (int j2 = 0; j2 < 2; ++j2) {
                    unsigned lo[2], hi[2];
#pragma unroll
                    for (int i = 0; i < 2; ++i) { const unsigned a = tq[2 * i][j2], bq = tq[2 * i + 1][j2]; lo[i] = (a & 0xffffu) | (bq << 16); hi[i] = (a >> 16) | (bq & 0xffff0000u); }
                    LAS unsigned* p0 = (LAS unsigned*)(XdT + (8 * xg + 4 * hf + 2 * j2) * 144 + 16 * chunk + 8 * (xst & 1)); p0[0] = lo[0]; p0[1] = lo[1];
                    LAS unsigned* p1 = (LAS unsigned*)(XdT + (8 * xg + 4 * hf + 2 * j2 + 1) * 144 + 16 * chunk + 8 * (xst & 1)); p1[0] = hi[0]; p1[1] = hi[1]; }
            }
        } else if (role == 1) {
            const int chunk = bst ^ (bg8 & 7);
            unsigned tq[8][4];
#pragma unroll
            for (int q = 0; q < 8; ++q) { const int l = 8 * bst + q; *(LAS u32x4*)(Bm + l * 272 + 16 * bg8) = raw[q]; const float d = dec[l]; f32x4 v0, v1; unpack8(raw[q], v0, v1);
                tq[q][0] = cvt_pk_bf16(v0[0] * d, v0[1] * d); tq[q][1] = cvt_pk_bf16(v0[2] * d, v0[3] * d); tq[q][2] = cvt_pk_bf16(v1[0] * d, v1[1] * d); tq[q][3] = cvt_pk_bf16(v1[2] * d, v1[3] * d); }
#pragma unroll
            for (int j2 = 0; j2 < 4; ++j2) { u32x4 lo, hi;
#pragma unroll
                for (int i = 0; i < 4; ++i) { const unsigned a = tq[2 * i][j2], bq = tq[2 * i + 1][j2]; lo[i] = (a & 0xffffu) | (bq << 16); hi[i] = (a >> 16) | (bq & 0xffff0000u); }
                *(LAS u32x4*)(BdT + (8 * bg8 + 2 * j2) * 144 + 16 * chunk) = lo; *(LAS u32x4*)(BdT + (8 * bg8 + 2 * j2 + 1) * 144 + 16 * chunk) = hi; }
        } else if (role == 2) {
#pragma unroll
            for (int q = 0; q < 8; ++q) *(LAS u32x4*)(Cm + (8 * bst + q) * 272 + 16 * bg8) = raw[q];
        }
        if (ch + 1 < NCH) {
            if (role == 0) {
#pragma unroll
                for (int i = 0; i < 7; ++i) { const int tt = 4 * xst - 3 + i; if (tt >= 0) raw[i] = *(const u32x4*)(PP + (size_t)(t0 + 64 + tt) * NPP + gcol); } }
            else if (role < 3) {
#pragma unroll
                for (int i = 0; i < 8; ++i) raw[i] = *(const u32x4*)(BCc + (size_t)(t0 + 64 + 8 * bst + i) * 1024 + bcol); }
            if (wid == 0) dtv = DT[(size_t)(t0 + 64 + lane) * 32 + h];
        }
        __syncthreads();
#pragma unroll
        for (int q = 0; q < 2; ++q) { const int ti = 2 * wid + q, lt = ti >> 2, stl = ti & 3; f32x4 a4 = (f32x4){0.f, 0.f, 0.f, 0.f};
            if (stl <= lt) {
#pragma unroll
                for (int ks = 0; ks < 4; ++ks) { const bf16x8 a = *(const LAS bf16x8*)(Bm + (16 * stl + lr) * 272 + (32 * ks + 8 * kg) * 2), bq = *(const LAS bf16x8*)(Cm + (16 * lt + lr) * 272 + (32 * ks + 8 * kg) * 2);
                    a4 = __builtin_amdgcn_mfma_f32_16x16x32_bf16(a, bq, a4, 0, 0, 0); } }
            const int l = 16 * lt + lr; const float cl = css[l]; f32x4 v;
#pragma unroll
            for (int r = 0; r < 4; ++r) { const int sI = 16 * stl + 4 * kg + r; v[r] = (sI <= l) ? a4[r] * __expf(cl - css[sI]) : 0.f; }
            unsigned* dummy = nullptr; (void)dummy;
            LAS unsigned* mp = (LAS unsigned*)(Mm + l * 144 + 2 * (16 * stl + 4 * kg)); mp[0] = cvt_pk_bf16(v[0], v[1]); mp[1] = cvt_pk_bf16(v[2], v[3]); }
        __syncthreads();
#pragma unroll
        for (int q = 0; q < 2; ++q) { const int ti = 2 * wid + q, pt = ti >> 2, lt = ti & 3; f32x4 a4 = (f32x4){0.f, 0.f, 0.f, 0.f};
#pragma unroll
            for (int ks = 0; ks < 4; ++ks) { const bf16x8 a = *(const LAS bf16x8*)(Sb + (16 * pt + lr) * 272 + (32 * ks + 8 * kg) * 2), bq = *(const LAS bf16x8*)(Cm + (16 * lt + lr) * 272 + (32 * ks + 8 * kg) * 2);
                a4 = __builtin_amdgcn_mfma_f32_16x16x32_bf16(a, bq, a4, 0, 0, 0); }
            const int l = 16 * lt + lr; const float el = __expf(css[l]);
#pragma unroll
            for (int r = 0; r < 4; ++r) a4[r] *= el;
            const int prow_ = 16 * pt + lr, sw = (2 * pt + (lr >> 3)) & 7;
#pragma unroll
            for (int ks = 0; ks < 2; ++ks) { const bf16x8 a = *(const LAS bf16x8*)(XdT + prow_ * 144 + 16 * ((4 * ks + kg) ^ sw)), bq = *(const LAS bf16x8*)(Mm + (16 * lt + lr) * 144 + (32 * ks + 8 * kg) * 2);
                a4 = __builtin_amdgcn_mfma_f32_16x16x32_bf16(a, bq, a4, 0, 0, 0); }
            const int p0 = 16 * pt + 4 * kg; const LAS unsigned* xp = (const LAS unsigned*)(Xr + l * 144 + 2 * p0); const unsigned x01 = xp[0], x23 = xp[1];
            const float y0 = a4[0] + Dh * bflo(x01), y1 = a4[1] + Dh * bfhi(x01), y2 = a4[2] + Dh * bflo(x23), y3 = a4[3] + Dh * bfhi(x23);
            if (!dry) { unsigned* yp = (unsigned*)(PP + (size_t)(t0 + l) * NPP + 1024 + 64 * h + p0); yp[0] = cvt_pk_bf16(y0, y1); yp[1] = cvt_pk_bf16(y2, y3); } }
        { const float ce = __expf(css[63]); const int nrow = 16 * wid + lr, swn = (2 * wid + (lr >> 3)) & 7;
#pragma unroll
          for (int m = 0; m < 4; ++m) { accS[m] *= ce; const int prow_ = 16 * m + lr, swp = (2 * m + (lr >> 3)) & 7;
#pragma unroll
            for (int ks = 0; ks < 2; ++ks) { const bf16x8 a = *(const LAS bf16x8*)(BdT + nrow * 144 + 16 * ((4 * ks + kg) ^ swn)), bq = *(const LAS bf16x8*)(XdT + prow_ * 144 + 16 * ((4 * ks + kg) ^ swp));
                accS[m] = __builtin_amdgcn_mfma_f32_16x16x32_bf16(a, bq, accS[m], 0, 0, 0); } } }
        __syncthreads();
#pragma unroll
        for (int m = 0; m < 4; ++m) { LAS unsigned* sp = (LAS unsigned*)(Sb + (16 * m + lr) * 272 + 2 * (16 * wid + 4 * kg)); sp[0] = cvt_pk_bf16(accS[m][0], accS[m][1]); sp[1] = cvt_pk_bf16(accS[m][2], accS[m][3]); }
    }
    if (!dry) {
#pragma unroll
        for (int m = 0; m < 4; ++m) *(f32x4*)(c.out + O_SHP + ((size_t)(b * 32 + h) * 64 + 16 * m + lr) * 128 + 16 * wid + 4 * kg) = accS[m];
    }
    __syncthreads();
}

__device__ __forceinline__ void lru_sample(const Ctx& c, int b, int head) {
    const int tid = otid(); LAS float* XC = (LAS float*)c.lds; LAS float* RG = XC + 2048; LAS float* IG = RG + 2048;
    const float* PS = (const float*)(c.ws + OFF_PS); bf16_t* ABRS = (bf16_t*)(c.ws + OFF_ABRS);
    const float* cw = c.in[12]; const float* cb = c.in[13]; const int ch0 = 128 * head;
    for (int e = tid; e < 2048; e += 512) { const int tk = e >> 7, cl = e & 127, cgl = ch0 + cl; float o = cb[cgl];
#pragma unroll
        for (int k = 0; k < 4; ++k) { const int tt = tk - 3 + k; const float v = tt >= 0 ? PS[(size_t)(b * 16 + tt) * 9216 + cgl] : SZ(c.in[2][(size_t)(b * 3 + tt + 3) * D + cgl]); o += cw[k * D + cgl] * v; }
        XC[e] = o; }
    if (tid < 384) { const int r = tid >> 7, cl = tid & 127; c.out[O_LCS + (size_t)(b * 3 + r) * D + ch0 + cl] = PS[(size_t)(b * 16 + 13 + r) * 9216 + ch0 + cl]; }
    __syncthreads();
    {
        LAS unsigned char* XCb = c.lds + 32768; const int wid = tid >> 6, lane = tid & 63, lr = lane & 15, kg = lane >> 4;
        for (int e = tid; e < 2048; e += 512) *(LAS bf16_t*)(XCb + (e >> 7) * 272 + 2 * (e & 127)) = f2bf(XC[e]);
        __syncthreads();
        const bf16_t* wr_ = (const bf16_t*)(c.ws + OFF_WRG) + (size_t)(ch0 + 16 * wid + lr) * 128 + 8 * kg; const bf16_t* wi_ = (const bf16_t*)(c.ws + OFF_WIG) + (size_t)(ch0 + 16 * wid + lr) * 128 + 8 * kg;
        f32x4 ar = (f32x4){0.f, 0.f, 0.f, 0.f}, ai_ = ar;
#pragma unroll
        for (int ks = 0; ks < 4; ++ks) { const bf16x8 br = *(const bf16x8*)(wr_ + 32 * ks), bi = *(const bf16x8*)(wi_ + 32 * ks), a = *(const LAS bf16x8*)(XCb + lr * 272 + (32 * ks + 8 * kg) * 2);
            ar = __builtin_amdgcn_mfma_f32_16x16x32_bf16(a, br, ar, 0, 0, 0); ai_ = __builtin_amdgcn_mfma_f32_16x16x32_bf16(a, bi, ai_, 0, 0, 0); }
        const int cl = 16 * wid + lr; const float b1 = c.in[15][ch0 + cl], b2 = c.in[17][ch0 + cl];
#pragma unroll
        for (int r = 0; r < 4; ++r) { const int tk = 4 * kg + r; RG[tk * 128 + cl] = sigmoidf_(ar[r] + b1); IG[tk * 128 + cl] = sigmoidf_(ai_[r] + b2); }
    }
    __syncthreads();
    if (tid < 128) { const int cgl = ch0 + tid; const float sp = softplusf_(-c.in[18][cgl]); float h = SZ(c.in[3][b * D + cgl]);
        for (int tk = 0; tk < 16; ++tk) { const float la = -8.0f * RG[tk * 128 + tid] * sp, a = __expf(la), u = sqrtf(-expm1f(2.0f * la)) * IG[tk * 128 + tid] * XC[tk * 128 + tid];
            h = a * h + u; ABRS[(size_t)(b * 16 + tk) * 3072 + cgl] = f2bf(gelu_tanh(PS[(size_t)(b * 16 + tk) * 9216 + 4096 + cgl]) * h); }
        c.out[O_LHS + b * D + cgl] = h; }
    __syncthreads();
}
__device__ __forceinline__ void ssd_sample(const Ctx& c, int b, int h) {
    const int tid = otid(); LAS float* XS = (LAS float*)c.lds; LAS float* BS = XS + 1024; LAS float* CS = BS + 2048; LAS float* DTL = CS + 2048;
    const float* PS = (const float*)(c.ws + OFF_PS); const float* DTS = (const float*)(c.ws + OFF_DTS); float* YGS = (float*)(c.ws + OFF_YGS);
    const float* cw = c.in[19]; const float* cb = c.in[20]; const int g = h >> 3;
    for (int e = tid; e < 16 * 320; e += 512) { const int tk = e / 320, q = e % 320; int cc; LAS float* dst;
        if (q < 64) { cc = 64 * h + q; dst = XS + tk * 64 + q; } else if (q < 192) { cc = 2048 + 128 * g + (q - 64); dst = BS + tk * 128 + (q - 64); } else { cc = 2560 + 128 * g + (q - 192); dst = CS + tk * 128 + (q - 192); }
        float o = cb[cc];
#pragma unroll
        for (int k = 0; k < 4; ++k) { const int tt = tk - 3 + k; const float v = tt >= 0 ? PS[(size_t)(b * 16 + tt) * 9216 + 1024 + cc] : SZ(c.in[4][(size_t)(b * 3 + tt + 3) * 3072 + cc]); o += cw[k * 3072 + cc] * v; }
        *dst = siluf_(o);
        if (tk >= 13 && (q < 64 || (h & 7) == 0)) c.out[O_SCS + (size_t)(b * 3 + tk - 13) * 3072 + cc] = PS[(size_t)(b * 16 + tk) * 9216 + 1024 + cc]; }
    if (tid < 16) DTL[tid] = softplusf_(DTS[(b * 16 + tid) * 32 + h] + c.in[21][h]);
    __syncthreads();
    const float Ah = -__expf(c.in[22][h]), Dh = c.in[23][h];
    const int p = tid >> 3, n0 = (tid & 7) * 16; float hs[16];
    const float* h0 = c.in[5] + ((size_t)(b * 32 + h) * 64 + p) * 128 + n0;
#pragma unroll
    for (int j = 0; j < 16; ++j) hs[j] = SZ(h0[j]);
    float zv[16];
#pragma unroll
    for (int tk = 0; tk < 16; ++tk) zv[tk] = PS[(size_t)(b * 16 + tk) * 9216 + 5120 + 64 * h + p];
#pragma unroll
    for (int tk = 0; tk < 16; ++tk) { const float d = DTL[tk], ea = __expf(d * Ah), xv = XS[tk * 64 + p], dx = d * xv; float y = 0.f;
#pragma unroll
        for (int j = 0; j < 16; ++j) { hs[j] = ea * hs[j] + dx * BS[tk * 128 + n0 + j]; y += CS[tk * 128 + n0 + j] * hs[j]; }
        y += __shfl_xor(y, 1); y += __shfl_xor(y, 2); y += __shfl_xor(y, 4);
        if ((tid & 7) == 0) { const int row = b * 16 + tk; YGS[(size_t)row * 2048 + 64 * h + p] = (y + Dh * xv) * siluf_(zv[tk]); } }
    float* ho = c.out + O_SHS + ((size_t)(b * 32 + h) * 64 + p) * 128 + n0;
#pragma unroll
    for (int j = 0; j < 16; ++j) ho[j] = hs[j];
    __syncthreads();
}

#ifdef DIAG
constexpr size_t OFF_DIAG = 266338304;
__device__ __forceinline__ int prow(int r) { return (r >> 4) * SEQ + (r & 15); }
template <class FA, class FB>
__device__ __forceinline__ void diag_rel(LAS float* red, float* dst, int ncols, FA fa, FB fb) {
    const int tid = threadIdx.x; float num = 0.f, den = 0.f;
    for (int e = tid; e < TS * ncols; e += 512) { const int r = e / ncols, cc = e % ncols; const float a = fa(r, cc), b = fb(r, cc); num += (a - b) * (a - b); den += b * b; }
    red[tid] = num; red[512 + tid] = den; __syncthreads();
    if (tid == 0) { float n = 0.f, d = 0.f; for (int i = 0; i < 512; ++i) { n += red[i]; d += red[512 + i]; } *dst = n / (d + 1e-30f); }
    __syncthreads();
}
#endif
constexpr size_t OFF_BAR = 266338304 + 4096, OFF_SSQS = OFF_BAR + 4096;
__device__ __forceinline__ void grid_barrier(unsigned* ctr, unsigned target) {
    asm volatile("s_waitcnt vmcnt(0) lgkmcnt(0)" ::: "memory");
    __syncthreads();
    if (threadIdx.x == 0) {
        __builtin_amdgcn_fence(__ATOMIC_RELEASE, "agent");
        asm volatile("s_waitcnt vmcnt(0)" ::: "memory");
        __hip_atomic_fetch_add(ctr, 1u, __ATOMIC_RELAXED, __HIP_MEMORY_SCOPE_AGENT);
        while (__hip_atomic_load(ctr, __ATOMIC_RELAXED, __HIP_MEMORY_SCOPE_AGENT) < target) __builtin_amdgcn_s_sleep(1);
        __builtin_amdgcn_fence(__ATOMIC_ACQUIRE, "agent");
        asm volatile("s_waitcnt vmcnt(0)" ::: "memory");
    }
    __syncthreads();
}
#define XB_TMO      128
#define XB_XCNT(j)  (256  + 64 * (j))
#define XB_XSUB(j)  (1280 + 64 * (j))
#define XB_XGEN(j)  (2304 + 64 * (j))
#define XB_TOP      3328
#define XB_TOPGEN   3392
#define XCD_BAR_WORDS 3456
#define XB_SPIN_CAP (1u << 18)
constexpr size_t OFF_XBAR = 266338304 + 4096 + 4096 + 65536;
__device__ __forceinline__ unsigned xb_ld(unsigned* p)              { return __hip_atomic_load(p, __ATOMIC_RELAXED, __HIP_MEMORY_SCOPE_AGENT); }
__device__ __forceinline__ unsigned xb_add(unsigned* p, unsigned v) { return __hip_atomic_fetch_add(p, v, __ATOMIC_RELAXED, __HIP_MEMORY_SCOPE_AGENT); }
__device__ __forceinline__ unsigned xb_xcc_id() { return (unsigned)__builtin_amdgcn_s_getreg((3 << 11) | 20) & 0xFu; }
#define XB_SPIN(cond, bar) do { unsigned _sp = 0; while (cond) { __builtin_amdgcn_s_sleep(1); \
    if ((++_sp & 255u) == 0u) { if (xb_ld(&(bar)[XB_TMO])) break; if (_sp > XB_SPIN_CAP) { atomicAdd(&(bar)[XB_TMO], 1u); break; } } } } while (0)
struct XcdBarrier { unsigned* bar; unsigned x; volatile LAS unsigned* st; };
__device__ __forceinline__ XcdBarrier xcd_barrier_post(unsigned* bar, volatile LAS unsigned* st) {
    XcdBarrier b; b.bar = bar; b.x = xb_xcc_id(); b.st = st;
    if (threadIdx.x == 0) (void)xb_add(&bar[XB_XCNT(b.x)], 1u);
    return b;
}
__device__ __forceinline__ void xcd_barrier_complete(unsigned* bar, unsigned x, unsigned& nloc, unsigned& nx) {
    const unsigned G = gridDim.x * gridDim.y * gridDim.z;
    unsigned sum, cnt, mine, sp = 0u;
    for (;;) {
        sum = 0u; cnt = 0u; mine = 0u;
#pragma unroll
        for (unsigned j = 0; j < 16; ++j) { const unsigned c = xb_ld(&bar[XB_XCNT(j)]); sum += c; cnt += (c > 0u) ? 1u : 0u; mine = (j == x) ? c : mine; }
        if (sum == G) break;
        __builtin_amdgcn_s_sleep(1);
        if ((++sp & 255u) == 0u) { if (xb_ld(&bar[XB_TMO])) break; if (sp > XB_SPIN_CAP) { atomicAdd(&bar[XB_TMO], 1u); break; } }
    }
    nloc = mine > 0u ? mine : 1u; nx = cnt > 0u ? cnt : 1u;
}
__device__ __forceinline__ void xcd_barrier(const XcdBarrier& b) {
    asm volatile("s_waitcnt vmcnt(0)" ::: "memory");
    __syncthreads();
    if (threadIdx.x == 0) {
        unsigned* bar = b.bar;
        __builtin_amdgcn_s_waitcnt(0);
        unsigned nloc = b.st[0], nx = b.st[1];
        if (nloc == 0u) { xcd_barrier_complete(bar, b.x, nloc, nx); b.st[0] = nloc; b.st[1] = nx; }
        const unsigned old = xb_add(&bar[XB_XSUB(b.x)], 1u);
        const unsigned gen = old / nloc;
        if (old + 1u == (gen + 1u) * nloc) {
            __builtin_amdgcn_fence(__ATOMIC_RELEASE, "agent");
            asm volatile("s_waitcnt vmcnt(0)" ::: "memory");
            const unsigned og = xb_add(&bar[XB_TOP], 1u);
            const unsigned tg = og / nx;
            if (og + 1u == (tg + 1u) * nx) xb_add(&bar[XB_TOPGEN], 1u);
            else XB_SPIN(xb_ld(&bar[XB_TOPGEN]) == tg, bar);
            __builtin_amdgcn_fence(__ATOMIC_ACQUIRE, "agent");
            xb_add(&bar[XB_XGEN(b.x)], 1u);
            asm volatile("s_waitcnt vmcnt(0)" ::: "memory");
        } else {
            XB_SPIN(xb_ld(&bar[XB_XGEN(b.x)]) == gen, bar);
            __builtin_amdgcn_fence(__ATOMIC_ACQUIRE, "agent");
            asm volatile("s_waitcnt vmcnt(0)" ::: "memory");
        }
    }
    __syncthreads();
}
#ifndef DUPX
#define DUPX 0
#endif
#ifdef TIMER_ID
#define TSTART(id) do { if ((id) == TIMER_ID) t0_ = __builtin_amdgcn_s_memrealtime(); } while (0)
#define TSTOP(id) do { if ((id) == TIMER_ID) tacc_ += __builtin_amdgcn_s_memrealtime() - t0_; } while (0)
#else
#define TSTART(id)
#define TSTOP(id)
#endif
__global__ void __launch_bounds__(512, 2) fwd_kernel(Params prm) {
    extern __shared__ __attribute__((aligned(16))) unsigned char lds_raw[];
    Ctx c; c.in = prm.in; c.out = prm.out; c.ws = prm.ws; c.lds = (LAS unsigned char*)lds_raw;
    unsigned char* ws = prm.ws; float* out = prm.out;
    const int tid = threadIdx.x, G = gridDim.x, bid = blockIdx.x;
    bf16_t* XB = (bf16_t*)(ws + OFF_XB); bf16_t* XN = (bf16_t*)(ws + OFF_XN); bf16_t* PP = (bf16_t*)(ws + OFF_PP); float* SSQ = (float*)(ws + OFF_SSQ);
    bf16_t* XNS = (bf16_t*)(ws + OFF_XNS); bf16_t* HS = (bf16_t*)(ws + OFF_HS); float* PS = (float*)(ws + OFF_PS); float* GSSQ = (float*)(ws + OFF_GSSQ);
    float* YS = out + O_YS; float* SSQS = (float*)(ws + OFF_SSQS);
    const int lo = prm.ph_lo, hi = prm.ph_hi;
#ifdef DIAG
    if (lo >= 100) {
        if (bid != 0) return;
        float* DG = (float*)(ws + OFF_DIAG); LAS float* red = (LAS float*)c.lds; const int st = lo - 100;
        const float* DTp = (const float*)(ws + OFF_DT); const float* DTs = (const float*)(ws + OFF_DTS); const bf16_t* ABRS = (const bf16_t*)(ws + OFF_ABRS); const bf16_t* MS = (const bf16_t*)(ws + OFF_MS); const float* bg = prm.in[11];
        if (st == 0 || st == 6 || st == 7) diag_rel(red, DG + st, D, [=](int r, int cc) { return out[O_YP + (size_t)prow(r) * D + cc]; }, [=](int r, int cc) { return YS[(size_t)r * D + cc]; });
        if (st == 1) { diag_rel(red, DG + 1, NPP, [=](int r, int cc) { return bf2f(PP[(size_t)prow(r) * NPP + cc]); }, [=](int r, int cc) { return PS[(size_t)r * 9216 + cc]; });
                       diag_rel(red, DG + 2, 32, [=](int r, int cc) { return DTp[(size_t)prow(r) * 32 + cc]; }, [=](int r, int cc) { return DTs[(size_t)r * 32 + cc]; }); }
        if (st == 8) { diag_rel(red, DG + 8, D, [=](int r, int cc) { return bf2f(XN[(size_t)prow(r) * D + cc]); }, [=](int r, int cc) { return sigmoidf_(PS[(size_t)r * 9216 + 7168 + cc] + bg[cc]); });
                       diag_rel(red, DG + 9, D, [=](int r, int cc) { return bf2f(PP[(size_t)prow(r) * NPP + 3072 + cc]); }, [=](int r, int cc) { return sigmoidf_(PS[(size_t)r * 9216 + 8192 + cc] + bg[1024 + cc]); }); }
        if (st == 3) { diag_rel(red, DG + 3, D, [=](int r, int cc) { return bf2f(PP[(size_t)prow(r) * NPP + cc]); }, [=](int r, int cc) { return bf2f(ABRS[(size_t)r * 3072 + cc]); });
                       diag_rel(red, DG + 4, 2048, [=](int r, int cc) { return bf2f(PP[(size_t)prow(r) * NPP + 1024 + cc]); }, [=](int r, int cc) { return bf2f(ABRS[(size_t)r * 3072 + 1024 + cc]); }); }
        if (st == 5) diag_rel(red, DG + 5, D, [=](int r, int cc) { return bf2f(XN[(size_t)prow(r) * D + cc]); }, [=](int r, int cc) { return bf2f(MS[(size_t)r * D + cc]); });
        if (st == 20) {
            int mask = 0; if (!(DG[8] < DIAG_TOL)) mask |= 1; if (!(DG[9] < DIAG_TOL)) mask |= 2; if (!(DG[3] < DIAG_TOL)) mask |= 4; if (!(DG[4] < DIAG_TOL)) mask |= 8; if (!(DG[5] < DIAG_TOL)) mask |= 16;
            if (mask == 0) { if (!(DG[6] < DIAG_TOL)) mask |= 32; if (!(DG[7] < DIAG_TOL)) mask |= 64; }
            float code = mask ? 100.f * (1 + mask) : 0.f;
            if (code > 0.f) for (int e = tid; e < TS * D; e += 512) YS[e] = code;
        }
        return;
    }
#endif
#ifndef PHMASK
#define PHMASK 0x1fff
#endif
#define IN(k) (((PHMASK >> (k)) & 1) && lo <= (k) && (k) < hi)
    unsigned* barctr = (unsigned*)(ws + OFF_BAR); unsigned nbar = 0; (void)barctr;
    volatile LAS unsigned* xbst = (volatile LAS unsigned*)(c.lds + LDS_BYTES - 16);
    if (tid < 4) xbst[tid] = 0u;
    __syncthreads();
    XcdBarrier xbar; xbar.bar = (unsigned*)(ws + OFF_XBAR); xbar.x = 0; xbar.st = xbst;
    if (hi - lo > 1) xbar = xcd_barrier_post((unsigned*)(ws + OFF_XBAR), xbst);
    unsigned long long t0_ = 0, tacc_ = 0; (void)t0_; (void)tacc_;
#define SEAM(k) do { if (IN(k) && IN((k) + 1)) { TSTART(12); ++nbar; xcd_barrier(xbar); TSTOP(12); } } while (0)
    auto rm_id = [](int col0, int) { return col0; };
    auto rm_up = [](int col0, int panel) { return (col0 >> 7) * 256 + panel * 128 + (col0 & 127); };

    if (IN(0)) {
        TSTART(0); prep_weights(c);
#if DUPX == 1
        prep_weights(c);
#endif
        rmsnorm_rows_bf16(prm.in[0], T, prm.in[6], XN); TSTOP(0);
#ifdef DIAG
        { const int t_ = otid(), lane = t_ & 63; for (int r = bid * 8 + (t_ >> 6); r < TS; r += G * 8) { const float* p = prm.in[0] + (size_t)prow(r) * D; float v[16]; float s = 0.f;
            for (int i = 0; i < 16; ++i) { v[i] = p[lane + 64 * i]; s += v[i] * v[i]; }
            for (int o = 1; o < 64; o <<= 1) s += __shfl_xor(s, o);
            const float inv = rsqrtf(s * (1.0f / 1024.0f) + EPS);
            for (int i = 0; i < 16; ++i) XNS[(size_t)r * D + lane + 64 * i] = f2bf(v[i] * inv * prm.in[6][lane + 64 * i]); } }
#else
        rmsnorm_rows_bf16(prm.in[1], TS, prm.in[6], XNS);
#endif
    }
    SEAM(0);
    if (IN(1)) {
        pg8::Gemm g{XN, D, (const bf16_t*)(ws + OFF_WUP1), D, T, 2 * FF, D}; pg8::StaticOrder S; S.init(T, 2 * FF, G, bid);

#if DUPX == 5
        pg8::gemm_phase(c.lds, g, S, EpiSwiglu{PP, (LAS const float*)nullptr});
#endif
        TSTART(1); pg8::gemm_phase(c.lds, g, S, EpiSwiglu{PP, (LAS const float*)nullptr}); TSTOP(1);
        TSTART(2); sgemm<16, 2, D>(c.lds, XNS, D, (const bf16_t*)(ws + OFF_WUP1), D, FF, nullptr, nullptr, rm_up,
            [=](int r, int cc, float v0, float v1, float) { HS[(size_t)r * FF + cc] = f2bf(siluf_(v0) * v1); return 0.f; }, G / 2); TSTOP(2);
    }
    SEAM(1);
    if (IN(2)) {
        pg8::Gemm g{PP, FF, (const bf16_t*)(ws + OFF_WDN1), FF, T, D, FF}; pg8::StaticOrder S; S.init(T, D, G, bid);
        TSTART(10); pg8::gemm_phase(c.lds, g, S, EpiResid{prm.in[0], out + O_YP, XB, SSQ, 0.5f}); TSTOP(10);
        const float* xs_in = prm.in[1];
        TSTART(2); sgemm<16, 1, FF>(c.lds, HS, FF, (const bf16_t*)(ws + OFF_WDN1), FF, D, nullptr, SSQS, rm_id,
            [=](int r, int cc, float v0, float, float) {
#ifdef DIAG
            const float x = prm.in[0][(size_t)prow(r) * D + cc] + 0.5f * v0;
#else
            const float x = xs_in[(size_t)r * D + cc] + 0.5f * v0;
#endif
            YS[(size_t)r * D + cc] = x; XNS[(size_t)r * D + cc] = f2bf(x); return x; }); TSTOP(2);
    }
    SEAM(2);
    if (IN(3)) {
        pg8::Gemm g{XB, D, (const bf16_t*)(ws + OFF_WIN), D, T, NPP, D}; pg8::StaticOrder S; S.init(T, NPP, G, bid);

#if DUPX == 6
        pg8::gemm_phase(c.lds, g, S, EpiScaleBf16{PP, SSQ});
#endif
        LAS const float* linv = fill_inv(c.lds, SSQ); TSTART(11); pg8::gemm_phase(c.lds, g, S, EpiScaleBf16{PP, linv}); TSTOP(11);
        float* DTp = (float*)(ws + OFF_DT); float* DTs = (float*)(ws + OFF_DTS);
        TSTART(2);
        {
            const int t_ = otid(), wv = t_ >> 6, ln = t_ & 63, lr = ln & 15, kg = ln >> 4; const bf16_t* WDT = (const bf16_t*)(ws + OFF_WDT);
            for (int wt = bid * 8 + wv; wt < T / 16; wt += G * 8) {
                f32x4 a0 = (f32x4){0.f, 0.f, 0.f, 0.f}, a1 = a0; f32x4 sq[4][4];
#pragma unroll
                for (int r = 0; r < 4; ++r)
#pragma unroll
                    for (int i = 0; i < 4; ++i) sq[r][i] = *(const f32x4*)(SSQ + (size_t)(16 * wt + 4 * kg + r) * 16 + 4 * i);
                const bf16_t* ap = XB + (size_t)(16 * wt + lr) * D + 8 * kg; const bf16_t* bp = WDT + (size_t)lr * D + 8 * kg;
#pragma unroll 8
                for (int k = 0; k < D; k += 32) { const bf16x8 a = *(const bf16x8*)(ap + k), b0 = *(const bf16x8*)(bp + k), b1 = *(const bf16x8*)(bp + 16 * D + k);
                    a0 = __builtin_amdgcn_mfma_f32_16x16x32_bf16(a, b0, a0, 0, 0, 0); a1 = __builtin_amdgcn_mfma_f32_16x16x32_bf16(a, b1, a1, 0, 0, 0); }
#pragma unroll
                for (int r = 0; r < 4; ++r) { const int row = 16 * wt + 4 * kg + r; const f32x4 sm = (sq[r][0] + sq[r][1]) + (sq[r][2] + sq[r][3]); const float inv = rsqrtf(((sm[0] + sm[1]) + (sm[2] + sm[3])) * (1.0f / 1024.0f) + EPS); DTp[(size_t)row * 32 + lr] = a0[r] * inv; DTp[(size_t)row * 32 + 16 + lr] = a1[r] * inv; }
            }
        }
        TSTOP(2);
        TSTART(2); sgemm<32, 1, D>(c.lds, XNS, D, (const bf16_t*)(ws + OFF_WIN), D, 9216, SSQS, nullptr, rm_id,
            [=](int r, int cc, float v0, float, float inv) { PS[(size_t)r * 9216 + cc] = v0 * inv; return 0.f; }); TSTOP(2);
        TSTART(2); sgemm<32, 1, D>(c.lds, XNS, D, (const bf16_t*)(ws + OFF_WDT), D, 32, SSQS, nullptr, rm_id,
            [=](int r, int cc, float v0, float, float inv) { DTs[(size_t)r * 32 + cc] = v0 * inv; return 0.f; }); TSTOP(2);
    }
    SEAM(3);
    if (IN(4)) {
        for (int e = bid * 512 + tid; e < 8 * 3 * 2048; e += G * 512) {
            const int cc = e & 2047, r = (e >> 11) % 3, b = e / (3 * 2048); const size_t row = (size_t)b * SEQ + 2045 + r;
            if (cc < 1024) out[O_LCP + (size_t)(b * 3 + r) * D + cc] = bf2f(PP[row * NPP + cc]);
            else out[O_SCP + (size_t)(b * 3 + r) * 3072 + 2048 + (cc - 1024)] = bf2f(PP[row * NPP + 3072 + (cc - 1024)]); }

#if DUPX == 4
        for (int it = bid; it < 256; it += G) lru_chunk<false>(c, it >> 5, it & 31);
#endif
        TSTART(19); for (int it = bid; it < 256; it += G) bc_conv(c, it >> 5, it & 31); TSTOP(19);
        TSTART(3); for (int it = bid; it < 256; it += G) lru_chunk<false>(c, it >> 5, it & 31); TSTOP(3);

#if DUPX == 3
        for (int it = bid; it < 256; it += G) ssd_seq(c, it >> 5, it & 31, prm.ph_lo == 0);
#endif


    }
    SEAM(4);
    if (IN(5)) {

#if DUPX == 2
        for (int it = bid; it < 256; it += G) lru_chunk<true>(c, it >> 5, it & 31, prm.ph_lo == 0);
#endif
        TSTART(4); for (int it = bid; it < 256; it += G) ssd_seq(c, it >> 5, it & 31); TSTOP(4);
        TSTART(5); for (int it = bid; it < 256; it += G) lru_chunk<true>(c, it >> 5, it & 31); TSTOP(5);
        TSTART(2); for (int it = bid; it < 64; it += G) lru_sample(c, it >> 3, it & 7); TSTOP(2);
        TSTART(2); for (int it = bid; it < 256; it += G) ssd_sample(c, it >> 5, it & 31); TSTOP(2);
    }
    SEAM(5);
    if (IN(6)) { TSTART(8);
        {
        const float* YGS = (const float*)(ws + OFF_YGS); bf16_t* ABRS = (bf16_t*)(ws + OFF_ABRS);
        const int lane = tid & 63;
        for (int w = bid * 8 + (tid >> 6); w < TS * 4; w += G * 8) { const int r = w >> 2, gq = w & 3; const float* p = YGS + (size_t)r * 2048 + 512 * gq; float v[8]; float s = 0.f;
#pragma unroll
            for (int j = 0; j < 8; ++j) { v[j] = p[lane + 64 * j]; s += v[j] * v[j]; }
#pragma unroll
            for (int o = 1; o < 64; o <<= 1) s += __shfl_xor(s, o);
            const float inv = rsqrtf(s * (1.0f / 512.0f) + EPS);
#pragma unroll
            for (int j = 0; j < 8; ++j) ABRS[(size_t)r * 3072 + 1024 + 512 * gq + lane + 64 * j] = f2bf(v[j] * inv); }
        }
        LAS const float* linv = fill_inv(c.lds, SSQ);
        { pg8::Gemm g{XB, D, (const bf16_t*)(ws + OFF_WIN) + (size_t)4096 * D, D, T, 3072, D}; pg8::StaticOrder S; S.init(T, 3072, G, bid);
          pg8::gemm_phase(c.lds, g, S, EpiGatesA{PP, linv, GSSQ}); }
        { pg8::Gemm g{XB, D, (const bf16_t*)(ws + OFF_WIN) + (size_t)7168 * D, D, T, D, D}; pg8::StaticOrder S; S.init(T, D, G, bid);
          pg8::gemm_phase(c.lds, g, S, EpiSigmoid{XN, D, linv, prm.in[11]}); }
        { pg8::Gemm g{XB, D, (const bf16_t*)(ws + OFF_WIN) + (size_t)8192 * D, D, T, D, D}; pg8::StaticOrder S; S.init(T, D, G, bid);
          pg8::gemm_phase(c.lds, g, S, EpiSigmoid{PP + 3072, NPP, linv, prm.in[11] + 1024}); } TSTOP(8);
    }
    SEAM(6);
    if (IN(7)) { TSTART(6);
        const int lane = tid & 63;
        for (int r = bid * 8 + (tid >> 6); r < T; r += G * 8) {
            float s = (lane < 32) ? GSSQ[(size_t)r * 32 + lane] : 0.f;
            s += __shfl_xor(s, 1); s += __shfl_xor(s, 2); s += __shfl_xor(s, 4);
            const float i0 = rsqrtf(__shfl(s, 0) * (1.0f / 512.0f) + EPS), i1 = rsqrtf(__shfl(s, 8) * (1.0f / 512.0f) + EPS), i2 = rsqrtf(__shfl(s, 16) * (1.0f / 512.0f) + EPS), i3 = rsqrtf(__shfl(s, 24) * (1.0f / 512.0f) + EPS);
#pragma unroll
            for (int i = 0; i < 4; ++i) { const float inv = i == 0 ? i0 : (i == 1 ? i1 : (i == 2 ? i2 : i3));
                bf16_t* p = PP + (size_t)r * NPP + 1024 + 512 * i + 8 * lane; f32x4 a, bq; unpack8(*(const u32x4*)p, a, bq); *(u32x4*)p = pack8(a * inv, bq * inv); }
        }
    }
    TSTOP(6); SEAM(7);
    if (IN(8)) {
        TSTART(9); { pg8::Gemm g{PP, NPP, (const bf16_t*)(ws + OFF_WBR), 3072, T, D, D}; pg8::StaticOrder S; S.init(T, D, G, bid); pg8::gemm_phase(c.lds, g, S, EpiBr{XN, PP, 0}); }
        { pg8::Gemm g{PP + 1024, NPP, (const bf16_t*)(ws + OFF_WBR) + 1024, 3072, T, D, 2048}; pg8::StaticOrder S; S.init(T, D, G, bid); pg8::gemm_phase(c.lds, g, S, EpiBr{XN, PP, 1}); } TSTOP(9);
        const bf16_t* ABRS = (const bf16_t*)(ws + OFF_ABRS); float* M1S = (float*)(ws + OFF_M1S); bf16_t* MS = (bf16_t*)(ws + OFF_MS); const float* bg = prm.in[11];
        TSTART(2); sgemm<16, 1, D>(c.lds, ABRS, 3072, (const bf16_t*)(ws + OFF_WBR), 3072, D, nullptr, nullptr, rm_id,
            [=](int r, int cc, float v0, float, float) { M1S[(size_t)r * D + cc] = sigmoidf_(PS[(size_t)r * 9216 + 7168 + cc] + bg[cc]) * v0; return 0.f; }); TSTOP(2);
        TSTART(2); sgemm<16, 1, 2048>(c.lds, ABRS + 1024, 3072, (const bf16_t*)(ws + OFF_WBR) + 1024, 3072, D, nullptr, nullptr, rm_id,
            [=](int r, int cc, float v0, float, float) { MS[(size_t)r * D + cc] = f2bf(M1S[(size_t)r * D + cc] + sigmoidf_(PS[(size_t)r * 9216 + 8192 + cc] + bg[1024 + cc]) * v0); return 0.f; }); TSTOP(2);
    }
    SEAM(8);
    if (IN(9)) {
        pg8::Gemm g{XN, D, (const bf16_t*)(ws + OFF_WOUT), D, T, D, D}; pg8::StaticOrder S; S.init(T, D, G, bid);
        TSTART(16); pg8::gemm_phase(c.lds, g, S, EpiResid{out + O_YP, out + O_YP, XB, SSQ, 1.0f}); TSTOP(16);
        const bf16_t* MS = (const bf16_t*)(ws + OFF_MS);
        TSTART(2); sgemm<16, 1, D>(c.lds, MS, D, (const bf16_t*)(ws + OFF_WOUT), D, D, nullptr, SSQS + 8192, rm_id,
            [=](int r, int cc, float v0, float, float) { const float x = YS[(size_t)r * D + cc] + v0; YS[(size_t)r * D + cc] = x; XNS[(size_t)r * D + cc] = f2bf(x); return x; }); TSTOP(2);
    }
    SEAM(9);
    if (IN(10)) {
        pg8::Gemm g{XB, D, (const bf16_t*)(ws + OFF_WUP2), D, T, 2 * FF, D}; pg8::StaticOrder S; S.init(T, 2 * FF, G, bid);
        LAS const float* linv = fill_inv(c.lds, SSQ);
        TSTART(17); pg8::gemm_phase(c.lds, g, S, EpiSwiglu{PP, linv}); TSTOP(17);
        TSTART(2); sgemm<16, 2, D>(c.lds, XNS, D, (const bf16_t*)(ws + OFF_WUP2), D, FF, SSQS + 8192, nullptr, rm_up,
            [=](int r, int cc, float v0, float v1, float inv) { HS[(size_t)r * FF + cc] = f2bf(siluf_(v0 * inv) * (v1 * inv)); return 0.f; }, G / 2); TSTOP(2);
    }
    SEAM(10);
    if (IN(11)) {
        pg8::Gemm g{PP, FF, (const bf16_t*)(ws + OFF_WDN2), FF, T, D, FF}; pg8::StaticOrder S; S.init(T, D, G, bid);
        TSTART(18); pg8::gemm_phase(c.lds, g, S, EpiResid{out + O_YP, out + O_YP, nullptr, SSQ, 0.5f}); TSTOP(18);
        TSTART(2); sgemm<16, 1, FF>(c.lds, HS, FF, (const bf16_t*)(ws + OFF_WDN2), FF, D, nullptr, nullptr, rm_id,
            [=](int r, int cc, float v0, float, float) { YS[(size_t)r * D + cc] += 0.5f * v0; return 0.f; }); TSTOP(2);
    }
    SEAM(11);
    if (IN(12)) {
        TSTART(7); rmsnorm_rows_f32(out + O_YP, T + TS, prm.in[31]); TSTOP(7);
    }
#ifdef TIMER_ID
    if (hi == 13) { ++nbar; grid_barrier(barctr, nbar * (unsigned)G);
        if (bid == TIMER_BLOCK) { const float us = (float)tacc_ * 0.0001f; for (int e = tid; e < TS * D; e += 512) YS[e] = us; } }
#endif
#undef IN
#undef SEAM
}

#ifndef N_LAUNCH_MODE
#define N_LAUNCH_MODE 1
#endif
extern "C" void kernel_launch(void* const* d_in, const int* in_sizes, int n_in, void* d_out, int out_size, void* d_ws, size_t ws_size, hipStream_t stream) {
    static int grid = 0;
    if (grid == 0) {
        if (n_in != 32 || ws_size < OFF_XBAR + XCD_BAR_WORDS * 4) { fprintf(stderr, "kernel_launch: unexpected n_in %d or ws_size %zu (< %zu)\n", n_in, ws_size, (size_t)WS_END); grid = -1; return; }
        int dev = 0, cus = 0, per_cu = 0;
        hipGetDevice(&dev); hipDeviceGetAttribute(&cus, hipDeviceAttributeMultiprocessorCount, dev);
        if (hipFuncSetAttribute((const void*)fwd_kernel, hipFuncAttributeMaxDynamicSharedMemorySize, LDS_BYTES) != hipSuccess) { fprintf(stderr, "kernel_launch: hipFuncSetAttribute failed\n"); grid = -1; return; }
        hipOccupancyMaxActiveBlocksPerMultiprocessor(&per_cu, (const void*)fwd_kernel, 512, LDS_BYTES);
        if (per_cu < 1) { fprintf(stderr, "kernel_launch: occupancy query says %d blocks per CU\n", per_cu); per_cu = 1; }
        grid = cus * 1;
        (void)hipGetLastError();
    }
    if (grid < 0) return;
    Params p{};
    for (int i = 0; i < 32; ++i) p.in[i] = (const float*)d_in[i];
    p.out = (float*)d_out; p.ws = (unsigned char*)d_ws;
#if N_LAUNCH_MODE == 0
    for (int ph = 0; ph < 13; ++ph) { p.ph_lo = ph; p.ph_hi = ph + 1; hipLaunchKernelGGL(fwd_kernel, dim3(grid), dim3(512), LDS_BYTES, stream, p);
#ifdef DIAG
        int st = -1; if (ph == 2) st = 0; if (ph == 3) st = 1; if (ph == 6) st = 8; if (ph == 7) st = 3; if (ph == 8) st = 5; if (ph == 9) st = 6; if (ph == 11) st = 7; if (ph == 12) st = 20;
        if (st >= 0) { p.ph_lo = 100 + st; p.ph_hi = 0; hipLaunchKernelGGL(fwd_kernel, dim3(grid), dim3(512), LDS_BYTES, stream, p); }
#endif
    }
#else
    p.ph_lo = 0; p.ph_hi = 13;
    hipMemsetAsync((char*)d_ws + OFF_XBAR, 0, XCD_BAR_WORDS * 4, stream);
    void* args[] = {&p};
    hipError_t e = hipLaunchCooperativeKernel((const void*)fwd_kernel, dim3(grid), dim3(512), args, LDS_BYTES, stream);
    if (e != hipSuccess) fprintf(stderr, "cooperative launch failed: %s (grid %d)\n", hipGetErrorString(e), grid);
#endif
}
```

```cpp
#include <hip/hip_runtime.h>
#include <hip/hip_cooperative_groups.h>
#include <cstdio>
namespace cg = cooperative_groups;

#define LAS __attribute__((address_space(3)))
typedef unsigned short bf16_t;
typedef short bf16x8 __attribute__((ext_vector_type(8)));
typedef float f32x4 __attribute__((ext_vector_type(4)));
typedef unsigned u32x4 __attribute__((ext_vector_type(4)));

constexpr int T = 16384, TS = 128, D = 1024, FF = 2816, NPP = 4096, SEQ = 2048, NCH = 32;
constexpr float EPS = 1e-6f;
constexpr size_t OFF_WUP1 = 0, OFF_WDN1 = 11534336;
constexpr size_t OFF_DT = 0, OFF_SUMM = 2097152, OFF_HALO = 4194304, OFF_GSSQ = 5767168, OFF_PS = 7864320,
                 OFF_DTS = 12582912, OFF_YGS = 12599296, OFF_ABRS = 13647872, OFF_M1S = 14434304, OFF_MS = 14958592;
constexpr size_t OFF_WIN = 17301504, OFF_WDT = 36175872, OFF_WBR = 36241408, OFF_WOUT = 42532864, OFF_WUP2 = 44630016,
                 OFF_WDN2 = 56164352, OFF_WRG = 61931520, OFF_WIG = 62193664, OFF_XB = 62455808, OFF_XN = 96010240,
                 OFF_PP = 129564672, OFF_SSQ = 263782400, OFF_XNS = 264830976, OFF_HS = 265093120, WS_END = 265814016;
constexpr size_t O_YP = 0, O_YS = 16777216, O_LCP = 16908288, O_LHP = 16932864, O_SCP = 16941056, O_SHP = 17014784,
                 O_LCS = 19111936, O_LHS = 19136512, O_SCS = 19144704, O_SHS = 19218432;
constexpr int LDS_BYTES = 143360;
constexpr int LDS_INV = 131072;

struct Params { const float* in[32]; float* out; unsigned char* ws; int ph_lo, ph_hi; };

#ifdef DIAG
#define SZ(x) 0.0f
#ifndef DIAG_TOL
#define DIAG_TOL 0.01f
#endif
#else
#define SZ(x) (x)
#endif
__device__ __forceinline__ int otid() { int t = threadIdx.x; asm volatile("" : "+v"(t)); return t; }
__device__ __forceinline__ unsigned cvt_pk_bf16(float lo, float hi) { unsigned r; asm volatile("v_cvt_pk_bf16_f32 %0, %1, %2" : "=v"(r) : "v"(lo), "v"(hi)); return r; }
__device__ __forceinline__ bf16_t f2bf(float f) { return (bf16_t)(cvt_pk_bf16(f, 0.f) & 0xffffu); }
__device__ __forceinline__ float bf2f(bf16_t b) { return __uint_as_float(((unsigned)b) << 16); }
__device__ __forceinline__ float bflo(unsigned w) { return __uint_as_float(w << 16); }
__device__ __forceinline__ float bfhi(unsigned w) { return __uint_as_float(w & 0xffff0000u); }
__device__ __forceinline__ float sigmoidf_(float x) { return __builtin_amdgcn_rcpf(1.0f + __expf(-x)); }
__device__ __forceinline__ float siluf_(float x) { return x * sigmoidf_(x); }
__device__ __forceinline__ float gelu_tanh(float x) { const float u = 0.7978845608028654f * (x + 0.044715f * x * x * x); return x * sigmoidf_(2.0f * u); }
__device__ __forceinline__ float softplusf_(float x) { return x > 20.f ? x : log1pf(__expf(x)); }
__device__ __forceinline__ u32x4 pack8(const f32x4 a, const f32x4 b) { u32x4 w; w.x = cvt_pk_bf16(a[0], a[1]); w.y = cvt_pk_bf16(a[2], a[3]); w.z = cvt_pk_bf16(b[0], b[1]); w.w = cvt_pk_bf16(b[2], b[3]); return w; }
__device__ __forceinline__ void unpack8(const u32x4 w, f32x4& a, f32x4& b) { a[0] = bflo(w.x); a[1] = bfhi(w.x); a[2] = bflo(w.y); a[3] = bfhi(w.y); b[0] = bflo(w.z); b[1] = bfhi(w.z); b[2] = bflo(w.w); b[3] = bfhi(w.w); }
__device__ __forceinline__ float rowinv16(const float* ssq, int row) {
    const f32x4* p = (const f32x4*)(ssq + (size_t)row * 16); const f32x4 a = p[0], b = p[1], c = p[2], d = p[3];
    const float s = ((a[0] + a[1]) + (a[2] + a[3])) + ((b[0] + b[1]) + (b[2] + b[3])) + ((c[0] + c[1]) + (c[2] + c[3])) + ((d[0] + d[1]) + (d[2] + d[3]));
    return rsqrtf(s * (1.0f / 1024.0f) + EPS);
}

namespace pg8 {
constexpr int BM = 256, BK = 64, HALF = 128, HTB = HALF * BK * 2, STAGE_BYTES = 8 * HTB, NXCD = 8, WGM = 8;
__device__ __forceinline__ int lds_byte(int r, int c) { const int st = (r >> 4) * 2 + (c >> 5), rr = r & 15, cc = c & 31, ob = rr * 64 + cc * 2; return st * 1024 + (ob ^ (((ob >> 9) & 1) << 5)); }
__device__ __forceinline__ void stage_rc(int b, int& R, int& C) { const int st = b / 1024, sb = b % 1024, swz = sb ^ (((sb >> 9) & 1) << 5); R = (st >> 1) * 16 + swz / 64; C = (st & 1) * 32 + (swz % 64) / 2; }
__device__ __forceinline__ int perm32(int rho) { const int n = rho >> 4, i = rho & 15; return 8 * (i >> 2) + 4 * n + (i & 3); }
struct Unit { int pm, pn; };
struct Gemm { const bf16_t* A; int lda; const bf16_t* Bt; int ldb; int M, N, K; };
struct StaticOrder {
    int nM, nN, nwg, G, c;
    __device__ __forceinline__ void init(int M, int N, int G_, int c_) { nM = M / BM; nN = N / BM; nwg = nM * nN; G = G_; c = c_; }
    __device__ __forceinline__ bool next(int i, Unit& u) const {
        const long L = (long)i * G + c; if (L >= nwg) return false;
        int wgid = (int)L; { const int q = nwg / NXCD, r = nwg % NXCD, xcd = wgid % NXCD, off = wgid / NXCD; wgid = (xcd < r ? xcd * (q + 1) : r * (q + 1) + (xcd - r) * q) + off; }
        const int nig = WGM * nN, gid = wgid / nig, fm = gid * WGM, gsz = (nM - fm) < WGM ? (nM - fm) : WGM;
        u.pm = fm + ((wgid % nig) % gsz); u.pn = (wgid % nig) / gsz; return true;
    }
};
template <class Epi>
__device__ __forceinline__ void gemm_phase(LAS unsigned char* lds, const Gemm g, const StaticOrder& S, const Epi& E) {
    const int tid = otid(), wid = __builtin_amdgcn_readfirstlane(tid >> 6), lane = tid & 63, wr = wid >> 2, wc = wid & 3, fr = lane & 15, fq = lane >> 4;
    const int K = g.K, nt = K / BK;
    unsigned voffA[2], voffB[2];
#pragma unroll
    for (int i = 0; i < 2; ++i) { int R, C; stage_rc(tid * 16 + i * 8192, R, C); const int Rb = (R & ~31) + perm32(R & 31);
        voffA[i] = (unsigned)(R * g.lda + C) * 2u; voffB[i] = (unsigned)(Rb * g.ldb + C) * 2u; }
    const size_t kstep = (size_t)(BK * 2);
    const size_t hstepA = (size_t)HALF * g.lda * 2, hstepB = (size_t)HALF * g.ldb * 2;
    const size_t tstepA = 2 * hstepA, tstepB = 2 * hstepB;
    const unsigned ldsw = (unsigned)wid * 1024u;
    const int aoff = lds_byte(wr * 64 + fr, fq * 8), boff = lds_byte(wc * 32 + fr, fq * 8);
#define PG8_SA(b, h) (((b) * 2 + (h)) * HTB)
#define PG8_SB(b, h) ((4 + (b) * 2 + (h)) * HTB)
#define PG8_STAGE(bufoff, gbase, voff) do { _Pragma("unroll") for (int _i = 0; _i < 2; ++_i) \
        __builtin_amdgcn_global_load_lds((const unsigned*)((const char*)(gbase) + (voff)[_i]), (LAS unsigned*)(lds + (bufoff) + ldsw + _i * 8192), 16, 0, 0); } while (0)
#define PG8_LDA(dst, b, h) do { _Pragma("unroll") for (int m = 0; m < 4; ++m) _Pragma("unroll") for (int k = 0; k < 2; ++k) dst[m][k] = *(const LAS bf16x8*)(lds + PG8_SA(b, h) + aoff + m * 2048 + k * 1024); } while (0)
#define PG8_LDB(dst, b, h) do { _Pragma("unroll") for (int n = 0; n < 2; ++n) _Pragma("unroll") for (int k = 0; k < 2; ++k) dst[n][k] = *(const LAS bf16x8*)(lds + PG8_SB(b, h) + boff + n * 2048 + k * 1024); } while (0)
#define PG8_MMA(ai, bj, At, Bt) do { __builtin_amdgcn_s_setprio(1); _Pragma("unroll") for (int m = 0; m < 4; ++m) _Pragma("unroll") for (int n = 0; n < 2; ++n) _Pragma("unroll") for (int k = 0; k < 2; ++k) \
        acc[ai][bj][m][n] = __builtin_amdgcn_mfma_f32_16x16x32_bf16(Bt[n][k], At[m][k], acc[ai][bj][m][n], 0, 0, 0); __builtin_amdgcn_s_setprio(0); } while (0)
#define PG8_WAIT_V(n) asm volatile("s_waitcnt vmcnt(" #n ")" ::: "memory")
#define PG8_WAIT_L(n) asm volatile("s_waitcnt lgkmcnt(" #n ")" ::: "memory")
#define PG8_BAR __builtin_amdgcn_s_barrier()
#define PG8_SCHED __builtin_amdgcn_sched_barrier(0)
    Unit cur, nxt; int ui = 0;
    if (!S.next(0, cur)) return;
    f32x4 acc[2][2][4][2];
#pragma unroll
    for (int a = 0; a < 2; ++a)
#pragma unroll
        for (int b = 0; b < 2; ++b)
#pragma unroll
            for (int m = 0; m < 4; ++m)
#pragma unroll
                for (int n = 0; n < 2; ++n) acc[a][b][m][n] = (f32x4){0.f, 0.f, 0.f, 0.f};
    bf16x8 At[4][2], B0[2][2], B1[2][2];
    const char* cA = (const char*)g.A + (size_t)cur.pm * tstepA; const char* cB = (const char*)g.Bt + (size_t)cur.pn * tstepB;
    PG8_STAGE(PG8_SB(0, 0), cB, voffB); PG8_STAGE(PG8_SA(0, 0), cA, voffA); PG8_STAGE(PG8_SB(0, 1), cB + hstepB, voffB); PG8_STAGE(PG8_SA(0, 1), cA + hstepA, voffA);
    if (wr == 1) PG8_BAR;
    PG8_WAIT_V(4); PG8_BAR;
    PG8_STAGE(PG8_SB(1, 0), cB + kstep, voffB); PG8_STAGE(PG8_SA(1, 0), cA + kstep, voffA); PG8_STAGE(PG8_SB(1, 1), cB + hstepB + kstep, voffB);
    PG8_WAIT_V(6); PG8_BAR;
    for (;;) {
        const bool has_next = S.next(ui + 1, nxt);
        const char* nA = has_next ? (const char*)g.A + (size_t)nxt.pm * tstepA : cA; const char* nB = has_next ? (const char*)g.Bt + (size_t)nxt.pn * tstepB : cB;
        for (int t = 0; t < nt; t += 2) {
            const bool last = (t == nt - 2);
            const char* a1 = cA + (size_t)(t + 1) * kstep;
            const char* a2 = last ? nA : cA + (size_t)(t + 2) * kstep; const char* b2 = last ? nB : cB + (size_t)(t + 2) * kstep;
            const char* a3 = a2 + kstep; const char* b3 = b2 + kstep;
            PG8_LDB(B0, 0, 0); PG8_SCHED; PG8_LDA(At, 0, 0); PG8_STAGE(PG8_SA(1, 1), a1 + hstepA, voffA);
            PG8_WAIT_L(8); PG8_BAR; PG8_WAIT_L(0); PG8_MMA(0, 0, At, B0); PG8_BAR; PG8_SCHED;
            PG8_LDB(B1, 0, 1); PG8_STAGE(PG8_SB(0, 0), b2, voffB);
            PG8_BAR; PG8_WAIT_L(0); PG8_MMA(0, 1, At, B1); PG8_BAR;
            PG8_LDA(At, 0, 1); PG8_STAGE(PG8_SA(0, 0), a2, voffA);
            PG8_BAR; PG8_WAIT_L(0); PG8_MMA(1, 0, At, B0); PG8_BAR; PG8_SCHED;
            PG8_STAGE(PG8_SB(0, 1), b2 + hstepB, voffB);
            PG8_WAIT_V(6); PG8_BAR; PG8_MMA(1, 1, At, B1); PG8_BAR;
            PG8_LDB(B0, 1, 0); PG8_SCHED; PG8_LDA(At, 1, 0); PG8_STAGE(PG8_SA(0, 1), a2 + hstepA, voffA);
            PG8_WAIT_L(8); PG8_BAR; PG8_WAIT_L(0); PG8_MMA(0, 0, At, B0); PG8_BAR; PG8_SCHED;
            PG8_LDB(B1, 1, 1); PG8_STAGE(PG8_SB(1, 0), b3, voffB);
            PG8_BAR; PG8_WAIT_L(0); PG8_MMA(0, 1, At, B1); PG8_BAR;
            PG8_LDA(At, 1, 1); PG8_STAGE(PG8_SA(1, 0), a3, voffA);
            PG8_BAR; PG8_WAIT_L(0); PG8_MMA(1, 0, At, B0); PG8_BAR; PG8_SCHED;
            PG8_STAGE(PG8_SB(1, 1), b3 + hstepB, voffB);
            PG8_WAIT_V(6); PG8_BAR; PG8_MMA(1, 1, At, B1); PG8_BAR;
        }
        E(acc, cur, wr, wc, fr, fq);
        if (!has_next) break;
#pragma unroll
        for (int a = 0; a < 2; ++a)
#pragma unroll
            for (int b = 0; b < 2; ++b)
#pragma unroll
                for (int m = 0; m < 4; ++m)
#pragma unroll
                    for (int n = 0; n < 2; ++n) acc[a][b][m][n] = (f32x4){0.f, 0.f, 0.f, 0.f};
        cur = nxt; cA = nA; cB = nB; ++ui;
    }
    PG8_WAIT_V(0);
    if (wr == 0) PG8_BAR;
    PG8_BAR;
#undef PG8_SA
#undef PG8_SB
#undef PG8_STAGE
#undef PG8_LDA
#undef PG8_LDB
#undef PG8_MMA
#undef PG8_WAIT_V
#undef PG8_WAIT_L
#undef PG8_BAR
#undef PG8_SCHED
}
}
typedef f32x4 Acc[2][2][4][2];

__device__ __forceinline__ LAS const float* fill_inv(LAS unsigned char* lds, const float* ssq) {
    LAS float* t = (LAS float*)(lds + LDS_INV); const int base = 2048 * (blockIdx.x & 7);
    for (int r = otid(); r < 2048; r += 512) t[r] = rowinv16(ssq, base + r);
    __syncthreads();
    return t;
}
struct EpiSwiglu {
    bf16_t* H; LAS const float* linv;
    __device__ __forceinline__ void operator()(const Acc& acc, const pg8::Unit& u, int wr, int wc, int fr, int fq) const {
        const int row0 = u.pm * 256 + wr * 64 + fr, col = u.pn * 128 + wc * 32 + 8 * fq;
#pragma unroll
        for (int ai = 0; ai < 2; ++ai)
#pragma unroll
            for (int m = 0; m < 4; ++m) {
                const int row = row0 + ai * 128 + m * 16; const float inv = linv ? linv[row & 2047] : 1.0f;
                f32x4 h0, h1;
#pragma unroll
                for (int j = 0; j < 4; ++j) { h0[j] = siluf_(acc[ai][0][m][0][j] * inv) * (acc[ai][1][m][0][j] * inv); h1[j] = siluf_(acc[ai][0][m][1][j] * inv) * (acc[ai][1][m][1][j] * inv); }
                *(u32x4*)(H + (size_t)row * FF + col) = pack8(h0, h1);
            }
    }
};
struct EpiResid {
    const float* xin; const bf16_t* xin_b; float* xout; bf16_t* xb; float* ssq; float alpha;
    __device__ __forceinline__ void operator()(const Acc& acc, const pg8::Unit& u, int wr, int wc, int fr, int fq) const {
        const int row0 = u.pm * 256 + wr * 64 + fr, col0 = u.pn * 256 + wc * 32 + 8 * fq;
#pragma unroll
        for (int ai = 0; ai < 2; ++ai) {
            f32x4 xv[4][2][2];
#pragma unroll
            for (int m = 0; m < 4; ++m)
#pragma unroll
                for (int bj = 0; bj < 2; ++bj) { const size_t o = (size_t)(row0 + ai * 128 + m * 16) * D + col0 + bj * 128;
                    if (xin_b) unpack8(*(const u32x4*)(xin_b + o), xv[m][bj][0], xv[m][bj][1]);
                    else { xv[m][bj][0] = *(const f32x4*)(xin + o); xv[m][bj][1] = *(const f32x4*)(xin + o + 4); } }
#pragma unroll
            for (int m = 0; m < 4; ++m) {
                const int row = row0 + ai * 128 + m * 16; float ss = 0.f;
#pragma unroll
                for (int bj = 0; bj < 2; ++bj) {
                    const size_t o = (size_t)row * D + col0 + bj * 128;
                    const f32x4 v0 = xv[m][bj][0] + alpha * acc[ai][bj][m][0], v1 = xv[m][bj][1] + alpha * acc[ai][bj][m][1];
                    if (xout) { *(f32x4*)(xout + o) = v0; *(f32x4*)(xout + o + 4) = v1; }
                    ss += (v0[0] * v0[0] + v0[1] * v0[1]) + (v0[2] * v0[2] + v0[3] * v0[3]) + (v1[0] * v1[0] + v1[1] * v1[1]) + (v1[2] * v1[2] + v1[3] * v1[3]);
                    if (xb) *(u32x4*)(xb + o) = pack8(v0, v1);
                }
                ss += __shfl_xor(ss, 16); ss += __shfl_xor(ss, 32);
                if (fq == 0) ssq[(size_t)row * 16 + u.pn * 4 + wc] = ss;
            }
        }
    }
};
struct EpiScaleBf16 {
    bf16_t* O; LAS const float* linv;
    __device__ __forceinline__ void operator()(const Acc& acc, const pg8::Unit& u, int wr, int wc, int fr, int fq) const {
        const int row0 = u.pm * 256 + wr * 64 + fr, col0 = u.pn * 256 + wc * 32 + 8 * fq;
#pragma unroll
        for (int ai = 0; ai < 2; ++ai)
#pragma unroll
            for (int m = 0; m < 4; ++m) {
                const int row = row0 + ai * 128 + m * 16; const float inv = linv[row & 2047];
#pragma unroll
                for (int bj = 0; bj < 2; ++bj) *(u32x4*)(O + (size_t)row * NPP + col0 + bj * 128) = pack8(acc[ai][bj][m][0] * inv, acc[ai][bj][m][1] * inv);
            }
    }
};
struct EpiGatesA {
    bf16_t* PP; LAS const float* linv; float* gssq;
    __device__ __forceinline__ void operator()(const Acc& acc, const pg8::Unit& u, int wr, int wc, int fr, int fq) const {
        const int row0 = u.pm * 256 + wr * 64 + fr, cw = wc * 32 + 8 * fq; const int pn = u.pn;
#pragma unroll
        for (int ai = 0; ai < 2; ++ai) {
            u32x4 sv[4][2];
#pragma unroll
            for (int m = 0; m < 4; ++m)
#pragma unroll
                for (int bj = 0; bj < 2; ++bj) sv[m][bj] = *(const u32x4*)(PP + (size_t)(row0 + ai * 128 + m * 16) * NPP + pn * 256 + bj * 128 + cw);
#pragma unroll
            for (int m = 0; m < 4; ++m) {
                const int row = row0 + ai * 128 + m * 16; const float inv = linv[row & 2047]; float ss = 0.f;
#pragma unroll
                for (int bj = 0; bj < 2; ++bj) {
                    const f32x4 a0 = acc[ai][bj][m][0] * inv, a1 = acc[ai][bj][m][1] * inv; f32x4 o0, o1;
                    bf16_t* p = PP + (size_t)row * NPP + pn * 256 + bj * 128 + cw; f32x4 s0, s1; unpack8(sv[m][bj], s0, s1);
                    if (pn < 4) {
#pragma unroll
                        for (int j = 0; j < 4; ++j) { o0[j] = gelu_tanh(a0[j]) * s0[j]; o1[j] = gelu_tanh(a1[j]) * s1[j]; }
                    } else {
#pragma unroll
                        for (int j = 0; j < 4; ++j) { o0[j] = siluf_(a0[j]) * s0[j]; o1[j] = siluf_(a1[j]) * s1[j]; ss += o0[j] * o0[j] + o1[j] * o1[j]; }
                    }
                    *(u32x4*)p = pack8(o0, o1);
                }
                if (pn >= 4) { ss += __shfl_xor(ss, 16); ss += __shfl_xor(ss, 32); if (fq == 0) gssq[(size_t)row * 32 + (pn - 4) * 4 + wc] = ss; }
            }
        }
    }
};
struct EpiSigmoid {
    bf16_t* O; int ldo; LAS const float* linv; const float* bias;
    __device__ __forceinline__ void operator()(const Acc& acc, const pg8::Unit& u, int wr, int wc, int fr, int fq) const {
        const int row0 = u.pm * 256 + wr * 64 + fr, col0 = u.pn * 256 + wc * 32 + 8 * fq;
#pragma unroll
        for (int ai = 0; ai < 2; ++ai)
#pragma unroll
            for (int m = 0; m < 4; ++m) {
                const int row = row0 + ai * 128 + m * 16; const float inv = linv[row & 2047];
#pragma unroll
                for (int bj = 0; bj < 2; ++bj) {
                    const int gc = col0 + bj * 128;
                    const f32x4 a0 = acc[ai][bj][m][0] * inv, a1 = acc[ai][bj][m][1] * inv; f32x4 o0, o1;
                    const f32x4 b0 = *(const f32x4*)(bias + gc), b1 = *(const f32x4*)(bias + gc + 4);
#pragma unroll
                    for (int j = 0; j < 4; ++j) { o0[j] = sigmoidf_(a0[j] + b0[j]); o1[j] = sigmoidf_(a1[j] + b1[j]); }
                    *(u32x4*)(O + (size_t)row * ldo + gc) = pack8(o0, o1);
                }
            }
    }
};
struct EpiBr {
    bf16_t* GA; const bf16_t* PP; int mode;
    __device__ __forceinline__ void operator()(const Acc& acc, const pg8::Unit& u, int wr, int wc, int fr, int fq) const {
        const int row0 = u.pm * 256 + wr * 64 + fr, col0 = u.pn * 256 + wc * 32 + 8 * fq;
#pragma unroll
        for (int ai = 0; ai < 2; ++ai) {
            u32x4 gv[4][2], hv[4][2];
#pragma unroll
            for (int m = 0; m < 4; ++m)
#pragma unroll
                for (int bj = 0; bj < 2; ++bj) { const int row = row0 + ai * 128 + m * 16; gv[m][bj] = *(const u32x4*)(GA + (size_t)row * D + col0 + bj * 128);
                    hv[m][bj] = (mode == 0) ? (u32x4){0u, 0u, 0u, 0u} : *(const u32x4*)(PP + (size_t)row * NPP + 3072 + col0 + bj * 128); }
#pragma unroll
            for (int m = 0; m < 4; ++m) {
                const int row = row0 + ai * 128 + m * 16;
#pragma unroll
                for (int bj = 0; bj < 2; ++bj) {
                    bf16_t* p = GA + (size_t)row * D + col0 + bj * 128; f32x4 g0, g1; unpack8(gv[m][bj], g0, g1);
                    if (mode == 0) { *(u32x4*)p = pack8(g0 * acc[ai][bj][m][0], g1 * acc[ai][bj][m][1]); }
                    else { f32x4 h0, h1; unpack8(hv[m][bj], h0, h1); *(u32x4*)p = pack8(g0 + h0 * acc[ai][bj][m][0], g1 + h1 * acc[ai][bj][m][1]); }
                }
            }
        }
    }
};

template <int NC, int NB, int K, class RM, class F>
__device__ __forceinline__ void small_gemm(LAS unsigned char* lds, const bf16_t* A, int lda, int M, const bf16_t* Bt, int ldb, int N,
                                           const float* rs_src, int rs_mode, RM rm, F f) {
    const int tid = otid(), wid = tid >> 6, lane = tid & 63, lr = lane & 15, kg = lane >> 4;
    LAS float* red = (LAS float*)lds;
    LAS float* invs = (LAS float*)(lds + 131072);
    const int nct = N / NC, items = (M / 16) * nct; constexpr int kw = K / 8;
    constexpr int CT = NC / 16;
    const int nrt = M / 16; const bool hoist = (rs_mode == 1) && (gridDim.x % nrt == 0); const int bix = gridDim.x - 1 - blockIdx.x;
    for (int it = bix; it < items; it += gridDim.x) {
        const int rt = it % nrt, ct = it / nrt, row0 = rt * 16, col0 = ct * NC;
        if (rs_mode == 1) { if (!(hoist && it != bix)) { const int r = tid >> 5, q = tid & 31; const float* p = rs_src + (size_t)(row0 + r) * D + q * 32; float s = 0.f;
            for (int j = 0; j < 32; j += 4) { const f32x4 v = *(const f32x4*)(p + j); s += v[0] * v[0] + v[1] * v[1] + v[2] * v[2] + v[3] * v[3]; }
            s += __shfl_xor(s, 1); s += __shfl_xor(s, 2); s += __shfl_xor(s, 4); s += __shfl_xor(s, 8); s += __shfl_xor(s, 16);
            if (q == 0) invs[r] = rsqrtf(s * (1.0f / 1024.0f) + EPS); } }
        else if (rs_mode == 2) { if (tid < 16) invs[tid] = rowinv16(rs_src, row0 + tid); }
        else { if (tid < 16) invs[tid] = 1.0f; }
        f32x4 acc[NB][CT];
#pragma unroll
        for (int p = 0; p < NB; ++p)
#pragma unroll
            for (int c = 0; c < CT; ++c) acc[p][c] = (f32x4){0.f, 0.f, 0.f, 0.f};
        const bf16_t* ap = A + (size_t)(row0 + lr) * lda + wid * kw + 8 * kg;
        const bf16_t* bp0 = Bt + (size_t)(rm(col0, 0) + lr) * ldb + wid * kw + 8 * kg;
        const bf16_t* bp1 = NB > 1 ? Bt + (size_t)(rm(col0, 1) + lr) * ldb + wid * kw + 8 * kg : bp0;
#pragma unroll
        for (int k = 0; k < kw; k += 32) {
            const bf16x8 a = *(const bf16x8*)(ap + k);
#pragma unroll
            for (int c = 0; c < CT; ++c) {
                const bf16x8 b = *(const bf16x8*)(bp0 + (size_t)c * 16 * ldb + k);
                acc[0][c] = __builtin_amdgcn_mfma_f32_16x16x32_bf16(a, b, acc[0][c], 0, 0, 0);
                if (NB > 1) { const bf16x8 b1 = *(const bf16x8*)(bp1 + (size_t)c * 16 * ldb + k); acc[NB - 1][c] = __builtin_amdgcn_mfma_f32_16x16x32_bf16(a, b1, acc[NB - 1][c], 0, 0, 0); }
            }
        }
#pragma unroll
        for (int p = 0; p < NB; ++p)
#pragma unroll
            for (int c = 0; c < CT; ++c)
#pragma unroll
                for (int r = 0; r < 4; ++r) red[((wid * NB + p) * 16 + 4 * kg + r) * NC + 16 * c + lr] = acc[p][c][r];
        __syncthreads();
        for (int e = tid; e < 16 * NC; e += 512) {
            float v0 = 0.f, v1 = 0.f;
#pragma unroll
            for (int w = 0; w < 8; ++w) { v0 += red[(w * NB) * 16 * NC + e]; if (NB > 1) v1 += red[(w * NB + 1) * 16 * NC + e]; }
            const int r = e / NC, c = e % NC;
            f(row0 + r, col0 + c, v0, v1, invs[r]);
        }
        __syncthreads();
    }
}

template <int NC, int NB, int K, class RM, class F>
__device__ __forceinline__ void sgemm(LAS unsigned char* lds, const bf16_t* A, int lda, const bf16_t* Bt, int ldb, int N, const float* ssq_src, float* ssq_out, RM rm, F f, int nblk = 0) {
    const int tid = otid(), wid = tid >> 6, lane = tid & 63, lr = lane & 15, kg = lane >> 4;
    constexpr int CT = NC / 16, KW = K / 8;
    LAS float* red = (LAS float*)lds;
    const int items = N / NC, bix = gridDim.x - 1 - blockIdx.x; if (nblk == 0) nblk = gridDim.x;
    LAS float* invs = (LAS float*)(lds + LDS_INV);
    if (bix < items && bix < nblk) {
        if (ssq_src) { const int row = tid >> 2, q = tid & 3; float sm = 0.f;
#pragma unroll
            for (int j = 0; j < 16; j += 4) { const f32x4 v = *(const f32x4*)(ssq_src + row * 64 + q * 16 + j); sm += (v[0] + v[1]) + (v[2] + v[3]); }
            sm += __shfl_xor(sm, 1); sm += __shfl_xor(sm, 2);
            if (q == 0) invs[row] = rsqrtf(sm * (1.0f / 1024.0f) + EPS); }
        else if (tid < 128) invs[tid] = 1.0f;
        __syncthreads();
    }
    for (int it = bix; it < items && bix < nblk; it += nblk) {
        const int col0 = it * NC;
        f32x4 acc[8][NB][CT];
#pragma unroll
        for (int t = 0; t < 8; ++t)
#pragma unroll
            for (int p = 0; p < NB; ++p)
#pragma unroll
                for (int c = 0; c < CT; ++c) acc[t][p][c] = (f32x4){0.f, 0.f, 0.f, 0.f};
        const bf16_t* ap = A + (size_t)lr * lda + wid * KW + 8 * kg;
        const bf16_t* bp0 = Bt + (size_t)(rm(col0, 0) + lr) * ldb + wid * KW + 8 * kg;
        const bf16_t* bp1 = NB > 1 ? Bt + (size_t)(rm(col0, 1) + lr) * ldb + wid * KW + 8 * kg : bp0;
#pragma unroll 4
        for (int k = 0; k < KW; k += 32) {
            bf16x8 bf[NB][CT];
#pragma unroll
            for (int c = 0; c < CT; ++c) { bf[0][c] = *(const bf16x8*)(bp0 + (size_t)c * 16 * ldb + k); if (NB > 1) bf[NB - 1][c] = *(const bf16x8*)(bp1 + (size_t)c * 16 * ldb + k); }
#pragma unroll
            for (int t = 0; t < 8; ++t) { const bf16x8 a = *(const bf16x8*)(ap + (size_t)t * 16 * lda + k);
#pragma unroll
                for (int p = 0; p < NB; ++p)
#pragma unroll
                    for (int c = 0; c < CT; ++c) acc[t][p][c] = __builtin_amdgcn_mfma_f32_16x16x32_bf16(a, bf[p][c], acc[t][p][c], 0, 0, 0); }
        }
#pragma unroll
        for (int t = 0; t < 8; ++t)
#pragma unroll
            for (int p = 0; p < NB; ++p)
#pragma unroll
                for (int c = 0; c < CT; ++c)
#pragma unroll
                    for (int r = 0; r < 4; ++r) red[((((wid * 8 + t) * NB + p) * CT + c) * 16 + 4 * kg + r) * 16 + lr] = acc[t][p][c][r];
        __syncthreads();
        for (int e = tid; e < 128 * NC; e += 512) {
            const int row = e / NC, col = e % NC, t = row >> 4, rr = row & 15, c = col >> 4, cl = col & 15;
            float v0 = 0.f, v1 = 0.f;
#pragma unroll
            for (int w = 0; w < 8; ++w) { v0 += red[((((w * 8 + t) * NB + 0) * CT + c) * 16 + rr) * 16 + cl]; if (NB > 1) v1 += red[((((w * 8 + t) * NB + (NB - 1)) * CT + c) * 16 + rr) * 16 + cl]; }
            float sq = f(row, col0 + col, v0, v1, invs[row]);
            if (ssq_out) { sq *= sq; sq += __shfl_xor(sq, 1); sq += __shfl_xor(sq, 2); sq += __shfl_xor(sq, 4); sq += __shfl_xor(sq, 8); if (NC > 16) sq += __shfl_xor(sq, 16);
                if ((col & (NC - 1)) == 0) ssq_out[row * 64 + it] = sq; }
        }
        __syncthreads();
    }
}

template <int CT, int NB, int K, class RM, class F>
__device__ __forceinline__ void wave_gemm(LAS unsigned char* lds, const bf16_t* A, int lda, const bf16_t* Bt, int ldb, int N, const float* rs_src, RM rm, F f) {
    const int tid = otid(), wid = tid >> 6, lane = tid & 63, lr = lane & 15, kg = lane >> 4;
    const int bix = gridDim.x - 1 - blockIdx.x, rt = bix & 7, row0 = rt * 16, nct = N / (16 * CT);
    LAS float* invs = (LAS float*)(lds + LDS_INV);
    if (rs_src) { const int r = tid >> 5, q = tid & 31; const float* p = rs_src + (size_t)(row0 + r) * D + q * 32; float s = 0.f;
        for (int j = 0; j < 32; j += 4) { const f32x4 v = *(const f32x4*)(p + j); s += v[0] * v[0] + v[1] * v[1] + v[2] * v[2] + v[3] * v[3]; }
        s += __shfl_xor(s, 1); s += __shfl_xor(s, 2); s += __shfl_xor(s, 4); s += __shfl_xor(s, 8); s += __shfl_xor(s, 16);
        if (q == 0) invs[r] = rsqrtf(s * (1.0f / 1024.0f) + EPS); }
    else if (tid < 16) invs[tid] = 1.0f;
    __syncthreads();
    for (int ct = (bix >> 3) * 8 + wid; ct < nct; ct += (gridDim.x >> 3) * 8) {
        const int col0 = ct * 16 * CT;
        f32x4 acc[NB][CT];
#pragma unroll
        for (int p = 0; p < NB; ++p)
#pragma unroll
            for (int c = 0; c < CT; ++c) acc[p][c] = (f32x4){0.f, 0.f, 0.f, 0.f};
        const bf16_t* ap = A + (size_t)(row0 + lr) * lda + 8 * kg;
        const bf16_t* bp0 = Bt + (size_t)(rm(col0, 0) + lr) * ldb + 8 * kg;
        const bf16_t* bp1 = NB > 1 ? Bt + (size_t)(rm(col0, 1) + lr) * ldb + 8 * kg : bp0;
#pragma unroll 4
        for (int k = 0; k < K; k += 32) {
            const bf16x8 a = *(const bf16x8*)(ap + k);
#pragma unroll
            for (int c = 0; c < CT; ++c) {
                const bf16x8 b = *(const bf16x8*)(bp0 + (size_t)c * 16 * ldb + k);
                acc[0][c] = __builtin_amdgcn_mfma_f32_16x16x32_bf16(a, b, acc[0][c], 0, 0, 0);
                if (NB > 1) { const bf16x8 b1 = *(const bf16x8*)(bp1 + (size_t)c * 16 * ldb + k); acc[NB - 1][c] = __builtin_amdgcn_mfma_f32_16x16x32_bf16(a, b1, acc[NB - 1][c], 0, 0, 0); }
            }
        }
#pragma unroll
        for (int c = 0; c < CT; ++c)
#pragma unroll
            for (int r = 0; r < 4; ++r) f(row0 + 4 * kg + r, col0 + 16 * c + lr, acc[0][c][r], NB > 1 ? acc[NB - 1][c][r] : 0.f, invs[4 * kg + r]);
    }
    __syncthreads();
}

struct Ctx { const float* const* in; float* out; unsigned char* ws; LAS unsigned char* lds; };

__device__ __forceinline__ void tp_tile(LAS float* tile, const float* src, int sld, int sc0, int k0, bf16_t* dst, int dld, int dr0, int dk0, const float* scale, int ncv) {
    const int lane = otid() & 63;
    float v[64];
    const float* sp = src + (size_t)k0 * sld + sc0 + lane;
#pragma unroll
    for (int kk = 0; kk < 64; ++kk) v[kk] = (lane < ncv) ? sp[(size_t)kk * sld] : 0.f;
    if (scale) {
#pragma unroll
        for (int kk = 0; kk < 64; ++kk) v[kk] *= scale[k0 + kk];
    }
#pragma unroll
    for (int kk = 0; kk < 64; ++kk) tile[kk * 65 + lane] = v[kk];
    const int j = lane & 7;
#pragma unroll
    for (int ps = 0; ps < 8; ++ps) { const int cc = (lane >> 3) + 8 * ps;
        float x[8];
#pragma unroll
        for (int i = 0; i < 8; ++i) x[i] = tile[(8 * j + i) * 65 + cc];
        u32x4 w; w.x = cvt_pk_bf16(x[0], x[1]); w.y = cvt_pk_bf16(x[2], x[3]); w.z = cvt_pk_bf16(x[4], x[5]); w.w = cvt_pk_bf16(x[6], x[7]);
        if (cc < ncv) *(u32x4*)(dst + (size_t)(dr0 + cc) * dld + dk0 + 8 * j) = w; }
}
__device__ __forceinline__ void prep_weights(const Ctx& c) {
    const int wv_ = __builtin_amdgcn_readfirstlane(otid() >> 6); LAS float* tile = (LAS float*)c.lds + wv_ * (64 * 65); unsigned char* ws = c.ws;
    constexpr int N_UP = 1408, N_DN = 704, N_IN = 2304, N_DT = 16, N_BRL = 256, N_BRS = 512, N_OUT = 256, N_RG = 32;
    constexpr int TOT = 2 * N_UP + 2 * N_DN + N_IN + N_DT + N_BRL + N_BRS + N_OUT + 2 * N_RG;
    for (int ti0 = blockIdx.x * 8 + wv_; ti0 < TOT; ti0 += gridDim.x * 8) {
        int ti = ti0;
        if (ti < 2 * N_UP) { const int l = ti >= N_UP; if (l) ti -= N_UP;
            const int j = ti >> 5, r = ti & 31, pn = j >> 1, panel = j & 1, ct = r >> 4, kt = r & 15;
            tp_tile(tile, c.in[l ? 29 : 7], 2 * FF, panel * FF + 128 * pn + 64 * ct, 64 * kt, (bf16_t*)(ws + (l ? OFF_WUP2 : OFF_WUP1)), D, 256 * pn + 128 * panel + 64 * ct, 64 * kt, l ? c.in[28] : nullptr, 64);
            continue; }
        ti -= 2 * N_UP;
        if (ti < 2 * N_DN) { const int l = ti >= N_DN; if (l) ti -= N_DN;
            const int nt = ti / 44, kt = ti % 44;
            tp_tile(tile, c.in[l ? 30 : 8], D, 64 * nt, 64 * kt, (bf16_t*)(ws + (l ? OFF_WDN2 : OFF_WDN1)), FF, 64 * nt, 64 * kt, nullptr, 64);
            continue; }
        ti -= 2 * N_DN;
        if (ti < N_IN) { const int nt = ti >> 4, kt = ti & 15, n0 = 64 * nt;
            const int sc = n0 < 1024 ? n0 : (n0 < 4096 ? n0 + 3072 : (n0 < 7168 ? n0 - 3072 : n0 + 32));
            tp_tile(tile, c.in[10], 9248, sc, 64 * kt, (bf16_t*)(ws + OFF_WIN), D, n0, 64 * kt, c.in[9], 64);
            continue; }
        ti -= N_IN;
        if (ti < N_DT) { tp_tile(tile, c.in[10], 9248, 7168, 64 * ti, (bf16_t*)(ws + OFF_WDT), D, 0, 64 * ti, c.in[9], 32); continue; }
        ti -= N_DT;
        if (ti < N_BRL) { const int nt = ti >> 4, kt = ti & 15; tp_tile(tile, c.in[25], D, 64 * nt, 64 * kt, (bf16_t*)(ws + OFF_WBR), 3072, 64 * nt, 64 * kt, nullptr, 64); continue; }
        ti -= N_BRL;
        if (ti < N_BRS) { const int nt = ti >> 5, kt = ti & 31; tp_tile(tile, c.in[26], D, 64 * nt, 64 * kt, (bf16_t*)(ws + OFF_WBR), 3072, 64 * nt, 1024 + 64 * kt, c.in[24], 64); continue; }
        ti -= N_BRS;
        if (ti < N_OUT) { const int nt = ti >> 4, kt = ti & 15; tp_tile(tile, c.in[27], D, 64 * nt, 64 * kt, (bf16_t*)(ws + OFF_WOUT), D, 64 * nt, 64 * kt, nullptr, 64); continue; }
        ti -= N_OUT;
        { const int l = ti >= N_RG; if (l) ti -= N_RG; const int h = ti >> 2, nt = (ti >> 1) & 1, kt = ti & 1;
          tp_tile(tile, c.in[l ? 16 : 14] + h * 16384, 128, 64 * nt, 64 * kt, (bf16_t*)(ws + (l ? OFF_WIG : OFF_WRG)) + h * 16384, 128, 64 * nt, 64 * kt, nullptr, 64); }
    }
}
__device__ __forceinline__ void rmsnorm_rows_bf16(const float* x, int nrows, const float* g, bf16_t* dst) {
    const int t_ = otid(), lane = t_ & 63, gw = blockIdx.x * 8 + (t_ >> 6), nw = gridDim.x * 8;
    f32x4 gg[4];
#pragma unroll
    for (int i = 0; i < 4; ++i) gg[i] = *(const f32x4*)(g + (i * 64 + lane) * 4);
    for (int r = gw; r < nrows; r += 2 * nw) {
        const int r2 = r + nw; const bool two = r2 < nrows;
        const float* p = x + (size_t)r * D; const float* p2 = x + (size_t)(two ? r2 : r) * D; f32x4 v[4], w[4]; float s = 0.f, s2 = 0.f;
#pragma unroll
        for (int i = 0; i < 4; ++i) { v[i] = *(const f32x4*)(p + (i * 64 + lane) * 4); w[i] = *(const f32x4*)(p2 + (i * 64 + lane) * 4); }
#pragma unroll
        for (int i = 0; i < 4; ++i) { s += v[i][0] * v[i][0] + v[i][1] * v[i][1] + v[i][2] * v[i][2] + v[i][3] * v[i][3]; s2 += w[i][0] * w[i][0] + w[i][1] * w[i][1] + w[i][2] * w[i][2] + w[i][3] * w[i][3]; }
#pragma unroll
        for (int o = 1; o < 64; o <<= 1) { s += __shfl_xor(s, o); s2 += __shfl_xor(s2, o); }
        const float inv = rsqrtf(s * (1.0f / 1024.0f) + EPS), inv2 = rsqrtf(s2 * (1.0f / 1024.0f) + EPS);
#pragma unroll
        for (int i = 0; i < 4; ++i) { const int cc = (i * 64 + lane) * 4; const f32x4 o = v[i] * inv * gg[i];
            unsigned* q = (unsigned*)(dst + (size_t)r * D + cc); q[0] = cvt_pk_bf16(o[0], o[1]); q[1] = cvt_pk_bf16(o[2], o[3]);
            if (two) { const f32x4 o2 = w[i] * inv2 * gg[i]; unsigned* q2 = (unsigned*)(dst + (size_t)r2 * D + cc); q2[0] = cvt_pk_bf16(o2[0], o2[1]); q2[1] = cvt_pk_bf16(o2[2], o2[3]); } }
    }
}
__device__ __forceinline__ void rmsnorm_rows_f32(float* x, int nrows, const float* g) {
    const int t_ = otid(), lane = t_ & 63, gw = blockIdx.x * 8 + (t_ >> 6), nw = gridDim.x * 8;
    f32x4 gg[4];
#pragma unroll
    for (int i = 0; i < 4; ++i) gg[i] = *(const f32x4*)(g + (i * 64 + lane) * 4);
    for (int r = gw; r < nrows; r += 2 * nw) {
        const int r2 = r + nw; const bool two = r2 < nrows;
        float* p = x + (size_t)r * D; float* p2 = x + (size_t)(two ? r2 : r) * D; f32x4 v[4], w[4]; float s = 0.f, s2 = 0.f;
#pragma unroll
        for (int i = 0; i < 4; ++i) { v[i] = *(const f32x4*)(p + (i * 64 + lane) * 4); w[i] = *(const f32x4*)(p2 + (i * 64 + lane) * 4); }
#pragma unroll
        for (int i = 0; i < 4; ++i) { s += v[i][0] * v[i][0] + v[i][1] * v[i][1] + v[i][2] * v[i][2] + v[i][3] * v[i][3]; s2 += w[i][0] * w[i][0] + w[i][1] * w[i][1] + w[i][2] * w[i][2] + w[i][3] * w[i][3]; }
#pragma unroll
        for (int o = 1; o < 64; o <<= 1) { s += __shfl_xor(s, o); s2 += __shfl_xor(s2, o); }
        const float inv = rsqrtf(s * (1.0f / 1024.0f) + EPS), inv2 = rsqrtf(s2 * (1.0f / 1024.0f) + EPS);
#pragma unroll
        for (int i = 0; i < 4; ++i) { const int cc = (i * 64 + lane) * 4; *(f32x4*)(p + cc) = v[i] * inv * gg[i]; if (two) *(f32x4*)(p2 + cc) = w[i] * inv2 * gg[i]; }
    }
}

template <bool FINAL>
__device__ __forceinline__ void lru_chunk(const Ctx& c, int b, int ch, bool dry = false) {
    const int tid = otid(), wid = tid >> 6, lane = tid & 63, lr = lane & 15, kg = lane >> 4;
    LAS float* XC = (LAS float*)c.lds; LAS float* AA = (LAS float*)(c.lds + 32768); LAS float* UU = (LAS float*)(c.lds + 65536); LAS unsigned char* XCb = c.lds + 98304;
    bf16_t* PP = (bf16_t*)(c.ws + OFF_PP); bf16_t* HALO = (bf16_t*)(c.ws + OFF_HALO); float* SUMM = (float*)(c.ws + OFF_SUMM);
    const bf16_t* WRG = (const bf16_t*)(c.ws + OFF_WRG); const bf16_t* WIG = (const bf16_t*)(c.ws + OFF_WIG);
    const float* cw = c.in[12]; const float* cb = c.in[13]; const float* brg = c.in[15]; const float* big = c.in[17]; const float* lam = c.in[18];
    const int t0 = b * SEQ + 64 * ch;
    LAS float* CARRY = (LAS float*)(c.lds + 115712);
    if (FINAL) {
        float h0 = 0.f, h1 = 0.f;
        for (int cp = 0; cp < ch; cp += 8) {
            float a0[8], b0[8], a1[8], b1[8];
#pragma unroll
            for (int i = 0; i < 8; ++i) { a0[i] = 1.f; b0[i] = 0.f; a1[i] = 1.f; b1[i] = 0.f;
                if (cp + i < ch) { const float* sp = SUMM + ((size_t)(b * NCH + cp + i) * D + tid) * 2; a0[i] = sp[0]; b0[i] = sp[1]; a1[i] = sp[1024]; b1[i] = sp[1025]; } }
#pragma unroll
            for (int i = 0; i < 8; ++i) { h0 = a0[i] * h0 + b0[i]; h1 = a1[i] * h1 + b1[i]; }
        }
        CARRY[tid] = h0; CARRY[tid + 512] = h1;
    }
    const int cg8 = tid & 15, tk = (tid >> 4) * 2;
    u32x4 rawp[5]; f32x4 wk[4][2], bb[2]; bf16x8 wrf[4], wif[4]; float pb1 = 0.f, pb2 = 0.f, plam = 0.f;
#define LRU_FETCH(hd) do { const int cc0_ = 128 * (hd) + 8 * cg8; \
        _Pragma("unroll") for (int i = 0; i < 5; ++i) { const int tt = tk - 3 + i; rawp[i] = (u32x4){0u, 0u, 0u, 0u}; \
            if (tt >= 0) rawp[i] = *(const u32x4*)(PP + (size_t)(t0 + tt) * NPP + cc0_); \
            else if (ch > 0) { if (FINAL) rawp[i] = *(const u32x4*)(HALO + ((size_t)((b * NCH + ch - 1) * 3 + (tt + 3))) * D + cc0_); else rawp[i] = *(const u32x4*)(PP + (size_t)(t0 + tt) * NPP + cc0_); } } \
        _Pragma("unroll") for (int k = 0; k < 4; ++k) { wk[k][0] = *(const f32x4*)(cw + k * D + cc0_); wk[k][1] = *(const f32x4*)(cw + k * D + cc0_ + 4); } \
        bb[0] = *(const f32x4*)(cb + cc0_); bb[1] = *(const f32x4*)(cb + cc0_ + 4); } while (0)
#define LRU_FETCHW(hd) do { \
        { const int cgl_ = 128 * (hd) + 16 * wid + lr; const bf16_t* wr__ = WRG + (size_t)cgl_ * 128 + 8 * kg; const bf16_t* wi__ = WIG + (size_t)cgl_ * 128 + 8 * kg; \
          _Pragma("unroll") for (int ks = 0; ks < 4; ++ks) { wrf[ks] = *(const bf16x8*)(wr__ + 32 * ks); wif[ks] = *(const bf16x8*)(wi__ + 32 * ks); } \
          pb1 = brg[cgl_]; pb2 = big[cgl_]; plam = lam[cgl_]; } } while (0)
    LRU_FETCH(0); LRU_FETCHW(0);
    for (int head = 0; head < 8; ++head) {
        const int ch0 = 128 * head;
        if (!FINAL) { if (tid < 48) { const int row = tid >> 4, cg8_ = tid & 15;
            *(u32x4*)(HALO + ((size_t)((b * NCH + ch) * 3 + row)) * D + ch0 + 8 * cg8_) = *(const u32x4*)(PP + (size_t)(t0 + 61 + row) * NPP + ch0 + 8 * cg8_); } }
        {
            f32x4 raw[5][2];
#pragma unroll
            for (int i = 0; i < 5; ++i) unpack8(rawp[i], raw[i][0], raw[i][1]);
#pragma unroll
            for (int q = 0; q < 2; ++q) { f32x4 o0 = bb[0], o1 = bb[1];
#pragma unroll
                for (int k = 0; k < 4; ++k) { o0 += wk[k][0] * raw[q + k][0]; o1 += wk[k][1] * raw[q + k][1]; }
                *(LAS f32x4*)(XC + (tk + q) * 128 + 8 * cg8) = o0; *(LAS f32x4*)(XC + (tk + q) * 128 + 8 * cg8 + 4) = o1;
                *(LAS u32x4*)(XCb + (tk + q) * 272 + 16 * cg8) = pack8(o0, o1); }
            if (head < 7) LRU_FETCH(head + 1);
        }
        __syncthreads();
        {
            f32x4 ar[4], ai_[4];
#pragma unroll
            for (int m = 0; m < 4; ++m) { ar[m] = (f32x4){0.f, 0.f, 0.f, 0.f}; ai_[m] = (f32x4){0.f, 0.f, 0.f, 0.f}; }
#pragma unroll
            for (int ks = 0; ks < 4; ++ks) { const bf16x8 br = wrf[ks], bi = wif[ks];
#pragma unroll
                for (int m = 0; m < 4; ++m) { const bf16x8 a = *(const LAS bf16x8*)(XCb + (16 * m + lr) * 272 + (32 * ks + 8 * kg) * 2);
                    ar[m] = __builtin_amdgcn_mfma_f32_16x16x32_bf16(a, br, ar[m], 0, 0, 0); ai_[m] = __builtin_amdgcn_mfma_f32_16x16x32_bf16(a, bi, ai_[m], 0, 0, 0); } }
            const int cl = 16 * wid + lr; const float b1 = pb1, b2 = pb2, sp = softplusf_(-plam);
            if (head < 7) LRU_FETCHW(head + 1);
#pragma unroll
            for (int m = 0; m < 4; ++m)
#pragma unroll
                for (int r = 0; r < 4; ++r) { const int tk = 16 * m + 4 * kg + r; const float rg = sigmoidf_(ar[m][r] + b1), ig = sigmoidf_(ai_[m][r] + b2);
                    const float la = -8.0f * rg * sp; const float a = __expf(la); const float u = sqrtf(-expm1f(2.0f * la)) * ig * XC[tk * 128 + cl];
                    AA[tk * 128 + cl] = a; UU[tk * 128 + cl] = u; }
        }
        __syncthreads();
        if (tid < 128) { const int cgl = ch0 + tid;
            if (!FINAL) { float A = 1.f, H = 0.f;
                for (int t8 = 0; t8 < 64; t8 += 16) { float av[16], uv[16];
#pragma unroll
                    for (int i = 0; i < 16; ++i) { av[i] = AA[(t8 + i) * 128 + tid]; uv[i] = UU[(t8 + i) * 128 + tid]; }
#pragma unroll
                    for (int i = 0; i < 16; ++i) { H = av[i] * H + uv[i]; A *= av[i]; } }
                float* s = SUMM + ((size_t)(b * NCH + ch) * D + cgl) * 2; s[0] = A; s[1] = H; }
            else { float h = CARRY[cgl];
                for (int t8 = 0; t8 < 64; t8 += 16) { float av[16], uv[16];
#pragma unroll
                    for (int i = 0; i < 16; ++i) { av[i] = AA[(t8 + i) * 128 + tid]; uv[i] = UU[(t8 + i) * 128 + tid]; }
#pragma unroll
                    for (int i = 0; i < 16; ++i) { h = av[i] * h + uv[i]; UU[(t8 + i) * 128 + tid] = h; } }
                if (ch == NCH - 1) c.out[O_LHP + b * D + cgl] = h; } }
        __syncthreads();
        if (FINAL) { const int cg8 = tid & 15, tk = (tid >> 4) * 2;
#pragma unroll
            for (int q = 0; q < 2; ++q) { const f32x4 o0 = *(const LAS f32x4*)(UU + (tk + q) * 128 + 8 * cg8), o1 = *(const LAS f32x4*)(UU + (tk + q) * 128 + 8 * cg8 + 4);
                if (!dry) *(u32x4*)(PP + (size_t)(t0 + tk + q) * NPP + ch0 + 8 * cg8) = pack8(o0, o1); }
            __syncthreads(); }
    }
}

__device__ __forceinline__ void bc_conv(const Ctx& c, int b, int ch) {
    const int tid = otid(); const bf16_t* PP = (const bf16_t*)(c.ws + OFF_PP); bf16_t* BCc = (bf16_t*)(c.ws + OFF_XN);
    const float* cw = c.in[19]; const float* cb = c.in[20]; const int t0 = b * SEQ + 64 * ch;
#pragma unroll 1
    for (int item = tid; item < 1024; item += 512) {
        const int cgq = item & 127, st = item >> 7, gcol = 3072 + 8 * cgq, ccol = 2048 + 8 * cgq;
        u32x4 raw[11];
#pragma unroll
        for (int i = 0; i < 11; ++i) { const int tt = 8 * st - 3 + i; raw[i] = (u32x4){0u, 0u, 0u, 0u}; if (tt >= 0 || ch > 0) raw[i] = *(const u32x4*)(PP + (size_t)(t0 + tt) * NPP + gcol); }
#pragma unroll
        for (int hf = 0; hf < 2; ++hf) {
            f32x4 wk[4]; const f32x4 bb = *(const f32x4*)(cb + ccol + 4 * hf);
#pragma unroll
            for (int k = 0; k < 4; ++k) wk[k] = *(const f32x4*)(cw + k * 3072 + ccol + 4 * hf);
#pragma unroll
            for (int q = 0; q < 8; ++q) { f32x4 o = bb;
#pragma unroll
                for (int k = 0; k < 4; ++k) { const unsigned w0 = raw[q + k][2 * hf], w1 = raw[q + k][2 * hf + 1]; const f32x4 r = (f32x4){bflo(w0), bfhi(w0), bflo(w1), bfhi(w1)}; o += wk[k] * r; }
#pragma unroll
                for (int j = 0; j < 4; ++j) o[j] = siluf_(o[j]);
                unsigned* op = (unsigned*)(BCc + (size_t)(t0 + 8 * st + q) * 1024 + 8 * cgq + 4 * hf); op[0] = cvt_pk_bf16(o[0], o[1]); op[1] = cvt_pk_bf16(o[2], o[3]); }
        }
    }
}

__device__ __forceinline__ void ssd_seq(const Ctx& c, int b, int h, bool dry = false) {
    const int tid = otid(), wid = tid >> 6, lane = tid & 63, lr = lane & 15, kg = lane >> 4;
    LAS unsigned char* L = c.lds;
    LAS unsigned char* Cm = L; LAS unsigned char* Bm = L + 17408; LAS unsigned char* BdT = L + 34816; LAS unsigned char* Sb = L + 53248;
    LAS unsigned char* XdT = L + 70656; LAS unsigned char* Xr = L + 79872; LAS unsigned char* Mm = L + 89088;
    LAS float* dts = (LAS float*)(L + 98304); LAS float* css = (LAS float*)(L + 98560); LAS float* dec = (LAS float*)(L + 98816); LAS bf16_t* halo = (LAS bf16_t*)(L + 99072);
    bf16_t* PP = (bf16_t*)(c.ws + OFF_PP); const float* DT = (const float*)(c.ws + OFF_DT);
    const float* cw = c.in[19]; const float* cb = c.in[20];
    const int g = h >> 3;
    const float Ah = -__expf(c.in[22][h]), Dh = c.in[23][h], dtb = c.in[21][h];
    f32x4 accS[4];
#pragma unroll
    for (int m = 0; m < 4; ++m) accS[m] = (f32x4){0.f, 0.f, 0.f, 0.f};
    for (int e = tid; e < 64 * 136; e += 512) ((LAS bf16_t*)Sb)[e] = 0;
    const bf16_t* BCc = (const bf16_t*)(c.ws + OFF_XN);
    const int role = tid >> 7, rt = tid & 127;
    const int xg = rt & 7, xst = rt >> 3;
    const int bg8 = rt & 15, bst = rt >> 4;
    const int gcol = 1024 + 64 * h + 8 * xg, ccol = 64 * h + 8 * xg;
    const int bcol = (role == 2 ? 512 : 0) + 128 * g + 8 * bg8;
    u32x4 raw[8]; float dtv = 0.f;
    f32x4 wkk[2][4], bbb[2];
#pragma unroll
    for (int hf = 0; hf < 2; ++hf) { bbb[hf] = *(const f32x4*)(cb + ccol + 4 * hf);
#pragma unroll
        for (int k = 0; k < 4; ++k) wkk[hf][k] = *(const f32x4*)(cw + k * 3072 + ccol + 4 * hf); }
    {
        const int t0 = b * SEQ;
        if (role == 0) {
#pragma unroll
            for (int i = 0; i < 7; ++i) { const int tt = 4 * xst - 3 + i; raw[i] = (u32x4){0u, 0u, 0u, 0u}; if (tt >= 0) raw[i] = *(const u32x4*)(PP + (size_t)(t0 + tt) * NPP + gcol); } }
        else if (role < 3) {
#pragma unroll
            for (int i = 0; i < 8; ++i) raw[i] = *(const u32x4*)(BCc + (size_t)(t0 + 8 * bst + i) * 1024 + bcol); }
        if (wid == 0) dtv = DT[(size_t)(t0 + lane) * 32 + h];
    }
    for (int ch = 0; ch < NCH; ++ch) {
        const int t0 = b * SEQ + 64 * ch;
        if (wid == 0) {
            const float d = softplusf_(dtv + dtb); float sc = d * Ah;
#pragma unroll
            for (int o = 1; o < 64; o <<= 1) { const float v = __shfl_up(sc, o); if (lane >= o) sc += v; }
            const float ce = __shfl(sc, 63);
            dts[lane] = d; css[lane] = sc; dec[lane] = __expf(ce - sc);
        }
        __syncthreads();
        if (role == 0) {
            if (xst == 0 && ch > 0) {
#pragma unroll
                for (int i = 0; i < 3; ++i) raw[i] = *(const LAS u32x4*)(halo + ((ch - 1) & 1) * 192 + i * 64 + 8 * xg); }
            if (xst == 15) {
#pragma unroll
                for (int i = 0; i < 3; ++i) *(LAS u32x4*)(halo + (ch & 1) * 192 + i * 64 + 8 * xg) = raw[4 + i];
                if (ch == NCH - 1 && !dry) {
#pragma unroll
                    for (int r = 0; r < 3; ++r) { f32x4 v0, v1; unpack8(raw[4 + r], v0, v1); float* o = c.out + O_SCP + (size_t)(b * 3 + r) * 3072 + ccol; *(f32x4*)o = v0; *(f32x4*)(o + 4) = v1; } } }
            const int chunk = (xst >> 1) ^ xg;
#pragma unroll
            for (int hf = 0; hf < 2; ++hf) {
                unsigned tq[4][2];
#pragma unroll
                for (int q = 0; q < 4; ++q) { f32x4 o = bbb[hf];
#pragma unroll
                    for (int k = 0; k < 4; ++k) { const unsigned w0 = raw[q + k][2 * hf], w1 = raw[q + k][2 * hf + 1]; const f32x4 r = (f32x4){bflo(w0), bfhi(w0), bflo(w1), bfhi(w1)}; o += wkk[hf][k] * r; }
#pragma unroll
                    for (int j = 0; j < 4; ++j) o[j] = siluf_(o[j]);
                    const int l = 4 * xst + q;
                    LAS unsigned* rp = (LAS unsigned*)(Xr + l * 144 + 16 * xg + 8 * hf); rp[0] = cvt_pk_bf16(o[0], o[1]); rp[1] = cvt_pk_bf16(o[2], o[3]);
                    const float d = dts[l]; tq[q][0] = cvt_pk_bf16(o[0] * d, o[1] * d); tq[q][1] = cvt_pk_bf16(o[2] * d, o[3] * d);
                }
#pragma unroll
                for (int j2 = 0; j2 < 2; ++j2) {
                    unsigned lo[2], hi[2];
#pragma unroll
                    for (int i = 0; i < 2; ++i) { const unsigned a = tq[2 * i][j2], bq = tq[2 * i + 1][j2]; lo[i] = (a & 0xffffu) | (bq << 16); hi[i] = (a >> 16) | (bq & 0xffff0000u); }
                    LAS unsigned* p0 = (LAS unsigned*)(XdT + (8 * xg + 4 * hf + 2 * j2) * 144 + 16 * chunk + 8 * (xst & 1)); p0[0] = lo[0]; p0[1] = lo[1];
                    LAS unsigned* p1 = (LAS unsigned*)(XdT + (8 * xg + 4 * hf + 2 * j2 + 1) * 144 + 16 * chunk + 8 * (xst & 1)); p1[0] = hi[0]; p1[1] = hi[1]; }
            }
        } else if (role == 1) {
            const int chunk = bst ^ (bg8 & 7);
            unsigned tq[8][4];
#pragma unroll
            for (int q = 0; q < 8; ++q) { const int l = 8 * bst + q; *(LAS u32x4*)(Bm + l * 272 + 16 * bg8) = raw[q]; const float d = dec[l]; f32x4 v0, v1; unpack8(raw[q], v0, v1);
                tq[q][0] = cvt_pk_bf16(v0[0] * d, v0[1] * d); tq[q][1] = cvt_pk_bf16(v0[2] * d, v0[3] * d); tq[q][2] = cvt_pk_bf16(v1[0] * d, v1[1] * d); tq[q][3] = cvt_pk_bf16(v1[2] * d, v1[3] * d); }
#pragma unroll
            for (int j2 = 0; j2 < 4; ++j2) { u32x4 lo, hi;
#pragma unroll
                for (int i = 0; i < 4; ++i) { const unsigned a = tq[2 * i][j2], bq = tq[2 * i + 1][j2]; lo[i] = (a & 0xffffu) | (bq << 16); hi[i] = (a >> 16) | (bq & 0xffff0000u); }
                *(LAS u32x4*)(BdT + (8 * bg8 + 2 * j2) * 144 + 16 * chunk) = lo; *(LAS u32x4*)(BdT + (8 * bg8 + 2 * j2 + 1) * 144 + 16 * chunk) = hi; }
        } else if (role == 2) {
#pragma unroll
            for (int q = 0; q < 8; ++q) *(LAS u32x4*)(Cm + (8 * bst + q) * 272 + 16 * bg8) = raw[q];
        }
        if (ch + 1 < NCH) {
            if (role == 0) {
#pragma unroll
                for (int i = 0; i < 7; ++i) { const int tt = 4 * xst - 3 + i; if (tt >= 0) raw[i] = *(const u32x4*)(PP + (size_t)(t0 + 64 + tt) * NPP + gcol); } }
            else if (role < 3) {
#pragma unroll
                for (int i = 0; i < 8; ++i) raw[i] = *(const u32x4*)(BCc + (size_t)(t0 + 64 + 8 * bst + i) * 1024 + bcol); }
            if (wid == 0) dtv = DT[(size_t)(t0 + 64 + lane) * 32 + h];
        }
        __syncthreads();
#pragma unroll
        for (int q = 0; q < 2; ++q) { const int ti = 2 * wid + q, lt = ti >> 2, stl = ti & 3; f32x4 a4 = (f32x4){0.f, 0.f, 0.f, 0.f};
            if (stl <= lt) {
#pragma unroll
                for (int ks = 0; ks < 4; ++ks) { const bf16x8 a = *(const LAS bf16x8*)(Bm + (16 * stl + lr) * 272 + (32 * ks + 8 * kg) * 2), bq = *(const LAS bf16x8*)(Cm + (16 * lt + lr) * 272 + (32 * ks + 8 * kg) * 2);
                    a4 = __builtin_amdgcn_mfma_f32_16x16x32_bf16(a, bq, a4, 0, 0, 0); } }
            const int l = 16 * lt + lr; const float cl = css[l]; f32x4 v;
#pragma unroll
            for (int r = 0; r < 4; ++r) { const int sI = 16 * stl + 4 * kg + r; v[r] = (sI <= l) ? a4[r] * __expf(cl - css[sI]) : 0.f; }
            unsigned* dummy = nullptr; (void)dummy;
            LAS unsigned* mp = (LAS unsigned*)(Mm + l * 144 + 2 * (16 * stl + 4 * kg)); mp[0] = cvt_pk_bf16(v[0], v[1]); mp[1] = cvt_pk_bf16(v[2], v[3]); }
        __syncthreads();
#pragma unroll
        for (int q = 0; q < 2; ++q) { const int ti = 2 * wid + q, pt = ti >> 2, lt = ti & 3; f32x4 a4 = (f32x4){0.f, 0.f, 0.f, 0.f};
#pragma unroll
            for (int ks = 0; ks < 4; ++ks) { const bf16x8 a = *(const LAS bf16x8*)(Sb + (16 * pt + lr) * 272 + (32 * ks + 8 * kg) * 2), bq = *(const LAS bf16x8*)(Cm + (16 * lt + lr) * 272 + (32 * ks + 8 * kg) * 2);
                a4 = __builtin_amdgcn_mfma_f32_16x16x32_bf16(a, bq, a4, 0, 0, 0); }
            const int l = 16 * lt + lr; const float el = __expf(css[l]);
#pragma unroll
            for (int r = 0; r < 4; ++r) a4[r] *= el;
            const int prow_ = 16 * pt + lr, sw = (2 * pt + (lr >> 3)) & 7;
#pragma unroll
            for (int ks = 0; ks < 2; ++ks) { const bf16x8 a = *(const LAS bf16x8*)(XdT + prow_ * 144 + 16 * ((4 * ks + kg) ^ sw)), bq = *(const LAS bf16x8*)(Mm + (16 * lt + lr) * 144 + (32 * ks + 8 * kg) * 2);
                a4 = __builtin_amdgcn_mfma_f32_16x16x32_bf16(a, bq, a4, 0, 0, 0); }
            const int p0 = 16 * pt + 4 * kg; const LAS unsigned* xp = (const LAS unsigned*)(Xr + l * 144 + 2 * p0); const unsigned x01 = xp[0], x23 = xp[1];
            const float y0 = a4[0] + Dh * bflo(x01), y1 = a4[1] + Dh * bfhi(x01), y2 = a4[2] + Dh * bflo(x23), y3 = a4[3] + Dh * bfhi(x23);
            if (!dry) { unsigned* yp = (unsigned*)(PP + (size_t)(t0 + l) * NPP + 1024 + 64 * h + p0); yp[0] = cvt_pk_bf16(y0, y1); yp[1] = cvt_pk_bf16(y2, y3); } }
        { const float ce = __expf(css[63]); const int nrow = 16 * wid + lr, swn = (2 * wid + (lr >> 3)) & 7;
#pragma unroll
          for (int m = 0; m < 4; ++m) { accS[m] *= ce; const int prow_ = 16 * m + lr, swp = (2 * m + (lr >> 3)) & 7;
#pragma unroll
            for (int ks = 0; ks < 2; ++ks) { const bf16x8 a = *(const LAS bf16x8*)(BdT + nrow * 144 + 16 * ((4 * ks + kg) ^ swn)), bq = *(const LAS bf16x8*)(XdT + prow_ * 144 + 16 * ((4 * ks + kg) ^ swp));
                accS[m] = __builtin_amdgcn_mfma_f32_16x16x32_bf16(a, bq, accS[m], 0, 0, 0); } } }
        __syncthreads();
#pragma unroll
        for (int m = 0; m < 4; ++m) { LAS unsigned* sp = (LAS unsigned*)(Sb + (16 * m + lr) * 272 + 2 * (16 * wid + 4 * kg)); sp[0] = cvt_pk_bf16(accS[m][0], accS[m][1]); sp[1] = cvt_pk_bf16(accS[m][2], accS[m][3]); }
    }
    if (!dry) {
#pragma unroll
        for (int m = 0; m < 4; ++m) *(f32x4*)(c.out + O_SHP + ((size_t)(b * 32 + h) * 64 + 16 * m + lr) * 128 + 16 * wid + 4 * kg) = accS[m];
    }
    __syncthreads();
}

__device__ __forceinline__ void lru_sample(const Ctx& c, int b, int head) {
    const int tid = otid(); LAS float* XC = (LAS float*)c.lds; LAS float* RG = XC + 2048; LAS float* IG = RG + 2048;
    const float* PS = (const float*)(c.ws + OFF_PS); bf16_t* ABRS = (bf16_t*)(c.ws + OFF_ABRS);
    const float* cw = c.in[12]; const float* cb = c.in[13]; const int ch0 = 128 * head;
    for (int e = tid; e < 2048; e += 512) { const int tk = e >> 7, cl = e & 127, cgl = ch0 + cl; float o = cb[cgl];
#pragma unroll
        for (int k = 0; k < 4; ++k) { const int tt = tk - 3 + k; const float v = tt >= 0 ? PS[(size_t)(b * 16 + tt) * 9216 + cgl] : SZ(c.in[2][(size_t)(b * 3 + tt + 3) * D + cgl]); o += cw[k * D + cgl] * v; }
        XC[e] = o; }
    if (tid < 384) { const int r = tid >> 7, cl = tid & 127; c.out[O_LCS + (size_t)(b * 3 + r) * D + ch0 + cl] = PS[(size_t)(b * 16 + 13 + r) * 9216 + ch0 + cl]; }
    __syncthreads();
    {
        LAS unsigned char* XCb = c.lds + 32768; const int wid = tid >> 6, lane = tid & 63, lr = lane & 15, kg = lane >> 4;
        for (int e = tid; e < 2048; e += 512) *(LAS bf16_t*)(XCb + (e >> 7) * 272 + 2 * (e & 127)) = f2bf(XC[e]);
        __syncthreads();
        const bf16_t* wr_ = (const bf16_t*)(c.ws + OFF_WRG) + (size_t)(ch0 + 16 * wid + lr) * 128 + 8 * kg; const bf16_t* wi_ = (const bf16_t*)(c.ws + OFF_WIG) + (size_t)(ch0 + 16 * wid + lr) * 128 + 8 * kg;
        f32x4 ar = (f32x4){0.f, 0.f, 0.f, 0.f}, ai_ = ar;
#pragma unroll
        for (int ks = 0; ks < 4; ++ks) { const bf16x8 br = *(const bf16x8*)(wr_ + 32 * ks), bi = *(const bf16x8*)(wi_ + 32 * ks), a = *(const LAS bf16x8*)(XCb + lr * 272 + (32 * ks + 8 * kg) * 2);
            ar = __builtin_amdgcn_mfma_f32_16x16x32_bf16(a, br, ar, 0, 0, 0); ai_ = __builtin_amdgcn_mfma_f32_16x16x32_bf16(a, bi, ai_, 0, 0, 0); }
        const int cl = 16 * wid + lr; const float b1 = c.in[15][ch0 + cl], b2 = c.in[17][ch0 + cl];
#pragma unroll
        for (int r = 0; r < 4; ++r) { const int tk = 4 * kg + r; RG[tk * 128 + cl] = sigmoidf_(ar[r] + b1); IG[tk * 128 + cl] = sigmoidf_(ai_[r] + b2); }
    }
    __syncthreads();
    if (tid < 128) { const int cgl = ch0 + tid; const float sp = softplusf_(-c.in[18][cgl]); float h = SZ(c.in[3][b * D + cgl]);
        for (int tk = 0; tk < 16; ++tk) { const float la = -8.0f * RG[tk * 128 + tid] * sp, a = __expf(la), u = sqrtf(-expm1f(2.0f * la)) * IG[tk * 128 + tid] * XC[tk * 128 + tid];
            h = a * h + u; ABRS[(size_t)(b * 16 + tk) * 3072 + cgl] = f2bf(gelu_tanh(PS[(size_t)(b * 16 + tk) * 9216 + 4096 + cgl]) * h); }
        c.out[O_LHS + b * D + cgl] = h; }
    __syncthreads();
}
__device__ __forceinline__ void ssd_sample(const Ctx& c, int b, int h) {
    const int tid = otid(); LAS float* XS = (LAS float*)c.lds; LAS float* BS = XS + 1024; LAS float* CS = BS + 2048; LAS float* DTL = CS + 2048;
    const float* PS = (const float*)(c.ws + OFF_PS); const float* DTS = (const float*)(c.ws + OFF_DTS); float* YGS = (float*)(c.ws + OFF_YGS);
    const float* cw = c.in[19]; const float* cb = c.in[20]; const int g = h >> 3;
    for (int e = tid; e < 16 * 320; e += 512) { const int tk = e / 320, q = e % 320; int cc; LAS float* dst;
        if (q < 64) { cc = 64 * h + q; dst = XS + tk * 64 + q; } else if (q < 192) { cc = 2048 + 128 * g + (q - 64); dst = BS + tk * 128 + (q - 64); } else { cc = 2560 + 128 * g + (q - 192); dst = CS + tk * 128 + (q - 192); }
        float o = cb[cc];
#pragma unroll
        for (int k = 0; k < 4; ++k) { const int tt = tk - 3 + k; const float v = tt >= 0 ? PS[(size_t)(b * 16 + tt) * 9216 + 1024 + cc] : SZ(c.in[4][(size_t)(b * 3 + tt + 3) * 3072 + cc]); o += cw[k * 3072 + cc] * v; }
        *dst = siluf_(o);
        if (tk >= 13 && (q < 64 || (h & 7) == 0)) c.out[O_SCS + (size_t)(b * 3 + tk - 13) * 3072 + cc] = PS[(size_t)(b * 16 + tk) * 9216 + 1024 + cc]; }
    if (tid < 16) DTL[tid] = softplusf_(DTS[(b * 16 + tid) * 32 + h] + c.in[21][h]);
    __syncthreads();
    const float Ah = -__expf(c.in[22][h]), Dh = c.in[23][h];
    const int p = tid >> 3, n0 = (tid & 7) * 16; float hs[16];
    const float* h0 = c.in[5] + ((size_t)(b * 32 + h) * 64 + p) * 128 + n0;
#pragma unroll
    for (int j = 0; j < 16; ++j) hs[j] = SZ(h0[j]);
    float zv[16];
#pragma unroll
    for (int tk = 0; tk < 16; ++tk) zv[tk] = PS[(size_t)(b * 16 + tk) * 9216 + 5120 + 64 * h + p];
#pragma unroll
    for (int tk = 0; tk < 16; ++tk) { const float d = DTL[tk], ea = __expf(d * Ah), xv = XS[tk * 64 + p], dx = d * xv; float y = 0.f;
#pragma unroll
        for (int j = 0; j < 16; ++j) { hs[j] = ea * hs[j] + dx * BS[tk * 128 + n0 + j]; y += CS[tk * 128 + n0 + j] * hs[j]; }
        y += __shfl_xor(y, 1); y += __shfl_xor(y, 2); y += __shfl_xor(y, 4);
        if ((tid & 7) == 0) { const int row = b * 16 + tk; YGS[(size_t)row * 2048 + 64 * h + p] = (y + Dh * xv) * siluf_(zv[tk]); } }
    float* ho = c.out + O_SHS + ((size_t)(b * 32 + h) * 64 + p) * 128 + n0;
#pragma unroll
    for (int j = 0; j < 16; ++j) ho[j] = hs[j];
    __syncthreads();
}

#ifdef DIAG
constexpr size_t OFF_DIAG = 266338304;
__device__ __forceinline__ int prow(int r) { return (r >> 4) * SEQ + (r & 15); }
template <class FA, class FB>
__device__ __forceinline__ void diag_rel(LAS float* red, float* dst, int ncols, FA fa, FB fb) {
    const int tid = threadIdx.x; float num = 0.f, den = 0.f;
    for (int e = tid; e < TS * ncols; e += 512) { const int r = e / ncols, cc = e % ncols; const float a = fa(r, cc), b = fb(r, cc); num += (a - b) * (a - b); den += b * b; }
    red[tid] = num; red[512 + tid] = den; __syncthreads();
    if (tid == 0) { float n = 0.f, d = 0.f; for (int i = 0; i < 512; ++i) { n += red[i]; d += red[512 + i]; } *dst = n / (d + 1e-30f); }
    __syncthreads();
}
#endif
constexpr size_t OFF_BAR = 266338304 + 4096, OFF_SSQS = OFF_BAR + 4096;
__device__ __forceinline__ void grid_barrier(unsigned* ctr, unsigned target) {
    asm volatile("s_waitcnt vmcnt(0) lgkmcnt(0)" ::: "memory");
    __syncthreads();
    if (threadIdx.x == 0) {
        __builtin_amdgcn_fence(__ATOMIC_RELEASE, "agent");
        asm volatile("s_waitcnt vmcnt(0)" ::: "memory");
        __hip_atomic_fetch_add(ctr, 1u, __ATOMIC_RELAXED, __HIP_MEMORY_SCOPE_AGENT);
        while (__hip_atomic_load(ctr, __ATOMIC_RELAXED, __HIP_MEMORY_SCOPE_AGENT) < target) __builtin_amdgcn_s_sleep(1);
        __builtin_amdgcn_fence(__ATOMIC_ACQUIRE, "agent");
        asm volatile("s_waitcnt vmcnt(0)" ::: "memory");
    }
    __syncthreads();
}
#define XB_TMO      128
#define XB_XCNT(j)  (256  + 64 * (j))
#define XB_XSUB(j)  (1280 + 64 * (j))
#define XB_XGEN(j)  (2304 + 64 * (j))
#define XB_TOP      3328
#define XB_TOPGEN   3392
#define XCD_BAR_WORDS 3456
#define XB_SPIN_CAP (1u << 18)
constexpr size_t OFF_XBAR = 266338304 + 4096 + 4096 + 65536;
__device__ __forceinline__ unsigned xb_ld(unsigned* p)              { return __hip_atomic_load(p, __ATOMIC_RELAXED, __HIP_MEMORY_SCOPE_AGENT); }
__device__ __forceinline__ unsigned xb_add(unsigned* p, unsigned v) { return __hip_atomic_fetch_add(p, v, __ATOMIC_RELAXED, __HIP_MEMORY_SCOPE_AGENT); }
__device__ __forceinline__ unsigned xb_xcc_id() { return (unsigned)__builtin_amdgcn_s_getreg((3 << 11) | 20) & 0xFu; }
#define XB_SPIN(cond, bar) do { unsigned _sp = 0; while (cond) { __builtin_amdgcn_s_sleep(1); \
    if ((++_sp & 255u) == 0u) { if (xb_ld(&(bar)[XB_TMO])) break; if (_sp > XB_SPIN_CAP) { atomicAdd(&(bar)[XB_TMO], 1u); break; } } } } while (0)
struct XcdBarrier { unsigned* bar; unsigned x; volatile LAS unsigned* st; };
__device__ __forceinline__ XcdBarrier xcd_barrier_post(unsigned* bar, volatile LAS unsigned* st) {
    XcdBarrier b; b.bar = bar; b.x = xb_xcc_id(); b.st = st;
    if (threadIdx.x == 0) (void)xb_add(&bar[XB_XCNT(b.x)], 1u);
    return b;
}
__device__ __forceinline__ void xcd_barrier_complete(unsigned* bar, unsigned x, unsigned& nloc, unsigned& nx) {
    const unsigned G = gridDim.x * gridDim.y * gridDim.z;
    unsigned sum, cnt, mine, sp = 0u;
    for (;;) {
        sum = 0u; cnt = 0u; mine = 0u;
#pragma unroll
        for (unsigned j = 0; j < 16; ++j) { const unsigned c = xb_ld(&bar[XB_XCNT(j)]); sum += c; cnt += (c > 0u) ? 1u : 0u; mine = (j == x) ? c : mine; }
        if (sum == G) break;
        __builtin_amdgcn_s_sleep(1);
        if ((++sp & 255u) == 0u) { if (xb_ld(&bar[XB_TMO])) break; if (sp > XB_SPIN_CAP) { atomicAdd(&bar[XB_TMO], 1u); break; } }
    }
    nloc = mine > 0u ? mine : 1u; nx = cnt > 0u ? cnt : 1u;
}
__device__ __forceinline__ void xcd_barrier(const XcdBarrier& b) {
    asm volatile("s_waitcnt vmcnt(0)" ::: "memory");
    __syncthreads();
    if (threadIdx.x == 0) {
        unsigned* bar = b.bar;
        __builtin_amdgcn_s_waitcnt(0);
        unsigned nloc = b.st[0], nx = b.st[1];
        if (nloc == 0u) { xcd_barrier_complete(bar, b.x, nloc, nx); b.st[0] = nloc; b.st[1] = nx; }
        const unsigned old = xb_add(&bar[XB_XSUB(b.x)], 1u);
        const unsigned gen = old / nloc;
        if (old + 1u == (gen + 1u) * nloc) {
            __builtin_amdgcn_fence(__ATOMIC_RELEASE, "agent");
            asm volatile("s_waitcnt vmcnt(0)" ::: "memory");
            const unsigned og = xb_add(&bar[XB_TOP], 1u);
            const unsigned tg = og / nx;
            if (og + 1u == (tg + 1u) * nx) xb_add(&bar[XB_TOPGEN], 1u);
            else XB_SPIN(xb_ld(&bar[XB_TOPGEN]) == tg, bar);
            __builtin_amdgcn_fence(__ATOMIC_ACQUIRE, "agent");
            xb_add(&bar[XB_XGEN(b.x)], 1u);
            asm volatile("s_waitcnt vmcnt(0)" ::: "memory");
        } else {
            XB_SPIN(xb_ld(&bar[XB_XGEN(b.x)]) == gen, bar);
            __builtin_amdgcn_fence(__ATOMIC_ACQUIRE, "agent");
            asm volatile("s_waitcnt vmcnt(0)" ::: "memory");
        }
    }
    __syncthreads();
}
#ifndef DUPX
#define DUPX 0
#endif
#ifdef TIMER_ID
#define TSTART(id) do { if ((id) == TIMER_ID) t0_ = __builtin_amdgcn_s_memrealtime(); } while (0)
#define TSTOP(id) do { if ((id) == TIMER_ID) tacc_ += __builtin_amdgcn_s_memrealtime() - t0_; } while (0)
#else
#define TSTART(id)
#define TSTOP(id)
#endif
__global__ void __launch_bounds__(512, 2) fwd_kernel(Params prm) {
    extern __shared__ __attribute__((aligned(16))) unsigned char lds_raw[];
    Ctx c; c.in = prm.in; c.out = prm.out; c.ws = prm.ws; c.lds = (LAS unsigned char*)lds_raw;
    unsigned char* ws = prm.ws; float* out = prm.out;
    const int tid = threadIdx.x, G = gridDim.x, bid = blockIdx.x;
    bf16_t* XB = (bf16_t*)(ws + OFF_XB); bf16_t* XN = (bf16_t*)(ws + OFF_XN); bf16_t* PP = (bf16_t*)(ws + OFF_PP); float* SSQ = (float*)(ws + OFF_SSQ);
    bf16_t* XNS = (bf16_t*)(ws + OFF_XNS); bf16_t* HS = (bf16_t*)(ws + OFF_HS); float* PS = (float*)(ws + OFF_PS); float* GSSQ = (float*)(ws + OFF_GSSQ);
    float* YS = out + O_YS; float* SSQS = (float*)(ws + OFF_SSQS);
    const int lo = prm.ph_lo, hi = prm.ph_hi;
#ifdef DIAG
    if (lo >= 100) {
        if (bid != 0) return;
        float* DG = (float*)(ws + OFF_DIAG); LAS float* red = (LAS float*)c.lds; const int st = lo - 100;
        const float* DTp = (const float*)(ws + OFF_DT); const float* DTs = (const float*)(ws + OFF_DTS); const bf16_t* ABRS = (const bf16_t*)(ws + OFF_ABRS); const bf16_t* MS = (const bf16_t*)(ws + OFF_MS); const float* bg = prm.in[11];
        if (st == 0 || st == 6 || st == 7) diag_rel(red, DG + st, D, [=](int r, int cc) { return out[O_YP + (size_t)prow(r) * D + cc]; }, [=](int r, int cc) { return YS[(size_t)r * D + cc]; });
        if (st == 1) { diag_rel(red, DG + 1, NPP, [=](int r, int cc) { return bf2f(PP[(size_t)prow(r) * NPP + cc]); }, [=](int r, int cc) { return PS[(size_t)r * 9216 + cc]; });
                       diag_rel(red, DG + 2, 32, [=](int r, int cc) { return DTp[(size_t)prow(r) * 32 + cc]; }, [=](int r, int cc) { return DTs[(size_t)r * 32 + cc]; }); }
        if (st == 8) { diag_rel(red, DG + 8, D, [=](int r, int cc) { return bf2f(XN[(size_t)prow(r) * D + cc]); }, [=](int r, int cc) { return sigmoidf_(PS[(size_t)r * 9216 + 7168 + cc] + bg[cc]); });
                       diag_rel(red, DG + 9, D, [=](int r, int cc) { return bf2f(PP[(size_t)prow(r) * NPP + 3072 + cc]); }, [=](int r, int cc) { return sigmoidf_(PS[(size_t)r * 9216 + 8192 + cc] + bg[1024 + cc]); }); }
        if (st == 3) { diag_rel(red, DG + 3, D, [=](int r, int cc) { return bf2f(PP[(size_t)prow(r) * NPP + cc]); }, [=](int r, int cc) { return bf2f(ABRS[(size_t)r * 3072 + cc]); });
                       diag_rel(red, DG + 4, 2048, [=](int r, int cc) { return bf2f(PP[(size_t)prow(r) * NPP + 1024 + cc]); }, [=](int r, int cc) { return bf2f(ABRS[(size_t)r * 3072 + 1024 + cc]); }); }
        if (st == 5) diag_rel(red, DG + 5, D, [=](int r, int cc) { return bf2f(XN[(size_t)prow(r) * D + cc]); }, [=](int r, int cc) { return bf2f(MS[(size_t)r * D + cc]); });
        if (st == 20) {
            int mask = 0; if (!(DG[8] < DIAG_TOL)) mask |= 1; if (!(DG[9] < DIAG_TOL)) mask |= 2; if (!(DG[3] < DIAG_TOL)) mask |= 4; if (!(DG[4] < DIAG_TOL)) mask |= 8; if (!(DG[5] < DIAG_TOL)) mask |= 16;
            if (mask == 0) { if (!(DG[6] < DIAG_TOL)) mask |= 32; if (!(DG[7] < DIAG_TOL)) mask |= 64; }
            float code = mask ? 100.f * (1 + mask) : 0.f;
            if (code > 0.f) for (int e = tid; e < TS * D; e += 512) YS[e] = code;
        }
        return;
    }
#endif
#ifndef PHMASK
#define PHMASK 0x1fff
#endif
#define IN(k) (((PHMASK >> (k)) & 1) && lo <= (k) && (k) < hi)
    unsigned* barctr = (unsigned*)(ws + OFF_BAR); unsigned nbar = 0; (void)barctr;
    volatile LAS unsigned* xbst = (volatile LAS unsigned*)(c.lds + LDS_BYTES - 16);
    if (tid < 4) xbst[tid] = 0u;
    __syncthreads();
    XcdBarrier xbar; xbar.bar = (unsigned*)(ws + OFF_XBAR); xbar.x = 0; xbar.st = xbst;
    if (hi - lo > 1) xbar = xcd_barrier_post((unsigned*)(ws + OFF_XBAR), xbst);
    unsigned long long t0_ = 0, tacc_ = 0; (void)t0_; (void)tacc_;
#define SEAM(k) do { if (IN(k) && IN((k) + 1)) { TSTART(12); ++nbar; xcd_barrier(xbar); TSTOP(12); } } while (0)
    auto rm_id = [](int col0, int) { return col0; };
    auto rm_up = [](int col0, int panel) { return (col0 >> 7) * 256 + panel * 128 + (col0 & 127); };

    if (IN(0)) {
        TSTART(0); prep_weights(c);
#if DUPX == 1
        prep_weights(c);
#endif
        rmsnorm_rows_bf16(prm.in[0], T, prm.in[6], XN); TSTOP(0);
#ifdef DIAG
        { const int t_ = otid(), lane = t_ & 63; for (int r = bid * 8 + (t_ >> 6); r < TS; r += G * 8) { const float* p = prm.in[0] + (size_t)prow(r) * D; float v[16]; float s = 0.f;
            for (int i = 0; i < 16; ++i) { v[i] = p[lane + 64 * i]; s += v[i] * v[i]; }
            for (int o = 1; o < 64; o <<= 1) s += __shfl_xor(s, o);
            const float inv = rsqrtf(s * (1.0f / 1024.0f) + EPS);
            for (int i = 0; i < 16; ++i) XNS[(size_t)r * D + lane + 64 * i] = f2bf(v[i] * inv * prm.in[6][lane + 64 * i]); } }
#else
        rmsnorm_rows_bf16(prm.in[1], TS, prm.in[6], XNS);
#endif
    }
    SEAM(0);
    if (IN(1)) {
        pg8::Gemm g{XN, D, (const bf16_t*)(ws + OFF_WUP1), D, T, 2 * FF, D}; pg8::StaticOrder S; S.init(T, 2 * FF, G, bid);

#if DUPX == 5
        pg8::gemm_phase(c.lds, g, S, EpiSwiglu{PP, (LAS const float*)nullptr});
#endif
        TSTART(1); pg8::gemm_phase(c.lds, g, S, EpiSwiglu{PP, (LAS const float*)nullptr}); TSTOP(1);
        TSTART(2); sgemm<16, 2, D>(c.lds, XNS, D, (const bf16_t*)(ws + OFF_WUP1), D, FF, nullptr, nullptr, rm_up,
            [=](int r, int cc, float v0, float v1, float) { HS[(size_t)r * FF + cc] = f2bf(siluf_(v0) * v1); return 0.f; }, G / 2); TSTOP(2);
    }
    SEAM(1);
    if (IN(2)) {
        pg8::Gemm g{PP, FF, (const bf16_t*)(ws + OFF_WDN1), FF, T, D, FF}; pg8::StaticOrder S; S.init(T, D, G, bid);
        TSTART(10); pg8::gemm_phase(c.lds, g, S, EpiResid{prm.in[0], nullptr, nullptr, XB, SSQ, 0.5f}); TSTOP(10);
        const float* xs_in = prm.in[1];
        TSTART(2); sgemm<16, 1, FF>(c.lds, HS, FF, (const bf16_t*)(ws + OFF_WDN1), FF, D, nullptr, SSQS, rm_id,
            [=](int r, int cc, float v0, float, float) {
#ifdef DIAG
            const float x = prm.in[0][(size_t)prow(r) * D + cc] + 0.5f * v0;
#else
            const float x = xs_in[(size_t)r * D + cc] + 0.5f * v0;
#endif
            YS[(size_t)r * D + cc] = x; XNS[(size_t)r * D + cc] = f2bf(x); return x; }); TSTOP(2);
    }
    SEAM(2);
    if (IN(3)) {
        pg8::Gemm g{XB, D, (const bf16_t*)(ws + OFF_WIN), D, T, NPP, D}; pg8::StaticOrder S; S.init(T, NPP, G, bid);

#if DUPX == 6
        pg8::gemm_phase(c.lds, g, S, EpiScaleBf16{PP, SSQ});
#endif
        LAS const float* linv = fill_inv(c.lds, SSQ); TSTART(11); pg8::gemm_phase(c.lds, g, S, EpiScaleBf16{PP, linv}); TSTOP(11);
        float* DTp = (float*)(ws + OFF_DT); float* DTs = (float*)(ws + OFF_DTS);
        TSTART(2);
        {
            const int t_ = otid(), wv = t_ >> 6, ln = t_ & 63, lr = ln & 15, kg = ln >> 4; const bf16_t* WDT = (const bf16_t*)(ws + OFF_WDT);
            for (int wt = bid * 8 + wv; wt < T / 16; wt += G * 8) {
                f32x4 a0 = (f32x4){0.f, 0.f, 0.f, 0.f}, a1 = a0; f32x4 sq[4][4];
#pragma unroll
                for (int r = 0; r < 4; ++r)
#pragma unroll
                    for (int i = 0; i < 4; ++i) sq[r][i] = *(const f32x4*)(SSQ + (size_t)(16 * wt + 4 * kg + r) * 16 + 4 * i);
                const bf16_t* ap = XB + (size_t)(16 * wt + lr) * D + 8 * kg; const bf16_t* bp = WDT + (size_t)lr * D + 8 * kg;
#pragma unroll 8
                for (int k = 0; k < D; k += 32) { const bf16x8 a = *(const bf16x8*)(ap + k), b0 = *(const bf16x8*)(bp + k), b1 = *(const bf16x8*)(bp + 16 * D + k);
                    a0 = __builtin_amdgcn_mfma_f32_16x16x32_bf16(a, b0, a0, 0, 0, 0); a1 = __builtin_amdgcn_mfma_f32_16x16x32_bf16(a, b1, a1, 0, 0, 0); }
#pragma unroll
                for (int r = 0; r < 4; ++r) { const int row = 16 * wt + 4 * kg + r; const f32x4 sm = (sq[r][0] + sq[r][1]) + (sq[r][2] + sq[r][3]); const float inv = rsqrtf(((sm[0] + sm[1]) + (sm[2] + sm[3])) * (1.0f / 1024.0f) + EPS); DTp[(size_t)row * 32 + lr] = a0[r] * inv; DTp[(size_t)row * 32 + 16 + lr] = a1[r] * inv; }
            }
        }
        TSTOP(2);
        TSTART(2); sgemm<32, 1, D>(c.lds, XNS, D, (const bf16_t*)(ws + OFF_WIN), D, 9216, SSQS, nullptr, rm_id,
            [=](int r, int cc, float v0, float, float inv) { PS[(size_t)r * 9216 + cc] = v0 * inv; return 0.f; }); TSTOP(2);
        TSTART(2); sgemm<32, 1, D>(c.lds, XNS, D, (const bf16_t*)(ws + OFF_WDT), D, 32, SSQS, nullptr, rm_id,
            [=](int r, int cc, float v0, float, float inv) { DTs[(size_t)r * 32 + cc] = v0 * inv; return 0.f; }); TSTOP(2);
    }
    SEAM(3);
    if (IN(4)) {
        for (int e = bid * 512 + tid; e < 8 * 3 * 2048; e += G * 512) {
            const int cc = e & 2047, r = (e >> 11) % 3, b = e / (3 * 2048); const size_t row = (size_t)b * SEQ + 2045 + r;
            if (cc < 1024) out[O_LCP + (size_t)(b * 3 + r) * D + cc] = bf2f(PP[row * NPP + cc]);
            else out[O_SCP + (size_t)(b * 3 + r) * 3072 + 2048 + (cc - 1024)] = bf2f(PP[row * NPP + 3072 + (cc - 1024)]); }

#if DUPX == 4
        for (int it = bid; it < 256; it += G) lru_chunk<false>(c, it >> 5, it & 31);
#endif
        TSTART(19); for (int it = bid; it < 256; it += G) bc_conv(c, it >> 5, it & 31); TSTOP(19);
        TSTART(3); for (int it = bid; it < 256; it += G) lru_chunk<false>(c, it >> 5, it & 31); TSTOP(3);

#if DUPX == 3
        for (int it = bid; it < 256; it += G) ssd_seq(c, it >> 5, it & 31, prm.ph_lo == 0);
#endif


    }
    SEAM(4);
    if (IN(5)) {

#if DUPX == 2
        for (int it = bid; it < 256; it += G) lru_chunk<true>(c, it >> 5, it & 31, prm.ph_lo == 0);
#endif
        TSTART(4); for (int it = bid; it < 256; it += G) ssd_seq(c, it >> 5, it & 31); TSTOP(4);
        TSTART(5); for (int it = bid; it < 256; it += G) lru_chunk<true>(c, it >> 5, it & 31); TSTOP(5);
        TSTART(2); for (int it = bid; it < 64; it += G) lru_sample(c, it >> 3, it & 7); TSTOP(2);
        TSTART(2); for (int it = bid; it < 256; it += G) ssd_sample(c, it >> 5, it & 31); TSTOP(2);
    }
    SEAM(5);
    if (IN(6)) { TSTART(8);
        {
        const float* YGS = (const float*)(ws + OFF_YGS); bf16_t* ABRS = (bf16_t*)(ws + OFF_ABRS);
        const int lane = tid & 63;
        for (int w = bid * 8 + (tid >> 6); w < TS * 4; w += G * 8) { const int r = w >> 2, gq = w & 3; const float* p = YGS + (size_t)r * 2048 + 512 * gq; float v[8]; float s = 0.f;
#pragma unroll
            for (int j = 0; j < 8; ++j) { v[j] = p[lane + 64 * j]; s += v[j] * v[j]; }
#pragma unroll
            for (int o = 1; o < 64; o <<= 1) s += __shfl_xor(s, o);
            const float inv = rsqrtf(s * (1.0f / 512.0f) + EPS);
#pragma unroll
            for (int j = 0; j < 8; ++j) ABRS[(size_t)r * 3072 + 1024 + 512 * gq + lane + 64 * j] = f2bf(v[j] * inv); }
        }
        LAS const float* linv = fill_inv(c.lds, SSQ);
        { pg8::Gemm g{XB, D, (const bf16_t*)(ws + OFF_WIN) + (size_t)4096 * D, D, T, 3072, D}; pg8::StaticOrder S; S.init(T, 3072, G, bid);
          pg8::gemm_phase(c.lds, g, S, EpiGatesA{PP, linv, GSSQ}); }
        { pg8::Gemm g{XB, D, (const bf16_t*)(ws + OFF_WIN) + (size_t)7168 * D, D, T, D, D}; pg8::StaticOrder S; S.init(T, D, G, bid);
          pg8::gemm_phase(c.lds, g, S, EpiSigmoid{XN, D, linv, prm.in[11]}); }
        { pg8::Gemm g{XB, D, (const bf16_t*)(ws + OFF_WIN) + (size_t)8192 * D, D, T, D, D}; pg8::StaticOrder S; S.init(T, D, G, bid);
          pg8::gemm_phase(c.lds, g, S, EpiSigmoid{PP + 3072, NPP, linv, prm.in[11] + 1024}); } TSTOP(8);
    }
    SEAM(6);
    if (IN(7)) { TSTART(6);
        const int lane = tid & 63;
        for (int r = bid * 8 + (tid >> 6); r < T; r += G * 8) {
            float s = (lane < 32) ? GSSQ[(size_t)r * 32 + lane] : 0.f;
            s += __shfl_xor(s, 1); s += __shfl_xor(s, 2); s += __shfl_xor(s, 4);
            const float i0 = rsqrtf(__shfl(s, 0) * (1.0f / 512.0f) + EPS), i1 = rsqrtf(__shfl(s, 8) * (1.0f / 512.0f) + EPS), i2 = rsqrtf(__shfl(s, 16) * (1.0f / 512.0f) + EPS), i3 = rsqrtf(__shfl(s, 24) * (1.0f / 512.0f) + EPS);
#pragma unroll
            for (int i = 0; i < 4; ++i) { const float inv = i == 0 ? i0 : (i == 1 ? i1 : (i == 2 ? i2 : i3));
                bf16_t* p = PP + (size_t)r * NPP + 1024 + 512 * i + 8 * lane; f32x4 a, bq; unpack8(*(const u32x4*)p, a, bq); *(u32x4*)p = pack8(a * inv, bq * inv); }
        }
    }
    TSTOP(6); SEAM(7);
    if (IN(8)) {
        TSTART(9); { pg8::Gemm g{PP, NPP, (const bf16_t*)(ws + OFF_WBR), 3072, T, D, D}; pg8::StaticOrder S; S.init(T, D, G, bid); pg8::gemm_phase(c.lds, g, S, EpiBr{XN, PP, 0}); }
        { pg8::Gemm g{PP + 1024, NPP, (const bf16_t*)(ws + OFF_WBR) + 1024, 3072, T, D, 2048}; pg8::StaticOrder S; S.init(T, D, G, bid); pg8::gemm_phase(c.lds, g, S, EpiBr{XN, PP, 1}); } TSTOP(9);
        const bf16_t* ABRS = (const bf16_t*)(ws + OFF_ABRS); float* M1S = (float*)(ws + OFF_M1S); bf16_t* MS = (bf16_t*)(ws + OFF_MS); const float* bg = prm.in[11];
        TSTART(2); sgemm<16, 1, D>(c.lds, ABRS, 3072, (const bf16_t*)(ws + OFF_WBR), 3072, D, nullptr, nullptr, rm_id,
            [=](int r, int cc, float v0, float, float) { M1S[(size_t)r * D + cc] = sigmoidf_(PS[(size_t)r * 9216 + 7168 + cc] + bg[cc]) * v0; return 0.f; }); TSTOP(2);
        TSTART(2); sgemm<16, 1, 2048>(c.lds, ABRS + 1024, 3072, (const bf16_t*)(ws + OFF_WBR) + 1024, 3072, D, nullptr, nullptr, rm_id,
            [=](int r, int cc, float v0, float, float) { MS[(size_t)r * D + cc] = f2bf(M1S[(size_t)r * D + cc] + sigmoidf_(PS[(size_t)r * 9216 + 8192 + cc] + bg[1024 + cc]) * v0); return 0.f; }); TSTOP(2);
    }
    SEAM(8);
    if (IN(9)) {
        pg8::Gemm g{XN, D, (const bf16_t*)(ws + OFF_WOUT), D, T, D, D}; pg8::StaticOrder S; S.init(T, D, G, bid);
        TSTART(16); pg8::gemm_phase(c.lds, g, S, EpiResid{nullptr, XB, nullptr, XB, SSQ, 1.0f}); TSTOP(16);
        const bf16_t* MS = (const bf16_t*)(ws + OFF_MS);
        TSTART(2); sgemm<16, 1, D>(c.lds, MS, D, (const bf16_t*)(ws + OFF_WOUT), D, D, nullptr, SSQS + 8192, rm_id,
            [=](int r, int cc, float v0, float, float) { const float x = YS[(size_t)r * D + cc] + v0; YS[(size_t)r * D + cc] = x; XNS[(size_t)r * D + cc] = f2bf(x); return x; }); TSTOP(2);
    }
    SEAM(9);
    if (IN(10)) {
        pg8::Gemm g{XB, D, (const bf16_t*)(ws + OFF_WUP2), D, T, 2 * FF, D}; pg8::StaticOrder S; S.init(T, 2 * FF, G, bid);
        LAS const float* linv = fill_inv(c.lds, SSQ);
        TSTART(17); pg8::gemm_phase(c.lds, g, S, EpiSwiglu{PP, linv}); TSTOP(17);
        TSTART(2); sgemm<16, 2, D>(c.lds, XNS, D, (const bf16_t*)(ws + OFF_WUP2), D, FF, SSQS + 8192, nullptr, rm_up,
            [=](int r, int cc, float v0, float v1, float inv) { HS[(size_t)r * FF + cc] = f2bf(siluf_(v0 * inv) * (v1 * inv)); return 0.f; }, G / 2); TSTOP(2);
    }
    SEAM(10);
    if (IN(11)) {
        pg8::Gemm g{PP, FF, (const bf16_t*)(ws + OFF_WDN2), FF, T, D, FF}; pg8::StaticOrder S; S.init(T, D, G, bid);
        TSTART(18); pg8::gemm_phase(c.lds, g, S, EpiResid{nullptr, XB, out + O_YP, nullptr, SSQ, 0.5f}); TSTOP(18);
        TSTART(2); sgemm<16, 1, FF>(c.lds, HS, FF, (const bf16_t*)(ws + OFF_WDN2), FF, D, nullptr, nullptr, rm_id,
            [=](int r, int cc, float v0, float, float) { YS[(size_t)r * D + cc] += 0.5f * v0; return 0.f; }); TSTOP(2);
    }
    SEAM(11);
    if (IN(12)) {
        TSTART(7); rmsnorm_rows_f32(out + O_YP, T + TS, prm.in[31]); TSTOP(7);
    }
#ifdef TIMER_ID
    if (hi == 13) { ++nbar; grid_barrier(barctr, nbar * (unsigned)G);
        if (bid == TIMER_BLOCK) { const float us = (float)tacc_ * 0.0001f; for (int e = tid; e < TS * D; e += 512) YS[e] = us; } }
#endif
#undef IN
#undef SEAM
}

#ifndef N_LAUNCH_MODE
#define N_LAUNCH_MODE 1
#endif
extern "C" void kernel_launch(void* const* d_in, const int* in_sizes, int n_in, void* d_out, int out_size, void* d_ws, size_t ws_size, hipStream_t stream) {
    static int grid = 0;
    if (grid == 0) {
        if (n_in != 32 || ws_size < OFF_XBAR + XCD_BAR_WORDS * 4) { fprintf(stderr, "kernel_launch: unexpected n_in %d or ws_size %zu (< %zu)\n", n_in, ws_size, (size_t)WS_END); grid = -1; return; }
        int dev = 0, cus = 0, per_cu = 0;
        hipGetDevice(&dev); hipDeviceGetAttribute(&cus, hipDeviceAttributeMultiprocessorCount, dev);
        if (hipFuncSetAttribute((const void*)fwd_kernel, hipFuncAttributeMaxDynamicSharedMemorySize, LDS_BYTES) != hipSuccess) { fprintf(stderr, "kernel_launch: hipFuncSetAttribute failed\n"); grid = -1; return; }
        hipOccupancyMaxActiveBlocksPerMultiprocessor(&per_cu, (const void*)fwd_kernel, 512, LDS_BYTES);
        if (per_cu < 1) { fprintf(stderr, "kernel_launch: occupancy query says %d blocks per CU\n", per_cu); per_cu = 1; }
        grid = cus * 1;
        (void)hipGetLastError();
    }
    if (grid < 0) return;
    Params p{};
    for (int i = 0; i < 32; ++i) p.in[i] = (const float*)d_in[i];
    p.out = (float*)d_out; p.ws = (unsigned char*)d_ws;
#if N_LAUNCH_MODE == 0
    for (int ph = 0; ph < 13; ++ph) { p.ph_lo = ph; p.ph_hi = ph + 1; hipLaunchKernelGGL(fwd_kernel, dim3(grid), dim3(512), LDS_BYTES, stream, p);
#ifdef DIAG
        int st = -1; if (ph == 2) st = 0; if (ph == 3) st = 1; if (ph == 6) st = 8; if (ph == 7) st = 3; if (ph == 8) st = 5; if (ph == 9) st = 6; if (ph == 11) st = 7; if (ph == 12) st = 20;
        if (st >= 0) { p.ph_lo = 100 + st; p.ph_hi = 0; hipLaunchKernelGGL(fwd_kernel, dim3(grid), dim3(512), LDS_BYTES, stream, p); }
#endif
    }
#else
    p.ph_lo = 0; p.ph_hi = 13;
    hipMemsetAsync((char*)d_ws + OFF_XBAR, 0, XCD_BAR_WORDS * 4, stream);
    void* args[] = {&p};
    hipError_t e = hipLaunchCooperativeKernel((const void*)fwd_kernel, dim3(grid), dim3(512), args, LDS_BYTES, stream);
    if (e != hipSuccess) fprintf(stderr, "cooperative launch failed: %s (grid %d)\n", hipGetErrorString(e), grid);
#endif
}
```

```cpp
#include <hip/hip_runtime.h>
#include <hip/hip_cooperative_groups.h>
#include <cstdio>
namespace cg = cooperative_groups;

#define LAS __attribute__((address_space(3)))
typedef unsigned short bf16_t;
typedef short bf16x8 __attribute__((ext_vector_type(8)));
typedef float f32x4 __attribute__((ext_vector_type(4)));
typedef unsigned u32x4 __attribute__((ext_vector_type(4)));

constexpr int T = 16384, TS = 128, D = 1024, FF = 2816, NPP = 4096, SEQ = 2048, NCH = 32;
constexpr float EPS = 1e-6f;
constexpr size_t OFF_WUP1 = 0, OFF_WDN1 = 11534336;
constexpr size_t OFF_DT = 0, OFF_SUMM = 2097152, OFF_HALO = 4194304, OFF_GSSQ = 5767168, OFF_PS = 7864320,
                 OFF_DTS = 12582912, OFF_YGS = 12599296, OFF_ABRS = 13647872, OFF_M1S = 14434304, OFF_MS = 14958592;
constexpr size_t OFF_WIN = 17301504, OFF_WDT = 36175872, OFF_WBR = 36241408, OFF_WOUT = 42532864, OFF_WUP2 = 44630016,
                 OFF_WDN2 = 56164352, OFF_WRG = 61931520, OFF_WIG = 62193664, OFF_XB = 62455808, OFF_XN = 96010240,
                 OFF_PP = 129564672, OFF_SSQ = 263782400, OFF_XNS = 264830976, OFF_HS = 265093120, WS_END = 265814016;
constexpr size_t O_YP = 0, O_YS = 16777216, O_LCP = 16908288, O_LHP = 16932864, O_SCP = 16941056, O_SHP = 17014784,
                 O_LCS = 19111936, O_LHS = 19136512, O_SCS = 19144704, O_SHS = 19218432;
constexpr int LDS_BYTES = 143360;
constexpr int LDS_INV = 131072;

struct Params { const float* in[32]; float* out; unsigned char* ws; int ph_lo, ph_hi; };

#ifdef DIAG
#define SZ(x) 0.0f
#ifndef DIAG_TOL
#define DIAG_TOL 0.01f
#endif
#else
#define SZ(x) (x)
#endif
__device__ __forceinline__ int otid() { int t = threadIdx.x; asm volatile("" : "+v"(t)); return t; }
__device__ __forceinline__ unsigned cvt_pk_bf16(float lo, float hi) { unsigned r; asm volatile("v_cvt_pk_bf16_f32 %0, %1, %2" : "=v"(r) : "v"(lo), "v"(hi)); return r; }
__device__ __forceinline__ bf16_t f2bf(float f) { return (bf16_t)(cvt_pk_bf16(f, 0.f) & 0xffffu); }
__device__ __forceinline__ float bf2f(bf16_t b) { return __uint_as_float(((unsigned)b) << 16); }
__device__ __forceinline__ float bflo(unsigned w) { return __uint_as_float(w << 16); }
__device__ __forceinline__ float bfhi(unsigned w) { return __uint_as_float(w & 0xffff0000u); }
__device__ __forceinline__ float sigmoidf_(float x) { return __builtin_amdgcn_rcpf(1.0f + __expf(-x)); }
__device__ __forceinline__ float siluf_(float x) { return x * sigmoidf_(x); }
__device__ __forceinline__ float gelu_tanh(float x) { const float u = 0.7978845608028654f * (x + 0.044715f * x * x * x); return x * sigmoidf_(2.0f * u); }
__device__ __forceinline__ float softplusf_(float x) { return x > 20.f ? x : log1pf(__expf(x)); }
__device__ __forceinline__ u32x4 pack8(const f32x4 a, const f32x4 b) { u32x4 w; w.x = cvt_pk_bf16(a[0], a[1]); w.y = cvt_pk_bf16(a[2], a[3]); w.z = cvt_pk_bf16(b[0], b[1]); w.w = cvt_pk_bf16(b[2], b[3]); return w; }
__device__ __forceinline__ void unpack8(const u32x4 w, f32x4& a, f32x4& b) { a[0] = bflo(w.x); a[1] = bfhi(w.x); a[2] = bflo(w.y); a[3] = bfhi(w.y); b[0] = bflo(w.z); b[1] = bfhi(w.z); b[2] = bflo(w.w); b[3] = bfhi(w.w); }
__device__ __forceinline__ float rowinv16(const float* ssq, int row) {
    const f32x4* p = (const f32x4*)(ssq + (size_t)row * 16); const f32x4 a = p[0], b = p[1], c = p[2], d = p[3];
    const float s = ((a[0] + a[1]) + (a[2] + a[3])) + ((b[0] + b[1]) + (b[2] + b[3])) + ((c[0] + c[1]) + (c[2] + c[3])) + ((d[0] + d[1]) + (d[2] + d[3]));
    return rsqrtf(s * (1.0f / 1024.0f) + EPS);
}

namespace pg8 {
constexpr int BM = 256, BK = 64, HALF = 128, HTB = HALF * BK * 2, STAGE_BYTES = 8 * HTB, NXCD = 8, WGM = 8;
__device__ __forceinline__ int lds_byte(int r, int c) { const int st = (r >> 4) * 2 + (c >> 5), rr = r & 15, cc = c & 31, ob = rr * 64 + cc * 2; return st * 1024 + (ob ^ (((ob >> 9) & 1) << 5)); }
__device__ __forceinline__ void stage_rc(int b, int& R, int& C) { const int st = b / 1024, sb = b % 1024, swz = sb ^ (((sb >> 9) & 1) << 5); R = (st >> 1) * 16 + swz / 64; C = (st & 1) * 32 + (swz % 64) / 2; }
__device__ __forceinline__ int perm32(int rho) { const int n = rho >> 4, i = rho & 15; return 8 * (i >> 2) + 4 * n + (i & 3); }
struct Unit { int pm, pn; };
struct Gemm { const bf16_t* A; int lda; const bf16_t* Bt; int ldb; int M, N, K; };
struct StaticOrder {
    int nM, nN, nwg, G, c;
    __device__ __forceinline__ void init(int M, int N, int G_, int c_) { nM = M / BM; nN = N / BM; nwg = nM * nN; G = G_; c = c_; }
    __device__ __forceinline__ bool next(int i, Unit& u) const {
        const long L = (long)i * G + c; if (L >= nwg) return false;
        int wgid = (int)L; { const int q = nwg / NXCD, r = nwg % NXCD, xcd = wgid % NXCD, off = wgid / NXCD; wgid = (xcd < r ? xcd * (q + 1) : r * (q + 1) + (xcd - r) * q) + off; }
        const int nig = WGM * nN, gid = wgid / nig, fm = gid * WGM, gsz = (nM - fm) < WGM ? (nM - fm) : WGM;
        u.pm = fm + ((wgid % nig) % gsz); u.pn = (wgid % nig) / gsz; return true;
    }
};
template <class Epi>
__device__ __forceinline__ void gemm_phase(LAS unsigned char* lds, const Gemm g, const StaticOrder& S, const Epi& E) {
    const int tid = otid(), wid = __builtin_amdgcn_readfirstlane(tid >> 6), lane = tid & 63, wr = wid >> 2, wc = wid & 3, fr = lane & 15, fq = lane >> 4;
    const int K = g.K, nt = K / BK;
    unsigned voffA[2], voffB[2];
#pragma unroll
    for (int i = 0; i < 2; ++i) { int R, C; stage_rc(tid * 16 + i * 8192, R, C); const int Rb = (R & ~31) + perm32(R & 31);
        voffA[i] = (unsigned)(R * g.lda + C) * 2u; voffB[i] = (unsigned)(Rb * g.ldb + C) * 2u; }
    const size_t kstep = (size_t)(BK * 2);
    const size_t hstepA = (size_t)HALF * g.lda * 2, hstepB = (size_t)HALF * g.ldb * 2;
    const size_t tstepA = 2 * hstepA, tstepB = 2 * hstepB;
    const unsigned ldsw = (unsigned)wid * 1024u;
    const int aoff = lds_byte(wr * 64 + fr, fq * 8), boff = lds_byte(wc * 32 + fr, fq * 8);
#define PG8_SA(b, h) (((b) * 2 + (h)) * HTB)
#define PG8_SB(b, h) ((4 + (b) * 2 + (h)) * HTB)
#define PG8_STAGE(bufoff, gbase, voff) do { _Pragma("unroll") for (int _i = 0; _i < 2; ++_i) \
        __builtin_amdgcn_global_load_lds((const unsigned*)((const char*)(gbase) + (voff)[_i]), (LAS unsigned*)(lds + (bufoff) + ldsw + _i * 8192), 16, 0, 0); } while (0)
#define PG8_LDA(dst, b, h) do { _Pragma("unroll") for (int m = 0; m < 4; ++m) _Pragma("unroll") for (int k = 0; k < 2; ++k) dst[m][k] = *(const LAS bf16x8*)(lds + PG8_SA(b, h) + aoff + m * 2048 + k * 1024); } while (0)
#define PG8_LDB(dst, b, h) do { _Pragma("unroll") for (int n = 0; n < 2; ++n) _Pragma("unroll") for (int k = 0; k < 2; ++k) dst[n][k] = *(const LAS bf16x8*)(lds + PG8_SB(b, h) + boff + n * 2048 + k * 1024); } while (0)
#define PG8_MMA(ai, bj, At, Bt) do { __builtin_amdgcn_s_setprio(1); _Pragma("unroll") for (int m = 0; m < 4; ++m) _Pragma("unroll") for (int n = 0; n < 2; ++n) _Pragma("unroll") for (int k = 0; k < 2; ++k) \
        acc[ai][bj][m][n] = __builtin_amdgcn_mfma_f32_16x16x32_bf16(Bt[n][k], At[m][k], acc[ai][bj][m][n], 0, 0, 0); __builtin_amdgcn_s_setprio(0); } while (0)
#define PG8_WAIT_V(n) asm volatile("s_waitcnt vmcnt(" #n ")" ::: "memory")
#define PG8_WAIT_L(n) asm volatile("s_waitcnt lgkmcnt(" #n ")" ::: "memory")
#define PG8_BAR __builtin_amdgcn_s_barrier()
#define PG8_SCHED __builtin_amdgcn_sched_barrier(0)
    Unit cur, nxt; int ui = 0;
    if (!S.next(0, cur)) return;
    f32x4 acc[2][2][4][2];
#pragma unroll
    for (int a = 0; a < 2; ++a)
#pragma unroll
        for (int b = 0; b < 2; ++b)
#pragma unroll
            for (int m = 0; m < 4; ++m)
#pragma unroll
                for (int n = 0; n < 2; ++n) acc[a][b][m][n] = (f32x4){0.f, 0.f, 0.f, 0.f};
    bf16x8 At[4][2], B0[2][2], B1[2][2];
    const char* cA = (const char*)g.A + (size_t)cur.pm * tstepA; const char* cB = (const char*)g.Bt + (size_t)cur.pn * tstepB;
    PG8_STAGE(PG8_SB(0, 0), cB, voffB); PG8_STAGE(PG8_SA(0, 0), cA, voffA); PG8_STAGE(PG8_SB(0, 1), cB + hstepB, voffB); PG8_STAGE(PG8_SA(0, 1), cA + hstepA, voffA);
    if (wr == 1) PG8_BAR;
    PG8_WAIT_V(4); PG8_BAR;
    PG8_STAGE(PG8_SB(1, 0), cB + kstep, voffB); PG8_STAGE(PG8_SA(1, 0), cA + kstep, voffA); PG8_STAGE(PG8_SB(1, 1), cB + hstepB + kstep, voffB);
    PG8_WAIT_V(6); PG8_BAR;
    for (;;) {
        const bool has_next = S.next(ui + 1, nxt);
        const char* nA = has_next ? (const char*)g.A + (size_t)nxt.pm * tstepA : cA; const char* nB = has_next ? (const char*)g.Bt + (size_t)nxt.pn * tstepB : cB;
        for (int t = 0; t < nt; t += 2) {
            const bool last = (t == nt - 2);
            const char* a1 = cA + (size_t)(t + 1) * kstep;
            const char* a2 = last ? nA : cA + (size_t)(t + 2) * kstep; const char* b2 = last ? nB : cB + (size_t)(t + 2) * kstep;
            const char* a3 = a2 + kstep; const char* b3 = b2 + kstep;
            PG8_LDB(B0, 0, 0); PG8_SCHED; PG8_LDA(At, 0, 0); PG8_STAGE(PG8_SA(1, 1), a1 + hstepA, voffA);
            PG8_WAIT_L(8); PG8_BAR; PG8_WAIT_L(0); PG8_MMA(0, 0, At, B0); PG8_BAR; PG8_SCHED;
            PG8_LDB(B1, 0, 1); PG8_STAGE(PG8_SB(0, 0), b2, voffB);
            PG8_BAR; PG8_WAIT_L(0); PG8_MMA(0, 1, At, B1); PG8_BAR;
            PG8_LDA(At, 0, 1); PG8_STAGE(PG8_SA(0, 0), a2, voffA);
            PG8_BAR; PG8_WAIT_L(0); PG8_MMA(1, 0, At, B0); PG8_BAR; PG8_SCHED;
            PG8_STAGE(PG8_SB(0, 1), b2 + hstepB, voffB);
            PG8_WAIT_V(6); PG8_BAR; PG8_MMA(1, 1, At, B1); PG8_BAR;
            PG8_LDB(B0, 1, 0); PG8_SCHED; PG8_LDA(At, 1, 0); PG8_STAGE(PG8_SA(0, 1), a2 + hstepA, voffA);
            PG8_WAIT_L(8); PG8_BAR; PG8_WAIT_L(0); PG8_MMA(0, 0, At, B0); PG8_BAR; PG8_SCHED;
            PG8_LDB(B1, 1, 1); PG8_STAGE(PG8_SB(1, 0), b3, voffB);
            PG8_BAR; PG8_WAIT_L(0); PG8_MMA(0, 1, At, B1); PG8_BAR;
            PG8_LDA(At, 1, 1); PG8_STAGE(PG8_SA(1, 0), a3, voffA);
            PG8_BAR; PG8_WAIT_L(0); PG8_MMA(1, 0, At, B0); PG8_BAR; PG8_SCHED;
            PG8_STAGE(PG8_SB(1, 1), b3 + hstepB, voffB);
            PG8_WAIT_V(6); PG8_BAR; PG8_MMA(1, 1, At, B1); PG8_BAR;
        }
        E(acc, cur, wr, wc, fr, fq);
        if (!has_next) break;
#pragma unroll
        for (int a = 0; a < 2; ++a)
#pragma unroll
            for (int b = 0; b < 2; ++b)
#pragma unroll
                for (int m = 0; m < 4; ++m)
#pragma unroll
                    for (int n = 0; n < 2; ++n) acc[a][b][m][n] = (f32x4){0.f, 0.f, 0.f, 0.f};
        cur = nxt; cA = nA; cB = nB; ++ui;
    }
    PG8_WAIT_V(0);
    if (wr == 0) PG8_BAR;
    PG8_BAR;
#undef PG8_SA
#undef PG8_SB
#undef PG8_STAGE
#undef PG8_LDA
#undef PG8_LDB
#undef PG8_MMA
#undef PG8_WAIT_V
#undef PG8_WAIT_L
#undef PG8_BAR
#undef PG8_SCHED
}
}
typedef f32x4 Acc[2][2][4][2];

__device__ __forceinline__ LAS const float* fill_inv(LAS unsigned char* lds, const float* ssq) {
    LAS float* t = (LAS float*)(lds + LDS_INV); const int base = 2048 * (blockIdx.x & 7);
    for (int r = otid(); r < 2048; r += 512) t[r] = rowinv16(ssq, base + r);
    __syncthreads();
    return t;
}
struct EpiSwiglu {
    bf16_t* H; LAS const float* linv;
    __device__ __forceinline__ void operator()(const Acc& acc, const pg8::Unit& u, int wr, int wc, int fr, int fq) const {
        const int row0 = u.pm * 256 + wr * 64 + fr, col = u.pn * 128 + wc * 32 + 8 * fq;
#pragma unroll
        for (int ai = 0; ai < 2; ++ai)
#pragma unroll
            for (int m = 0; m < 4; ++m) {
                const int row = row0 + ai * 128 + m * 16; const float inv = linv ? linv[row & 2047] : 1.0f;
                f32x4 h0, h1;
#pragma unroll
                for (int j = 0; j < 4; ++j) { h0[j] = siluf_(acc[ai][0][m][0][j] * inv) * (acc[ai][1][m][0][j] * inv); h1[j] = siluf_(acc[ai][0][m][1][j] * inv) * (acc[ai][1][m][1][j] * inv); }
                *(u32x4*)(H + (size_t)row * FF + col) = pack8(h0, h1);
            }
    }
};
struct EpiResid {
    const float* xin; const bf16_t* xin_b; float* xout; bf16_t* xb; float* ssq; float alpha;
    __device__ __forceinline__ void operator()(const Acc& acc, const pg8::Unit& u, int wr, int wc, int fr, int fq) const {
        const int row0 = u.pm * 256 + wr * 64 + fr, col0 = u.pn * 256 + wc * 32 + 8 * fq;
#pragma unroll
        for (int ai = 0; ai < 2; ++ai) {
            f32x4 xv[4][2][2];
#pragma unroll
            for (int m = 0; m < 4; ++m)
#pragma unroll
                for (int bj = 0; bj < 2; ++bj) { const size_t o = (size_t)(row0 + ai * 128 + m * 16) * D + col0 + bj * 128;
                    if (xin_b) unpack8(*(const u32x4*)(xin_b + o), xv[m][bj][0], xv[m][bj][1]);
                    else { xv[m][bj][0] = *(const f32x4*)(xin + o); xv[m][bj][1] = *(const f32x4*)(xin + o + 4); } }
#pragma unroll
            for (int m = 0; m < 4; ++m) {
                const int row = row0 + ai * 128 + m * 16; float ss = 0.f;
#pragma unroll
                for (int bj = 0; bj < 2; ++bj) {
                    const size_t o = (size_t)row * D + col0 + bj * 128;
                    const f32x4 v0 = xv[m][bj][0] + alpha * acc[ai][bj][m][0], v1 = xv[m][bj][1] + alpha * acc[ai][bj][m][1];
                    if (xout) { *(f32x4*)(xout + o) = v0; *(f32x4*)(xout + o + 4) = v1; }
                    ss += (v0[0] * v0[0] + v0[1] * v0[1]) + (v0[2] * v0[2] + v0[3] * v0[3]) + (v1[0] * v1[0] + v1[1] * v1[1]) + (v1[2] * v1[2] + v1[3] * v1[3]);
                    if (xb) *(u32x4*)(xb + o) = pack8(v0, v1);
                }
                ss += __shfl_xor(ss, 16); ss += __shfl_xor(ss, 32);
                if (fq == 0) ssq[(size_t)row * 16 + u.pn * 4 + wc] = ss;
            }
        }
    }
};
struct EpiScaleBf16 {
    bf16_t* O; LAS const float* linv;
    __device__ __forceinline__ void operator()(const Acc& acc, const pg8::Unit& u, int wr, int wc, int fr, int fq) const {
        const int row0 = u.pm * 256 + wr * 64 + fr, col0 = u.pn * 256 + wc * 32 + 8 * fq;
#pragma unroll
        for (int ai = 0; ai < 2; ++ai)
#pragma unroll
            for (int m = 0; m < 4; ++m) {
                const int row = row0 + ai * 128 + m * 16; const float inv = linv[row & 2047];
#pragma unroll
                for (int bj = 0; bj < 2; ++bj) *(u32x4*)(O + (size_t)row * NPP + col0 + bj * 128) = pack8(acc[ai][bj][m][0] * inv, acc[ai][bj][m][1] * inv);
            }
    }
};
struct EpiGatesA {
    bf16_t* PP; LAS const float* linv; float* gssq;
    __device__ __forceinline__ void operator()(const Acc& acc, const pg8::Unit& u, int wr, int wc, int fr, int fq) const {
        const int row0 = u.pm * 256 + wr * 64 + fr, cw = wc * 32 + 8 * fq; const int pn = u.pn;
#pragma unroll
        for (int ai = 0; ai < 2; ++ai) {
            u32x4 sv[4][2];
#pragma unroll
            for (int m = 0; m < 4; ++m)
#pragma unroll
                for (int bj = 0; bj < 2; ++bj) sv[m][bj] = *(const u32x4*)(PP + (size_t)(row0 + ai * 128 + m * 16) * NPP + pn * 256 + bj * 128 + cw);
#pragma unroll
            for (int m = 0; m < 4; ++m) {
                const int row = row0 + ai * 128 + m * 16; const float inv = linv[row & 2047]; float ss = 0.f;
#pragma unroll
                for (int bj = 0; bj < 2; ++bj) {
                    const f32x4 a0 = acc[ai][bj][m][0] * inv, a1 = acc[ai][bj][m][1] * inv; f32x4 o0, o1;
                    bf16_t* p = PP + (size_t)row * NPP + pn * 256 + bj * 128 + cw; f32x4 s0, s1; unpack8(sv[m][bj], s0, s1);
                    if (pn < 4) {
#pragma unroll
                        for (int j = 0; j < 4; ++j) { o0[j] = gelu_tanh(a0[j]) * s0[j]; o1[j] = gelu_tanh(a1[j]) * s1[j]; }
                    } else {
#pragma unroll
                        for (int j = 0; j < 4; ++j) { o0[j] = siluf_(a0[j]) * s0[j]; o1[j] = siluf_(a1[j]) * s1[j]; ss += o0[j] * o0[j] + o1[j] * o1[j]; }
                    }
                    *(u32x4*)p = pack8(o0, o1);
                }
                if (pn >= 4) { ss += __shfl_xor(ss, 16); ss += __shfl_xor(ss, 32); if (fq == 0) gssq[(size_t)row * 32 + (pn - 4) * 4 + wc] = ss; }
            }
        }
    }
};
struct EpiSigmoid {
    bf16_t* O; int ldo; LAS const float* linv; const float* bias;
    __device__ __forceinline__ void operator()(const Acc& acc, const pg8::Unit& u, int wr, int wc, int fr, int fq) const {
        const int row0 = u.pm * 256 + wr * 64 + fr, col0 = u.pn * 256 + wc * 32 + 8 * fq;
#pragma unroll
        for (int ai = 0; ai < 2; ++ai)
#pragma unroll
            for (int m = 0; m < 4; ++m) {
                const int row = row0 + ai * 128 + m * 16; const float inv = linv[row & 2047];
#pragma unroll
                for (int bj = 0; bj < 2; ++bj) {
                    const int gc = col0 + bj * 128;
                    const f32x4 a0 = acc[ai][bj][m][0] * inv, a1 = acc[ai][bj][m][1] * inv; f32x4 o0, o1;
                    const f32x4 b0 = *(const f32x4*)(bias + gc), b1 = *(const f32x4*)(bias + gc + 4);
#pragma unroll
                    for (int j = 0; j < 4; ++j) { o0[j] = sigmoidf_(a0[j] + b0[j]); o1[j] = sigmoidf_(a1[j] + b1[j]); }
                    *(u32x4*)(O + (size_t)row * ldo + gc) = pack8(o0, o1);
                }
            }
    }
};
struct EpiBr {
    bf16_t* GA; const bf16_t* PP; int mode;
    __device__ __forceinline__ void operator()(const Acc& acc, const pg8::Unit& u, int wr, int wc, int fr, int fq) const {
        const int row0 = u.pm * 256 + wr * 64 + fr, col0 = u.pn * 256 + wc * 32 + 8 * fq;
#pragma unroll
        for (int ai = 0; ai < 2; ++ai) {
            u32x4 gv[4][2], hv[4][2];
#pragma unroll
            for (int m = 0; m < 4; ++m)
#pragma unroll
                for (int bj = 0; bj < 2; ++bj) { const int row = row0 + ai * 128 + m * 16; gv[m][bj] = *(const u32x4*)(GA + (size_t)row * D + col0 + bj * 128);
                    hv[m][bj] = (mode == 0) ? (u32x4){0u, 0u, 0u, 0u} : *(const u32x4*)(PP + (size_t)row * NPP + 3072 + col0 + bj * 128); }
#pragma unroll
            for (int m = 0; m < 4; ++m) {
                const int row = row0 + ai * 128 + m * 16;
#pragma unroll
                for (int bj = 0; bj < 2; ++bj) {
                    bf16_t* p = GA + (size_t)row * D + col0 + bj * 128; f32x4 g0, g1; unpack8(gv[m][bj], g0, g1);
                    if (mode == 0) { *(u32x4*)p = pack8(g0 * acc[ai][bj][m][0], g1 * acc[ai][bj][m][1]); }
                    else { f32x4 h0, h1; unpack8(hv[m][bj], h0, h1); *(u32x4*)p = pack8(g0 + h0 * acc[ai][bj][m][0], g1 + h1 * acc[ai][bj][m][1]); }
                }
            }
        }
    }
};

template <int NC, int NB, int K, class RM, class F>
__device__ __forceinline__ void small_gemm(LAS unsigned char* lds, const bf16_t* A, int lda, int M, const bf16_t* Bt, int ldb, int N,
                                           const float* rs_src, int rs_mode, RM rm, F f) {
    const int tid = otid(), wid = tid >> 6, lane = tid & 63, lr = lane & 15, kg = lane >> 4;
    LAS float* red = (LAS float*)lds;
    LAS float* invs = (LAS float*)(lds + 131072);
    const int nct = N / NC, items = (M / 16) * nct; constexpr int kw = K / 8;
    constexpr int CT = NC / 16;
    const int nrt = M / 16; const bool hoist = (rs_mode == 1) && (gridDim.x % nrt == 0); const int bix = gridDim.x - 1 - blockIdx.x;
    for (int it = bix; it < items; it += gridDim.x) {
        const int rt = it % nrt, ct = it / nrt, row0 = rt * 16, col0 = ct * NC;
        if (rs_mode == 1) { if (!(hoist && it != bix)) { const int r = tid >> 5, q = tid & 31; const float* p = rs_src + (size_t)(row0 + r) * D + q * 32; float s = 0.f;
            for (int j = 0; j < 32; j += 4) { const f32x4 v = *(const f32x4*)(p + j); s += v[0] * v[0] + v[1] * v[1] + v[2] * v[2] + v[3] * v[3]; }
            s += __shfl_xor(s, 1); s += __shfl_xor(s, 2); s += __shfl_xor(s, 4); s += __shfl_xor(s, 8); s += __shfl_xor(s, 16);
            if (q == 0) invs[r] = rsqrtf(s * (1.0f / 1024.0f) + EPS); } }
        else if (rs_mode == 2) { if (tid < 16) invs[tid] = rowinv16(rs_src, row0 + tid); }
        else { if (tid < 16) invs[tid] = 1.0f; }
        f32x4 acc[NB][CT];
#pragma unroll
        for (int p = 0; p < NB; ++p)
#pragma unroll
            for (int c = 0; c < CT; ++c) acc[p][c] = (f32x4){0.f, 0.f, 0.f, 0.f};
        const bf16_t* ap = A + (size_t)(row0 + lr) * lda + wid * kw + 8 * kg;
        const bf16_t* bp0 = Bt + (size_t)(rm(col0, 0) + lr) * ldb + wid * kw + 8 * kg;
        const bf16_t* bp1 = NB > 1 ? Bt + (size_t)(rm(col0, 1) + lr) * ldb + wid * kw + 8 * kg : bp0;
#pragma unroll
        for (int k = 0; k < kw; k += 32) {
            const bf16x8 a = *(const bf16x8*)(ap + k);
#pragma unroll
            for (int c = 0; c < CT; ++c) {
                const bf16x8 b = *(const bf16x8*)(bp0 + (size_t)c * 16 * ldb + k);
                acc[0][c] = __builtin_amdgcn_mfma_f32_16x16x32_bf16(a, b, acc[0][c], 0, 0, 0);
                if (NB > 1) { const bf16x8 b1 = *(const bf16x8*)(bp1 + (size_t)c * 16 * ldb + k); acc[NB - 1][c] = __builtin_amdgcn_mfma_f32_16x16x32_bf16(a, b1, acc[NB - 1][c], 0, 0, 0); }
            }
        }
#pragma unroll
        for (int p = 0; p < NB; ++p)
#pragma unroll
            for (int c = 0; c < CT; ++c)
#pragma unroll
                for (int r = 0; r < 4; ++r) red[((wid * NB + p) * 16 + 4 * kg + r) * NC + 16 * c + lr] = acc[p][c][r];
        __syncthreads();
        for (int e = tid; e < 16 * NC; e += 512) {
            float v0 = 0.f, v1 = 0.f;
#pragma unroll
            for (int w = 0; w < 8; ++w) { v0 += red[(w * NB) * 16 * NC + e]; if (NB > 1) v1 += red[(w * NB + 1) * 16 * NC + e]; }
            const int r = e / NC, c = e % NC;
            f(row0 + r, col0 + c, v0, v1, invs[r]);
        }
        __syncthreads();
    }
}

template <int NC, int NB, int K, class RM, class F>
__device__ __forceinline__ void sgemm(LAS unsigned char* lds, const bf16_t* A, int lda, const bf16_t* Bt, int ldb, int N, const float* ssq_src, float* ssq_out, RM rm, F f, int nblk = 0) {
    const int tid = otid(), wid = tid >> 6, lane = tid & 63, lr = lane & 15, kg = lane >> 4;
    constexpr int CT = NC / 16, KW = K / 8;
    LAS float* red = (LAS float*)lds;
    const int items = N / NC, bix = gridDim.x - 1 - blockIdx.x; if (nblk == 0) nblk = gridDim.x;
    LAS float* invs = (LAS float*)(lds + LDS_INV);
    if (bix < items && bix < nblk) {
        if (ssq_src) { const int row = tid >> 2, q = tid & 3; float sm = 0.f;
#pragma unroll
            for (int j = 0; j < 16; j += 4) { const f32x4 v = *(const f32x4*)(ssq_src + row * 64 + q * 16 + j); sm += (v[0] + v[1]) + (v[2] + v[3]); }
            sm += __shfl_xor(sm, 1); sm += __shfl_xor(sm, 2);
            if (q == 0) invs[row] = rsqrtf(sm * (1.0f / 1024.0f) + EPS); }
        else if (tid < 128) invs[tid] = 1.0f;
        __syncthreads();
    }
    for (int it = bix; it < items && bix < nblk; it += nblk) {
        const int col0 = it * NC;
        f32x4 acc[8][NB][CT];
#pragma unroll
        for (int t = 0; t < 8; ++t)
#pragma unroll
            for (int p = 0; p < NB; ++p)
#pragma unroll
                for (int c = 0; c < CT; ++c) acc[t][p][c] = (f32x4){0.f, 0.f, 0.f, 0.f};
        const bf16_t* ap = A + (size_t)lr * lda + wid * KW + 8 * kg;
        const bf16_t* bp0 = Bt + (size_t)(rm(col0, 0) + lr) * ldb + wid * KW + 8 * kg;
        const bf16_t* bp1 = NB > 1 ? Bt + (size_t)(rm(col0, 1) + lr) * ldb + wid * KW + 8 * kg : bp0;
#pragma unroll 4
        for (int k = 0; k < KW; k += 32) {
            bf16x8 bf[NB][CT];
#pragma unroll
            for (int c = 0; c < CT; ++c) { bf[0][c] = *(const bf16x8*)(bp0 + (size_t)c * 16 * ldb + k); if (NB > 1) bf[NB - 1][c] = *(const bf16x8*)(bp1 + (size_t)c * 16 * ldb + k); }
#pragma unroll
            for (int t = 0; t < 8; ++t) { const bf16x8 a = *(const bf16x8*)(ap + (size_t)t * 16 * lda + k);
#pragma unroll
                for (int p = 0; p < NB; ++p)
#pragma unroll
                    for (int c = 0; c < CT; ++c) acc[t][p][c] = __builtin_amdgcn_mfma_f32_16x16x32_bf16(a, bf[p][c], acc[t][p][c], 0, 0, 0); }
        }
#pragma unroll
        for (int t = 0; t < 8; ++t)
#pragma unroll
            for (int p = 0; p < NB; ++p)
#pragma unroll
                for (int c = 0; c < CT; ++c)
#pragma unroll
                    for (int r = 0; r < 4; ++r) red[((((wid * 8 + t) * NB + p) * CT + c) * 16 + 4 * kg + r) * 16 + lr] = acc[t][p][c][r];
        __syncthreads();
        for (int e = tid; e < 128 * NC; e += 512) {
            const int row = e / NC, col = e % NC, t = row >> 4, rr = row & 15, c = col >> 4, cl = col & 15;
            float v0 = 0.f, v1 = 0.f;
#pragma unroll
            for (int w = 0; w < 8; ++w) { v0 += red[((((w * 8 + t) * NB + 0) * CT + c) * 16 + rr) * 16 + cl]; if (NB > 1) v1 += red[((((w * 8 + t) * NB + (NB - 1)) * CT + c) * 16 + rr) * 16 + cl]; }
            float sq = f(row, col0 + col, v0, v1, invs[row]);
            if (ssq_out) { sq *= sq; sq += __shfl_xor(sq, 1); sq += __shfl_xor(sq, 2); sq += __shfl_xor(sq, 4); sq += __shfl_xor(sq, 8); if (NC > 16) sq += __shfl_xor(sq, 16);
                if ((col & (NC - 1)) == 0) ssq_out[row * 64 + it] = sq; }
        }
        __syncthreads();
    }
}

template <int CT, int NB, int K, class RM, class F>
__device__ __forceinline__ void wave_gemm(LAS unsigned char* lds, const bf16_t* A, int lda, const bf16_t* Bt, int ldb, int N, const float* rs_src, RM rm, F f) {
    const int tid = otid(), wid = tid >> 6, lane = tid & 63, lr = lane & 15, kg = lane >> 4;
    const int bix = gridDim.x - 1 - blockIdx.x, rt = bix & 7, row0 = rt * 16, nct = N / (16 * CT);
    LAS float* invs = (LAS float*)(lds + LDS_INV);
    if (rs_src) { const int r = tid >> 5, q = tid & 31; const float* p = rs_src + (size_t)(row0 + r) * D + q * 32; float s = 0.f;
        for (int j = 0; j < 32; j += 4) { const f32x4 v = *(const f32x4*)(p + j); s += v[0] * v[0] + v[1] * v[1] + v[2] * v[2] + v[3] * v[3]; }
        s += __shfl_xor(s, 1); s += __shfl_xor(s, 2); s += __shfl_xor(s, 4); s += __shfl_xor(s, 8); s += __shfl_xor(s, 16);
        if (q == 0) invs[r] = rsqrtf(s * (1.0f / 1024.0f) + EPS); }
    else if (tid < 16) invs[tid] = 1.0f;
    __syncthreads();
    for (int ct = (bix >> 3) * 8 + wid; ct < nct; ct += (gridDim.x >> 3) * 8) {
        const int col0 = ct * 16 * CT;
        f32x4 acc[NB][CT];
#pragma unroll
        for (int p = 0; p < NB; ++p)
#pragma unroll
            for (int c = 0; c < CT; ++c) acc[p][c] = (f32x4){0.f, 0.f, 0.f, 0.f};
        const bf16_t* ap = A + (size_t)(row0 + lr) * lda + 8 * kg;
        const bf16_t* bp0 = Bt + (size_t)(rm(col0, 0) + lr) * ldb + 8 * kg;
        const bf16_t* bp1 = NB > 1 ? Bt + (size_t)(rm(col0, 1) + lr) * ldb + 8 * kg : bp0;
#pragma unroll 4
        for (int k = 0; k < K; k += 32) {
            const bf16x8 a = *(const bf16x8*)(ap + k);
#pragma unroll
            for (int c = 0; c < CT; ++c) {
                const bf16x8 b = *(const bf16x8*)(bp0 + (size_t)c * 16 * ldb + k);
                acc[0][c] = __builtin_amdgcn_mfma_f32_16x16x32_bf16(a, b, acc[0][c], 0, 0, 0);
                if (NB > 1) { const bf16x8 b1 = *(const bf16x8*)(bp1 + (size_t)c * 16 * ldb + k); acc[NB - 1][c] = __builtin_amdgcn_mfma_f32_16x16x32_bf16(a, b1, acc[NB - 1][c], 0, 0, 0); }
            }
        }
#pragma unroll
        for (int c = 0; c < CT; ++c)
#pragma unroll
            for (int r = 0; r < 4; ++r) f(row0 + 4 * kg + r, col0 + 16 * c + lr, acc[0][c][r], NB > 1 ? acc[NB - 1][c][r] : 0.f, invs[4 * kg + r]);
    }
    __syncthreads();
}

struct Ctx { const float* const* in; float* out; unsigned char* ws; LAS unsigned char* lds; };

__device__ __forceinline__ void tp_tile(LAS float* tile, const float* src, int sld, int sc0, int k0, bf16_t* dst, int dld, int dr0, int dk0, const float* scale, int ncv) {
    const int lane = otid() & 63;
    float v[64];
    const float* sp = src + (size_t)k0 * sld + sc0 + lane;
#pragma unroll
    for (int kk = 0; kk < 64; ++kk) v[kk] = (lane < ncv) ? sp[(size_t)kk * sld] : 0.f;
    if (scale) {
#pragma unroll
        for (int kk = 0; kk < 64; ++kk) v[kk] *= scale[k0 + kk];
    }
#pragma unroll
    for (int kk = 0; kk < 64; ++kk) tile[kk * 65 + lane] = v[kk];
    const int j = lane & 7;
#pragma unroll
    for (int ps = 0; ps < 8; ++ps) { const int cc = (lane >> 3) + 8 * ps;
        float x[8];
#pragma unroll
        for (int i = 0; i < 8; ++i) x[i] = tile[(8 * j + i) * 65 + cc];
        u32x4 w; w.x = cvt_pk_bf16(x[0], x[1]); w.y = cvt_pk_bf16(x[2], x[3]); w.z = cvt_pk_bf16(x[4], x[5]); w.w = cvt_pk_bf16(x[6], x[7]);
        if (cc < ncv) *(u32x4*)(dst + (size_t)(dr0 + cc) * dld + dk0 + 8 * j) = w; }
}
__device__ __forceinline__ void prep_weights(const Ctx& c) {
    const int wv_ = __builtin_amdgcn_readfirstlane(otid() >> 6); LAS float* tile = (LAS float*)c.lds + wv_ * (64 * 65); unsigned char* ws = c.ws;
    constexpr int N_UP = 1408, N_DN = 704, N_IN = 2304, N_DT = 16, N_BRL = 256, N_BRS = 512, N_OUT = 256, N_RG = 32;
    constexpr int TOT = 2 * N_UP + 2 * N_DN + N_IN + N_DT + N_BRL + N_BRS + N_OUT + 2 * N_RG;
    for (int ti0 = blockIdx.x * 8 + wv_; ti0 < TOT; ti0 += gridDim.x * 8) {
        int ti = ti0;
        if (ti < 2 * N_UP) { const int l = ti >= N_UP; if (l) ti -= N_UP;
            const int j = ti >> 5, r = ti & 31, pn = j >> 1, panel = j & 1, ct = r >> 4, kt = r & 15;
            tp_tile(tile, c.in[l ? 29 : 7], 2 * FF, panel * FF + 128 * pn + 64 * ct, 64 * kt, (bf16_t*)(ws + (l ? OFF_WUP2 : OFF_WUP1)), D, 256 * pn + 128 * panel + 64 * ct, 64 * kt, l ? c.in[28] : nullptr, 64);
            continue; }
        ti -= 2 * N_UP;
        if (ti < 2 * N_DN) { const int l = ti >= N_DN; if (l) ti -= N_DN;
            const int nt = ti / 44, kt = ti % 44;
            tp_tile(tile, c.in[l ? 30 : 8], D, 64 * nt, 64 * kt, (bf16_t*)(ws + (l ? OFF_WDN2 : OFF_WDN1)), FF, 64 * nt, 64 * kt, nullptr, 64);
            continue; }
        ti -= 2 * N_DN;
        if (ti < N_IN) { const int nt = ti >> 4, kt = ti & 15, n0 = 64 * nt;
            const int sc = n0 < 1024 ? n0 : (n0 < 4096 ? n0 + 3072 : (n0 < 7168 ? n0 - 3072 : n0 + 32));
            tp_tile(tile, c.in[10], 9248, sc, 64 * kt, (bf16_t*)(ws + OFF_WIN), D, n0, 64 * kt, c.in[9], 64);
            continue; }
        ti -= N_IN;
        if (ti < N_DT) { tp_tile(tile, c.in[10], 9248, 7168, 64 * ti, (bf16_t*)(ws + OFF_WDT), D, 0, 64 * ti, c.in[9], 32); continue; }
        ti -= N_DT;
        if (ti < N_BRL) { const int nt = ti >> 4, kt = ti & 15; tp_tile(tile, c.in[25], D, 64 * nt, 64 * kt, (bf16_t*)(ws + OFF_WBR), 3072, 64 * nt, 64 * kt, nullptr, 64); continue; }
        ti -= N_BRL;
        if (ti < N_BRS) { const int nt = ti >> 5, kt = ti & 31; tp_tile(tile, c.in[26], D, 64 * nt, 64 * kt, (bf16_t*)(ws + OFF_WBR), 3072, 64 * nt, 1024 + 64 * kt, c.in[24], 64); continue; }
        ti -= N_BRS;
        if (ti < N_OUT) { const int nt = ti >> 4, kt = ti & 15; tp_tile(tile, c.in[27], D, 64 * nt, 64 * kt, (bf16_t*)(ws + OFF_WOUT), D, 64 * nt, 64 * kt, nullptr, 64); continue; }
        ti -= N_OUT;
        { const int l = ti >= N_RG; if (l) ti -= N_RG; const int h = ti >> 2, nt = (ti >> 1) & 1, kt = ti & 1;
          tp_tile(tile, c.in[l ? 16 : 14] + h * 16384, 128, 64 * nt, 64 * kt, (bf16_t*)(ws + (l ? OFF_WIG : OFF_WRG)) + h * 16384, 128, 64 * nt, 64 * kt, nullptr, 64); }
    }
}
__device__ __forceinline__ void rmsnorm_rows_bf16(const float* x, int nrows, const float* g, bf16_t* dst) {
    const int t_ = otid(), lane = t_ & 63, gw = blockIdx.x * 8 + (t_ >> 6), nw = gridDim.x * 8;
    f32x4 gg[4];
#pragma unroll
    for (int i = 0; i < 4; ++i) gg[i] = *(const f32x4*)(g + (i * 64 + lane) * 4);
    for (int r = gw; r < nrows; r += 2 * nw) {
        const int r2 = r + nw; const bool two = r2 < nrows;
        const float* p = x + (size_t)r * D; const float* p2 = x + (size_t)(two ? r2 : r) * D; f32x4 v[4], w[4]; float s = 0.f, s2 = 0.f;
#pragma unroll
        for (int i = 0; i < 4; ++i) { v[i] = *(const f32x4*)(p + (i * 64 + lane) * 4); w[i] = *(const f32x4*)(p2 + (i * 64 + lane) * 4); }
#pragma unroll
        for (int i = 0; i < 4; ++i) { s += v[i][0] * v[i][0] + v[i][1] * v[i][1] + v[i][2] * v[i][2] + v[i][3] * v[i][3]; s2 += w[i][0] * w[i][0] + w[i][1] * w[i][1] + w[i][2] * w[i][2] + w[i][3] * w[i][3]; }
#pragma unroll
        for (int o = 1; o < 64; o <<= 1) { s += __shfl_xor(s, o); s2 += __shfl_xor(s2, o); }
        const float inv = rsqrtf(s * (1.0f / 1024.0f) + EPS), inv2 = rsqrtf(s2 * (1.0f / 1024.0f) + EPS);
#pragma unroll
        for (int i = 0; i < 4; ++i) { const int cc = (i * 64 + lane) * 4; const f32x4 o = v[i] * inv * gg[i];
            unsigned* q = (unsigned*)(dst + (size_t)r * D + cc); q[0] = cvt_pk_bf16(o[0], o[1]); q[1] = cvt_pk_bf16(o[2], o[3]);
            if (two) { const f32x4 o2 = w[i] * inv2 * gg[i]; unsigned* q2 = (unsigned*)(dst + (size_t)r2 * D + cc); q2[0] = cvt_pk_bf16(o2[0], o2[1]); q2[1] = cvt_pk_bf16(o2[2], o2[3]); } }
    }
}
__device__ __forceinline__ void rmsnorm_rows_f32(float* x, int nrows, const float* g) {
    const int t_ = otid(), lane = t_ & 63, gw = blockIdx.x * 8 + (t_ >> 6), nw = gridDim.x * 8;
    f32x4 gg[4];
#pragma unroll
    for (int i = 0; i < 4; ++i) gg[i] = *(const f32x4*)(g + (i * 64 + lane) * 4);
    for (int r = gw; r < nrows; r += 2 * nw) {
        const int r2 = r + nw; const bool two = r2 < nrows;
        float* p = x + (size_t)r * D; float* p2 = x + (size_t)(two ? r2 : r) * D; f32x4 v[4], w[4]; float s = 0.f, s2 = 0.f;
#pragma unroll
        for (int i = 0; i < 4; ++i) { v[i] = *(const f32x4*)(p + (i * 64 + lane) * 4); w[i] = *(const f32x4*)(p2 + (i * 64 + lane) * 4); }
#pragma unroll
        for (int i = 0; i < 4; ++i) { s += v[i][0] * v[i][0] + v[i][1] * v[i][1] + v[i][2] * v[i][2] + v[i][3] * v[i][3]; s2 += w[i][0] * w[i][0] + w[i][1] * w[i][1] + w[i][2] * w[i][2] + w[i][3] * w[i][3]; }
#pragma unroll
        for (int o = 1; o < 64; o <<= 1) { s += __shfl_xor(s, o); s2 += __shfl_xor(s2, o); }
        const float inv = rsqrtf(s * (1.0f / 1024.0f) + EPS), inv2 = rsqrtf(s2 * (1.0f / 1024.0f) + EPS);
#pragma unroll
        for (int i = 0; i < 4; ++i) { const int cc = (i * 64 + lane) * 4; *(f32x4*)(p + cc) = v[i] * inv * gg[i]; if (two) *(f32x4*)(p2 + cc) = w[i] * inv2 * gg[i]; }
    }
}

template <bool FINAL>
__device__ __forceinline__ void lru_chunk(const Ctx& c, int b, int ch, bool dry = false) {
    const int tid = otid(), wid = tid >> 6, lane = tid & 63, lr = lane & 15, kg = lane >> 4;
    LAS float* XC = (LAS float*)c.lds; LAS float* AA = (LAS float*)(c.lds + 32768); LAS float* UU = (LAS float*)(c.lds + 65536); LAS unsigned char* XCb = c.lds + 98304;
    bf16_t* PP = (bf16_t*)(c.ws + OFF_PP); bf16_t* HALO = (bf16_t*)(c.ws + OFF_HALO); float* SUMM = (float*)(c.ws + OFF_SUMM);
    const bf16_t* WRG = (const bf16_t*)(c.ws + OFF_WRG); const bf16_t* WIG = (const bf16_t*)(c.ws + OFF_WIG);
    const float* cw = c.in[12]; const float* cb = c.in[13]; const float* brg = c.in[15]; const float* big = c.in[17]; const float* lam = c.in[18];
    const int t0 = b * SEQ + 64 * ch;
    LAS float* CARRY = (LAS float*)(c.lds + 115712);
    if (FINAL) {
        float h0 = 0.f, h1 = 0.f;
        for (int cp = 0; cp < ch; cp += 8) {
            float a0[8], b0[8], a1[8], b1[8];
#pragma unroll
            for (int i = 0; i < 8; ++i) { a0[i] = 1.f; b0[i] = 0.f; a1[i] = 1.f; b1[i] = 0.f;
                if (cp + i < ch) { const float* sp = SUMM + ((size_t)(b * NCH + cp + i) * D + tid) * 2; a0[i] = sp[0]; b0[i] = sp[1]; a1[i] = sp[1024]; b1[i] = sp[1025]; } }
#pragma unroll
            for (int i = 0; i < 8; ++i) { h0 = a0[i] * h0 + b0[i]; h1 = a1[i] * h1 + b1[i]; }
        }
        CARRY[tid] = h0; CARRY[tid + 512] = h1;
    }
    const int cg8 = tid & 15, tk = (tid >> 4) * 2;
    u32x4 rawp[5]; f32x4 wk[4][2], bb[2]; bf16x8 wrf[4], wif[4]; float pb1 = 0.f, pb2 = 0.f, plam = 0.f;
#define LRU_FETCH(hd) do { const int cc0_ = 128 * (hd) + 8 * cg8; \
        _Pragma("unroll") for (int i = 0; i < 5; ++i) { const int tt = tk - 3 + i; rawp[i] = (u32x4){0u, 0u, 0u, 0u}; \
            if (tt >= 0) rawp[i] = *(const u32x4*)(PP + (size_t)(t0 + tt) * NPP + cc0_); \
            else if (ch > 0) rawp[i] = *(const u32x4*)(HALO + ((size_t)((b * NCH + ch - 1) * 3 + (tt + 3))) * D + cc0_); } \
        _Pragma("unroll") for (int k = 0; k < 4; ++k) { wk[k][0] = *(const f32x4*)(cw + k * D + cc0_); wk[k][1] = *(const f32x4*)(cw + k * D + cc0_ + 4); } \
        bb[0] = *(const f32x4*)(cb + cc0_); bb[1] = *(const f32x4*)(cb + cc0_ + 4); } while (0)
#define LRU_FETCHW(hd) do { \
        { const int cgl_ = 128 * (hd) + 16 * wid + lr; const bf16_t* wr__ = WRG + (size_t)cgl_ * 128 + 8 * kg; const bf16_t* wi__ = WIG + (size_t)cgl_ * 128 + 8 * kg; \
          _Pragma("unroll") for (int ks = 0; ks < 4; ++ks) { wrf[ks] = *(const bf16x8*)(wr__ + 32 * ks); wif[ks] = *(const bf16x8*)(wi__ + 32 * ks); } \
          pb1 = brg[cgl_]; pb2 = big[cgl_]; plam = lam[cgl_]; } } while (0)
    LRU_FETCH(0); LRU_FETCHW(0);
    for (int head = 0; head < 8; ++head) {
        const int ch0 = 128 * head;
        {
            f32x4 raw[5][2];
#pragma unroll
            for (int i = 0; i < 5; ++i) unpack8(rawp[i], raw[i][0], raw[i][1]);
#pragma unroll
            for (int q = 0; q < 2; ++q) { f32x4 o0 = bb[0], o1 = bb[1];
#pragma unroll
                for (int k = 0; k < 4; ++k) { o0 += wk[k][0] * raw[q + k][0]; o1 += wk[k][1] * raw[q + k][1]; }
                *(LAS f32x4*)(XC + (tk + q) * 128 + 8 * cg8) = o0; *(LAS f32x4*)(XC + (tk + q) * 128 + 8 * cg8 + 4) = o1;
                *(LAS u32x4*)(XCb + (tk + q) * 272 + 16 * cg8) = pack8(o0, o1); }
            if (head < 7) LRU_FETCH(head + 1);
        }
        __syncthreads();
        {
            f32x4 ar[4], ai_[4];
#pragma unroll
            for (int m = 0; m < 4; ++m) { ar[m] = (f32x4){0.f, 0.f, 0.f, 0.f}; ai_[m] = (f32x4){0.f, 0.f, 0.f, 0.f}; }
#pragma unroll
            for (int ks = 0; ks < 4; ++ks) { const bf16x8 br = wrf[ks], bi = wif[ks];
#pragma unroll
                for (int m = 0; m < 4; ++m) { const bf16x8 a = *(const LAS bf16x8*)(XCb + (16 * m + lr) * 272 + (32 * ks + 8 * kg) * 2);
                    ar[m] = __builtin_amdgcn_mfma_f32_16x16x32_bf16(a, br, ar[m], 0, 0, 0); ai_[m] = __builtin_amdgcn_mfma_f32_16x16x32_bf16(a, bi, ai_[m], 0, 0, 0); } }
            const int cl = 16 * wid + lr; const float b1 = pb1, b2 = pb2, sp = softplusf_(-plam);
            if (head < 7) LRU_FETCHW(head + 1);
#pragma unroll
            for (int m = 0; m < 4; ++m)
#pragma unroll
                for (int r = 0; r < 4; ++r) { const int tk = 16 * m + 4 * kg + r; const float rg = sigmoidf_(ar[m][r] + b1), ig = sigmoidf_(ai_[m][r] + b2);
                    const float la = -8.0f * rg * sp; const float u = sqrtf(-expm1f(2.0f * la)) * ig * XC[tk * 128 + cl];
                    AA[tk * 128 + cl] = la; UU[tk * 128 + cl] = u; }
        }
        __syncthreads();
        if (!FINAL) {
            const int cg8s = tid & 15, tks = (tid >> 4) * 2;
#pragma unroll
            for (int q = 0; q < 2; ++q) { const f32x4 o0 = *(const LAS f32x4*)(UU + (tks + q) * 128 + 8 * cg8s), o1 = *(const LAS f32x4*)(UU + (tks + q) * 128 + 8 * cg8s + 4);
                const f32x4 l0 = *(const LAS f32x4*)(AA + (tks + q) * 128 + 8 * cg8s), l1 = *(const LAS f32x4*)(AA + (tks + q) * 128 + 8 * cg8s + 4);
                *(u32x4*)(PP + (size_t)(t0 + tks + q) * NPP + ch0 + 8 * cg8s) = pack8(o0, o1); *(u32x4*)(PP + (size_t)(t0 + tks + q) * NPP + 3072 + ch0 + 8 * cg8s) = pack8(l0, l1); } }
        if (tid < 128) { const int cgl = ch0 + tid;
            if (!FINAL) { float A = 1.f, H = 0.f;
                for (int t8 = 0; t8 < 64; t8 += 16) { float av[16], uv[16];
#pragma unroll
                    for (int i = 0; i < 16; ++i) { av[i] = AA[(t8 + i) * 128 + tid]; uv[i] = UU[(t8 + i) * 128 + tid]; }
#pragma unroll
                    for (int i = 0; i < 16; ++i) { const float a_ = __expf(av[i]); H = a_ * H + uv[i]; A *= a_; } }
                float* s = SUMM + ((size_t)(b * NCH + ch) * D + cgl) * 2; s[0] = A; s[1] = H; }
            else { float h = CARRY[cgl];
                for (int t8 = 0; t8 < 64; t8 += 16) { float av[16], uv[16];
#pragma unroll
                    for (int i = 0; i < 16; ++i) { av[i] = AA[(t8 + i) * 128 + tid]; uv[i] = UU[(t8 + i) * 128 + tid]; }
#pragma unroll
                    for (int i = 0; i < 16; ++i) { h = av[i] * h + uv[i]; UU[(t8 + i) * 128 + tid] = h; } }
                if (ch == NCH - 1) c.out[O_LHP + b * D + cgl] = h; } }
        __syncthreads();
        if (FINAL) { const int cg8 = tid & 15, tk = (tid >> 4) * 2;
#pragma unroll
            for (int q = 0; q < 2; ++q) { const f32x4 o0 = *(const LAS f32x4*)(UU + (tk + q) * 128 + 8 * cg8), o1 = *(const LAS f32x4*)(UU + (tk + q) * 128 + 8 * cg8 + 4);
                if (!dry) *(u32x4*)(PP + (size_t)(t0 + tk + q) * NPP + ch0 + 8 * cg8) = pack8(o0, o1); }
            __syncthreads(); }
    }
}

__device__ __forceinline__ void lru_final(const Ctx& c, int b, int ch) {
    const int tid = otid(); bf16_t* PP = (bf16_t*)(c.ws + OFF_PP); const float* SUMM = (const float*)(c.ws + OFF_SUMM);
    const int t0 = b * SEQ + 64 * ch, c2 = 2 * tid;
    float h0 = 0.f, h1 = 0.f;
    for (int cp = 0; cp < ch; cp += 8) {
        f32x4 sv[8];
#pragma unroll
        for (int i = 0; i < 8; ++i) { sv[i] = (f32x4){1.f, 0.f, 1.f, 0.f}; if (cp + i < ch) sv[i] = *(const f32x4*)(SUMM + ((size_t)(b * NCH + cp + i) * D + c2) * 2); }
#pragma unroll
        for (int i = 0; i < 8; ++i) { h0 = sv[i][0] * h0 + sv[i][1]; h1 = sv[i][2] * h1 + sv[i][3]; }
    }
    for (int t8 = 0; t8 < 64; t8 += 16) {
        unsigned uu[16], ll[16];
#pragma unroll
        for (int i = 0; i < 16; ++i) { const bf16_t* p = PP + (size_t)(t0 + t8 + i) * NPP + c2; uu[i] = *(const unsigned*)p; ll[i] = *(const unsigned*)(p + 3072); }
#pragma unroll
        for (int i = 0; i < 16; ++i) { h0 = __expf(bflo(ll[i])) * h0 + bflo(uu[i]); h1 = __expf(bfhi(ll[i])) * h1 + bfhi(uu[i]);
            *(unsigned*)(PP + (size_t)(t0 + t8 + i) * NPP + c2) = cvt_pk_bf16(h0, h1); }
    }
    if (ch == NCH - 1) { c.out[O_LHP + b * D + c2] = h0; c.out[O_LHP + b * D + c2 + 1] = h1; }
}

__device__ __forceinline__ void bc_conv(const Ctx& c, int b, int ch) {
    const int tid = otid(); const bf16_t* PP = (const bf16_t*)(c.ws + OFF_PP); bf16_t* BCc = (bf16_t*)(c.ws + OFF_XN);
    const float* cw = c.in[19]; const float* cb = c.in[20]; const int t0 = b * SEQ + 64 * ch;
    if (tid < 384) { const int row = tid >> 7, cg8 = tid & 127;
        *(u32x4*)((bf16_t*)(c.ws + OFF_HALO) + ((size_t)((b * NCH + ch) * 3 + row)) * D + 8 * cg8) = *(const u32x4*)(PP + (size_t)(t0 + 61 + row) * NPP + 8 * cg8); }
#pragma unroll 1
    for (int item = tid; item < 1024; item += 512) {
        const int cgq = item & 127, st = item >> 7, gcol = 3072 + 8 * cgq, ccol = 2048 + 8 * cgq;
        u32x4 raw[11];
#pragma unroll
        for (int i = 0; i < 11; ++i) { const int tt = 8 * st - 3 + i; raw[i] = (u32x4){0u, 0u, 0u, 0u}; if (tt >= 0 || ch > 0) raw[i] = *(const u32x4*)(PP + (size_t)(t0 + tt) * NPP + gcol); }
#pragma unroll
        for (int hf = 0; hf < 2; ++hf) {
            f32x4 wk[4]; const f32x4 bb = *(const f32x4*)(cb + ccol + 4 * hf);
#pragma unroll
            for (int k = 0; k < 4; ++k) wk[k] = *(const f32x4*)(cw + k * 3072 + ccol + 4 * hf);
#pragma unroll
            for (int q = 0; q < 8; ++q) { f32x4 o = bb;
#pragma unroll
                for (int k = 0; k < 4; ++k) { const unsigned w0 = raw[q + k][2 * hf], w1 = raw[q + k][2 * hf + 1]; const f32x4 r = (f32x4){bflo(w0), bfhi(w0), bflo(w1), bfhi(w1)}; o += wk[k] * r; }
#pragma unroll
                for (int j = 0; j < 4; ++j) o[j] = siluf_(o[j]);
                unsigned* op = (unsigned*)(BCc + (size_t)(t0 + 8 * st + q) * 1024 + 8 * cgq + 4 * hf); op[0] = cvt_pk_bf16(o[0], o[1]); op[1] = cvt_pk_bf16(o[2], o[3]); }
        }
    }
}

__device__ __forceinline__ void ssd_seq(const Ctx& c, int b, int h, bool dry = false) {
    const int tid = otid(), wid = tid >> 6, lane = tid & 63, lr = lane & 15, kg = lane >> 4;
    LAS unsigned char* L = c.lds;
    LAS unsigned char* Cm = L; LAS unsigned char* Bm = L + 17408; LAS unsigned char* BdT = L + 34816; LAS unsigned char* Sb = L + 53248;
    LAS unsigned char* XdT = L + 70656; LAS unsigned char* Xr = L + 79872; LAS unsigned char* Mm = L + 89088;
    LAS float* dts = (LAS float*)(L + 98304); LAS float* css = (LAS float*)(L + 98560); LAS float* dec = (LAS float*)(L + 98816); LAS bf16_t* halo = (LAS bf16_t*)(L + 99072);
    bf16_t* PP = (bf16_t*)(c.ws + OFF_PP); const float* DT = (const float*)(c.ws + OFF_DT);
    const float* cw = c.in[19]; const float* cb = c.in[20];
    const int g = h >> 3;
    const float Ah = -__expf(c.in[22][h]), Dh = c.in[23][h], dtb = c.in[21][h];
    f32x4 accS[4];
#pragma unroll
    for (int m = 0; m < 4; ++m) accS[m] = (f32x4){0.f, 0.f, 0.f, 0.f};
    for (int e = tid; e < 64 * 136; e += 512) ((LAS bf16_t*)Sb)[e] = 0;
    const bf16_t* BCc = (const bf16_t*)(c.ws + OFF_XN);
    const int role = tid >> 7, rt = tid & 127;
    const int xg = rt & 7, xst = rt >> 3;
    const int bg8 = rt & 15, bst = rt >> 4;
    const int gcol = 1024 + 64 * h + 8 * xg, ccol = 64 * h + 8 * xg;
    const int bcol = (role == 2 ? 512 : 0) + 128 * g + 8 * bg8;
    u32x4 raw[8]; float dtv = 0.f;
    f32x4 wkk[2][4], bbb[2];
#pragma unroll
    for (int hf = 0; hf < 2; ++hf) { bbb[hf] = *(const f32x4*)(cb + ccol + 4 * hf);
#pragma unroll
        for (int k = 0; k < 4; ++k) wkk[hf][k] = *(const f32x4*)(cw + k * 3072 + ccol + 4 * hf); }
    {
        const int t0 = b * SEQ;
        if (role == 0) {
#pragma unroll
            for (int i = 0; i < 7; ++i) { const int tt = 4 * xst - 3 + i; raw[i] = (u32x4){0u, 0u, 0u, 0u}; if (tt >= 0) raw[i] = *(const u32x4*)(PP + (size_t)(t0 + tt) * NPP + gcol); } }
        else if (role < 3) {
#pragma unroll
            for (int i = 0; i < 8; ++i) raw[i] = *(const u32x4*)(BCc + (size_t)(t0 + 8 * bst + i) * 1024 + bcol); }
        if (wid == 0) dtv = DT[(size_t)(t0 + lane) * 32 + h];
    }
    for (int ch = 0; ch < NCH; ++ch) {
        const int t0 = b * SEQ + 64 * ch;
        if (wid == 0) {
            const float d = softplusf_(dtv + dtb); float sc = d * Ah;
#pragma unroll
            for (int o = 1; o < 64; o <<= 1) { const float v = __shfl_up(sc, o); if (lane >= o) sc += v; }
            const float ce = __shfl(sc, 63);
            dts[lane] = d; css[lane] = sc; dec[lane] = __expf(ce - sc);
        }
        __syncthreads();
        if (role == 0) {
            if (xst == 0 && ch > 0) {
#pragma unroll
                for (int i = 0; i < 3; ++i) raw[i] = *(const LAS u32x4*)(halo + ((ch - 1) & 1) * 192 + i * 64 + 8 * xg); }
            if (xst == 15) {
#pragma unroll
                for (int i = 0; i < 3; ++i) *(LAS u32x4*)(halo + (ch & 1) * 192 + i * 64 + 8 * xg) = raw[4 + i];
                if (ch == NCH - 1 && !dry) {
#pragma unroll
                    for (int r = 0; r < 3; ++r) { f32x4 v0, v1; unpack8(raw[4 + r], v0, v1); float* o = c.out + O_SCP + (size_t)(b * 3 + r) * 3072 + ccol; *(f32x4*)o = v0; *(f32x4*)(o + 4) = v1; } } }
            const int chunk = (xst >> 1) ^ xg;
#pragma unroll
            for (int hf = 0; hf < 2; ++hf) {
                unsigned tq[4][2];
#pragma unroll
                for (int q = 0; q < 4; ++q) { f32x4 o = bbb[hf];
#pragma unroll
                    for (int k = 0; k < 4; ++k) { const unsigned w0 = raw[q + k][2 * hf], w1 = raw[q + k][2 * hf + 1]; const f32x4 r = (f32x4){bflo(w0), bfhi(w0), bflo(w1), bfhi(w1)}; o += wkk[hf][k] * r; }
#pragma unroll
                    for (int j = 0; j < 4; ++j) o[j] = siluf_(o[j]);
                    const int l = 4 * xst + q;
                    LAS unsigned* rp = (LAS unsigned*)(Xr + l * 144 + 16 * xg + 8 * hf); rp[0] = cvt_pk_bf16(o[0], o[1]); rp[1] = cvt_pk_bf16(o[2], o[3]);
                    const float d = dts[l]; tq[q][0] = cvt_pk_bf16(o[0] * d, o[1] * d); tq[q][1] = cvt_pk_bf16(o[2] * d, o[3] * d);
                }
#pragma unroll
                for (int j2 = 0; j2 < 2; ++j2) {
                    unsigned lo[2], hi[2];
#pragma unroll
                    for (int i = 0; i < 2; ++i) { const unsigned a = tq[2 * i][j2], bq = tq[2 * i + 1][j2]; lo[i] = (a & 0xffffu) | (bq << 16); hi[i] = (a >> 16) | (bq & 0xffff0000u); }
                    LAS unsigned* p0 = (LAS unsigned*)(XdT + (8 * xg + 4 * hf + 2 * j2) * 144 + 16 * chunk + 8 * (xst & 1)); p0[0] = lo[0]; p0[1] = lo[1];
                    LAS unsigned* p1 = (LAS unsigned*)(XdT + (8 * xg + 4 * hf + 2 * j2 + 1) * 144 + 16 * chunk + 8 * (xst & 1)); p1[0] = hi[0]; p1[1] = hi[1]; }
            }
        } else if (role == 1) {
            const int chunk = bst ^ (bg8 & 7);
            unsigned tq[8][4];
#pragma unroll
            for (int q = 0; q < 8; ++q) { const int l = 8 * bst + q; *(LAS u32x4*)(Bm + l * 272 + 16 * bg8) = raw[q]; const float d = dec[l]; f32x4 v0, v1; unpack8(raw[q], v0, v1);
                tq[q][0] = cvt_pk_bf16(v0[0] * d, v0[1] * d); tq[q][1] = cvt_pk_bf16(v0[2] * d, v0[3] * d); tq[q][2] = cvt_pk_bf16(v1[0] * d, v1[1] * d); tq[q][3] = cvt_pk_bf16(v1[2] * d, v1[3] * d); }
#pragma unroll
            for (int j2 = 0; j2 < 4; ++j2) { u32x4 lo, hi;
#pragma unroll
                for (int i = 0; i < 4; ++i) { const unsigned a = tq[2 * i][j2], bq = tq[2 * i + 1][j2]; lo[i] = (a & 0xffffu) | (bq << 16); hi[i] = (a >> 16) | (bq & 0xffff0000u); }
                *(LAS u32x4*)(BdT + (8 * bg8 + 2 * j2) * 144 + 16 * chunk) = lo; *(LAS u32x4*)(BdT + (8 * bg8 + 2 * j2 + 1) * 144 + 16 * chunk) = hi; }
        } else if (role == 2) {
#pragma unroll
            for (int q = 0; q < 8; ++q) *(LAS u32x4*)(Cm + (8 * bst + q) * 272 + 16 * bg8) = raw[q];
        }
        if (ch + 1 < NCH) {
            if (role == 0) {
#pragma unroll
                for (int i = 0; i < 7; ++i) { const int tt = 4 * xst - 3 + i; if (tt >= 0) raw[i] = *(const u32x4*)(PP + (size_t)(t0 + 64 + tt) * NPP + gcol); } }
            else if (role < 3) {
#pragma unroll
                for (int i = 0; i < 8; ++i) raw[i] = *(const u32x4*)(BCc + (size_t)(t0 + 64 + 8 * bst + i) * 1024 + bcol); }
            if (wid == 0) dtv = DT[(size_t)(t0 + 64 + lane) * 32 + h];
        }
        __syncthreads();
#pragma unroll
        for (int q = 0; q < 2; ++q) { const int ti = 2 * wid + q, lt = ti >> 2, stl = ti & 3; f32x4 a4 = (f32x4){0.f, 0.f, 0.f, 0.f};
            if (stl <= lt) {
#pragma unroll
                for (int ks = 0; ks < 4; ++ks) { const bf16x8 a = *(const LAS bf16x8*)(Bm + (16 * stl + lr) * 272 + (32 * ks + 8 * kg) * 2), bq = *(const LAS bf16x8*)(Cm + (16 * lt + lr) * 272 + (32 * ks + 8 * kg) * 2);
                    a4 = __builtin_amdgcn_mfma_f32_16x16x32_bf16(a, bq, a4, 0, 0, 0); } }
            const int l = 16 * lt + lr; const float cl = css[l]; f32x4 v;
#pragma unroll
            for (int r = 0; r < 4; ++r) { const int sI = 16 * stl + 4 * kg + r; v[r] = (sI <= l) ? a4[r] * __expf(cl - css[sI]) : 0.f; }
            unsigned* dummy = nullptr; (void)dummy;
            LAS unsigned* mp = (LAS unsigned*)(Mm + l * 144 + 2 * (16 * stl + 4 * kg)); mp[0] = cvt_pk_bf16(v[0], v[1]); mp[1] = cvt_pk_bf16(v[2], v[3]); }
        __syncthreads();
#pragma unroll
        for (int q = 0; q < 2; ++q) { const int ti = 2 * wid + q, pt = ti >> 2, lt = ti & 3; f32x4 a4 = (f32x4){0.f, 0.f, 0.f, 0.f};
#pragma unroll
            for (int ks = 0; ks < 4; ++ks) { const bf16x8 a = *(const LAS bf16x8*)(Sb + (16 * pt + lr) * 272 + (32 * ks + 8 * kg) * 2), bq = *(const LAS bf16x8*)(Cm + (16 * lt + lr) * 272 + (32 * ks + 8 * kg) * 2);
                a4 = __builtin_amdgcn_mfma_f32_16x16x32_bf16(a, bq, a4, 0, 0, 0); }
            const int l = 16 * lt + lr; const float el = __expf(css[l]);
#pragma unroll
            for (int r = 0; r < 4; ++r) a4[r] *= el;
            const int prow_ = 16 * pt + lr, sw = (2 * pt + (lr >> 3)) & 7;
#pragma unroll
            for (int ks = 0; ks < 2; ++ks) { const bf16x8 a = *(const LAS bf16x8*)(XdT + prow_ * 144 + 16 * ((4 * ks + kg) ^ sw)), bq = *(const LAS bf16x8*)(Mm + (16 * lt + lr) * 144 + (32 * ks + 8 * kg) * 2);
                a4 = __builtin_amdgcn_mfma_f32_16x16x32_bf16(a, bq, a4, 0, 0, 0); }
            const int p0 = 16 * pt + 4 * kg; const LAS unsigned* xp = (const LAS unsigned*)(Xr + l * 144 + 2 * p0); const unsigned x01 = xp[0], x23 = xp[1];
            const float y0 = a4[0] + Dh * bflo(x01), y1 = a4[1] + Dh * bfhi(x01), y2 = a4[2] + Dh * bflo(x23), y3 = a4[3] + Dh * bfhi(x23);
            if (!dry) { unsigned* yp = (unsigned*)(PP + (size_t)(t0 + l) * NPP + 1024 + 64 * h + p0); yp[0] = cvt_pk_bf16(y0, y1); yp[1] = cvt_pk_bf16(y2, y3); } }
        { const float ce = __expf(css[63]); const int nrow = 16 * wid + lr, swn = (2 * wid + (lr >> 3)) & 7;
#pragma unroll
          for (int m = 0; m < 4; ++m) { accS[m] *= ce; const int prow_ = 16 * m + lr, swp = (2 * m + (lr >> 3)) & 7;
#pragma unroll
            for (int ks = 0; ks < 2; ++ks) { const bf16x8 a = *(const LAS bf16x8*)(BdT + nrow * 144 + 16 * ((4 * ks + kg) ^ swn)), bq = *(const LAS bf16x8*)(XdT + prow_ * 144 + 16 * ((4 * ks + kg) ^ swp));
                accS[m] = __builtin_amdgcn_mfma_f32_16x16x32_bf16(a, bq, accS[m], 0, 0, 0); } } }
        __syncthreads();
#pragma unroll
        for (int m = 0; m < 4; ++m) { LAS unsigned* sp = (LAS unsigned*)(Sb + (16 * m + lr) * 272 + 2 * (16 * wid + 4 * kg)); sp[0] = cvt_pk_bf16(accS[m][0], accS[m][1]); sp[1] = cvt_pk_bf16(accS[m][2], accS[m][3]); }
    }
    if (!dry) {
#pragma unroll
        for (int m = 0; m < 4; ++m) *(f32x4*)(c.out + O_SHP + ((size_t)(b * 32 + h) * 64 + 16 * m + lr) * 128 + 16 * wid + 4 * kg) = accS[m];
    }
    __syncthreads();
}

__device__ __forceinline__ void lru_sample(const Ctx& c, int b, int head) {
    const int tid = otid(); LAS float* XC = (LAS float*)c.lds; LAS float* RG = XC + 2048; LAS float* IG = RG + 2048;
    const float* PS = (const float*)(c.ws + OFF_PS); bf16_t* ABRS = (bf16_t*)(c.ws + OFF_ABRS);
    const float* cw = c.in[12]; const float* cb = c.in[13]; const int ch0 = 128 * head;
    for (int e = tid; e < 2048; e += 512) { const int tk = e >> 7, cl = e & 127, cgl = ch0 + cl; float o = cb[cgl];
#pragma unroll
        for (int k = 0; k < 4; ++k) { const int tt = tk - 3 + k; const float v = tt >= 0 ? PS[(size_t)(b * 16 + tt) * 9216 + cgl] : SZ(c.in[2][(size_t)(b * 3 + tt + 3) * D + cgl]); o += cw[k * D + cgl] * v; }
        XC[e] = o; }
    if (tid < 384) { const int r = tid >> 7, cl = tid & 127; c.out[O_LCS + (size_t)(b * 3 + r) * D + ch0 + cl] = PS[(size_t)(b * 16 + 13 + r) * 9216 + ch0 + cl]; }
    __syncthreads();
    {
        LAS unsigned char* XCb = c.lds + 32768; const int wid = tid >> 6, lane = tid & 63, lr = lane & 15, kg = lane >> 4;
        for (int e = tid; e < 2048; e += 512) *(LAS bf16_t*)(XCb + (e >> 7) * 272 + 2 * (e & 127)) = f2bf(XC[e]);
        __syncthreads();
        const bf16_t* wr_ = (const bf16_t*)(c.ws + OFF_WRG) + (size_t)(ch0 + 16 * wid + lr) * 128 + 8 * kg; const bf16_t* wi_ = (const bf16_t*)(c.ws + OFF_WIG) + (size_t)(ch0 + 16 * wid + lr) * 128 + 8 * kg;
        f32x4 ar = (f32x4){0.f, 0.f, 0.f, 0.f}, ai_ = ar;
#pragma unroll
        for (int ks = 0; ks < 4; ++ks) { const bf16x8 br = *(const bf16x8*)(wr_ + 32 * ks), bi = *(const bf16x8*)(wi_ + 32 * ks), a = *(const LAS bf16x8*)(XCb + lr * 272 + (32 * ks + 8 * kg) * 2);
            ar = __builtin_amdgcn_mfma_f32_16x16x32_bf16(a, br, ar, 0, 0, 0); ai_ = __builtin_amdgcn_mfma_f32_16x16x32_bf16(a, bi, ai_, 0, 0, 0); }
        const int cl = 16 * wid + lr; const float b1 = c.in[15][ch0 + cl], b2 = c.in[17][ch0 + cl];
#pragma unroll
        for (int r = 0; r < 4; ++r) { const int tk = 4 * kg + r; RG[tk * 128 + cl] = sigmoidf_(ar[r] + b1); IG[tk * 128 + cl] = sigmoidf_(ai_[r] + b2); }
    }
    __syncthreads();
    if (tid < 128) { const int cgl = ch0 + tid; const float sp = softplusf_(-c.in[18][cgl]); float h = SZ(c.in[3][b * D + cgl]);
        for (int tk = 0; tk < 16; ++tk) { const float la = -8.0f * RG[tk * 128 + tid] * sp, a = __expf(la), u = sqrtf(-expm1f(2.0f * la)) * IG[tk * 128 + tid] * XC[tk * 128 + tid];
            h = a * h + u; ABRS[(size_t)(b * 16 + tk) * 3072 + cgl] = f2bf(gelu_tanh(PS[(size_t)(b * 16 + tk) * 9216 + 4096 + cgl]) * h); }
        c.out[O_LHS + b * D + cgl] = h; }
    __syncthreads();
}
__device__ __forceinline__ void ssd_sample(const Ctx& c, int b, int h) {
    const int tid = otid(); LAS float* XS = (LAS float*)c.lds; LAS float* BS = XS + 1024; LAS float* CS = BS + 2048; LAS float* DTL = CS + 2048;
    const float* PS = (const float*)(c.ws + OFF_PS); const float* DTS = (const float*)(c.ws + OFF_DTS); float* YGS = (float*)(c.ws + OFF_YGS);
    const float* cw = c.in[19]; const float* cb = c.in[20]; const int g = h >> 3;
    for (int e = tid; e < 16 * 320; e += 512) { const int tk = e / 320, q = e % 320; int cc; LAS float* dst;
        if (q < 64) { cc = 64 * h + q; dst = XS + tk * 64 + q; } else if (q < 192) { cc = 2048 + 128 * g + (q - 64); dst = BS + tk * 128 + (q - 64); } else { cc = 2560 + 128 * g + (q - 192); dst = CS + tk * 128 + (q - 192); }
        float o = cb[cc];
#pragma unroll
        for (int k = 0; k < 4; ++k) { const int tt = tk - 3 + k; const float v = tt >= 0 ? PS[(size_t)(b * 16 + tt) * 9216 + 1024 + cc] : SZ(c.in[4][(size_t)(b * 3 + tt + 3) * 3072 + cc]); o += cw[k * 3072 + cc] * v; }
        *dst = siluf_(o);
        if (tk >= 13 && (q < 64 || (h & 7) == 0)) c.out[O_SCS + (size_t)(b * 3 + tk - 13) * 3072 + cc] = PS[(size_t)(b * 16 + tk) * 9216 + 1024 + cc]; }
    if (tid < 16) DTL[tid] = softplusf_(DTS[(b * 16 + tid) * 32 + h] + c.in[21][h]);
    __syncthreads();
    const float Ah = -__expf(c.in[22][h]), Dh = c.in[23][h];
    const int p = tid >> 3, n0 = (tid & 7) * 16; float hs[16];
    const float* h0 = c.in[5] + ((size_t)(b * 32 + h) * 64 + p) * 128 + n0;
#pragma unroll
    for (int j = 0; j < 16; ++j) hs[j] = SZ(h0[j]);
    float zv[16];
#pragma unroll
    for (int tk = 0; tk < 16; ++tk) zv[tk] = PS[(size_t)(b * 16 + tk) * 9216 + 5120 + 64 * h + p];
#pragma unroll
    for (int tk = 0; tk < 16; ++tk) { const float d = DTL[tk], ea = __expf(d * Ah), xv = XS[tk * 64 + p], dx = d * xv; float y = 0.f;
#pragma unroll
        for (int j = 0; j < 16; ++j) { hs[j] = ea * hs[j] + dx * BS[tk * 128 + n0 + j]; y += CS[tk * 128 + n0 + j] * hs[j]; }
        y += __shfl_xor(y, 1); y += __shfl_xor(y, 2); y += __shfl_xor(y, 4);
        if ((tid & 7) == 0) { const int row = b * 16 + tk; YGS[(size_t)row * 2048 + 64 * h + p] = (y + Dh * xv) * siluf_(zv[tk]); } }
    float* ho = c.out + O_SHS + ((size_t)(b * 32 + h) * 64 + p) * 128 + n0;
#pragma unroll
    for (int j = 0; j < 16; ++j) ho[j] = hs[j];
    __syncthreads();
}

#ifdef DIAG
constexpr size_t OFF_DIAG = 266338304;
__device__ __forceinline__ int prow(int r) { return (r >> 4) * SEQ + (r & 15); }
template <class FA, class FB>
__device__ __forceinline__ void diag_rel(LAS float* red, float* dst, int ncols, FA fa, FB fb) {
    const int tid = threadIdx.x; float num = 0.f, den = 0.f;
    for (int e = tid; e < TS * ncols; e += 512) { const int r = e / ncols, cc = e % ncols; const float a = fa(r, cc), b = fb(r, cc); num += (a - b) * (a - b); den += b * b; }
    red[tid] = num; red[512 + tid] = den; __syncthreads();
    if (tid == 0) { float n = 0.f, d = 0.f; for (int i = 0; i < 512; ++i) { n += red[i]; d += red[512 + i]; } *dst = n / (d + 1e-30f); }
    __syncthreads();
}
#endif
constexpr size_t OFF_BAR = 266338304 + 4096, OFF_SSQS = OFF_BAR + 4096;
__device__ __forceinline__ void grid_barrier(unsigned* ctr, unsigned target) {
    asm volatile("s_waitcnt vmcnt(0) lgkmcnt(0)" ::: "memory");
    __syncthreads();
    if (threadIdx.x == 0) {
        __builtin_amdgcn_fence(__ATOMIC_RELEASE, "agent");
        asm volatile("s_waitcnt vmcnt(0)" ::: "memory");
        __hip_atomic_fetch_add(ctr, 1u, __ATOMIC_RELAXED, __HIP_MEMORY_SCOPE_AGENT);
        while (__hip_atomic_load(ctr, __ATOMIC_RELAXED, __HIP_MEMORY_SCOPE_AGENT) < target) __builtin_amdgcn_s_sleep(1);
        __builtin_amdgcn_fence(__ATOMIC_ACQUIRE, "agent");
        asm volatile("s_waitcnt vmcnt(0)" ::: "memory");
    }
    __syncthreads();
}
#define XB_TMO      128
#define XB_XCNT(j)  (256  + 64 * (j))
#define XB_XSUB(j)  (1280 + 64 * (j))
#define XB_XGEN(j)  (2304 + 64 * (j))
#define XB_TOP      3328
#define XB_TOPGEN   3392
#define XCD_BAR_WORDS 3456
#define XB_SPIN_CAP (1u << 18)
constexpr size_t OFF_XBAR = 266338304 + 4096 + 4096 + 65536;
__device__ __forceinline__ unsigned xb_ld(unsigned* p)              { return __hip_atomic_load(p, __ATOMIC_RELAXED, __HIP_MEMORY_SCOPE_AGENT); }
__device__ __forceinline__ unsigned xb_add(unsigned* p, unsigned v) { return __hip_atomic_fetch_add(p, v, __ATOMIC_RELAXED, __HIP_MEMORY_SCOPE_AGENT); }
__device__ __forceinline__ unsigned xb_xcc_id() { return (unsigned)__builtin_amdgcn_s_getreg((3 << 11) | 20) & 0xFu; }
#define XB_SPIN(cond, bar) do { unsigned _sp = 0; while (cond) { __builtin_amdgcn_s_sleep(1); \
    if ((++_sp & 255u) == 0u) { if (xb_ld(&(bar)[XB_TMO])) break; if (_sp > XB_SPIN_CAP) { atomicAdd(&(bar)[XB_TMO], 1u); break; } } } } while (0)
struct XcdBarrier { unsigned* bar; unsigned x; volatile LAS unsigned* st; };
__device__ __forceinline__ XcdBarrier xcd_barrier_post(unsigned* bar, volatile LAS unsigned* st) {
    XcdBarrier b; b.bar = bar; b.x = xb_xcc_id(); b.st = st;
    if (threadIdx.x == 0) (void)xb_add(&bar[XB_XCNT(b.x)], 1u);
    return b;
}
__device__ __forceinline__ void xcd_barrier_complete(unsigned* bar, unsigned x, unsigned& nloc, unsigned& nx) {
    const unsigned G = gridDim.x * gridDim.y * gridDim.z;
    unsigned sum, cnt, mine, sp = 0u;
    for (;;) {
        sum = 0u; cnt = 0u; mine = 0u;
#pragma unroll
        for (unsigned j = 0; j < 16; ++j) { const unsigned c = xb_ld(&bar[XB_XCNT(j)]); sum += c; cnt += (c > 0u) ? 1u : 0u; mine = (j == x) ? c : mine; }
        if (sum == G) break;
        __builtin_amdgcn_s_sleep(1);
        if ((++sp & 255u) == 0u) { if (xb_ld(&bar[XB_TMO])) break; if (sp > XB_SPIN_CAP) { atomicAdd(&bar[XB_TMO], 1u); break; } }
    }
    nloc = mine > 0u ? mine : 1u; nx = cnt > 0u ? cnt : 1u;
}
__device__ __forceinline__ void xcd_barrier(const XcdBarrier& b) {
    asm volatile("s_waitcnt vmcnt(0)" ::: "memory");
    __syncthreads();
    if (threadIdx.x == 0) {
        unsigned* bar = b.bar;
        __builtin_amdgcn_s_waitcnt(0);
        unsigned nloc = b.st[0], nx = b.st[1];
        if (nloc == 0u) { xcd_barrier_complete(bar, b.x, nloc, nx); b.st[0] = nloc; b.st[1] = nx; }
        const unsigned old = xb_add(&bar[XB_XSUB(b.x)], 1u);
        const unsigned gen = old / nloc;
        if (old + 1u == (gen + 1u) * nloc) {
            __builtin_amdgcn_fence(__ATOMIC_RELEASE, "agent");
            asm volatile("s_waitcnt vmcnt(0)" ::: "memory");
            const unsigned og = xb_add(&bar[XB_TOP], 1u);
            const unsigned tg = og / nx;
            if (og + 1u == (tg + 1u) * nx) xb_add(&bar[XB_TOPGEN], 1u);
            else XB_SPIN(xb_ld(&bar[XB_TOPGEN]) == tg, bar);
            __builtin_amdgcn_fence(__ATOMIC_ACQUIRE, "agent");
            xb_add(&bar[XB_XGEN(b.x)], 1u);
            asm volatile("s_waitcnt vmcnt(0)" ::: "memory");
        } else {
            XB_SPIN(xb_ld(&bar[XB_XGEN(b.x)]) == gen, bar);
            __builtin_amdgcn_fence(__ATOMIC_ACQUIRE, "agent");
            asm volatile("s_waitcnt vmcnt(0)" ::: "memory");
        }
    }
    __syncthreads();
}
#ifndef DUPX
#define DUPX 0
#endif
#ifdef TIMER_ID
#define TSTART(id) do { if ((id) == TIMER_ID) t0_ = __builtin_amdgcn_s_memrealtime(); } while (0)
#define TSTOP(id) do { if ((id) == TIMER_ID) tacc_ += __builtin_amdgcn_s_memrealtime() - t0_; } while (0)
#else
#define TSTART(id)
#define TSTOP(id)
#endif
__global__ void __launch_bounds__(512, 2) fwd_kernel(Params prm) {
    extern __shared__ __attribute__((aligned(16))) unsigned char lds_raw[];
    Ctx c; c.in = prm.in; c.out = prm.out; c.ws = prm.ws; c.lds = (LAS unsigned char*)lds_raw;
    unsigned char* ws = prm.ws; float* out = prm.out;
    const int tid = threadIdx.x, G = gridDim.x, bid = blockIdx.x;
    bf16_t* XB = (bf16_t*)(ws + OFF_XB); bf16_t* XN = (bf16_t*)(ws + OFF_XN); bf16_t* PP = (bf16_t*)(ws + OFF_PP); float* SSQ = (float*)(ws + OFF_SSQ);
    bf16_t* XNS = (bf16_t*)(ws + OFF_XNS); bf16_t* HS = (bf16_t*)(ws + OFF_HS); float* PS = (float*)(ws + OFF_PS); float* GSSQ = (float*)(ws + OFF_GSSQ);
    float* YS = out + O_YS; float* SSQS = (float*)(ws + OFF_SSQS);
    const int lo = prm.ph_lo, hi = prm.ph_hi;
#ifdef DIAG
    if (lo >= 100) {
        if (bid != 0) return;
        float* DG = (float*)(ws + OFF_DIAG); LAS float* red = (LAS float*)c.lds; const int st = lo - 100;
        const float* DTp = (const float*)(ws + OFF_DT); const float* DTs = (const float*)(ws + OFF_DTS); const bf16_t* ABRS = (const bf16_t*)(ws + OFF_ABRS); const bf16_t* MS = (const bf16_t*)(ws + OFF_MS); const float* bg = prm.in[11];
        if (st == 0 || st == 6 || st == 7) diag_rel(red, DG + st, D, [=](int r, int cc) { return out[O_YP + (size_t)prow(r) * D + cc]; }, [=](int r, int cc) { return YS[(size_t)r * D + cc]; });
        if (st == 1) { diag_rel(red, DG + 1, NPP, [=](int r, int cc) { return bf2f(PP[(size_t)prow(r) * NPP + cc]); }, [=](int r, int cc) { return PS[(size_t)r * 9216 + cc]; });
                       diag_rel(red, DG + 2, 32, [=](int r, int cc) { return DTp[(size_t)prow(r) * 32 + cc]; }, [=](int r, int cc) { return DTs[(size_t)r * 32 + cc]; }); }
        if (st == 8) { diag_rel(red, DG + 8, D, [=](int r, int cc) { return bf2f(XN[(size_t)prow(r) * D + cc]); }, [=](int r, int cc) { return sigmoidf_(PS[(size_t)r * 9216 + 7168 + cc] + bg[cc]); });
                       diag_rel(red, DG + 9, D, [=](int r, int cc) { return bf2f(PP[(size_t)prow(r) * NPP + 3072 + cc]); }, [=](int r, int cc) { return sigmoidf_(PS[(size_t)r * 9216 + 8192 + cc] + bg[1024 + cc]); }); }
        if (st == 3) { diag_rel(red, DG + 3, D, [=](int r, int cc) { return bf2f(PP[(size_t)prow(r) * NPP + cc]); }, [=](int r, int cc) { return bf2f(ABRS[(size_t)r * 3072 + cc]); });
                       diag_rel(red, DG + 4, 2048, [=](int r, int cc) { return bf2f(PP[(size_t)prow(r) * NPP + 1024 + cc]); }, [=](int r, int cc) { return bf2f(ABRS[(size_t)r * 3072 + 1024 + cc]); }); }
        if (st == 5) diag_rel(red, DG + 5, D, [=](int r, int cc) { return bf2f(XN[(size_t)prow(r) * D + cc]); }, [=](int r, int cc) { return bf2f(MS[(size_t)r * D + cc]); });
        if (st == 20) {
            int mask = 0; if (!(DG[8] < DIAG_TOL)) mask |= 1; if (!(DG[9] < DIAG_TOL)) mask |= 2; if (!(DG[3] < DIAG_TOL)) mask |= 4; if (!(DG[4] < DIAG_TOL)) mask |= 8; if (!(DG[5] < DIAG_TOL)) mask |= 16;
            if (mask == 0) { if (!(DG[6] < DIAG_TOL)) mask |= 32; if (!(DG[7] < DIAG_TOL)) mask |= 64; }
            float code = mask ? 100.f * (1 + mask) : 0.f;
            if (code > 0.f) for (int e = tid; e < TS * D; e += 512) YS[e] = code;
        }
        return;
    }
#endif
#ifndef PHMASK
#define PHMASK 0x1fff
#endif
#define IN(k) (((PHMASK >> (k)) & 1) && lo <= (k) && (k) < hi)
    unsigned* barctr = (unsigned*)(ws + OFF_BAR); unsigned nbar = 0; (void)barctr;
    volatile LAS unsigned* xbst = (volatile LAS unsigned*)(c.lds + LDS_BYTES - 16);
    if (tid < 4) xbst[tid] = 0u;
    __syncthreads();
    XcdBarrier xbar; xbar.bar = (unsigned*)(ws + OFF_XBAR); xbar.x = 0; xbar.st = xbst;
    if (hi - lo > 1) xbar = xcd_barrier_post((unsigned*)(ws + OFF_XBAR), xbst);
    unsigned long long t0_ = 0, tacc_ = 0; (void)t0_; (void)tacc_;
#define SEAM(k) do { if (IN(k) && IN((k) + 1)) { TSTART(12); ++nbar; xcd_barrier(xbar); TSTOP(12); } } while (0)
    auto rm_id = [](int col0, int) { return col0; };
    auto rm_up = [](int col0, int panel) { return (col0 >> 7) * 256 + panel * 128 + (col0 & 127); };

    if (IN(0)) {
        TSTART(0); prep_weights(c);
#if DUPX == 1
        prep_weights(c);
#endif
        rmsnorm_rows_bf16(prm.in[0], T, prm.in[6], XN); TSTOP(0);
#ifdef DIAG
        { const int t_ = otid(), lane = t_ & 63; for (int r = bid * 8 + (t_ >> 6); r < TS; r += G * 8) { const float* p = prm.in[0] + (size_t)prow(r) * D; float v[16]; float s = 0.f;
            for (int i = 0; i < 16; ++i) { v[i] = p[lane + 64 * i]; s += v[i] * v[i]; }
            for (int o = 1; o < 64; o <<= 1) s += __shfl_xor(s, o);
            const float inv = rsqrtf(s * (1.0f / 1024.0f) + EPS);
            for (int i = 0; i < 16; ++i) XNS[(size_t)r * D + lane + 64 * i] = f2bf(v[i] * inv * prm.in[6][lane + 64 * i]); } }
#else
        rmsnorm_rows_bf16(prm.in[1], TS, prm.in[6], XNS);
#endif
    }
    SEAM(0);
    if (IN(1)) {
        pg8::Gemm g{XN, D, (const bf16_t*)(ws + OFF_WUP1), D, T, 2 * FF, D}; pg8::StaticOrder S; S.init(T, 2 * FF, G, bid);

#if DUPX == 5
        pg8::gemm_phase(c.lds, g, S, EpiSwiglu{PP, (LAS const float*)nullptr});
#endif
        TSTART(1); pg8::gemm_phase(c.lds, g, S, EpiSwiglu{PP, (LAS const float*)nullptr}); TSTOP(1);
        TSTART(2); sgemm<16, 2, D>(c.lds, XNS, D, (const bf16_t*)(ws + OFF_WUP1), D, FF, nullptr, nullptr, rm_up,
            [=](int r, int cc, float v0, float v1, float) { HS[(size_t)r * FF + cc] = f2bf(siluf_(v0) * v1); return 0.f; }, G / 2); TSTOP(2);
    }
    SEAM(1);
    if (IN(2)) {
        pg8::Gemm g{PP, FF, (const bf16_t*)(ws + OFF_WDN1), FF, T, D, FF}; pg8::StaticOrder S; S.init(T, D, G, bid);
        TSTART(10); pg8::gemm_phase(c.lds, g, S, EpiResid{prm.in[0], nullptr, nullptr, XB, SSQ, 0.5f}); TSTOP(10);
        const float* xs_in = prm.in[1];
        TSTART(2); sgemm<16, 1, FF>(c.lds, HS, FF, (const bf16_t*)(ws + OFF_WDN1), FF, D, nullptr, SSQS, rm_id,
            [=](int r, int cc, float v0, float, float) {
#ifdef DIAG
            const float x = prm.in[0][(size_t)prow(r) * D + cc] + 0.5f * v0;
#else
            const float x = xs_in[(size_t)r * D + cc] + 0.5f * v0;
#endif
            YS[(size_t)r * D + cc] = x; XNS[(size_t)r * D + cc] = f2bf(x); return x; }); TSTOP(2);
    }
    SEAM(2);
    if (IN(3)) {
        pg8::Gemm g{XB, D, (const bf16_t*)(ws + OFF_WIN), D, T, NPP, D}; pg8::StaticOrder S; S.init(T, NPP, G, bid);

#if DUPX == 6
        pg8::gemm_phase(c.lds, g, S, EpiScaleBf16{PP, SSQ});
#endif
        LAS const float* linv = fill_inv(c.lds, SSQ); TSTART(11); pg8::gemm_phase(c.lds, g, S, EpiScaleBf16{PP, linv}); TSTOP(11);
        float* DTp = (float*)(ws + OFF_DT); float* DTs = (float*)(ws + OFF_DTS);
        TSTART(2);
        {
            const int t_ = otid(), wv = t_ >> 6, ln = t_ & 63, lr = ln & 15, kg = ln >> 4; const bf16_t* WDT = (const bf16_t*)(ws + OFF_WDT);
            for (int wt = bid * 8 + wv; wt < T / 16; wt += G * 8) {
                f32x4 a0 = (f32x4){0.f, 0.f, 0.f, 0.f}, a1 = a0; f32x4 sq[4][4];
#pragma unroll
                for (int r = 0; r < 4; ++r)
#pragma unroll
                    for (int i = 0; i < 4; ++i) sq[r][i] = *(const f32x4*)(SSQ + (size_t)(16 * wt + 4 * kg + r) * 16 + 4 * i);
                const bf16_t* ap = XB + (size_t)(16 * wt + lr) * D + 8 * kg; const bf16_t* bp = WDT + (size_t)lr * D + 8 * kg;
#pragma unroll 8
                for (int k = 0; k < D; k += 32) { const bf16x8 a = *(const bf16x8*)(ap + k), b0 = *(const bf16x8*)(bp + k), b1 = *(const bf16x8*)(bp + 16 * D + k);
                    a0 = __builtin_amdgcn_mfma_f32_16x16x32_bf16(a, b0, a0, 0, 0, 0); a1 = __builtin_amdgcn_mfma_f32_16x16x32_bf16(a, b1, a1, 0, 0, 0); }
#pragma unroll
                for (int r = 0; r < 4; ++r) { const int row = 16 * wt + 4 * kg + r; const f32x4 sm = (sq[r][0] + sq[r][1]) + (sq[r][2] + sq[r][3]); const float inv = rsqrtf(((sm[0] + sm[1]) + (sm[2] + sm[3])) * (1.0f / 1024.0f) + EPS); DTp[(size_t)row * 32 + lr] = a0[r] * inv; DTp[(size_t)row * 32 + 16 + lr] = a1[r] * inv; }
            }
        }
        TSTOP(2);
        TSTART(2); sgemm<32, 1, D>(c.lds, XNS, D, (const bf16_t*)(ws + OFF_WIN), D, 9216, SSQS, nullptr, rm_id,
            [=](int r, int cc, float v0, float, float inv) { PS[(size_t)r * 9216 + cc] = v0 * inv; return 0.f; }); TSTOP(2);
        TSTART(2); sgemm<32, 1, D>(c.lds, XNS, D, (const bf16_t*)(ws + OFF_WDT), D, 32, SSQS, nullptr, rm_id,
            [=](int r, int cc, float v0, float, float inv) { DTs[(size_t)r * 32 + cc] = v0 * inv; return 0.f; }); TSTOP(2);
    }
    SEAM(3);
    if (IN(4)) {
        for (int e = bid * 512 + tid; e < 8 * 3 * 2048; e += G * 512) {
            const int cc = e & 2047, r = (e >> 11) % 3, b = e / (3 * 2048); const size_t row = (size_t)b * SEQ + 2045 + r;
            if (cc < 1024) out[O_LCP + (size_t)(b * 3 + r) * D + cc] = bf2f(PP[row * NPP + cc]);
            else out[O_SCP + (size_t)(b * 3 + r) * 3072 + 2048 + (cc - 1024)] = bf2f(PP[row * NPP + 3072 + (cc - 1024)]); }

#if DUPX == 4
        for (int it = bid; it < 256; it += G) lru_chunk<false>(c, it >> 5, it & 31);
#endif
        TSTART(19); for (int it = bid; it < 256; it += G) bc_conv(c, it >> 5, it & 31); TSTOP(19);
        if (hi - lo > 1) xcd_barrier(xbar);
        TSTART(3); for (int it = bid; it < 256; it += G) lru_chunk<false>(c, it >> 5, it & 31); TSTOP(3);

#if DUPX == 3
        for (int it = bid; it < 256; it += G) ssd_seq(c, it >> 5, it & 31, prm.ph_lo == 0);
#endif


    }
    SEAM(4);
    if (IN(5)) {

#if DUPX == 2
        for (int it = bid; it < 256; it += G) lru_chunk<true>(c, it >> 5, it & 31, prm.ph_lo == 0);
#endif
        TSTART(4); for (int it = bid; it < 256; it += G) ssd_seq(c, it >> 5, it & 31); TSTOP(4);
        TSTART(5); for (int it = bid; it < 256; it += G) lru_final(c, it >> 5, it & 31); TSTOP(5);
        TSTART(2); for (int it = bid; it < 64; it += G) lru_sample(c, it >> 3, it & 7); TSTOP(2);
        TSTART(2); for (int it = bid; it < 256; it += G) ssd_sample(c, it >> 5, it & 31); TSTOP(2);
    }
    SEAM(5);
    if (IN(6)) { TSTART(8);
        {
        const float* YGS = (const float*)(ws + OFF_YGS); bf16_t* ABRS = (bf16_t*)(ws + OFF_ABRS);
        const int lane = tid & 63;
        for (int w = bid * 8 + (tid >> 6); w < TS * 4; w += G * 8) { const int r = w >> 2, gq = w & 3; const float* p = YGS + (size_t)r * 2048 + 512 * gq; float v[8]; float s = 0.f;
#pragma unroll
            for (int j = 0; j < 8; ++j) { v[j] = p[lane + 64 * j]; s += v[j] * v[j]; }
#pragma unroll
            for (int o = 1; o < 64; o <<= 1) s += __shfl_xor(s, o);
            const float inv = rsqrtf(s * (1.0f / 512.0f) + EPS);
#pragma unroll
            for (int j = 0; j < 8; ++j) ABRS[(size_t)r * 3072 + 1024 + 512 * gq + lane + 64 * j] = f2bf(v[j] * inv); }
        }
        LAS const float* linv = fill_inv(c.lds, SSQ);
        { pg8::Gemm g{XB, D, (const bf16_t*)(ws + OFF_WIN) + (size_t)4096 * D, D, T, 3072, D}; pg8::StaticOrder S; S.init(T, 3072, G, bid);
          pg8::gemm_phase(c.lds, g, S, EpiGatesA{PP, linv, GSSQ}); }
        { pg8::Gemm g{XB, D, (const bf16_t*)(ws + OFF_WIN) + (size_t)7168 * D, D, T, D, D}; pg8::StaticOrder S; S.init(T, D, G, bid);
          pg8::gemm_phase(c.lds, g, S, EpiSigmoid{XN, D, linv, prm.in[11]}); }
        { pg8::Gemm g{XB, D, (const bf16_t*)(ws + OFF_WIN) + (size_t)8192 * D, D, T, D, D}; pg8::StaticOrder S; S.init(T, D, G, bid);
          pg8::gemm_phase(c.lds, g, S, EpiSigmoid{PP + 3072, NPP, linv, prm.in[11] + 1024}); } TSTOP(8);
    }
    SEAM(6);
    if (IN(7)) { TSTART(6);
        const int lane = tid & 63;
        for (int r = bid * 8 + (tid >> 6); r < T; r += G * 8) {
            float s = (lane < 32) ? GSSQ[(size_t)r * 32 + lane] : 0.f;
            s += __shfl_xor(s, 1); s += __shfl_xor(s, 2); s += __shfl_xor(s, 4);
            const float i0 = rsqrtf(__shfl(s, 0) * (1.0f / 512.0f) + EPS), i1 = rsqrtf(__shfl(s, 8) * (1.0f / 512.0f) + EPS), i2 = rsqrtf(__shfl(s, 16) * (1.0f / 512.0f) + EPS), i3 = rsqrtf(__shfl(s, 24) * (1.0f / 512.0f) + EPS);
#pragma unroll
            for (int i = 0; i < 4; ++i) { const float inv = i == 0 ? i0 : (i == 1 ? i1 : (i == 2 ? i2 : i3));
                bf16_t* p = PP + (size_t)r * NPP + 1024 + 512 * i + 8 * lane; f32x4 a, bq; unpack8(*(const u32x4*)p, a, bq); *(u32x4*)p = pack8(a * inv, bq * inv); }
        }
    }
    TSTOP(6); SEAM(7);
    if (IN(8)) {
        TSTART(9); { pg8::Gemm g{PP, NPP, (const bf16_t*)(ws + OFF_WBR), 3072, T, D, D}; pg8::StaticOrder S; S.init(T, D, G, bid); pg8::gemm_phase(c.lds, g, S, EpiBr{XN, PP, 0}); }
        { pg8::Gemm g{PP + 1024, NPP, (const bf16_t*)(ws + OFF_WBR) + 1024, 3072, T, D, 2048}; pg8::StaticOrder S; S.init(T, D, G, bid); pg8::gemm_phase(c.lds, g, S, EpiBr{XN, PP, 1}); } TSTOP(9);
        const bf16_t* ABRS = (const bf16_t*)(ws + OFF_ABRS); float* M1S = (float*)(ws + OFF_M1S); bf16_t* MS = (bf16_t*)(ws + OFF_MS); const float* bg = prm.in[11];
        TSTART(2); sgemm<16, 1, D>(c.lds, ABRS, 3072, (const bf16_t*)(ws + OFF_WBR), 3072, D, nullptr, nullptr, rm_id,
            [=](int r, int cc, float v0, float, float) { M1S[(size_t)r * D + cc] = sigmoidf_(PS[(size_t)r * 9216 + 7168 + cc] + bg[cc]) * v0; return 0.f; }); TSTOP(2);
        TSTART(2); sgemm<16, 1, 2048>(c.lds, ABRS + 1024, 3072, (const bf16_t*)(ws + OFF_WBR) + 1024, 3072, D, nullptr, nullptr, rm_id,
            [=](int r, int cc, float v0, float, float) { MS[(size_t)r * D + cc] = f2bf(M1S[(size_t)r * D + cc] + sigmoidf_(PS[(size_t)r * 9216 + 8192 + cc] + bg[1024 + cc]) * v0); return 0.f; }); TSTOP(2);
    }
    SEAM(8);
    if (IN(9)) {
        pg8::Gemm g{XN, D, (const bf16_t*)(ws + OFF_WOUT), D, T, D, D}; pg8::StaticOrder S; S.init(T, D, G, bid);
        TSTART(16); pg8::gemm_phase(c.lds, g, S, EpiResid{nullptr, XB, nullptr, XB, SSQ, 1.0f}); TSTOP(16);
        const bf16_t* MS = (const bf16_t*)(ws + OFF_MS);
        TSTART(2); sgemm<16, 1, D>(c.lds, MS, D, (const bf16_t*)(ws + OFF_WOUT), D, D, nullptr, SSQS + 8192, rm_id,
            [=](int r, int cc, float v0, float, float) { const float x = YS[(size_t)r * D + cc] + v0; YS[(size_t)r * D + cc] = x; XNS[(size_t)r * D + cc] = f2bf(x); return x; }); TSTOP(2);
    }
    SEAM(9);
    if (IN(10)) {
        pg8::Gemm g{XB, D, (const bf16_t*)(ws + OFF_WUP2), D, T, 2 * FF, D}; pg8::StaticOrder S; S.init(T, 2 * FF, G, bid);
        LAS const float* linv = fill_inv(c.lds, SSQ);
        TSTART(17); pg8::gemm_phase(c.lds, g, S, EpiSwiglu{PP, linv}); TSTOP(17);
        TSTART(2); sgemm<16, 2, D>(c.lds, XNS, D, (const bf16_t*)(ws + OFF_WUP2), D, FF, SSQS + 8192, nullptr, rm_up,
            [=](int r, int cc, float v0, float v1, float inv) { HS[(size_t)r * FF + cc] = f2bf(siluf_(v0 * inv) * (v1 * inv)); return 0.f; }, G / 2); TSTOP(2);
    }
    SEAM(10);
    if (IN(11)) {
        pg8::Gemm g{PP, FF, (const bf16_t*)(ws + OFF_WDN2), FF, T, D, FF}; pg8::StaticOrder S; S.init(T, D, G, bid);
        TSTART(18); pg8::gemm_phase(c.lds, g, S, EpiResid{nullptr, XB, out + O_YP, nullptr, SSQ, 0.5f}); TSTOP(18);
        TSTART(2); sgemm<16, 1, FF>(c.lds, HS, FF, (const bf16_t*)(ws + OFF_WDN2), FF, D, nullptr, nullptr, rm_id,
            [=](int r, int cc, float v0, float, float) { YS[(size_t)r * D + cc] += 0.5f * v0; return 0.f; }); TSTOP(2);
    }
    SEAM(11);
    if (IN(12)) {
        TSTART(7); rmsnorm_rows_f32(out + O_YP, T + TS, prm.in[31]); TSTOP(7);
    }
#ifdef TIMER_ID
    if (hi == 13) { ++nbar; grid_barrier(barctr, nbar * (unsigned)G);
        if (bid == TIMER_BLOCK) { const float us = (float)tacc_ * 0.0001f; for (int e = tid; e < TS * D; e += 512) YS[e] = us; } }
#endif
#undef IN
#undef SEAM
}

#ifndef N_LAUNCH_MODE
#define N_LAUNCH_MODE 1
#endif
extern "C" void kernel_launch(void* const* d_in, const int* in_sizes, int n_in, void* d_out, int out_size, void* d_ws, size_t ws_size, hipStream_t stream) {
    static int grid = 0;
    if (grid == 0) {
        if (n_in != 32 || ws_size < OFF_XBAR + XCD_BAR_WORDS * 4) { fprintf(stderr, "kernel_launch: unexpected n_in %d or ws_size %zu (< %zu)\n", n_in, ws_size, (size_t)WS_END); grid = -1; return; }
        int dev = 0, cus = 0, per_cu = 0;
        hipGetDevice(&dev); hipDeviceGetAttribute(&cus, hipDeviceAttributeMultiprocessorCount, dev);
        if (hipFuncSetAttribute((const void*)fwd_kernel, hipFuncAttributeMaxDynamicSharedMemorySize, LDS_BYTES) != hipSuccess) { fprintf(stderr, "kernel_launch: hipFuncSetAttribute failed\n"); grid = -1; return; }
        hipOccupancyMaxActiveBlocksPerMultiprocessor(&per_cu, (const void*)fwd_kernel, 512, LDS_BYTES);
        if (per_cu < 1) { fprintf(stderr, "kernel_launch: occupancy query says %d blocks per CU\n", per_cu); per_cu = 1; }
        grid = cus * 1;
        (void)hipGetLastError();
    }
    if (grid < 0) return;
    Params p{};
    for (int i = 0; i < 32; ++i) p.in[i] = (const float*)d_in[i];
    p.out = (float*)d_out; p.ws = (unsigned char*)d_ws;
#if N_LAUNCH_MODE == 0
    for (int ph = 0; ph < 13; ++ph) { p.ph_lo = ph; p.ph_hi = ph + 1; hipLaunchKernelGGL(fwd_kernel, dim3(grid), dim3(512), LDS_BYTES, stream, p);
#ifdef DIAG
        int st = -1; if (ph == 2) st = 0; if (ph == 3) st = 1; if (ph == 6) st = 8; if (ph == 7) st = 3; if (ph == 8) st = 5; if (ph == 9) st = 6; if (ph == 11) st = 7; if (ph == 12) st = 20;
        if (st >= 0) { p.ph_lo = 100 + st; p.ph_hi = 0; hipLaunchKernelGGL(fwd_kernel, dim3(grid), dim3(512), LDS_BYTES, stream, p); }
#endif
    }
#else
    p.ph_lo = 0; p.ph_hi = 13;
    hipMemsetAsync((char*)d_ws + OFF_XBAR, 0, XCD_BAR_WORDS * 4, stream);
    void* args[] = {&p};
    hipError_t e = hipLaunchCooperativeKernel((const void*)fwd_kernel, dim3(grid), dim3(512), args, LDS_BYTES, stream);
    if (e != hipSuccess) fprintf(stderr, "cooperative launch failed: %s (grid %d)\n", hipGetErrorString(e), grid);
#endif
}
```

```cpp
#include <hip/hip_runtime.h>
#include <hip/hip_cooperative_groups.h>
#include <cstdio>
namespace cg = cooperative_groups;

#define LAS __attribute__((address_space(3)))
typedef unsigned short bf16_t;
typedef short bf16x8 __attribute__((ext_vector_type(8)));
typedef float f32x4 __attribute__((ext_vector_type(4)));
typedef unsigned u32x4 __attribute__((ext_vector_type(4)));

constexpr int T = 16384, TS = 128, D = 1024, FF = 2816, NPP = 4096, SEQ = 2048, NCH = 32;
constexpr float EPS = 1e-6f;
constexpr size_t OFF_WUP1 = 0, OFF_WDN1 = 11534336;
constexpr size_t OFF_DT = 0, OFF_SUMM = 2097152, OFF_HALO = 4194304, OFF_GSSQ = 5767168, OFF_PS = 7864320,
                 OFF_DTS = 12582912, OFF_YGS = 12599296, OFF_ABRS = 13647872, OFF_M1S = 14434304, OFF_MS = 14958592;
constexpr size_t OFF_WIN = 17301504, OFF_WDT = 36175872, OFF_WBR = 36241408, OFF_WOUT = 42532864, OFF_WUP2 = 44630016,
                 OFF_WDN2 = 56164352, OFF_WRG = 61931520, OFF_WIG = 62193664, OFF_XB = 62455808, OFF_XN = 96010240,
                 OFF_PP = 129564672, OFF_SSQ = 263782400, OFF_XNS = 264830976, OFF_HS = 265093120, WS_END = 265814016;
constexpr size_t O_YP = 0, O_YS = 16777216, O_LCP = 16908288, O_LHP = 16932864, O_SCP = 16941056, O_SHP = 17014784,
                 O_LCS = 19111936, O_LHS = 19136512, O_SCS = 19144704, O_SHS = 19218432;
constexpr int LDS_BYTES = 143360;
constexpr int LDS_INV = 131072;

struct Params { const float* in[32]; float* out; unsigned char* ws; int ph_lo, ph_hi; };

#ifdef DIAG
#define SZ(x) 0.0f
#ifndef DIAG_TOL
#define DIAG_TOL 0.01f
#endif
#else
#define SZ(x) (x)
#endif
#define A256(base, row, chunk) ((base) + (row) * 256 + 16 * ((chunk) ^ ((row) & 15)))
#define A128(base, row, chunk) ((base) + (row) * 128 + 16 * ((chunk) ^ ((((row) >> 1) ^ ((row) >> 3)) & 7)))
__device__ __forceinline__ int otid() { int t = threadIdx.x; asm volatile("" : "+v"(t)); return t; }
__device__ __forceinline__ unsigned cvt_pk_bf16(float lo, float hi) { unsigned r; asm volatile("v_cvt_pk_bf16_f32 %0, %1, %2" : "=v"(r) : "v"(lo), "v"(hi)); return r; }
__device__ __forceinline__ bf16_t f2bf(float f) { return (bf16_t)(cvt_pk_bf16(f, 0.f) & 0xffffu); }
__device__ __forceinline__ float bf2f(bf16_t b) { return __uint_as_float(((unsigned)b) << 16); }
__device__ __forceinline__ float bflo(unsigned w) { return __uint_as_float(w << 16); }
__device__ __forceinline__ float bfhi(unsigned w) { return __uint_as_float(w & 0xffff0000u); }
__device__ __forceinline__ float sigmoidf_(float x) { return __builtin_amdgcn_rcpf(1.0f + __expf(-x)); }
__device__ __forceinline__ float siluf_(float x) { return x * sigmoidf_(x); }
__device__ __forceinline__ float gelu_tanh(float x) { const float u = 0.7978845608028654f * (x + 0.044715f * x * x * x); return x * sigmoidf_(2.0f * u); }
__device__ __forceinline__ float softplusf_(float x) { return x > 20.f ? x : log1pf(__expf(x)); }
__device__ __forceinline__ u32x4 pack8(const f32x4 a, const f32x4 b) { u32x4 w; w.x = cvt_pk_bf16(a[0], a[1]); w.y = cvt_pk_bf16(a[2], a[3]); w.z = cvt_pk_bf16(b[0], b[1]); w.w = cvt_pk_bf16(b[2], b[3]); return w; }
__device__ __forceinline__ void unpack8(const u32x4 w, f32x4& a, f32x4& b) { a[0] = bflo(w.x); a[1] = bfhi(w.x); a[2] = bflo(w.y); a[3] = bfhi(w.y); b[0] = bflo(w.z); b[1] = bfhi(w.z); b[2] = bflo(w.w); b[3] = bfhi(w.w); }
__device__ __forceinline__ float rowinv16(const float* ssq, int row) {
    const f32x4* p = (const f32x4*)(ssq + (size_t)row * 16); const f32x4 a = p[0], b = p[1], c = p[2], d = p[3];
    const float s = ((a[0] + a[1]) + (a[2] + a[3])) + ((b[0] + b[1]) + (b[2] + b[3])) + ((c[0] + c[1]) + (c[2] + c[3])) + ((d[0] + d[1]) + (d[2] + d[3]));
    return rsqrtf(s * (1.0f / 1024.0f) + EPS);
}

namespace pg8 {
constexpr int BM = 256, BK = 64, HALF = 128, HTB = HALF * BK * 2, STAGE_BYTES = 8 * HTB, NXCD = 8, WGM = 8;
__device__ __forceinline__ int lds_byte(int r, int c) { const int st = (r >> 4) * 2 + (c >> 5), rr = r & 15, cc = c & 31, ob = rr * 64 + cc * 2; return st * 1024 + (ob ^ (((ob >> 9) & 1) << 5)); }
__device__ __forceinline__ void stage_rc(int b, int& R, int& C) { const int st = b / 1024, sb = b % 1024, swz = sb ^ (((sb >> 9) & 1) << 5); R = (st >> 1) * 16 + swz / 64; C = (st & 1) * 32 + (swz % 64) / 2; }
__device__ __forceinline__ int perm32(int rho) { const int n = rho >> 4, i = rho & 15; return 8 * (i >> 2) + 4 * n + (i & 3); }
struct Unit { int pm, pn; };
struct Gemm { const bf16_t* A; int lda; const bf16_t* Bt; int ldb; int M, N, K; };
struct StaticOrder {
    int nM, nN, nwg, G, c;
    __device__ __forceinline__ void init(int M, int N, int G_, int c_) { nM = M / BM; nN = N / BM; nwg = nM * nN; G = G_; c = c_; }
    __device__ __forceinline__ bool next(int i, Unit& u) const {
        const long L = (long)i * G + c; if (L >= nwg) return false;
        int wgid = (int)L; { const int q = nwg / NXCD, r = nwg % NXCD, xcd = wgid % NXCD, off = wgid / NXCD; wgid = (xcd < r ? xcd * (q + 1) : r * (q + 1) + (xcd - r) * q) + off; }
        const int nig = WGM * nN, gid = wgid / nig, fm = gid * WGM, gsz = (nM - fm) < WGM ? (nM - fm) : WGM;
        u.pm = fm + ((wgid % nig) % gsz); u.pn = (wgid % nig) / gsz; return true;
    }
};
template <class Epi>
__device__ __forceinline__ void gemm_phase(LAS unsigned char* lds, const Gemm g, const StaticOrder& S, const Epi& E) {
    const int tid = otid(), wid = __builtin_amdgcn_readfirstlane(tid >> 6), lane = tid & 63, wr = wid >> 2, wc = wid & 3, fr = lane & 15, fq = lane >> 4;
    const int K = g.K, nt = K / BK;
    unsigned voffA[2], voffB[2];
#pragma unroll
    for (int i = 0; i < 2; ++i) { int R, C; stage_rc(tid * 16 + i * 8192, R, C); const int Rb = (R & ~31) + perm32(R & 31);
        voffA[i] = (unsigned)(R * g.lda + C) * 2u; voffB[i] = (unsigned)(Rb * g.ldb + C) * 2u; }
    const size_t kstep = (size_t)(BK * 2);
    const size_t hstepA = (size_t)HALF * g.lda * 2, hstepB = (size_t)HALF * g.ldb * 2;
    const size_t tstepA = 2 * hstepA, tstepB = 2 * hstepB;
    const unsigned ldsw = (unsigned)wid * 1024u;
    const int aoff = lds_byte(wr * 64 + fr, fq * 8), boff = lds_byte(wc * 32 + fr, fq * 8);
#define PG8_SA(b, h) (((b) * 2 + (h)) * HTB)
#define PG8_SB(b, h) ((4 + (b) * 2 + (h)) * HTB)
#define PG8_STAGE(bufoff, gbase, voff) do { _Pragma("unroll") for (int _i = 0; _i < 2; ++_i) \
        __builtin_amdgcn_global_load_lds((const unsigned*)((const char*)(gbase) + (voff)[_i]), (LAS unsigned*)(lds + (bufoff) + ldsw + _i * 8192), 16, 0, 0); } while (0)
#define PG8_LDA(dst, b, h) do { _Pragma("unroll") for (int m = 0; m < 4; ++m) _Pragma("unroll") for (int k = 0; k < 2; ++k) dst[m][k] = *(const LAS bf16x8*)(lds + PG8_SA(b, h) + aoff + m * 2048 + k * 1024); } while (0)
#define PG8_LDB(dst, b, h) do { _Pragma("unroll") for (int n = 0; n < 2; ++n) _Pragma("unroll") for (int k = 0; k < 2; ++k) dst[n][k] = *(const LAS bf16x8*)(lds + PG8_SB(b, h) + boff + n * 2048 + k * 1024); } while (0)
#define PG8_MMA(ai, bj, At, Bt) do { __builtin_amdgcn_s_setprio(1); _Pragma("unroll") for (int m = 0; m < 4; ++m) _Pragma("unroll") for (int n = 0; n < 2; ++n) _Pragma("unroll") for (int k = 0; k < 2; ++k) \
        acc[ai][bj][m][n] = __builtin_amdgcn_mfma_f32_16x16x32_bf16(Bt[n][k], At[m][k], acc[ai][bj][m][n], 0, 0, 0); __builtin_amdgcn_s_setprio(0); } while (0)
#define PG8_WAIT_V(n) asm volatile("s_waitcnt vmcnt(" #n ")" ::: "memory")
#define PG8_WAIT_L(n) asm volatile("s_waitcnt lgkmcnt(" #n ")" ::: "memory")
#define PG8_BAR __builtin_amdgcn_s_barrier()
#define PG8_SCHED __builtin_amdgcn_sched_barrier(0)
    Unit cur, nxt; int ui = 0;
    if (!S.next(0, cur)) return;
    f32x4 acc[2][2][4][2];
#pragma unroll
    for (int a = 0; a < 2; ++a)
#pragma unroll
        for (int b = 0; b < 2; ++b)
#pragma unroll
            for (int m = 0; m < 4; ++m)
#pragma unroll
                for (int n = 0; n < 2; ++n) acc[a][b][m][n] = (f32x4){0.f, 0.f, 0.f, 0.f};
    bf16x8 At[4][2], B0[2][2], B1[2][2];
    const char* cA = (const char*)g.A + (size_t)cur.pm * tstepA; const char* cB = (const char*)g.Bt + (size_t)cur.pn * tstepB;
    PG8_STAGE(PG8_SB(0, 0), cB, voffB); PG8_STAGE(PG8_SA(0, 0), cA, voffA); PG8_STAGE(PG8_SB(0, 1), cB + hstepB, voffB); PG8_STAGE(PG8_SA(0, 1), cA + hstepA, voffA);
    if (wr == 1) PG8_BAR;
    PG8_WAIT_V(4); PG8_BAR;
    PG8_STAGE(PG8_SB(1, 0), cB + kstep, voffB); PG8_STAGE(PG8_SA(1, 0), cA + kstep, voffA); PG8_STAGE(PG8_SB(1, 1), cB + hstepB + kstep, voffB);
    PG8_WAIT_V(6); PG8_BAR;
    for (;;) {
        const bool has_next = S.next(ui + 1, nxt);
        const char* nA = has_next ? (const char*)g.A + (size_t)nxt.pm * tstepA : cA; const char* nB = has_next ? (const char*)g.Bt + (size_t)nxt.pn * tstepB : cB;
        for (int t = 0; t < nt; t += 2) {
            const bool last = (t == nt - 2);
            const char* a1 = cA + (size_t)(t + 1) * kstep;
            const char* a2 = last ? nA : cA + (size_t)(t + 2) * kstep; const char* b2 = last ? nB : cB + (size_t)(t + 2) * kstep;
            const char* a3 = a2 + kstep; const char* b3 = b2 + kstep;
            PG8_LDB(B0, 0, 0); PG8_SCHED; PG8_LDA(At, 0, 0); PG8_STAGE(PG8_SA(1, 1), a1 + hstepA, voffA);
            PG8_WAIT_L(8); PG8_BAR; PG8_WAIT_L(0); PG8_MMA(0, 0, At, B0); PG8_BAR; PG8_SCHED;
            PG8_LDB(B1, 0, 1); PG8_STAGE(PG8_SB(0, 0), b2, voffB);
            PG8_BAR; PG8_WAIT_L(0); PG8_MMA(0, 1, At, B1); PG8_BAR;
            PG8_LDA(At, 0, 1); PG8_STAGE(PG8_SA(0, 0), a2, voffA);
            PG8_BAR; PG8_WAIT_L(0); PG8_MMA(1, 0, At, B0); PG8_BAR; PG8_SCHED;
            PG8_STAGE(PG8_SB(0, 1), b2 + hstepB, voffB);
            PG8_WAIT_V(6); PG8_BAR; PG8_MMA(1, 1, At, B1); PG8_BAR;
            PG8_LDB(B0, 1, 0); PG8_SCHED; PG8_LDA(At, 1, 0); PG8_STAGE(PG8_SA(0, 1), a2 + hstepA, voffA);
            PG8_WAIT_L(8); PG8_BAR; PG8_WAIT_L(0); PG8_MMA(0, 0, At, B0); PG8_BAR; PG8_SCHED;
            PG8_LDB(B1, 1, 1); PG8_STAGE(PG8_SB(1, 0), b3, voffB);
            PG8_BAR; PG8_WAIT_L(0); PG8_MMA(0, 1, At, B1); PG8_BAR;
            PG8_LDA(At, 1, 1); PG8_STAGE(PG8_SA(1, 0), a3, voffA);
            PG8_BAR; PG8_WAIT_L(0); PG8_MMA(1, 0, At, B0); PG8_BAR; PG8_SCHED;
            PG8_STAGE(PG8_SB(1, 1), b3 + hstepB, voffB);
            PG8_WAIT_V(6); PG8_BAR; PG8_MMA(1, 1, At, B1); PG8_BAR;
        }
        E(acc, cur, wr, wc, fr, fq);
        if (!has_next) break;
#pragma unroll
        for (int a = 0; a < 2; ++a)
#pragma unroll
            for (int b = 0; b < 2; ++b)
#pragma unroll
                for (int m = 0; m < 4; ++m)
#pragma unroll
                    for (int n = 0; n < 2; ++n) acc[a][b][m][n] = (f32x4){0.f, 0.f, 0.f, 0.f};
        cur = nxt; cA = nA; cB = nB; ++ui;
    }
    PG8_WAIT_V(0);
    if (wr == 0) PG8_BAR;
    PG8_BAR;
#undef PG8_SA
#undef PG8_SB
#undef PG8_STAGE
#undef PG8_LDA
#undef PG8_LDB
#undef PG8_MMA
#undef PG8_WAIT_V
#undef PG8_WAIT_L
#undef PG8_BAR
#undef PG8_SCHED
}
}
typedef f32x4 Acc[2][2][4][2];

__device__ __forceinline__ LAS const float* fill_inv(LAS unsigned char* lds, const float* ssq) {
    LAS float* t = (LAS float*)(lds + LDS_INV); const int base = 2048 * (blockIdx.x & 7);
    for (int r = otid(); r < 2048; r += 512) t[r] = rowinv16(ssq, base + r);
    __syncthreads();
    return t;
}
struct EpiSwiglu {
    bf16_t* H; LAS const float* linv;
    __device__ __forceinline__ void operator()(const Acc& acc, const pg8::Unit& u, int wr, int wc, int fr, int fq) const {
        const int row0 = u.pm * 256 + wr * 64 + fr, col = u.pn * 128 + wc * 32 + 8 * fq;
#pragma unroll
        for (int ai = 0; ai < 2; ++ai)
#pragma unroll
            for (int m = 0; m < 4; ++m) {
                const int row = row0 + ai * 128 + m * 16; const float inv = linv ? linv[row & 2047] : 1.0f;
                f32x4 h0, h1;
#pragma unroll
                for (int j = 0; j < 4; ++j) { h0[j] = siluf_(acc[ai][0][m][0][j] * inv) * (acc[ai][1][m][0][j] * inv); h1[j] = siluf_(acc[ai][0][m][1][j] * inv) * (acc[ai][1][m][1][j] * inv); }
                *(u32x4*)(H + (size_t)row * FF + col) = pack8(h0, h1);
            }
    }
};
struct EpiResid {
    const float* xin; const bf16_t* xin_b; float* xout; bf16_t* xb; float* ssq; float alpha;
    __device__ __forceinline__ void operator()(const Acc& acc, const pg8::Unit& u, int wr, int wc, int fr, int fq) const {
        const int row0 = u.pm * 256 + wr * 64 + fr, col0 = u.pn * 256 + wc * 32 + 8 * fq;
#pragma unroll
        for (int ai = 0; ai < 2; ++ai) {
            f32x4 xv[4][2][2];
#pragma unroll
            for (int m = 0; m < 4; ++m)
#pragma unroll
                for (int bj = 0; bj < 2; ++bj) { const size_t o = (size_t)(row0 + ai * 128 + m * 16) * D + col0 + bj * 128;
                    if (xin_b) unpack8(*(const u32x4*)(xin_b + o), xv[m][bj][0], xv[m][bj][1]);
                    else { xv[m][bj][0] = *(const f32x4*)(xin + o); xv[m][bj][1] = *(const f32x4*)(xin + o + 4); } }
#pragma unroll
            for (int m = 0; m < 4; ++m) {
                const int row = row0 + ai * 128 + m * 16; float ss = 0.f;
#pragma unroll
                for (int bj = 0; bj < 2; ++bj) {
                    const size_t o = (size_t)row * D + col0 + bj * 128;
                    const f32x4 v0 = xv[m][bj][0] + alpha * acc[ai][bj][m][0], v1 = xv[m][bj][1] + alpha * acc[ai][bj][m][1];
                    if (xout) { *(f32x4*)(xout + o) = v0; *(f32x4*)(xout + o + 4) = v1; }
                    ss += (v0[0] * v0[0] + v0[1] * v0[1]) + (v0[2] * v0[2] + v0[3] * v0[3]) + (v1[0] * v1[0] + v1[1] * v1[1]) + (v1[2] * v1[2] + v1[3] * v1[3]);
                    if (xb) *(u32x4*)(xb + o) = pack8(v0, v1);
                }
                ss += __shfl_xor(ss, 16); ss += __shfl_xor(ss, 32);
                if (fq == 0) ssq[(size_t)row * 16 + u.pn * 4 + wc] = ss;
            }
        }
    }
};
struct EpiScaleBf16 {
    bf16_t* O; LAS const float* linv;
    __device__ __forceinline__ void operator()(const Acc& acc, const pg8::Unit& u, int wr, int wc, int fr, int fq) const {
        const int row0 = u.pm * 256 + wr * 64 + fr, col0 = u.pn * 256 + wc * 32 + 8 * fq;
#pragma unroll
        for (int ai = 0; ai < 2; ++ai)
#pragma unroll
            for (int m = 0; m < 4; ++m) {
                const int row = row0 + ai * 128 + m * 16; const float inv = linv[row & 2047];
#pragma unroll
                for (int bj = 0; bj < 2; ++bj) *(u32x4*)(O + (size_t)row * NPP + col0 + bj * 128) = pack8(acc[ai][bj][m][0] * inv, acc[ai][bj][m][1] * inv);
            }
    }
};
struct EpiGatesA {
    bf16_t* PP; LAS const float* linv; float* gssq;
    __device__ __forceinline__ void operator()(const Acc& acc, const pg8::Unit& u, int wr, int wc, int fr, int fq) const {
        const int row0 = u.pm * 256 + wr * 64 + fr, cw = wc * 32 + 8 * fq; const int pn = u.pn;
#pragma unroll
        for (int ai = 0; ai < 2; ++ai) {
            u32x4 sv[4][2];
#pragma unroll
            for (int m = 0; m < 4; ++m)
#pragma unroll
                for (int bj = 0; bj < 2; ++bj) sv[m][bj] = *(const u32x4*)(PP + (size_t)(row0 + ai * 128 + m * 16) * NPP + pn * 256 + bj * 128 + cw);
#pragma unroll
            for (int m = 0; m < 4; ++m) {
                const int row = row0 + ai * 128 + m * 16; const float inv = linv[row & 2047]; float ss = 0.f;
#pragma unroll
                for (int bj = 0; bj < 2; ++bj) {
                    const f32x4 a0 = acc[ai][bj][m][0] * inv, a1 = acc[ai][bj][m][1] * inv; f32x4 o0, o1;
                    bf16_t* p = PP + (size_t)row * NPP + pn * 256 + bj * 128 + cw; f32x4 s0, s1; unpack8(sv[m][bj], s0, s1);
                    if (pn < 4) {
#pragma unroll
                        for (int j = 0; j < 4; ++j) { o0[j] = gelu_tanh(a0[j]) * s0[j]; o1[j] = gelu_tanh(a1[j]) * s1[j]; }
                    } else {
#pragma unroll
                        for (int j = 0; j < 4; ++j) { o0[j] = siluf_(a0[j]) * s0[j]; o1[j] = siluf_(a1[j]) * s1[j]; ss += o0[j] * o0[j] + o1[j] * o1[j]; }
                    }
                    *(u32x4*)p = pack8(o0, o1);
                }
                if (pn >= 4) { ss += __shfl_xor(ss, 16); ss += __shfl_xor(ss, 32); if (fq == 0) gssq[(size_t)row * 32 + (pn - 4) * 4 + wc] = ss; }
            }
        }
    }
};
struct EpiSigmoid {
    bf16_t* O; int ldo; LAS const float* linv; const float* bias;
    __device__ __forceinline__ void operator()(const Acc& acc, const pg8::Unit& u, int wr, int wc, int fr, int fq) const {
        const int row0 = u.pm * 256 + wr * 64 + fr, col0 = u.pn * 256 + wc * 32 + 8 * fq;
#pragma unroll
        for (int ai = 0; ai < 2; ++ai)
#pragma unroll
            for (int m = 0; m < 4; ++m) {
                const int row = row0 + ai * 128 + m * 16; const float inv = linv[row & 2047];
#pragma unroll
                for (int bj = 0; bj < 2; ++bj) {
                    const int gc = col0 + bj * 128;
                    const f32x4 a0 = acc[ai][bj][m][0] * inv, a1 = acc[ai][bj][m][1] * inv; f32x4 o0, o1;
                    const f32x4 b0 = *(const f32x4*)(bias + gc), b1 = *(const f32x4*)(bias + gc + 4);
#pragma unroll
                    for (int j = 0; j < 4; ++j) { o0[j] = sigmoidf_(a0[j] + b0[j]); o1[j] = sigmoidf_(a1[j] + b1[j]); }
                    *(u32x4*)(O + (size_t)row * ldo + gc) = pack8(o0, o1);
                }
            }
    }
};
struct EpiBr {
    bf16_t* GA; const bf16_t* PP; int mode;
    __device__ __forceinline__ void operator()(const Acc& acc, const pg8::Unit& u, int wr, int wc, int fr, int fq) const {
        const int row0 = u.pm * 256 + wr * 64 + fr, col0 = u.pn * 256 + wc * 32 + 8 * fq;
#pragma unroll
        for (int ai = 0; ai < 2; ++ai) {
            u32x4 gv[4][2], hv[4][2];
#pragma unroll
            for (int m = 0; m < 4; ++m)
#pragma unroll
                for (int bj = 0; bj < 2; ++bj) { const int row = row0 + ai * 128 + m * 16; gv[m][bj] = *(const u32x4*)(GA + (size_t)row * D + col0 + bj * 128);
                    hv[m][bj] = (mode == 0) ? (u32x4){0u, 0u, 0u, 0u} : *(const u32x4*)(PP + (size_t)row * NPP + 3072 + col0 + bj * 128); }
#pragma unroll
            for (int m = 0; m < 4; ++m) {
                const int row = row0 + ai * 128 + m * 16;
#pragma unroll
                for (int bj = 0; bj < 2; ++bj) {
                    bf16_t* p = GA + (size_t)row * D + col0 + bj * 128; f32x4 g0, g1; unpack8(gv[m][bj], g0, g1);
                    if (mode == 0) { *(u32x4*)p = pack8(g0 * acc[ai][bj][m][0], g1 * acc[ai][bj][m][1]); }
                    else { f32x4 h0, h1; unpack8(hv[m][bj], h0, h1); *(u32x4*)p = pack8(g0 + h0 * acc[ai][bj][m][0], g1 + h1 * acc[ai][bj][m][1]); }
                }
            }
        }
    }
};

template <int NC, int NB, int K, class RM, class F>
__device__ __forceinline__ void small_gemm(LAS unsigned char* lds, const bf16_t* A, int lda, int M, const bf16_t* Bt, int ldb, int N,
                                           const float* rs_src, int rs_mode, RM rm, F f) {
    const int tid = otid(), wid = tid >> 6, lane = tid & 63, lr = lane & 15, kg = lane >> 4;
    LAS float* red = (LAS float*)lds;
    LAS float* invs = (LAS float*)(lds + 131072);
    const int nct = N / NC, items = (M / 16) * nct; constexpr int kw = K / 8;
    constexpr int CT = NC / 16;
    const int nrt = M / 16; const bool hoist = (rs_mode == 1) && (gridDim.x % nrt == 0); const int bix = gridDim.x - 1 - blockIdx.x;
    for (int it = bix; it < items; it += gridDim.x) {
        const int rt = it % nrt, ct = it / nrt, row0 = rt * 16, col0 = ct * NC;
        if (rs_mode == 1) { if (!(hoist && it != bix)) { const int r = tid >> 5, q = tid & 31; const float* p = rs_src + (size_t)(row0 + r) * D + q * 32; float s = 0.f;
            for (int j = 0; j < 32; j += 4) { const f32x4 v = *(const f32x4*)(p + j); s += v[0] * v[0] + v[1] * v[1] + v[2] * v[2] + v[3] * v[3]; }
            s += __shfl_xor(s, 1); s += __shfl_xor(s, 2); s += __shfl_xor(s, 4); s += __shfl_xor(s, 8); s += __shfl_xor(s, 16);
            if (q == 0) invs[r] = rsqrtf(s * (1.0f / 1024.0f) + EPS); } }
        else if (rs_mode == 2) { if (tid < 16) invs[tid] = rowinv16(rs_src, row0 + tid); }
        else { if (tid < 16) invs[tid] = 1.0f; }
        f32x4 acc[NB][CT];
#pragma unroll
        for (int p = 0; p < NB; ++p)
#pragma unroll
            for (int c = 0; c < CT; ++c) acc[p][c] = (f32x4){0.f, 0.f, 0.f, 0.f};
        const bf16_t* ap = A + (size_t)(row0 + lr) * lda + wid * kw + 8 * kg;
        const bf16_t* bp0 = Bt + (size_t)(rm(col0, 0) + lr) * ldb + wid * kw + 8 * kg;
        const bf16_t* bp1 = NB > 1 ? Bt + (size_t)(rm(col0, 1) + lr) * ldb + wid * kw + 8 * kg : bp0;
#pragma unroll
        for (int k = 0; k < kw; k += 32) {
            const bf16x8 a = *(const bf16x8*)(ap + k);
#pragma unroll
            for (int c = 0; c < CT; ++c) {
                const bf16x8 b = *(const bf16x8*)(bp0 + (size_t)c * 16 * ldb + k);
                acc[0][c] = __builtin_amdgcn_mfma_f32_16x16x32_bf16(a, b, acc[0][c], 0, 0, 0);
                if (NB > 1) { const bf16x8 b1 = *(const bf16x8*)(bp1 + (size_t)c * 16 * ldb + k); acc[NB - 1][c] = __builtin_amdgcn_mfma_f32_16x16x32_bf16(a, b1, acc[NB - 1][c], 0, 0, 0); }
            }
        }
#pragma unroll
        for (int p = 0; p < NB; ++p)
#pragma unroll
            for (int c = 0; c < CT; ++c)
#pragma unroll
                for (int r = 0; r < 4; ++r) red[((wid * NB + p) * 16 + 4 * kg + r) * NC + 16 * c + lr] = acc[p][c][r];
        __syncthreads();
        for (int e = tid; e < 16 * NC; e += 512) {
            float v0 = 0.f, v1 = 0.f;
#pragma unroll
            for (int w = 0; w < 8; ++w) { v0 += red[(w * NB) * 16 * NC + e]; if (NB > 1) v1 += red[(w * NB + 1) * 16 * NC + e]; }
            const int r = e / NC, c = e % NC;
            f(row0 + r, col0 + c, v0, v1, invs[r]);
        }
        __syncthreads();
    }
}

template <int NC, int NB, int K, class RM, class F>
__device__ __forceinline__ void sgemm(LAS unsigned char* lds, const bf16_t* A, int lda, const bf16_t* Bt, int ldb, int N, const float* ssq_src, float* ssq_out, RM rm, F f, int nblk = 0) {
    const int tid = otid(), wid = tid >> 6, lane = tid & 63, lr = lane & 15, kg = lane >> 4;
    constexpr int CT = NC / 16, KW = K / 8;
    LAS float* red = (LAS float*)lds;
    const int items = N / NC, bix = gridDim.x - 1 - blockIdx.x; if (nblk == 0) nblk = gridDim.x;
    LAS float* invs = (LAS float*)(lds + LDS_INV);
    if (bix < items && bix < nblk) {
        if (ssq_src) { const int row = tid >> 2, q = tid & 3; float sm = 0.f;
#pragma unroll
            for (int j = 0; j < 16; j += 4) { const f32x4 v = *(const f32x4*)(ssq_src + row * 64 + q * 16 + j); sm += (v[0] + v[1]) + (v[2] + v[3]); }
            sm += __shfl_xor(sm, 1); sm += __shfl_xor(sm, 2);
            if (q == 0) invs[row] = rsqrtf(sm * (1.0f / 1024.0f) + EPS); }
        else if (tid < 128) invs[tid] = 1.0f;
        __syncthreads();
    }
    for (int it = bix; it < items && bix < nblk; it += nblk) {
        const int col0 = it * NC;
        f32x4 acc[8][NB][CT];
#pragma unroll
        for (int t = 0; t < 8; ++t)
#pragma unroll
            for (int p = 0; p < NB; ++p)
#pragma unroll
                for (int c = 0; c < CT; ++c) acc[t][p][c] = (f32x4){0.f, 0.f, 0.f, 0.f};
        const bf16_t* ap = A + (size_t)lr * lda + wid * KW + 8 * kg;
        const bf16_t* bp0 = Bt + (size_t)(rm(col0, 0) + lr) * ldb + wid * KW + 8 * kg;
        const bf16_t* bp1 = NB > 1 ? Bt + (size_t)(rm(col0, 1) + lr) * ldb + wid * KW + 8 * kg : bp0;
#pragma unroll 4
        for (int k = 0; k < KW; k += 32) {
            bf16x8 bf[NB][CT];
#pragma unroll
            for (int c = 0; c < CT; ++c) { bf[0][c] = *(const bf16x8*)(bp0 + (size_t)c * 16 * ldb + k); if (NB > 1) bf[NB - 1][c] = *(const bf16x8*)(bp1 + (size_t)c * 16 * ldb + k); }
#pragma unroll
            for (int t = 0; t < 8; ++t) { const bf16x8 a = *(const bf16x8*)(ap + (size_t)t * 16 * lda + k);
#pragma unroll
                for (int p = 0; p < NB; ++p)
#pragma unroll
                    for (int c = 0; c < CT; ++c) acc[t][p][c] = __builtin_amdgcn_mfma_f32_16x16x32_bf16(a, bf[p][c], acc[t][p][c], 0, 0, 0); }
        }
#pragma unroll
        for (int t = 0; t < 8; ++t)
#pragma unroll
            for (int p = 0; p < NB; ++p)
#pragma unroll
                for (int c = 0; c < CT; ++c)
#pragma unroll
                    for (int r = 0; r < 4; ++r) red[((((wid * 8 + t) * NB + p) * CT + c) * 16 + 4 * kg + r) * 16 + lr] = acc[t][p][c][r];
        __syncthreads();
        for (int e = tid; e < 128 * NC; e += 512) {
            const int row = e / NC, col = e % NC, t = row >> 4, rr = row & 15, c = col >> 4, cl = col & 15;
            float v0 = 0.f, v1 = 0.f;
#pragma unroll
            for (int w = 0; w < 8; ++w) { v0 += red[((((w * 8 + t) * NB + 0) * CT + c) * 16 + rr) * 16 + cl]; if (NB > 1) v1 += red[((((w * 8 + t) * NB + (NB - 1)) * CT + c) * 16 + rr) * 16 + cl]; }
            float sq = f(row, col0 + col, v0, v1, invs[row]);
            if (ssq_out) { sq *= sq; sq += __shfl_xor(sq, 1); sq += __shfl_xor(sq, 2); sq += __shfl_xor(sq, 4); sq += __shfl_xor(sq, 8); if (NC > 16) sq += __shfl_xor(sq, 16);
                if ((col & (NC - 1)) == 0) ssq_out[row * 64 + it] = sq; }
        }
        __syncthreads();
    }
}

template <int CT, int NB, int K, class RM, class F>
__device__ __forceinline__ void wave_gemm(LAS unsigned char* lds, const bf16_t* A, int lda, const bf16_t* Bt, int ldb, int N, const float* rs_src, RM rm, F f) {
    const int tid = otid(), wid = tid >> 6, lane = tid & 63, lr = lane & 15, kg = lane >> 4;
    const int bix = gridDim.x - 1 - blockIdx.x, rt = bix & 7, row0 = rt * 16, nct = N / (16 * CT);
    LAS float* invs = (LAS float*)(lds + LDS_INV);
    if (rs_src) { const int r = tid >> 5, q = tid & 31; const float* p = rs_src + (size_t)(row0 + r) * D + q * 32; float s = 0.f;
        for (int j = 0; j < 32; j += 4) { const f32x4 v = *(const f32x4*)(p + j); s += v[0] * v[0] + v[1] * v[1] + v[2] * v[2] + v[3] * v[3]; }
        s += __shfl_xor(s, 1); s += __shfl_xor(s, 2); s += __shfl_xor(s, 4); s += __shfl_xor(s, 8); s += __shfl_xor(s, 16);
        if (q == 0) invs[r] = rsqrtf(s * (1.0f / 1024.0f) + EPS); }
    else if (tid < 16) invs[tid] = 1.0f;
    __syncthreads();
    for (int ct = (bix >> 3) * 8 + wid; ct < nct; ct += (gridDim.x >> 3) * 8) {
        const int col0 = ct * 16 * CT;
        f32x4 acc[NB][CT];
#pragma unroll
        for (int p = 0; p < NB; ++p)
#pragma unroll
            for (int c = 0; c < CT; ++c) acc[p][c] = (f32x4){0.f, 0.f, 0.f, 0.f};
        const bf16_t* ap = A + (size_t)(row0 + lr) * lda + 8 * kg;
        const bf16_t* bp0 = Bt + (size_t)(rm(col0, 0) + lr) * ldb + 8 * kg;
        const bf16_t* bp1 = NB > 1 ? Bt + (size_t)(rm(col0, 1) + lr) * ldb + 8 * kg : bp0;
#pragma unroll 4
        for (int k = 0; k < K; k += 32) {
            const bf16x8 a = *(const bf16x8*)(ap + k);
#pragma unroll
            for (int c = 0; c < CT; ++c) {
                const bf16x8 b = *(const bf16x8*)(bp0 + (size_t)c * 16 * ldb + k);
                acc[0][c] = __builtin_amdgcn_mfma_f32_16x16x32_bf16(a, b, acc[0][c], 0, 0, 0);
                if (NB > 1) { const bf16x8 b1 = *(const bf16x8*)(bp1 + (size_t)c * 16 * ldb + k); acc[NB - 1][c] = __builtin_amdgcn_mfma_f32_16x16x32_bf16(a, b1, acc[NB - 1][c], 0, 0, 0); }
            }
        }
#pragma unroll
        for (int c = 0; c < CT; ++c)
#pragma unroll
            for (int r = 0; r < 4; ++r) f(row0 + 4 * kg + r, col0 + 16 * c + lr, acc[0][c][r], NB > 1 ? acc[NB - 1][c][r] : 0.f, invs[4 * kg + r]);
    }
    __syncthreads();
}

struct Ctx { const float* const* in; float* out; unsigned char* ws; LAS unsigned char* lds; };

__device__ __forceinline__ void tp_tile(LAS float* tile, const float* src, int sld, int sc0, int k0, bf16_t* dst, int dld, int dr0, int dk0, const float* scale, int ncv) {
    const int lane = otid() & 63;
    float v[64];
    const float* sp = src + (size_t)k0 * sld + sc0 + lane;
#pragma unroll
    for (int kk = 0; kk < 64; ++kk) v[kk] = (lane < ncv) ? sp[(size_t)kk * sld] : 0.f;
    if (scale) {
#pragma unroll
        for (int kk = 0; kk < 64; ++kk) v[kk] *= scale[k0 + kk];
    }
#pragma unroll
    for (int kk = 0; kk < 64; ++kk) tile[kk * 65 + lane] = v[kk];
    const int j = lane & 7;
#pragma unroll
    for (int ps = 0; ps < 8; ++ps) { const int cc = (lane >> 3) + 8 * ps;
        float x[8];
#pragma unroll
        for (int i = 0; i < 8; ++i) x[i] = tile[(8 * j + i) * 65 + cc];
        u32x4 w; w.x = cvt_pk_bf16(x[0], x[1]); w.y = cvt_pk_bf16(x[2], x[3]); w.z = cvt_pk_bf16(x[4], x[5]); w.w = cvt_pk_bf16(x[6], x[7]);
        if (cc < ncv) *(u32x4*)(dst + (size_t)(dr0 + cc) * dld + dk0 + 8 * j) = w; }
}
__device__ __forceinline__ void prep_weights(const Ctx& c) {
    const int wv_ = __builtin_amdgcn_readfirstlane(otid() >> 6); LAS float* tile = (LAS float*)c.lds + wv_ * (64 * 65); unsigned char* ws = c.ws;
    constexpr int N_UP = 1408, N_DN = 704, N_IN = 2304, N_DT = 16, N_BRL = 256, N_BRS = 512, N_OUT = 256, N_RG = 32;
    constexpr int TOT = 2 * N_UP + 2 * N_DN + N_IN + N_DT + N_BRL + N_BRS + N_OUT + 2 * N_RG;
    for (int ti0 = blockIdx.x * 8 + wv_; ti0 < TOT; ti0 += gridDim.x * 8) {
        int ti = ti0;
        if (ti < 2 * N_UP) { const int l = ti >= N_UP; if (l) ti -= N_UP;
            const int j = ti >> 5, r = ti & 31, pn = j >> 1, panel = j & 1, ct = r >> 4, kt = r & 15;
            tp_tile(tile, c.in[l ? 29 : 7], 2 * FF, panel * FF + 128 * pn + 64 * ct, 64 * kt, (bf16_t*)(ws + (l ? OFF_WUP2 : OFF_WUP1)), D, 256 * pn + 128 * panel + 64 * ct, 64 * kt, l ? c.in[28] : nullptr, 64);
            continue; }
        ti -= 2 * N_UP;
        if (ti < 2 * N_DN) { const int l = ti >= N_DN; if (l) ti -= N_DN;
            const int nt = ti / 44, kt = ti % 44;
            tp_tile(tile, c.in[l ? 30 : 8], D, 64 * nt, 64 * kt, (bf16_t*)(ws + (l ? OFF_WDN2 : OFF_WDN1)), FF, 64 * nt, 64 * kt, nullptr, 64);
            continue; }
        ti -= 2 * N_DN;
        if (ti < N_IN) { const int nt = ti >> 4, kt = ti & 15, n0 = 64 * nt;
            const int sc = n0 < 1024 ? n0 : (n0 < 4096 ? n0 + 3072 : (n0 < 7168 ? n0 - 3072 : n0 + 32));
            tp_tile(tile, c.in[10], 9248, sc, 64 * kt, (bf16_t*)(ws + OFF_WIN), D, n0, 64 * kt, c.in[9], 64);
            continue; }
        ti -= N_IN;
        if (ti < N_DT) { tp_tile(tile, c.in[10], 9248, 7168, 64 * ti, (bf16_t*)(ws + OFF_WDT), D, 0, 64 * ti, c.in[9], 32); continue; }
        ti -= N_DT;
        if (ti < N_BRL) { const int nt = ti >> 4, kt = ti & 15; tp_tile(tile, c.in[25], D, 64 * nt, 64 * kt, (bf16_t*)(ws + OFF_WBR), 3072, 64 * nt, 64 * kt, nullptr, 64); continue; }
        ti -= N_BRL;
        if (ti < N_BRS) { const int nt = ti >> 5, kt = ti & 31; tp_tile(tile, c.in[26], D, 64 * nt, 64 * kt, (bf16_t*)(ws + OFF_WBR), 3072, 64 * nt, 1024 + 64 * kt, c.in[24], 64); continue; }
        ti -= N_BRS;
        if (ti < N_OUT) { const int nt = ti >> 4, kt = ti & 15; tp_tile(tile, c.in[27], D, 64 * nt, 64 * kt, (bf16_t*)(ws + OFF_WOUT), D, 64 * nt, 64 * kt, nullptr, 64); continue; }
        ti -= N_OUT;
        { const int l = ti >= N_RG; if (l) ti -= N_RG; const int h = ti >> 2, nt = (ti >> 1) & 1, kt = ti & 1;
          tp_tile(tile, c.in[l ? 16 : 14] + h * 16384, 128, 64 * nt, 64 * kt, (bf16_t*)(ws + (l ? OFF_WIG : OFF_WRG)) + h * 16384, 128, 64 * nt, 64 * kt, nullptr, 64); }
    }
}
__device__ __forceinline__ void rmsnorm_rows_bf16(const float* x, int nrows, const float* g, bf16_t* dst) {
    const int t_ = otid(), lane = t_ & 63, gw = blockIdx.x * 8 + (t_ >> 6), nw = gridDim.x * 8;
    f32x4 gg[4];
#pragma unroll
    for (int i = 0; i < 4; ++i) gg[i] = *(const f32x4*)(g + (i * 64 + lane) * 4);
    for (int r = gw; r < nrows; r += 2 * nw) {
        const int r2 = r + nw; const bool two = r2 < nrows;
        const float* p = x + (size_t)r * D; const float* p2 = x + (size_t)(two ? r2 : r) * D; f32x4 v[4], w[4]; float s = 0.f, s2 = 0.f;
#pragma unroll
        for (int i = 0; i < 4; ++i) { v[i] = *(const f32x4*)(p + (i * 64 + lane) * 4); w[i] = *(const f32x4*)(p2 + (i * 64 + lane) * 4); }
#pragma unroll
        for (int i = 0; i < 4; ++i) { s += v[i][0] * v[i][0] + v[i][1] * v[i][1] + v[i][2] * v[i][2] + v[i][3] * v[i][3]; s2 += w[i][0] * w[i][0] + w[i][1] * w[i][1] + w[i][2] * w[i][2] + w[i][3] * w[i][3]; }
#pragma unroll
        for (int o = 1; o < 64; o <<= 1) { s += __shfl_xor(s, o); s2 += __shfl_xor(s2, o); }
        const float inv = rsqrtf(s * (1.0f / 1024.0f) + EPS), inv2 = rsqrtf(s2 * (1.0f / 1024.0f) + EPS);
#pragma unroll
        for (int i = 0; i < 4; ++i) { const int cc = (i * 64 + lane) * 4; const f32x4 o = v[i] * inv * gg[i];
            unsigned* q = (unsigned*)(dst + (size_t)r * D + cc); q[0] = cvt_pk_bf16(o[0], o[1]); q[1] = cvt_pk_bf16(o[2], o[3]);
            if (two) { const f32x4 o2 = w[i] * inv2 * gg[i]; unsigned* q2 = (unsigned*)(dst + (size_t)r2 * D + cc); q2[0] = cvt_pk_bf16(o2[0], o2[1]); q2[1] = cvt_pk_bf16(o2[2], o2[3]); } }
    }
}
__device__ __forceinline__ void rmsnorm_rows_f32(float* x, int nrows, const float* g) {
    const int t_ = otid(), lane = t_ & 63, gw = blockIdx.x * 8 + (t_ >> 6), nw = gridDim.x * 8;
    f32x4 gg[4];
#pragma unroll
    for (int i = 0; i < 4; ++i) gg[i] = *(const f32x4*)(g + (i * 64 + lane) * 4);
    for (int r = gw; r < nrows; r += 2 * nw) {
        const int r2 = r + nw; const bool two = r2 < nrows;
        float* p = x + (size_t)r * D; float* p2 = x + (size_t)(two ? r2 : r) * D; f32x4 v[4], w[4]; float s = 0.f, s2 = 0.f;
#pragma unroll
        for (int i = 0; i < 4; ++i) { v[i] = *(const f32x4*)(p + (i * 64 + lane) * 4); w[i] = *(const f32x4*)(p2 + (i * 64 + lane) * 4); }
#pragma unroll
        for (int i = 0; i < 4; ++i) { s += v[i][0] * v[i][0] + v[i][1] * v[i][1] + v[i][2] * v[i][2] + v[i][3] * v[i][3]; s2 += w[i][0] * w[i][0] + w[i][1] * w[i][1] + w[i][2] * w[i][2] + w[i][3] * w[i][3]; }
#pragma unroll
        for (int o = 1; o < 64; o <<= 1) { s += __shfl_xor(s, o); s2 += __shfl_xor(s2, o); }
        const float inv = rsqrtf(s * (1.0f / 1024.0f) + EPS), inv2 = rsqrtf(s2 * (1.0f / 1024.0f) + EPS);
#pragma unroll
        for (int i = 0; i < 4; ++i) { const int cc = (i * 64 + lane) * 4; *(f32x4*)(p + cc) = v[i] * inv * gg[i]; if (two) *(f32x4*)(p2 + cc) = w[i] * inv2 * gg[i]; }
    }
}

template <bool FINAL>
__device__ __forceinline__ void lru_chunk(const Ctx& c, int b, int ch, bool dry = false) {
    const int tid = otid(), wid = tid >> 6, lane = tid & 63, lr = lane & 15, kg = lane >> 4;
    LAS float* XC = (LAS float*)c.lds; LAS float* AA = (LAS float*)(c.lds + 32768); LAS float* UU = (LAS float*)(c.lds + 65536); LAS unsigned char* XCb = c.lds + 98304;
    bf16_t* PP = (bf16_t*)(c.ws + OFF_PP); bf16_t* HALO = (bf16_t*)(c.ws + OFF_HALO); float* SUMM = (float*)(c.ws + OFF_SUMM);
    const bf16_t* WRG = (const bf16_t*)(c.ws + OFF_WRG); const bf16_t* WIG = (const bf16_t*)(c.ws + OFF_WIG);
    const float* cw = c.in[12]; const float* cb = c.in[13]; const float* brg = c.in[15]; const float* big = c.in[17]; const float* lam = c.in[18];
    const int t0 = b * SEQ + 64 * ch;
    LAS float* CARRY = (LAS float*)(c.lds + 115712);
    if (FINAL) {
        float h0 = 0.f, h1 = 0.f;
        for (int cp = 0; cp < ch; cp += 8) {
            float a0[8], b0[8], a1[8], b1[8];
#pragma unroll
            for (int i = 0; i < 8; ++i) { a0[i] = 1.f; b0[i] = 0.f; a1[i] = 1.f; b1[i] = 0.f;
                if (cp + i < ch) { const float* sp = SUMM + ((size_t)(b * NCH + cp + i) * D + tid) * 2; a0[i] = sp[0]; b0[i] = sp[1]; a1[i] = sp[1024]; b1[i] = sp[1025]; } }
#pragma unroll
            for (int i = 0; i < 8; ++i) { h0 = a0[i] * h0 + b0[i]; h1 = a1[i] * h1 + b1[i]; }
        }
        CARRY[tid] = h0; CARRY[tid + 512] = h1;
    }
    const int cg8 = tid & 15, tk = (tid >> 4) * 2;
    u32x4 rawp[5]; f32x4 wk[4][2], bb[2]; bf16x8 wrf[4], wif[4]; float pb1 = 0.f, pb2 = 0.f, plam = 0.f;
#define LRU_FETCH(hd) do { const int cc0_ = 128 * (hd) + 8 * cg8; \
        _Pragma("unroll") for (int i = 0; i < 5; ++i) { const int tt = tk - 3 + i; rawp[i] = (u32x4){0u, 0u, 0u, 0u}; \
            if (tt >= 0) rawp[i] = *(const u32x4*)(PP + (size_t)(t0 + tt) * NPP + cc0_); \
            else if (ch > 0) rawp[i] = *(const u32x4*)(HALO + ((size_t)((b * NCH + ch - 1) * 3 + (tt + 3))) * D + cc0_); } \
        _Pragma("unroll") for (int k = 0; k < 4; ++k) { wk[k][0] = *(const f32x4*)(cw + k * D + cc0_); wk[k][1] = *(const f32x4*)(cw + k * D + cc0_ + 4); } \
        bb[0] = *(const f32x4*)(cb + cc0_); bb[1] = *(const f32x4*)(cb + cc0_ + 4); } while (0)
#define LRU_FETCHW(hd) do { \
        { const int cgl_ = 128 * (hd) + 16 * wid + lr; const bf16_t* wr__ = WRG + (size_t)cgl_ * 128 + 8 * kg; const bf16_t* wi__ = WIG + (size_t)cgl_ * 128 + 8 * kg; \
          _Pragma("unroll") for (int ks = 0; ks < 4; ++ks) { wrf[ks] = *(const bf16x8*)(wr__ + 32 * ks); wif[ks] = *(const bf16x8*)(wi__ + 32 * ks); } \
          pb1 = brg[cgl_]; pb2 = big[cgl_]; plam = lam[cgl_]; } } while (0)
    LRU_FETCH(0); LRU_FETCHW(0);
    for (int head = 0; head < 8; ++head) {
        const int ch0 = 128 * head;
        {
            f32x4 raw[5][2];
#pragma unroll
            for (int i = 0; i < 5; ++i) unpack8(rawp[i], raw[i][0], raw[i][1]);
#pragma unroll
            for (int q = 0; q < 2; ++q) { f32x4 o0 = bb[0], o1 = bb[1];
#pragma unroll
                for (int k = 0; k < 4; ++k) { o0 += wk[k][0] * raw[q + k][0]; o1 += wk[k][1] * raw[q + k][1]; }
                *(LAS f32x4*)(XC + (tk + q) * 128 + 8 * cg8) = o0; *(LAS f32x4*)(XC + (tk + q) * 128 + 8 * cg8 + 4) = o1;
                *(LAS u32x4*)A256(XCb, tk + q, cg8) = pack8(o0, o1); }
            if (head < 7) LRU_FETCH(head + 1);
        }
        __syncthreads();
        {
            f32x4 ar[4], ai_[4];
#pragma unroll
            for (int m = 0; m < 4; ++m) { ar[m] = (f32x4){0.f, 0.f, 0.f, 0.f}; ai_[m] = (f32x4){0.f, 0.f, 0.f, 0.f}; }
#pragma unroll
            for (int ks = 0; ks < 4; ++ks) { const bf16x8 br = wrf[ks], bi = wif[ks];
#pragma unroll
                for (int m = 0; m < 4; ++m) { const bf16x8 a = *(const LAS bf16x8*)A256(XCb, 16 * m + lr, 4 * ks + kg);
                    ar[m] = __builtin_amdgcn_mfma_f32_16x16x32_bf16(a, br, ar[m], 0, 0, 0); ai_[m] = __builtin_amdgcn_mfma_f32_16x16x32_bf16(a, bi, ai_[m], 0, 0, 0); } }
            const int cl = 16 * wid + lr; const float b1 = pb1, b2 = pb2, sp = softplusf_(-plam);
            if (head < 7) LRU_FETCHW(head + 1);
#pragma unroll
            for (int m = 0; m < 4; ++m)
#pragma unroll
                for (int r = 0; r < 4; ++r) { const int tk = 16 * m + 4 * kg + r; const float rg = sigmoidf_(ar[m][r] + b1), ig = sigmoidf_(ai_[m][r] + b2);
                    const float la = -8.0f * rg * sp; const float u = sqrtf(-expm1f(2.0f * la)) * ig * XC[tk * 128 + cl];
                    AA[tk * 128 + cl] = la; UU[tk * 128 + cl] = u; }
        }
        __syncthreads();
        if (!FINAL) {
            const int cg8s = tid & 15, tks = (tid >> 4) * 2;
#pragma unroll
            for (int q = 0; q < 2; ++q) { const f32x4 o0 = *(const LAS f32x4*)(UU + (tks + q) * 128 + 8 * cg8s), o1 = *(const LAS f32x4*)(UU + (tks + q) * 128 + 8 * cg8s + 4);
                const f32x4 l0 = *(const LAS f32x4*)(AA + (tks + q) * 128 + 8 * cg8s), l1 = *(const LAS f32x4*)(AA + (tks + q) * 128 + 8 * cg8s + 4);
                *(u32x4*)(PP + (size_t)(t0 + tks + q) * NPP + ch0 + 8 * cg8s) = pack8(o0, o1); *(u32x4*)(PP + (size_t)(t0 + tks + q) * NPP + 3072 + ch0 + 8 * cg8s) = pack8(l0, l1); } }
        if (tid < 128) { const int cgl = ch0 + tid;
            if (!FINAL) { float A = 1.f, H = 0.f;
                for (int t8 = 0; t8 < 64; t8 += 16) { float av[16], uv[16];
#pragma unroll
                    for (int i = 0; i < 16; ++i) { av[i] = AA[(t8 + i) * 128 + tid]; uv[i] = UU[(t8 + i) * 128 + tid]; }
#pragma unroll
                    for (int i = 0; i < 16; ++i) { const float a_ = __expf(av[i]); H = a_ * H + uv[i]; A *= a_; } }
                float* s = SUMM + ((size_t)(b * NCH + ch) * D + cgl) * 2; s[0] = A; s[1] = H; }
            else { float h = CARRY[cgl];
                for (int t8 = 0; t8 < 64; t8 += 16) { float av[16], uv[16];
#pragma unroll
                    for (int i = 0; i < 16; ++i) { av[i] = AA[(t8 + i) * 128 + tid]; uv[i] = UU[(t8 + i) * 128 + tid]; }
#pragma unroll
                    for (int i = 0; i < 16; ++i) { h = av[i] * h + uv[i]; UU[(t8 + i) * 128 + tid] = h; } }
                if (ch == NCH - 1) c.out[O_LHP + b * D + cgl] = h; } }
        __syncthreads();
        if (FINAL) { const int cg8 = tid & 15, tk = (tid >> 4) * 2;
#pragma unroll
            for (int q = 0; q < 2; ++q) { const f32x4 o0 = *(const LAS f32x4*)(UU + (tk + q) * 128 + 8 * cg8), o1 = *(const LAS f32x4*)(UU + (tk + q) * 128 + 8 * cg8 + 4);
                if (!dry) *(u32x4*)(PP + (size_t)(t0 + tk + q) * NPP + ch0 + 8 * cg8) = pack8(o0, o1); }
            __syncthreads(); }
    }
}

__device__ __forceinline__ void lru_final(const Ctx& c, int b, int ch) {
    const int tid = otid(); bf16_t* PP = (bf16_t*)(c.ws + OFF_PP); const float* SUMM = (const float*)(c.ws + OFF_SUMM);
    const int t0 = b * SEQ + 64 * ch, c2 = 2 * tid;
    float h0 = 0.f, h1 = 0.f;
    for (int cp = 0; cp < ch; cp += 8) {
        f32x4 sv[8];
#pragma unroll
        for (int i = 0; i < 8; ++i) { sv[i] = (f32x4){1.f, 0.f, 1.f, 0.f}; if (cp + i < ch) sv[i] = *(const f32x4*)(SUMM + ((size_t)(b * NCH + cp + i) * D + c2) * 2); }
#pragma unroll
        for (int i = 0; i < 8; ++i) { h0 = sv[i][0] * h0 + sv[i][1]; h1 = sv[i][2] * h1 + sv[i][3]; }
    }
    for (int t8 = 0; t8 < 64; t8 += 16) {
        unsigned uu[16], ll[16];
#pragma unroll
        for (int i = 0; i < 16; ++i) { const bf16_t* p = PP + (size_t)(t0 + t8 + i) * NPP + c2; uu[i] = *(const unsigned*)p; ll[i] = *(const unsigned*)(p + 3072); }
#pragma unroll
        for (int i = 0; i < 16; ++i) { h0 = __expf(bflo(ll[i])) * h0 + bflo(uu[i]); h1 = __expf(bfhi(ll[i])) * h1 + bfhi(uu[i]);
            *(unsigned*)(PP + (size_t)(t0 + t8 + i) * NPP + c2) = cvt_pk_bf16(h0, h1); }
    }
    if (ch == NCH - 1) { c.out[O_LHP + b * D + c2] = h0; c.out[O_LHP + b * D + c2 + 1] = h1; }
}

__device__ __forceinline__ void bc_conv(const Ctx& c, int b, int ch) {
    const int tid = otid(); const bf16_t* PP = (const bf16_t*)(c.ws + OFF_PP); bf16_t* BCc = (bf16_t*)(c.ws + OFF_XN);
    const float* cw = c.in[19]; const float* cb = c.in[20]; const int t0 = b * SEQ + 64 * ch;
    if (tid < 384) { const int row = tid >> 7, cg8 = tid & 127;
        *(u32x4*)((bf16_t*)(c.ws + OFF_HALO) + ((size_t)((b * NCH + ch) * 3 + row)) * D + 8 * cg8) = *(const u32x4*)(PP + (size_t)(t0 + 61 + row) * NPP + 8 * cg8); }
#pragma unroll 1
    for (int item = tid; item < 1024; item += 512) {
        const int cgq = item & 127, st = item >> 7, gcol = 3072 + 8 * cgq, ccol = 2048 + 8 * cgq;
        u32x4 raw[11];
#pragma unroll
        for (int i = 0; i < 11; ++i) { const int tt = 8 * st - 3 + i; raw[i] = (u32x4){0u, 0u, 0u, 0u}; if (tt >= 0 || ch > 0) raw[i] = *(const u32x4*)(PP + (size_t)(t0 + tt) * NPP + gcol); }
#pragma unroll
        for (int hf = 0; hf < 2; ++hf) {
            f32x4 wk[4]; const f32x4 bb = *(const f32x4*)(cb + ccol + 4 * hf);
#pragma unroll
            for (int k = 0; k < 4; ++k) wk[k] = *(const f32x4*)(cw + k * 3072 + ccol + 4 * hf);
#pragma unroll
            for (int q = 0; q < 8; ++q) { f32x4 o = bb;
#pragma unroll
                for (int k = 0; k < 4; ++k) { const unsigned w0 = raw[q + k][2 * hf], w1 = raw[q + k][2 * hf + 1]; const f32x4 r = (f32x4){bflo(w0), bfhi(w0), bflo(w1), bfhi(w1)}; o += wk[k] * r; }
#pragma unroll
                for (int j = 0; j < 4; ++j) o[j] = siluf_(o[j]);
                unsigned* op = (unsigned*)(BCc + (size_t)(t0 + 8 * st + q) * 1024 + 8 * cgq + 4 * hf); op[0] = cvt_pk_bf16(o[0], o[1]); op[1] = cvt_pk_bf16(o[2], o[3]); }
        }
    }
}

__device__ __forceinline__ void ssd_seq(const Ctx& c, int b, int h, bool dry = false) {
    const int tid = otid(), wid = tid >> 6, lane = tid & 63, lr = lane & 15, kg = lane >> 4;
    LAS unsigned char* L = c.lds;
    LAS unsigned char* Cm = L; LAS unsigned char* Bm = L + 16384; LAS unsigned char* BdT = L + 32768; LAS unsigned char* Sb = L + 49152;
    LAS unsigned char* XdT = L + 65536; LAS unsigned char* Xr = L + 73728; LAS unsigned char* Mm = L + 82944;
    LAS float* dts = (LAS float*)(L + 91136); LAS float* css = (LAS float*)(L + 91392); LAS float* dec = (LAS float*)(L + 91648); LAS bf16_t* halo = (LAS bf16_t*)(L + 91904);
    bf16_t* PP = (bf16_t*)(c.ws + OFF_PP); const float* DT = (const float*)(c.ws + OFF_DT);
    const float* cw = c.in[19]; const float* cb = c.in[20];
    const int g = h >> 3;
    const float Ah = -__expf(c.in[22][h]), Dh = c.in[23][h], dtb = c.in[21][h];
    f32x4 accS[4];
#pragma unroll
    for (int m = 0; m < 4; ++m) accS[m] = (f32x4){0.f, 0.f, 0.f, 0.f};
    for (int e = tid; e < 64 * 128; e += 512) ((LAS bf16_t*)Sb)[e] = 0;
    const bf16_t* BCc = (const bf16_t*)(c.ws + OFF_XN);
    const int role = tid >> 7, rt = tid & 127;
    const int xg = rt & 7, xst = rt >> 3;
    const int bg8 = rt & 15, bst = rt >> 4;
    const int gcol = 1024 + 64 * h + 8 * xg, ccol = 64 * h + 8 * xg;
    const int bcol = (role == 2 ? 512 : 0) + 128 * g + 8 * bg8;
    u32x4 raw[8]; float dtv = 0.f;
    f32x4 wkk[2][4], bbb[2];
#pragma unroll
    for (int hf = 0; hf < 2; ++hf) { bbb[hf] = *(const f32x4*)(cb + ccol + 4 * hf);
#pragma unroll
        for (int k = 0; k < 4; ++k) wkk[hf][k] = *(const f32x4*)(cw + k * 3072 + ccol + 4 * hf); }
    {
        const int t0 = b * SEQ;
        if (role == 0) {
#pragma unroll
            for (int i = 0; i < 7; ++i) { const int tt = 4 * xst - 3 + i; raw[i] = (u32x4){0u, 0u, 0u, 0u}; if (tt >= 0) raw[i] = *(const u32x4*)(PP + (size_t)(t0 + tt) * NPP + gcol); } }
        else if (role < 3) {
#pragma unroll
            for (int i = 0; i < 8; ++i) raw[i] = *(const u32x4*)(BCc + (size_t)(t0 + 8 * bst + i) * 1024 + bcol); }
        if (wid == 0) dtv = DT[(size_t)(t0 + lane) * 32 + h];
    }
    for (int ch = 0; ch < NCH; ++ch) {
        const int t0 = b * SEQ + 64 * ch;
        if (wid == 0) {
            const float d = softplusf_(dtv + dtb); float sc = d * Ah;
#pragma unroll
            for (int o = 1; o < 64; o <<= 1) { const float v = __shfl_up(sc, o); if (lane >= o) sc += v; }
            const float ce = __shfl(sc, 63);
            dts[lane] = d; css[lane] = sc; dec[lane] = __expf(ce - sc);
        }
        __syncthreads();
        if (role == 0) {
            if (xst == 0 && ch > 0) {
#pragma unroll
                for (int i = 0; i < 3; ++i) raw[i] = *(const LAS u32x4*)(halo + ((ch - 1) & 1) * 192 + i * 64 + 8 * xg); }
            if (xst == 15) {
#pragma unroll
                for (int i = 0; i < 3; ++i) *(LAS u32x4*)(halo + (ch & 1) * 192 + i * 64 + 8 * xg) = raw[4 + i];
                if (ch == NCH - 1 && !dry) {
#pragma unroll
                    for (int r = 0; r < 3; ++r) { f32x4 v0, v1; unpack8(raw[4 + r], v0, v1); float* o = c.out + O_SCP + (size_t)(b * 3 + r) * 3072 + ccol; *(f32x4*)o = v0; *(f32x4*)(o + 4) = v1; } } }
            const int chunk = (xst >> 1) ^ xg;
#pragma unroll
            for (int hf = 0; hf < 2; ++hf) {
                unsigned tq[4][2];
#pragma unroll
                for (int q = 0; q < 4; ++q) { f32x4 o = bbb[hf];
#pragma unroll
                    for (int k = 0; k < 4; ++k) { const unsigned w0 = raw[q + k][2 * hf], w1 = raw[q + k][2 * hf + 1]; const f32x4 r = (f32x4){bflo(w0), bfhi(w0), bflo(w1), bfhi(w1)}; o += wkk[hf][k] * r; }
#pragma unroll
                    for (int j = 0; j < 4; ++j) o[j] = siluf_(o[j]);
                    const int l = 4 * xst + q;
                    LAS unsigned* rp = (LAS unsigned*)(Xr + l * 144 + 16 * xg + 8 * hf); rp[0] = cvt_pk_bf16(o[0], o[1]); rp[1] = cvt_pk_bf16(o[2], o[3]);
                    const float d = dts[l]; tq[q][0] = cvt_pk_bf16(o[0] * d, o[1] * d); tq[q][1] = cvt_pk_bf16(o[2] * d, o[3] * d);
                }
#pragma unroll
                for (int j2 = 0; j2 < 2; ++j2) {
                    unsigned lo[2], hi[2];
#pragma unroll
                    for (int i = 0; i < 2; ++i) { const unsigned a = tq[2 * i][j2], bq = tq[2 * i + 1][j2]; lo[i] = (a & 0xffffu) | (bq << 16); hi[i] = (a >> 16) | (bq & 0xffff0000u); }
                    LAS unsigned* p0 = (LAS unsigned*)(A128(XdT, 8 * xg + 4 * hf + 2 * j2, xst >> 1) + 8 * (xst & 1)); p0[0] = lo[0]; p0[1] = lo[1];
                    LAS unsigned* p1 = (LAS unsigned*)(A128(XdT, 8 * xg + 4 * hf + 2 * j2 + 1, xst >> 1) + 8 * (xst & 1)); p1[0] = hi[0]; p1[1] = hi[1]; }
            }
        } else if (role == 1) {
            const int chunk = bst ^ (bg8 & 7);
            unsigned tq[8][4];
#pragma unroll
            for (int q = 0; q < 8; ++q) { const int l = 8 * bst + q; *(LAS u32x4*)A256(Bm, l, bg8) = raw[q]; const float d = dec[l]; f32x4 v0, v1; unpack8(raw[q], v0, v1);
                tq[q][0] = cvt_pk_bf16(v0[0] * d, v0[1] * d); tq[q][1] = cvt_pk_bf16(v0[2] * d, v0[3] * d); tq[q][2] = cvt_pk_bf16(v1[0] * d, v1[1] * d); tq[q][3] = cvt_pk_bf16(v1[2] * d, v1[3] * d); }
#pragma unroll
            for (int j2 = 0; j2 < 4; ++j2) { u32x4 lo, hi;
#pragma unroll
                for (int i = 0; i < 4; ++i) { const unsigned a = tq[2 * i][j2], bq = tq[2 * i + 1][j2]; lo[i] = (a & 0xffffu) | (bq << 16); hi[i] = (a >> 16) | (bq & 0xffff0000u); }
                *(LAS u32x4*)A128(BdT, 8 * bg8 + 2 * j2, bst) = lo; *(LAS u32x4*)A128(BdT, 8 * bg8 + 2 * j2 + 1, bst) = hi; }
        } else if (role == 2) {
#pragma unroll
            for (int q = 0; q < 8; ++q) *(LAS u32x4*)A256(Cm, 8 * bst + q, bg8) = raw[q];
        }
        if (ch + 1 < NCH) {
            if (role == 0) {
#pragma unroll
                for (int i = 0; i < 7; ++i) { const int tt = 4 * xst - 3 + i; if (tt >= 0) raw[i] = *(const u32x4*)(PP + (size_t)(t0 + 64 + tt) * NPP + gcol); } }
            else if (role < 3) {
#pragma unroll
                for (int i = 0; i < 8; ++i) raw[i] = *(const u32x4*)(BCc + (size_t)(t0 + 64 + 8 * bst + i) * 1024 + bcol); }
            if (wid == 0) dtv = DT[(size_t)(t0 + 64 + lane) * 32 + h];
        }
        __syncthreads();
#pragma unroll
        for (int q = 0; q < 2; ++q) { const int ti = 2 * wid + q, lt = ti >> 2, stl = ti & 3; f32x4 a4 = (f32x4){0.f, 0.f, 0.f, 0.f};
            if (stl <= lt) {
#pragma unroll
                for (int ks = 0; ks < 4; ++ks) { const bf16x8 a = *(const LAS bf16x8*)A256(Bm, 16 * stl + lr, 4 * ks + kg), bq = *(const LAS bf16x8*)A256(Cm, 16 * lt + lr, 4 * ks + kg);
                    a4 = __builtin_amdgcn_mfma_f32_16x16x32_bf16(a, bq, a4, 0, 0, 0); } }
            const int l = 16 * lt + lr; const float cl = css[l]; f32x4 v;
#pragma unroll
            for (int r = 0; r < 4; ++r) { const int sI = 16 * stl + 4 * kg + r; v[r] = (sI <= l) ? a4[r] * __expf(cl - css[sI]) : 0.f; }
            unsigned* dummy = nullptr; (void)dummy;
            LAS unsigned* mp = (LAS unsigned*)(A128(Mm, l, 2 * stl + (kg >> 1)) + 8 * (kg & 1)); mp[0] = cvt_pk_bf16(v[0], v[1]); mp[1] = cvt_pk_bf16(v[2], v[3]); }
        __syncthreads();
#pragma unroll
        for (int q = 0; q < 2; ++q) { const int ti = 2 * wid + q, pt = ti >> 2, lt = ti & 3; f32x4 a4 = (f32x4){0.f, 0.f, 0.f, 0.f};
#pragma unroll
            for (int ks = 0; ks < 4; ++ks) { const bf16x8 a = *(const LAS bf16x8*)A256(Sb, 16 * pt + lr, 4 * ks + kg), bq = *(const LAS bf16x8*)A256(Cm, 16 * lt + lr, 4 * ks + kg);
                a4 = __builtin_amdgcn_mfma_f32_16x16x32_bf16(a, bq, a4, 0, 0, 0); }
            const int l = 16 * lt + lr; const float el = __expf(css[l]);
#pragma unroll
            for (int r = 0; r < 4; ++r) a4[r] *= el;
            const int prow_ = 16 * pt + lr, sw = (2 * pt + (lr >> 3)) & 7;
#pragma unroll
            for (int ks = 0; ks < 2; ++ks) { const bf16x8 a = *(const LAS bf16x8*)A128(XdT, prow_, 4 * ks + kg), bq = *(const LAS bf16x8*)A128(Mm, 16 * lt + lr, 4 * ks + kg);
                a4 = __builtin_amdgcn_mfma_f32_16x16x32_bf16(a, bq, a4, 0, 0, 0); }
            const int p0 = 16 * pt + 4 * kg; const LAS unsigned* xp = (const LAS unsigned*)(Xr + l * 144 + 2 * p0); const unsigned x01 = xp[0], x23 = xp[1];
            const float y0 = a4[0] + Dh * bflo(x01), y1 = a4[1] + Dh * bfhi(x01), y2 = a4[2] + Dh * bflo(x23), y3 = a4[3] + Dh * bfhi(x23);
            if (!dry) { unsigned* yp = (unsigned*)(PP + (size_t)(t0 + l) * NPP + 1024 + 64 * h + p0); yp[0] = cvt_pk_bf16(y0, y1); yp[1] = cvt_pk_bf16(y2, y3); } }
        { const float ce = __expf(css[63]); const int nrow = 16 * wid + lr, swn = (2 * wid + (lr >> 3)) & 7;
#pragma unroll
          for (int m = 0; m < 4; ++m) { accS[m] *= ce; const int prow_ = 16 * m + lr, swp = (2 * m + (lr >> 3)) & 7;
#pragma unroll
            for (int ks = 0; ks < 2; ++ks) { const bf16x8 a = *(const LAS bf16x8*)A128(BdT, nrow, 4 * ks + kg), bq = *(const LAS bf16x8*)A128(XdT, prow_, 4 * ks + kg);
                accS[m] = __builtin_amdgcn_mfma_f32_16x16x32_bf16(a, bq, accS[m], 0, 0, 0); } } }
        __syncthreads();
#pragma unroll
        for (int m = 0; m < 4; ++m) { LAS unsigned* sp = (LAS unsigned*)(A256(Sb, 16 * m + lr, 2 * wid + (kg >> 1)) + 8 * (kg & 1)); sp[0] = cvt_pk_bf16(accS[m][0], accS[m][1]); sp[1] = cvt_pk_bf16(accS[m][2], accS[m][3]); }
    }
    if (!dry) {
#pragma unroll
        for (int m = 0; m < 4; ++m) *(f32x4*)(c.out + O_SHP + ((size_t)(b * 32 + h) * 64 + 16 * m + lr) * 128 + 16 * wid + 4 * kg) = accS[m];
    }
    __syncthreads();
}

__device__ __forceinline__ void lru_sample(const Ctx& c, int b, int head) {
    const int tid = otid(); LAS float* XC = (LAS float*)c.lds; LAS float* RG = XC + 2048; LAS float* IG = RG + 2048;
    const float* PS = (const float*)(c.ws + OFF_PS); bf16_t* ABRS = (bf16_t*)(c.ws + OFF_ABRS);
    const float* cw = c.in[12]; const float* cb = c.in[13]; const int ch0 = 128 * head;
    for (int e = tid; e < 2048; e += 512) { const int tk = e >> 7, cl = e & 127, cgl = ch0 + cl; float o = cb[cgl];
#pragma unroll
        for (int k = 0; k < 4; ++k) { const int tt = tk - 3 + k; const float v = tt >= 0 ? PS[(size_t)(b * 16 + tt) * 9216 + cgl] : SZ(c.in[2][(size_t)(b * 3 + tt + 3) * D + cgl]); o += cw[k * D + cgl] * v; }
        XC[e] = o; }
    if (tid < 384) { const int r = tid >> 7, cl = tid & 127; c.out[O_LCS + (size_t)(b * 3 + r) * D + ch0 + cl] = PS[(size_t)(b * 16 + 13 + r) * 9216 + ch0 + cl]; }
    __syncthreads();
    {
        LAS unsigned char* XCb = c.lds + 32768; const int wid = tid >> 6, lane = tid & 63, lr = lane & 15, kg = lane >> 4;
        for (int e = tid; e < 2048; e += 512) *(LAS bf16_t*)(XCb + (e >> 7) * 272 + 2 * (e & 127)) = f2bf(XC[e]);
        __syncthreads();
        const bf16_t* wr_ = (const bf16_t*)(c.ws + OFF_WRG) + (size_t)(ch0 + 16 * wid + lr) * 128 + 8 * kg; const bf16_t* wi_ = (const bf16_t*)(c.ws + OFF_WIG) + (size_t)(ch0 + 16 * wid + lr) * 128 + 8 * kg;
        f32x4 ar = (f32x4){0.f, 0.f, 0.f, 0.f}, ai_ = ar;
#pragma unroll
        for (int ks = 0; ks < 4; ++ks) { const bf16x8 br = *(const bf16x8*)(wr_ + 32 * ks), bi = *(const bf16x8*)(wi_ + 32 * ks), a = *(const LAS bf16x8*)(XCb + lr * 272 + (32 * ks + 8 * kg) * 2);
            ar = __builtin_amdgcn_mfma_f32_16x16x32_bf16(a, br, ar, 0, 0, 0); ai_ = __builtin_amdgcn_mfma_f32_16x16x32_bf16(a, bi, ai_, 0, 0, 0); }
        const int cl = 16 * wid + lr; const float b1 = c.in[15][ch0 + cl], b2 = c.in[17][ch0 + cl];
#pragma unroll
        for (int r = 0; r < 4; ++r) { const int tk = 4 * kg + r; RG[tk * 128 + cl] = sigmoidf_(ar[r] + b1); IG[tk * 128 + cl] = sigmoidf_(ai_[r] + b2); }
    }
    __syncthreads();
    if (tid < 128) { const int cgl = ch0 + tid; const float sp = softplusf_(-c.in[18][cgl]); float h = SZ(c.in[3][b * D + cgl]);
        for (int tk = 0; tk < 16; ++tk) { const float la = -8.0f * RG[tk * 128 + tid] * sp, a = __expf(la), u = sqrtf(-expm1f(2.0f * la)) * IG[tk * 128 + tid] * XC[tk * 128 + tid];
            h = a * h + u; ABRS[(size_t)(b * 16 + tk) * 3072 + cgl] = f2bf(gelu_tanh(PS[(size_t)(b * 16 + tk) * 9216 + 4096 + cgl]) * h); }
        c.out[O_LHS + b * D + cgl] = h; }
    __syncthreads();
}
__device__ __forceinline__ void ssd_sample(const Ctx& c, int b, int h) {
    const int tid = otid(); LAS float* XS = (LAS float*)c.lds; LAS float* BS = XS + 1024; LAS float* CS = BS + 2048; LAS float* DTL = CS + 2048;
    const float* PS = (const float*)(c.ws + OFF_PS); const float* DTS = (const float*)(c.ws + OFF_DTS); float* YGS = (float*)(c.ws + OFF_YGS);
    const float* cw = c.in[19]; const float* cb = c.in[20]; const int g = h >> 3;
    for (int e = tid; e < 16 * 320; e += 512) { const int tk = e / 320, q = e % 320; int cc; LAS float* dst;
        if (q < 64) { cc = 64 * h + q; dst = XS + tk * 64 + q; } else if (q < 192) { cc = 2048 + 128 * g + (q - 64); dst = BS + tk * 128 + (q - 64); } else { cc = 2560 + 128 * g + (q - 192); dst = CS + tk * 128 + (q - 192); }
        float o = cb[cc];
#pragma unroll
        for (int k = 0; k < 4; ++k) { const int tt = tk - 3 + k; const float v = tt >= 0 ? PS[(size_t)(b * 16 + tt) * 9216 + 1024 + cc] : SZ(c.in[4][(size_t)(b * 3 + tt + 3) * 3072 + cc]); o += cw[k * 3072 + cc] * v; }
        *dst = siluf_(o);
        if (tk >= 13 && (q < 64 || (h & 7) == 0)) c.out[O_SCS + (size_t)(b * 3 + tk - 13) * 3072 + cc] = PS[(size_t)(b * 16 + tk) * 9216 + 1024 + cc]; }
    if (tid < 16) DTL[tid] = softplusf_(DTS[(b * 16 + tid) * 32 + h] + c.in[21][h]);
    __syncthreads();
    const float Ah = -__expf(c.in[22][h]), Dh = c.in[23][h];
    const int p = tid >> 3, n0 = (tid & 7) * 16; float hs[16];
    const float* h0 = c.in[5] + ((size_t)(b * 32 + h) * 64 + p) * 128 + n0;
#pragma unroll
    for (int j = 0; j < 16; ++j) hs[j] = SZ(h0[j]);
    float zv[16];
#pragma unroll
    for (int tk = 0; tk < 16; ++tk) zv[tk] = PS[(size_t)(b * 16 + tk) * 9216 + 5120 + 64 * h + p];
#pragma unroll
    for (int tk = 0; tk < 16; ++tk) { const float d = DTL[tk], ea = __expf(d * Ah), xv = XS[tk * 64 + p], dx = d * xv; float y = 0.f;
#pragma unroll
        for (int j = 0; j < 16; ++j) { hs[j] = ea * hs[j] + dx * BS[tk * 128 + n0 + j]; y += CS[tk * 128 + n0 + j] * hs[j]; }
        y += __shfl_xor(y, 1); y += __shfl_xor(y, 2); y += __shfl_xor(y, 4);
        if ((tid & 7) == 0) { const int row = b * 16 + tk; YGS[(size_t)row * 2048 + 64 * h + p] = (y + Dh * xv) * siluf_(zv[tk]); } }
    float* ho = c.out + O_SHS + ((size_t)(b * 32 + h) * 64 + p) * 128 + n0;
#pragma unroll
    for (int j = 0; j < 16; ++j) ho[j] = hs[j];
    __syncthreads();
}

#ifdef DIAG
constexpr size_t OFF_DIAG = 266338304;
__device__ __forceinline__ int prow(int r) { return (r >> 4) * SEQ + (r & 15); }
template <class FA, class FB>
__device__ __forceinline__ void diag_rel(LAS float* red, float* dst, int ncols, FA fa, FB fb) {
    const int tid = threadIdx.x; float num = 0.f, den = 0.f;
    for (int e = tid; e < TS * ncols; e += 512) { const int r = e / ncols, cc = e % ncols; const float a = fa(r, cc), b = fb(r, cc); num += (a - b) * (a - b); den += b * b; }
    red[tid] = num; red[512 + tid] = den; __syncthreads();
    if (tid == 0) { float n = 0.f, d = 0.f; for (int i = 0; i < 512; ++i) { n += red[i]; d += red[512 + i]; } *dst = n / (d + 1e-30f); }
    __syncthreads();
}
#endif
constexpr size_t OFF_BAR = 266338304 + 4096, OFF_SSQS = OFF_BAR + 4096;
__device__ __forceinline__ void grid_barrier(unsigned* ctr, unsigned target) {
    asm volatile("s_waitcnt vmcnt(0) lgkmcnt(0)" ::: "memory");
    __syncthreads();
    if (threadIdx.x == 0) {
        __builtin_amdgcn_fence(__ATOMIC_RELEASE, "agent");
        asm volatile("s_waitcnt vmcnt(0)" ::: "memory");
        __hip_atomic_fetch_add(ctr, 1u, __ATOMIC_RELAXED, __HIP_MEMORY_SCOPE_AGENT);
        while (__hip_atomic_load(ctr, __ATOMIC_RELAXED, __HIP_MEMORY_SCOPE_AGENT) < target) __builtin_amdgcn_s_sleep(1);
        __builtin_amdgcn_fence(__ATOMIC_ACQUIRE, "agent");
        asm volatile("s_waitcnt vmcnt(0)" ::: "memory");
    }
    __syncthreads();
}
#define XB_TMO      128
#define XB_XCNT(j)  (256  + 64 * (j))
#define XB_XSUB(j)  (1280 + 64 * (j))
#define XB_XGEN(j)  (2304 + 64 * (j))
#define XB_TOP      3328
#define XB_TOPGEN   3392
#define XCD_BAR_WORDS 3456
#define XB_SPIN_CAP (1u << 18)
constexpr size_t OFF_XBAR = 266338304 + 4096 + 4096 + 65536;
__device__ __forceinline__ unsigned xb_ld(unsigned* p)              { return __hip_atomic_load(p, __ATOMIC_RELAXED, __HIP_MEMORY_SCOPE_AGENT); }
__device__ __forceinline__ unsigned xb_add(unsigned* p, unsigned v) { return __hip_atomic_fetch_add(p, v, __ATOMIC_RELAXED, __HIP_MEMORY_SCOPE_AGENT); }
__device__ __forceinline__ unsigned xb_xcc_id() { return (unsigned)__builtin_amdgcn_s_getreg((3 << 11) | 20) & 0xFu; }
#define XB_SPIN(cond, bar) do { unsigned _sp = 0; while (cond) { __builtin_amdgcn_s_sleep(1); \
    if ((++_sp & 255u) == 0u) { if (xb_ld(&(bar)[XB_TMO])) break; if (_sp > XB_SPIN_CAP) { atomicAdd(&(bar)[XB_TMO], 1u); break; } } } } while (0)
struct XcdBarrier { unsigned* bar; unsigned x; volatile LAS unsigned* st; };
__device__ __forceinline__ XcdBarrier xcd_barrier_post(unsigned* bar, volatile LAS unsigned* st) {
    XcdBarrier b; b.bar = bar; b.x = xb_xcc_id(); b.st = st;
    if (threadIdx.x == 0) (void)xb_add(&bar[XB_XCNT(b.x)], 1u);
    return b;
}
__device__ __forceinline__ void xcd_barrier_complete(unsigned* bar, unsigned x, unsigned& nloc, unsigned& nx) {
    const unsigned G = gridDim.x * gridDim.y * gridDim.z;
    unsigned sum, cnt, mine, sp = 0u;
    for (;;) {
        sum = 0u; cnt = 0u; mine = 0u;
#pragma unroll
        for (unsigned j = 0; j < 16; ++j) { const unsigned c = xb_ld(&bar[XB_XCNT(j)]); sum += c; cnt += (c > 0u) ? 1u : 0u; mine = (j == x) ? c : mine; }
        if (sum == G) break;
        __builtin_amdgcn_s_sleep(1);
        if ((++sp & 255u) == 0u) { if (xb_ld(&bar[XB_TMO])) break; if (sp > XB_SPIN_CAP) { atomicAdd(&bar[XB_TMO], 1u); break; } }
    }
    nloc = mine > 0u ? mine : 1u; nx = cnt > 0u ? cnt : 1u;
}
__device__ __forceinline__ void xcd_barrier(const XcdBarrier& b) {
    asm volatile("s_waitcnt vmcnt(0)" ::: "memory");
    __syncthreads();
    if (threadIdx.x == 0) {
        unsigned* bar = b.bar;
        __builtin_amdgcn_s_waitcnt(0);
        unsigned nloc = b.st[0], nx = b.st[1];
        if (nloc == 0u) { xcd_barrier_complete(bar, b.x, nloc, nx); b.st[0] = nloc; b.st[1] = nx; }
        const unsigned old = xb_add(&bar[XB_XSUB(b.x)], 1u);
        const unsigned gen = old / nloc;
        if (old + 1u == (gen + 1u) * nloc) {
            __builtin_amdgcn_fence(__ATOMIC_RELEASE, "agent");
            asm volatile("s_waitcnt vmcnt(0)" ::: "memory");
            const unsigned og = xb_add(&bar[XB_TOP], 1u);
            const unsigned tg = og / nx;
            if (og + 1u == (tg + 1u) * nx) xb_add(&bar[XB_TOPGEN], 1u);
            else XB_SPIN(xb_ld(&bar[XB_TOPGEN]) == tg, bar);
            __builtin_amdgcn_fence(__ATOMIC_ACQUIRE, "agent");
            xb_add(&bar[XB_XGEN(b.x)], 1u);
            asm volatile("s_waitcnt vmcnt(0)" ::: "memory");
        } else {
            XB_SPIN(xb_ld(&bar[XB_XGEN(b.x)]) == gen, bar);
            __builtin_amdgcn_fence(__ATOMIC_ACQUIRE, "agent");
            asm volatile("s_waitcnt vmcnt(0)" ::: "memory");
        }
    }
    __syncthreads();
}
#ifndef DUPX
#define DUPX 0
#endif
#ifdef TIMER_ID
#define TSTART(id) do { if ((id) == TIMER_ID) t0_ = __builtin_amdgcn_s_memrealtime(); } while (0)
#define TSTOP(id) do { if ((id) == TIMER_ID) tacc_ += __builtin_amdgcn_s_memrealtime() - t0_; } while (0)
#else
#define TSTART(id)
#define TSTOP(id)
#endif
__global__ void __launch_bounds__(512, 2) fwd_kernel(Params prm) {
    extern __shared__ __attribute__((aligned(16))) unsigned char lds_raw[];
    Ctx c; c.in = prm.in; c.out = prm.out; c.ws = prm.ws; c.lds = (LAS unsigned char*)lds_raw;
    unsigned char* ws = prm.ws; float* out = prm.out;
    const int tid = threadIdx.x, G = gridDim.x, bid = blockIdx.x;
    bf16_t* XB = (bf16_t*)(ws + OFF_XB); bf16_t* XN = (bf16_t*)(ws + OFF_XN); bf16_t* PP = (bf16_t*)(ws + OFF_PP); float* SSQ = (float*)(ws + OFF_SSQ);
    bf16_t* XNS = (bf16_t*)(ws + OFF_XNS); bf16_t* HS = (bf16_t*)(ws + OFF_HS); float* PS = (float*)(ws + OFF_PS); float* GSSQ = (float*)(ws + OFF_GSSQ);
    float* YS = out + O_YS; float* SSQS = (float*)(ws + OFF_SSQS);
    const int lo = prm.ph_lo, hi = prm.ph_hi;
#ifdef DIAG
    if (lo >= 100) {
        if (bid != 0) return;
        float* DG = (float*)(ws + OFF_DIAG); LAS float* red = (LAS float*)c.lds; const int st = lo - 100;
        const float* DTp = (const float*)(ws + OFF_DT); const float* DTs = (const float*)(ws + OFF_DTS); const bf16_t* ABRS = (const bf16_t*)(ws + OFF_ABRS); const bf16_t* MS = (const bf16_t*)(ws + OFF_MS); const float* bg = prm.in[11];
        if (st == 0 || st == 6 || st == 7) diag_rel(red, DG + st, D, [=](int r, int cc) { return out[O_YP + (size_t)prow(r) * D + cc]; }, [=](int r, int cc) { return YS[(size_t)r * D + cc]; });
        if (st == 1) { diag_rel(red, DG + 1, NPP, [=](int r, int cc) { return bf2f(PP[(size_t)prow(r) * NPP + cc]); }, [=](int r, int cc) { return PS[(size_t)r * 9216 + cc]; });
                       diag_rel(red, DG + 2, 32, [=](int r, int cc) { return DTp[(size_t)prow(r) * 32 + cc]; }, [=](int r, int cc) { return DTs[(size_t)r * 32 + cc]; }); }
        if (st == 8) { diag_rel(red, DG + 8, D, [=](int r, int cc) { return bf2f(XN[(size_t)prow(r) * D + cc]); }, [=](int r, int cc) { return sigmoidf_(PS[(size_t)r * 9216 + 7168 + cc] + bg[cc]); });
                       diag_rel(red, DG + 9, D, [=](int r, int cc) { return bf2f(PP[(size_t)prow(r) * NPP + 3072 + cc]); }, [=](int r, int cc) { return sigmoidf_(PS[(size_t)r * 9216 + 8192 + cc] + bg[1024 + cc]); }); }
        if (st == 3) { diag_rel(red, DG + 3, D, [=](int r, int cc) { return bf2f(PP[(size_t)prow(r) * NPP + cc]); }, [=](int r, int cc) { return bf2f(ABRS[(size_t)r * 3072 + cc]); });
                       diag_rel(red, DG + 4, 2048, [=](int r, int cc) { return bf2f(PP[(size_t)prow(r) * NPP + 1024 + cc]); }, [=](int r, int cc) { return bf2f(ABRS[(size_t)r * 3072 + 1024 + cc]); }); }
        if (st == 5) diag_rel(red, DG + 5, D, [=](int r, int cc) { return bf2f(XN[(size_t)prow(r) * D + cc]); }, [=](int r, int cc) { return bf2f(MS[(size_t)r * D + cc]); });
        if (st == 20) {
            int mask = 0; if (!(DG[8] < DIAG_TOL)) mask |= 1; if (!(DG[9] < DIAG_TOL)) mask |= 2; if (!(DG[3] < DIAG_TOL)) mask |= 4; if (!(DG[4] < DIAG_TOL)) mask |= 8; if (!(DG[5] < DIAG_TOL)) mask |= 16;
            if (mask == 0) { if (!(DG[6] < DIAG_TOL)) mask |= 32; if (!(DG[7] < DIAG_TOL)) mask |= 64; }
            float code = mask ? 100.f * (1 + mask) : 0.f;
            if (code > 0.f) for (int e = tid; e < TS * D; e += 512) YS[e] = code;
        }
        return;
    }
#endif
#ifndef PHMASK
#define PHMASK 0x1fff
#endif
#define IN(k) (((PHMASK >> (k)) & 1) && lo <= (k) && (k) < hi)
    unsigned* barctr = (unsigned*)(ws + OFF_BAR); unsigned nbar = 0; (void)barctr;
    volatile LAS unsigned* xbst = (volatile LAS unsigned*)(c.lds + LDS_BYTES - 16);
    if (tid < 4) xbst[tid] = 0u;
    __syncthreads();
    XcdBarrier xbar; xbar.bar = (unsigned*)(ws + OFF_XBAR); xbar.x = 0; xbar.st = xbst;
    if (hi - lo > 1) xbar = xcd_barrier_post((unsigned*)(ws + OFF_XBAR), xbst);
    unsigned long long t0_ = 0, tacc_ = 0; (void)t0_; (void)tacc_;
#define SEAM(k) do { if (IN(k) && IN((k) + 1)) { TSTART(12); ++nbar; xcd_barrier(xbar); TSTOP(12); } } while (0)
    auto rm_id = [](int col0, int) { return col0; };
    auto rm_up = [](int col0, int panel) { return (col0 >> 7) * 256 + panel * 128 + (col0 & 127); };

    if (IN(0)) {
        TSTART(0); prep_weights(c);
#if DUPX == 1
        prep_weights(c);
#endif
        rmsnorm_rows_bf16(prm.in[0], T, prm.in[6], XN); TSTOP(0);
#ifdef DIAG
        { const int t_ = otid(), lane = t_ & 63; for (int r = bid * 8 + (t_ >> 6); r < TS; r += G * 8) { const float* p = prm.in[0] + (size_t)prow(r) * D; float v[16]; float s = 0.f;
            for (int i = 0; i < 16; ++i) { v[i] = p[lane + 64 * i]; s += v[i] * v[i]; }
            for (int o = 1; o < 64; o <<= 1) s += __shfl_xor(s, o);
            const float inv = rsqrtf(s * (1.0f / 1024.0f) + EPS);
            for (int i = 0; i < 16; ++i) XNS[(size_t)r * D + lane + 64 * i] = f2bf(v[i] * inv * prm.in[6][lane + 64 * i]); } }
#else
        rmsnorm_rows_bf16(prm.in[1], TS, prm.in[6], XNS);
#endif
    }
    SEAM(0);
    if (IN(1)) {
        pg8::Gemm g{XN, D, (const bf16_t*)(ws + OFF_WUP1), D, T, 2 * FF, D}; pg8::StaticOrder S; S.init(T, 2 * FF, G, bid);

#if DUPX == 5
        pg8::gemm_phase(c.lds, g, S, EpiSwiglu{PP, (LAS const float*)nullptr});
#endif
        TSTART(1); pg8::gemm_phase(c.lds, g, S, EpiSwiglu{PP, (LAS const float*)nullptr}); TSTOP(1);
        TSTART(2); sgemm<16, 2, D>(c.lds, XNS, D, (const bf16_t*)(ws + OFF_WUP1), D, FF, nullptr, nullptr, rm_up,
            [=](int r, int cc, float v0, float v1, float) { HS[(size_t)r * FF + cc] = f2bf(siluf_(v0) * v1); return 0.f; }, G / 2); TSTOP(2);
    }
    SEAM(1);
    if (IN(2)) {
        pg8::Gemm g{PP, FF, (const bf16_t*)(ws + OFF_WDN1), FF, T, D, FF}; pg8::StaticOrder S; S.init(T, D, G, bid);
        TSTART(10); pg8::gemm_phase(c.lds, g, S, EpiResid{prm.in[0], nullptr, nullptr, XB, SSQ, 0.5f}); TSTOP(10);
        const float* xs_in = prm.in[1];
        TSTART(2); sgemm<16, 1, FF>(c.lds, HS, FF, (const bf16_t*)(ws + OFF_WDN1), FF, D, nullptr, SSQS, rm_id,
            [=](int r, int cc, float v0, float, float) {
#ifdef DIAG
            const float x = prm.in[0][(size_t)prow(r) * D + cc] + 0.5f * v0;
#else
            const float x = xs_in[(size_t)r * D + cc] + 0.5f * v0;
#endif
            YS[(size_t)r * D + cc] = x; XNS[(size_t)r * D + cc] = f2bf(x); return x; }); TSTOP(2);
    }
    SEAM(2);
    if (IN(3)) {
        pg8::Gemm g{XB, D, (const bf16_t*)(ws + OFF_WIN), D, T, NPP, D}; pg8::StaticOrder S; S.init(T, NPP, G, bid);

#if DUPX == 6
        pg8::gemm_phase(c.lds, g, S, EpiScaleBf16{PP, SSQ});
#endif
        LAS const float* linv = fill_inv(c.lds, SSQ); TSTART(11); pg8::gemm_phase(c.lds, g, S, EpiScaleBf16{PP, linv}); TSTOP(11);
        float* DTp = (float*)(ws + OFF_DT); float* DTs = (float*)(ws + OFF_DTS);
        TSTART(2);
        {
            const int t_ = otid(), wv = t_ >> 6, ln = t_ & 63, lr = ln & 15, kg = ln >> 4; const bf16_t* WDT = (const bf16_t*)(ws + OFF_WDT);
            for (int wt = bid * 8 + wv; wt < T / 16; wt += G * 8) {
                f32x4 a0 = (f32x4){0.f, 0.f, 0.f, 0.f}, a1 = a0; f32x4 sq[4][4];
#pragma unroll
                for (int r = 0; r < 4; ++r)
#pragma unroll
                    for (int i = 0; i < 4; ++i) sq[r][i] = *(const f32x4*)(SSQ + (size_t)(16 * wt + 4 * kg + r) * 16 + 4 * i);
                const bf16_t* ap = XB + (size_t)(16 * wt + lr) * D + 8 * kg; const bf16_t* bp = WDT + (size_t)lr * D + 8 * kg;
#pragma unroll 8
                for (int k = 0; k < D; k += 32) { const bf16x8 a = *(const bf16x8*)(ap + k), b0 = *(const bf16x8*)(bp + k), b1 = *(const bf16x8*)(bp + 16 * D + k);
                    a0 = __builtin_amdgcn_mfma_f32_16x16x32_bf16(a, b0, a0, 0, 0, 0); a1 = __builtin_amdgcn_mfma_f32_16x16x32_bf16(a, b1, a1, 0, 0, 0); }
#pragma unroll
                for (int r = 0; r < 4; ++r) { const int row = 16 * wt + 4 * kg + r; const f32x4 sm = (sq[r][0] + sq[r][1]) + (sq[r][2] + sq[r][3]); const float inv = rsqrtf(((sm[0] + sm[1]) + (sm[2] + sm[3])) * (1.0f / 1024.0f) + EPS); DTp[(size_t)row * 32 + lr] = a0[r] * inv; DTp[(size_t)row * 32 + 16 + lr] = a1[r] * inv; }
            }
        }
        TSTOP(2);
        TSTART(2); sgemm<32, 1, D>(c.lds, XNS, D, (const bf16_t*)(ws + OFF_WIN), D, 9216, SSQS, nullptr, rm_id,
            [=](int r, int cc, float v0, float, float inv) { PS[(size_t)r * 9216 + cc] = v0 * inv; return 0.f; }); TSTOP(2);
        TSTART(2); sgemm<32, 1, D>(c.lds, XNS, D, (const bf16_t*)(ws + OFF_WDT), D, 32, SSQS, nullptr, rm_id,
            [=](int r, int cc, float v0, float, float inv) { DTs[(size_t)r * 32 + cc] = v0 * inv; return 0.f; }); TSTOP(2);
    }
    SEAM(3);
    if (IN(4)) {
        for (int e = bid * 512 + tid; e < 8 * 3 * 2048; e += G * 512) {
            const int cc = e & 2047, r = (e >> 11) % 3, b = e / (3 * 2048); const size_t row = (size_t)b * SEQ + 2045 + r;
            if (cc < 1024) out[O_LCP + (size_t)(b * 3 + r) * D + cc] = bf2f(PP[row * NPP + cc]);
            else out[O_SCP + (size_t)(b * 3 + r) * 3072 + 2048 + (cc - 1024)] = bf2f(PP[row * NPP + 3072 + (cc - 1024)]); }

#if DUPX == 4
        for (int it = bid; it < 256; it += G) lru_chunk<false>(c, it >> 5, it & 31);
#endif
        TSTART(19); for (int it = bid; it < 256; it += G) bc_conv(c, it >> 5, it & 31); TSTOP(19);
        if (hi - lo > 1) xcd_barrier(xbar);
        TSTART(3); for (int it = bid; it < 256; it += G) lru_chunk<false>(c, it >> 5, it & 31); TSTOP(3);

#if DUPX == 3
        for (int it = bid; it < 256; it += G) ssd_seq(c, it >> 5, it & 31, prm.ph_lo == 0);
#endif


    }
    SEAM(4);
    if (IN(5)) {

#if DUPX == 2
        for (int it = bid; it < 256; it += G) lru_chunk<true>(c, it >> 5, it & 31, prm.ph_lo == 0);
#endif
        TSTART(4); for (int it = bid; it < 256; it += G) ssd_seq(c, it >> 5, it & 31); TSTOP(4);
        TSTART(5); for (int it = bid; it < 256; it += G) lru_final(c, it >> 5, it & 31); TSTOP(5);
        TSTART(2); for (int it = bid; it < 64; it += G) lru_sample(c, it >> 3, it & 7); TSTOP(2);
        TSTART(2); for (int it = bid; it < 256; it += G) ssd_sample(c, it >> 5, it & 31); TSTOP(2);
    }
    SEAM(5);
    if (IN(6)) { TSTART(8);
        {
        const float* YGS = (const float*)(ws + OFF_YGS); bf16_t* ABRS = (bf16_t*)(ws + OFF_ABRS);
        const int lane = tid & 63;
        for (int w = bid * 8 + (tid >> 6); w < TS * 4; w += G * 8) { const int r = w >> 2, gq = w & 3; const float* p = YGS + (size_t)r * 2048 + 512 * gq; float v[8]; float s = 0.f;
#pragma unroll
            for (int j = 0; j < 8; ++j) { v[j] = p[lane + 64 * j]; s += v[j] * v[j]; }
#pragma unroll
            for (int o = 1; o < 64; o <<= 1) s += __shfl_xor(s, o);
            const float inv = rsqrtf(s * (1.0f / 512.0f) + EPS);
#pragma unroll
            for (int j = 0; j < 8; ++j) ABRS[(size_t)r * 3072 + 1024 + 512 * gq + lane + 64 * j] = f2bf(v[j] * inv); }
        }
        LAS const float* linv = fill_inv(c.lds, SSQ);
        { pg8::Gemm g{XB, D, (const bf16_t*)(ws + OFF_WIN) + (size_t)4096 * D, D, T, 3072, D}; pg8::StaticOrder S; S.init(T, 3072, G, bid);
          pg8::gemm_phase(c.lds, g, S, EpiGatesA{PP, linv, GSSQ}); }
        { pg8::Gemm g{XB, D, (const bf16_t*)(ws + OFF_WIN) + (size_t)7168 * D, D, T, D, D}; pg8::StaticOrder S; S.init(T, D, G, bid);
          pg8::gemm_phase(c.lds, g, S, EpiSigmoid{XN, D, linv, prm.in[11]}); }
        { pg8::Gemm g{XB, D, (const bf16_t*)(ws + OFF_WIN) + (size_t)8192 * D, D, T, D, D}; pg8::StaticOrder S; S.init(T, D, G, bid);
          pg8::gemm_phase(c.lds, g, S, EpiSigmoid{PP + 3072, NPP, linv, prm.in[11] + 1024}); } TSTOP(8);
    }
    SEAM(6);
    if (IN(7)) { TSTART(6);
        const int lane = tid & 63;
        for (int r = bid * 8 + (tid >> 6); r < T; r += G * 8) {
            float s = (lane < 32) ? GSSQ[(size_t)r * 32 + lane] : 0.f;
            s += __shfl_xor(s, 1); s += __shfl_xor(s, 2); s += __shfl_xor(s, 4);
            const float i0 = rsqrtf(__shfl(s, 0) * (1.0f / 512.0f) + EPS), i1 = rsqrtf(__shfl(s, 8) * (1.0f / 512.0f) + EPS), i2 = rsqrtf(__shfl(s, 16) * (1.0f / 512.0f) + EPS), i3 = rsqrtf(__shfl(s, 24) * (1.0f / 512.0f) + EPS);
#pragma unroll
            for (int i = 0; i < 4; ++i) { const float inv = i == 0 ? i0 : (i == 1 ? i1 : (i == 2 ? i2 : i3));
                bf16_t* p = PP + (size_t)r * NPP + 1024 + 512 * i + 8 * lane; f32x4 a, bq; unpack8(*(const u32x4*)p, a, bq); *(u32x4*)p = pack8(a * inv, bq * inv); }
        }
    }
    TSTOP(6); SEAM(7);
    if (IN(8)) {
        TSTART(9); { pg8::Gemm g{PP, NPP, (const bf16_t*)(ws + OFF_WBR), 3072, T, D, D}; pg8::StaticOrder S; S.init(T, D, G, bid); pg8::gemm_phase(c.lds, g, S, EpiBr{XN, PP, 0}); }
        { pg8::Gemm g{PP + 1024, NPP, (const bf16_t*)(ws + OFF_WBR) + 1024, 3072, T, D, 2048}; pg8::StaticOrder S; S.init(T, D, G, bid); pg8::gemm_phase(c.lds, g, S, EpiBr{XN, PP, 1}); } TSTOP(9);
        const bf16_t* ABRS = (const bf16_t*)(ws + OFF_ABRS); float* M1S = (float*)(ws + OFF_M1S); bf16_t* MS = (bf16_t*)(ws + OFF_MS); const float* bg = prm.in[11];
        TSTART(2); sgemm<16, 1, D>(c.lds, ABRS, 3072, (const bf16_t*)(ws + OFF_WBR), 3072, D, nullptr, nullptr, rm_id,
            [=](int r, int cc, float v0, float, float) { M1S[(size_t)r * D + cc] = sigmoidf_(PS[(size_t)r * 9216 + 7168 + cc] + bg[cc]) * v0; return 0.f; }); TSTOP(2);
        TSTART(2); sgemm<16, 1, 2048>(c.lds, ABRS + 1024, 3072, (const bf16_t*)(ws + OFF_WBR) + 1024, 3072, D, nullptr, nullptr, rm_id,
            [=](int r, int cc, float v0, float, float) { MS[(size_t)r * D + cc] = f2bf(M1S[(size_t)r * D + cc] + sigmoidf_(PS[(size_t)r * 9216 + 8192 + cc] + bg[1024 + cc]) * v0); return 0.f; }); TSTOP(2);
    }
    SEAM(8);
    if (IN(9)) {
        pg8::Gemm g{XN, D, (const bf16_t*)(ws + OFF_WOUT), D, T, D, D}; pg8::StaticOrder S; S.init(T, D, G, bid);
        TSTART(16); pg8::gemm_phase(c.lds, g, S, EpiResid{nullptr, XB, nullptr, XB, SSQ, 1.0f}); TSTOP(16);
        const bf16_t* MS = (const bf16_t*)(ws + OFF_MS);
        TSTART(2); sgemm<16, 1, D>(c.lds, MS, D, (const bf16_t*)(ws + OFF_WOUT), D, D, nullptr, SSQS + 8192, rm_id,
            [=](int r, int cc, float v0, float, float) { const float x = YS[(size_t)r * D + cc] + v0; YS[(size_t)r * D + cc] = x; XNS[(size_t)r * D + cc] = f2bf(x); return x; }); TSTOP(2);
    }
    SEAM(9);
    if (IN(10)) {
        pg8::Gemm g{XB, D, (const bf16_t*)(ws + OFF_WUP2), D, T, 2 * FF, D}; pg8::StaticOrder S; S.init(T, 2 * FF, G, bid);
        LAS const float* linv = fill_inv(c.lds, SSQ);
        TSTART(17); pg8::gemm_phase(c.lds, g, S, EpiSwiglu{PP, linv}); TSTOP(17);
        TSTART(2); sgemm<16, 2, D>(c.lds, XNS, D, (const bf16_t*)(ws + OFF_WUP2), D, FF, SSQS + 8192, nullptr, rm_up,
            [=](int r, int cc, float v0, float v1, float inv) { HS[(size_t)r * FF + cc] = f2bf(siluf_(v0 * inv) * (v1 * inv)); return 0.f; }, G / 2); TSTOP(2);
    }
    SEAM(10);
    if (IN(11)) {
        pg8::Gemm g{PP, FF, (const bf16_t*)(ws + OFF_WDN2), FF, T, D, FF}; pg8::StaticOrder S; S.init(T, D, G, bid);
        TSTART(18); pg8::gemm_phase(c.lds, g, S, EpiResid{nullptr, XB, out + O_YP, nullptr, SSQ, 0.5f}); TSTOP(18);
        TSTART(2); sgemm<16, 1, FF>(c.lds, HS, FF, (const bf16_t*)(ws + OFF_WDN2), FF, D, nullptr, nullptr, rm_id,
            [=](int r, int cc, float v0, float, float) { YS[(size_t)r * D + cc] += 0.5f * v0; return 0.f; }); TSTOP(2);
    }
    SEAM(11);
    if (IN(12)) {
        TSTART(7); rmsnorm_rows_f32(out + O_YP, T + TS, prm.in[31]); TSTOP(7);
    }
#ifdef TIMER_ID
    if (hi == 13) { ++nbar; grid_barrier(barctr, nbar * (unsigned)G);
        if (bid == TIMER_BLOCK) { const float us = (float)tacc_ * 0.0001f; for (int e = tid; e < TS * D; e += 512) YS[e] = us; } }
#endif
#undef IN
#undef SEAM
}

#ifndef N_LAUNCH_MODE
#define N_LAUNCH_MODE 1
#endif
extern "C" void kernel_launch(void* const* d_in, const int* in_sizes, int n_in, void* d_out, int out_size, void* d_ws, size_t ws_size, hipStream_t stream) {
    static int grid = 0;
    if (grid == 0) {
        if (n_in != 32 || ws_size < OFF_XBAR + XCD_BAR_WORDS * 4) { fprintf(stderr, "kernel_launch: unexpected n_in %d or ws_size %zu (< %zu)\n", n_in, ws_size, (size_t)WS_END); grid = -1; return; }
        int dev = 0, cus = 0, per_cu = 0;
        hipGetDevice(&dev); hipDeviceGetAttribute(&cus, hipDeviceAttributeMultiprocessorCount, dev);
        if (hipFuncSetAttribute((const void*)fwd_kernel, hipFuncAttributeMaxDynamicSharedMemorySize, LDS_BYTES) != hipSuccess) { fprintf(stderr, "kernel_launch: hipFuncSetAttribute failed\n"); grid = -1; return; }
        hipOccupancyMaxActiveBlocksPerMultiprocessor(&per_cu, (const void*)fwd_kernel, 512, LDS_BYTES);
        if (per_cu < 1) { fprintf(stderr, "kernel_launch: occupancy query says %d blocks per CU\n", per_cu); per_cu = 1; }
        grid = cus * 1;
        (void)hipGetLastError();
    }
    if (grid < 0) return;
    Params p{};
    for (int i = 0; i < 32; ++i) p.in[i] = (const float*)d_in[i];
    p.out = (float*)d_out; p.ws = (unsigned char*)d_ws;
#if N_LAUNCH_MODE == 0
    for (int ph = 0; ph < 13; ++ph) { p.ph_lo = ph; p.ph_hi = ph + 1; hipLaunchKernelGGL(fwd_kernel, dim3(grid), dim3(512), LDS_BYTES, stream, p);
#ifdef DIAG
        int st = -1; if (ph == 2) st = 0; if (ph == 3) st = 1; if (ph == 6) st = 8; if (ph == 7) st = 3; if (ph == 8) st = 5; if (ph == 9) st = 6; if (ph == 11) st = 7; if (ph == 12) st = 20;
        if (st >= 0) { p.ph_lo = 100 + st; p.ph_hi = 0; hipLaunchKernelGGL(fwd_kernel, dim3(grid), dim3(512), LDS_BYTES, stream, p); }
#endif
    }
#else
    p.ph_lo = 0; p.ph_hi = 13;
    hipMemsetAsync((char*)d_ws + OFF_XBAR, 0, XCD_BAR_WORDS * 4, stream);
    void* args[] = {&p};
    hipError_t e = hipLaunchCooperativeKernel((const void*)fwd_kernel, dim3(grid), dim3(512), args, LDS_BYTES, stream);
    if (e != hipSuccess) fprintf(stderr, "cooperative launch failed: %s (grid %d)\n", hipGetErrorString(e), grid);
#endif
}
```

```cpp
#include <hip/hip_runtime.h>
#include <hip/hip_cooperative_groups.h>
#include <cstdio>
namespace cg = cooperative_groups;

#define LAS __attribute__((address_space(3)))
typedef unsigned short bf16_t;
typedef short bf16x8 __attribute__((ext_vector_type(8)));
typedef float f32x4 __attribute__((ext_vector_type(4)));
typedef unsigned u32x4 __attribute__((ext_vector_type(4)));

constexpr int T = 16384, TS = 128, D = 1024, FF = 2816, NPP = 4096, SEQ = 2048, NCH = 32;
constexpr float EPS = 1e-6f;
constexpr size_t OFF_WUP1 = 0, OFF_WDN1 = 11534336;
constexpr size_t OFF_DT = 0, OFF_SUMM = 2097152, OFF_HALO = 4194304, OFF_GSSQ = 5767168, OFF_PS = 7864320,
                 OFF_DTS = 12582912, OFF_YGS = 12599296, OFF_ABRS = 13647872, OFF_M1S = 14434304, OFF_MS = 14958592;
constexpr size_t OFF_WIN = 17301504, OFF_WDT = 36175872, OFF_WBR = 36241408, OFF_WOUT = 42532864, OFF_WUP2 = 44630016,
                 OFF_WDN2 = 56164352, OFF_WRG = 61931520, OFF_WIG = 62193664, OFF_XB = 62455808, OFF_XN = 96010240,
                 OFF_PP = 129564672, OFF_SSQ = 263782400, OFF_XNS = 264830976, OFF_HS = 265093120, WS_END = 265814016;
constexpr size_t O_YP = 0, O_YS = 16777216, O_LCP = 16908288, O_LHP = 16932864, O_SCP = 16941056, O_SHP = 17014784,
                 O_LCS = 19111936, O_LHS = 19136512, O_SCS = 19144704, O_SHS = 19218432;
constexpr int LDS_BYTES = 143360;
constexpr int LDS_INV = 131072;

struct Params { const float* in[32]; float* out; unsigned char* ws; int ph_lo, ph_hi; };

#ifdef DIAG
#define SZ(x) 0.0f
#ifndef DIAG_TOL
#define DIAG_TOL 0.01f
#endif
#else
#define SZ(x) (x)
#endif
#define A256(base, row, chunk) ((base) + (row) * 256 + 16 * ((chunk) ^ ((row) & 15)))
#define A128(base, row, chunk) ((base) + (row) * 128 + 16 * ((chunk) ^ ((((row) >> 1) ^ ((row) >> 3)) & 7)))
__device__ __forceinline__ int otid() { int t = threadIdx.x; asm volatile("" : "+v"(t)); return t; }
__device__ __forceinline__ unsigned cvt_pk_bf16(float lo, float hi) { unsigned r; asm volatile("v_cvt_pk_bf16_f32 %0, %1, %2" : "=v"(r) : "v"(lo), "v"(hi)); return r; }
__device__ __forceinline__ bf16_t f2bf(float f) { return (bf16_t)(cvt_pk_bf16(f, 0.f) & 0xffffu); }
__device__ __forceinline__ float bf2f(bf16_t b) { return __uint_as_float(((unsigned)b) << 16); }
__device__ __forceinline__ float bflo(unsigned w) { return __uint_as_float(w << 16); }
__device__ __forceinline__ float bfhi(unsigned w) { return __uint_as_float(w & 0xffff0000u); }
__device__ __forceinline__ float sigmoidf_(float x) { return __builtin_amdgcn_rcpf(1.0f + __expf(-x)); }
__device__ __forceinline__ float siluf_(float x) { return x * sigmoidf_(x); }
__device__ __forceinline__ float gelu_tanh(float x) { const float u = 0.7978845608028654f * (x + 0.044715f * x * x * x); return x * sigmoidf_(2.0f * u); }
__device__ __forceinline__ float softplusf_(float x) { return x > 20.f ? x : log1pf(__expf(x)); }
__device__ __forceinline__ u32x4 pack8(const f32x4 a, const f32x4 b) { u32x4 w; w.x = cvt_pk_bf16(a[0], a[1]); w.y = cvt_pk_bf16(a[2], a[3]); w.z = cvt_pk_bf16(b[0], b[1]); w.w = cvt_pk_bf16(b[2], b[3]); return w; }
__device__ __forceinline__ void unpack8(const u32x4 w, f32x4& a, f32x4& b) { a[0] = bflo(w.x); a[1] = bfhi(w.x); a[2] = bflo(w.y); a[3] = bfhi(w.y); b[0] = bflo(w.z); b[1] = bfhi(w.z); b[2] = bflo(w.w); b[3] = bfhi(w.w); }
__device__ __forceinline__ float rowinv16(const float* ssq, int row) {
    const f32x4* p = (const f32x4*)(ssq + (size_t)row * 16); const f32x4 a = p[0], b = p[1], c = p[2], d = p[3];
    const float s = ((a[0] + a[1]) + (a[2] + a[3])) + ((b[0] + b[1]) + (b[2] + b[3])) + ((c[0] + c[1]) + (c[2] + c[3])) + ((d[0] + d[1]) + (d[2] + d[3]));
    return rsqrtf(s * (1.0f / 1024.0f) + EPS);
}

namespace pg8 {
constexpr int BM = 256, BK = 64, HALF = 128, HTB = HALF * BK * 2, STAGE_BYTES = 8 * HTB, NXCD = 8, WGM = 8;
__device__ __forceinline__ int lds_byte(int r, int c) { const int st = (r >> 4) * 2 + (c >> 5), rr = r & 15, cc = c & 31, ob = rr * 64 + cc * 2; return st * 1024 + (ob ^ (((ob >> 9) & 1) << 5)); }
__device__ __forceinline__ void stage_rc(int b, int& R, int& C) { const int st = b / 1024, sb = b % 1024, swz = sb ^ (((sb >> 9) & 1) << 5); R = (st >> 1) * 16 + swz / 64; C = (st & 1) * 32 + (swz % 64) / 2; }
__device__ __forceinline__ int perm32(int rho) { const int n = rho >> 4, i = rho & 15; return 8 * (i >> 2) + 4 * n + (i & 3); }
struct Unit { int pm, pn; };
struct Gemm { const bf16_t* A; int lda; const bf16_t* Bt; int ldb; int M, N, K; };
struct StaticOrder {
    int nM, nN, nwg, G, c;
    __device__ __forceinline__ void init(int M, int N, int G_, int c_) { nM = M / BM; nN = N / BM; nwg = nM * nN; G = G_; c = c_; }
    __device__ __forceinline__ bool next(int i, Unit& u) const {
        const long L = (long)i * G + c; if (L >= nwg) return false;
        int wgid = (int)L; { const int q = nwg / NXCD, r = nwg % NXCD, xcd = wgid % NXCD, off = wgid / NXCD; wgid = (xcd < r ? xcd * (q + 1) : r * (q + 1) + (xcd - r) * q) + off; }
        const int nig = WGM * nN, gid = wgid / nig, fm = gid * WGM, gsz = (nM - fm) < WGM ? (nM - fm) : WGM;
        u.pm = fm + ((wgid % nig) % gsz); u.pn = (wgid % nig) / gsz; return true;
    }
};
template <class Epi>
__device__ __forceinline__ void gemm_phase(LAS unsigned char* lds, const Gemm g, const StaticOrder& S, const Epi& E) {
    const int tid = otid(), wid = __builtin_amdgcn_readfirstlane(tid >> 6), lane = tid & 63, wr = wid >> 2, wc = wid & 3, fr = lane & 15, fq = lane >> 4;
    const int K = g.K, nt = K / BK;
    unsigned voffA[2], voffB[2];
#pragma unroll
    for (int i = 0; i < 2; ++i) { int R, C; stage_rc(tid * 16 + i * 8192, R, C); const int Rb = (R & ~31) + perm32(R & 31);
        voffA[i] = (unsigned)(R * g.lda + C) * 2u; voffB[i] = (unsigned)(Rb * g.ldb + C) * 2u; }
    const size_t kstep = (size_t)(BK * 2);
    const size_t hstepA = (size_t)HALF * g.lda * 2, hstepB = (size_t)HALF * g.ldb * 2;
    const size_t tstepA = 2 * hstepA, tstepB = 2 * hstepB;
    const unsigned ldsw = (unsigned)wid * 1024u;
    const int aoff = lds_byte(wr * 64 + fr, fq * 8), boff = lds_byte(wc * 32 + fr, fq * 8);
#define PG8_SA(b, h) (((b) * 2 + (h)) * HTB)
#define PG8_SB(b, h) ((4 + (b) * 2 + (h)) * HTB)
#define PG8_STAGE(bufoff, gbase, voff) do { _Pragma("unroll") for (int _i = 0; _i < 2; ++_i) \
        __builtin_amdgcn_global_load_lds((const unsigned*)((const char*)(gbase) + (voff)[_i]), (LAS unsigned*)(lds + (bufoff) + ldsw + _i * 8192), 16, 0, 0); } while (0)
#define PG8_LDA(dst, b, h) do { _Pragma("unroll") for (int m = 0; m < 4; ++m) _Pragma("unroll") for (int k = 0; k < 2; ++k) dst[m][k] = *(const LAS bf16x8*)(lds + PG8_SA(b, h) + aoff + m * 2048 + k * 1024); } while (0)
#define PG8_LDB(dst, b, h) do { _Pragma("unroll") for (int n = 0; n < 2; ++n) _Pragma("unroll") for (int k = 0; k < 2; ++k) dst[n][k] = *(const LAS bf16x8*)(lds + PG8_SB(b, h) + boff + n * 2048 + k * 1024); } while (0)
#define PG8_MMA(ai, bj, At, Bt) do { __builtin_amdgcn_s_setprio(1); _Pragma("unroll") for (int m = 0; m < 4; ++m) _Pragma("unroll") for (int n = 0; n < 2; ++n) _Pragma("unroll") for (int k = 0; k < 2; ++k) \
        acc[ai][bj][m][n] = __builtin_amdgcn_mfma_f32_16x16x32_bf16(Bt[n][k], At[m][k], acc[ai][bj][m][n], 0, 0, 0); __builtin_amdgcn_s_setprio(0); } while (0)
#define PG8_WAIT_V(n) asm volatile("s_waitcnt vmcnt(" #n ")" ::: "memory")
#define PG8_WAIT_L(n) asm volatile("s_waitcnt lgkmcnt(" #n ")" ::: "memory")
#define PG8_BAR __builtin_amdgcn_s_barrier()
#define PG8_SCHED __builtin_amdgcn_sched_barrier(0)
    Unit cur, nxt; int ui = 0;
    if (!S.next(0, cur)) return;
    f32x4 acc[2][2][4][2];
#pragma unroll
    for (int a = 0; a < 2; ++a)
#pragma unroll
        for (int b = 0; b < 2; ++b)
#pragma unroll
            for (int m = 0; m < 4; ++m)
#pragma unroll
                for (int n = 0; n < 2; ++n) acc[a][b][m][n] = (f32x4){0.f, 0.f, 0.f, 0.f};
    bf16x8 At[4][2], B0[2][2], B1[2][2];
    const char* cA = (const char*)g.A + (size_t)cur.pm * tstepA; const char* cB = (const char*)g.Bt + (size_t)cur.pn * tstepB;
    PG8_STAGE(PG8_SB(0, 0), cB, voffB); PG8_STAGE(PG8_SA(0, 0), cA, voffA); PG8_STAGE(PG8_SB(0, 1), cB + hstepB, voffB); PG8_STAGE(PG8_SA(0, 1), cA + hstepA, voffA);
    if (wr == 1) PG8_BAR;
    PG8_WAIT_V(4); PG8_BAR;
    PG8_STAGE(PG8_SB(1, 0), cB + kstep, voffB); PG8_STAGE(PG8_SA(1, 0), cA + kstep, voffA); PG8_STAGE(PG8_SB(1, 1), cB + hstepB + kstep, voffB);
    PG8_WAIT_V(6); PG8_BAR;
    for (;;) {
        const bool has_next = S.next(ui + 1, nxt);
        const char* nA = has_next ? (const char*)g.A + (size_t)nxt.pm * tstepA : cA; const char* nB = has_next ? (const char*)g.Bt + (size_t)nxt.pn * tstepB : cB;
        for (int t = 0; t < nt; t += 2) {
            const bool last = (t == nt - 2);
            const char* a1 = cA + (size_t)(t + 1) * kstep;
            const char* a2 = last ? nA : cA + (size_t)(t + 2) * kstep; const char* b2 = last ? nB : cB + (size_t)(t + 2) * kstep;
            const char* a3 = a2 + kstep; const char* b3 = b2 + kstep;
            PG8_LDB(B0, 0, 0); PG8_SCHED; PG8_LDA(At, 0, 0); PG8_STAGE(PG8_SA(1, 1), a1 + hstepA, voffA);
            PG8_WAIT_L(8); PG8_BAR; PG8_WAIT_L(0); PG8_MMA(0, 0, At, B0); PG8_BAR; PG8_SCHED;
            PG8_LDB(B1, 0, 1); PG8_STAGE(PG8_SB(0, 0), b2, voffB);
            PG8_BAR; PG8_WAIT_L(0); PG8_MMA(0, 1, At, B1); PG8_BAR;
            PG8_LDA(At, 0, 1); PG8_STAGE(PG8_SA(0, 0), a2, voffA);
            PG8_BAR; PG8_WAIT_L(0); PG8_MMA(1, 0, At, B0); PG8_BAR; PG8_SCHED;
            PG8_STAGE(PG8_SB(0, 1), b2 + hstepB, voffB);
            PG8_WAIT_V(6); PG8_BAR; PG8_MMA(1, 1, At, B1); PG8_BAR;
            PG8_LDB(B0, 1, 0); PG8_SCHED; PG8_LDA(At, 1, 0); PG8_STAGE(PG8_SA(0, 1), a2 + hstepA, voffA);
            PG8_WAIT_L(8); PG8_BAR; PG8_WAIT_L(0); PG8_MMA(0, 0, At, B0); PG8_BAR; PG8_SCHED;
            PG8_LDB(B1, 1, 1); PG8_STAGE(PG8_SB(1, 0), b3, voffB);
            PG8_BAR; PG8_WAIT_L(0); PG8_MMA(0, 1, At, B1); PG8_BAR;
            PG8_LDA(At, 1, 1); PG8_STAGE(PG8_SA(1, 0), a3, voffA);
            PG8_BAR; PG8_WAIT_L(0); PG8_MMA(1, 0, At, B0); PG8_BAR; PG8_SCHED;
            PG8_STAGE(PG8_SB(1, 1), b3 + hstepB, voffB);
            PG8_WAIT_V(6); PG8_BAR; PG8_MMA(1, 1, At, B1); PG8_BAR;
        }
        E(acc, cur, wr, wc, fr, fq);
        if (!has_next) break;
#pragma unroll
        for (int a = 0; a < 2; ++a)
#pragma unroll
            for (int b = 0; b < 2; ++b)
#pragma unroll
                for (int m = 0; m < 4; ++m)
#pragma unroll
                    for (int n = 0; n < 2; ++n) acc[a][b][m][n] = (f32x4){0.f, 0.f, 0.f, 0.f};
        cur = nxt; cA = nA; cB = nB; ++ui;
    }
    PG8_WAIT_V(0);
    if (wr == 0) PG8_BAR;
    PG8_BAR;
#undef PG8_SA
#undef PG8_SB
#undef PG8_STAGE
#undef PG8_LDA
#undef PG8_LDB
#undef PG8_MMA
#undef PG8_WAIT_V
#undef PG8_WAIT_L
#undef PG8_BAR
#undef PG8_SCHED
}
}
typedef f32x4 Acc[2][2][4][2];

__device__ __forceinline__ LAS const float* fill_inv(LAS unsigned char* lds, const float* ssq) {
    LAS float* t = (LAS float*)(lds + LDS_INV); const int base = 2048 * (blockIdx.x & 7);
    for (int r = otid(); r < 2048; r += 512) t[r] = rowinv16(ssq, base + r);
    __syncthreads();
    return t;
}
struct EpiSwiglu {
    bf16_t* H; LAS const float* linv;
    __device__ __forceinline__ void operator()(const Acc& acc, const pg8::Unit& u, int wr, int wc, int fr, int fq) const {
        const int row0 = u.pm * 256 + wr * 64 + fr, col = u.pn * 128 + wc * 32 + 8 * fq;
#pragma unroll
        for (int ai = 0; ai < 2; ++ai)
#pragma unroll
            for (int m = 0; m < 4; ++m) {
                const int row = row0 + ai * 128 + m * 16; const float inv = linv ? linv[row & 2047] : 1.0f;
                f32x4 h0, h1;
#pragma unroll
                for (int j = 0; j < 4; ++j) { h0[j] = siluf_(acc[ai][0][m][0][j] * inv) * (acc[ai][1][m][0][j] * inv); h1[j] = siluf_(acc[ai][0][m][1][j] * inv) * (acc[ai][1][m][1][j] * inv); }
                *(u32x4*)(H + (size_t)row * FF + col) = pack8(h0, h1);
            }
    }
};
struct EpiResid {
    const float* xin; const bf16_t* xin_b; float* xout; bf16_t* xb; float* ssq; float alpha;
    __device__ __forceinline__ void operator()(const Acc& acc, const pg8::Unit& u, int wr, int wc, int fr, int fq) const {
        const int row0 = u.pm * 256 + wr * 64 + fr, col0 = u.pn * 256 + wc * 32 + 8 * fq;
#pragma unroll
        for (int ai = 0; ai < 2; ++ai) {
            f32x4 xv[4][2][2];
#pragma unroll
            for (int m = 0; m < 4; ++m)
#pragma unroll
                for (int bj = 0; bj < 2; ++bj) { const size_t o = (size_t)(row0 + ai * 128 + m * 16) * D + col0 + bj * 128;
                    if (xin_b) unpack8(*(const u32x4*)(xin_b + o), xv[m][bj][0], xv[m][bj][1]);
                    else { xv[m][bj][0] = *(const f32x4*)(xin + o); xv[m][bj][1] = *(const f32x4*)(xin + o + 4); } }
#pragma unroll
            for (int m = 0; m < 4; ++m) {
                const int row = row0 + ai * 128 + m * 16; float ss = 0.f;
#pragma unroll
                for (int bj = 0; bj < 2; ++bj) {
                    const size_t o = (size_t)row * D + col0 + bj * 128;
                    const f32x4 v0 = xv[m][bj][0] + alpha * acc[ai][bj][m][0], v1 = xv[m][bj][1] + alpha * acc[ai][bj][m][1];
                    if (xout) { *(f32x4*)(xout + o) = v0; *(f32x4*)(xout + o + 4) = v1; }
                    ss += (v0[0] * v0[0] + v0[1] * v0[1]) + (v0[2] * v0[2] + v0[3] * v0[3]) + (v1[0] * v1[0] + v1[1] * v1[1]) + (v1[2] * v1[2] + v1[3] * v1[3]);
                    if (xb) *(u32x4*)(xb + o) = pack8(v0, v1);
                }
                ss += __shfl_xor(ss, 16); ss += __shfl_xor(ss, 32);
                if (fq == 0) ssq[(size_t)row * 16 + u.pn * 4 + wc] = ss;
            }
        }
    }
};
struct EpiScaleBf16 {
    bf16_t* O; LAS const float* linv;
    __device__ __forceinline__ void operator()(const Acc& acc, const pg8::Unit& u, int wr, int wc, int fr, int fq) const {
        const int row0 = u.pm * 256 + wr * 64 + fr, col0 = u.pn * 256 + wc * 32 + 8 * fq;
#pragma unroll
        for (int ai = 0; ai < 2; ++ai)
#pragma unroll
            for (int m = 0; m < 4; ++m) {
                const int row = row0 + ai * 128 + m * 16; const float inv = linv[row & 2047];
#pragma unroll
                for (int bj = 0; bj < 2; ++bj) *(u32x4*)(O + (size_t)row * NPP + col0 + bj * 128) = pack8(acc[ai][bj][m][0] * inv, acc[ai][bj][m][1] * inv);
            }
    }
};
struct EpiGatesA {
    bf16_t* PP; LAS const float* linv; float* gssq;
    __device__ __forceinline__ void operator()(const Acc& acc, const pg8::Unit& u, int wr, int wc, int fr, int fq) const {
        const int row0 = u.pm * 256 + wr * 64 + fr, cw = wc * 32 + 8 * fq; const int pn = u.pn;
#pragma unroll
        for (int ai = 0; ai < 2; ++ai) {
            u32x4 sv[4][2];
#pragma unroll
            for (int m = 0; m < 4; ++m)
#pragma unroll
                for (int bj = 0; bj < 2; ++bj) sv[m][bj] = *(const u32x4*)(PP + (size_t)(row0 + ai * 128 + m * 16) * NPP + pn * 256 + bj * 128 + cw);
#pragma unroll
            for (int m = 0; m < 4; ++m) {
                const int row = row0 + ai * 128 + m * 16; const float inv = linv[row & 2047]; float ss = 0.f;
#pragma unroll
                for (int bj = 0; bj < 2; ++bj) {
                    const f32x4 a0 = acc[ai][bj][m][0] * inv, a1 = acc[ai][bj][m][1] * inv; f32x4 o0, o1;
                    bf16_t* p = PP + (size_t)row * NPP + pn * 256 + bj * 128 + cw; f32x4 s0, s1; unpack8(sv[m][bj], s0, s1);
                    if (pn < 4) {
#pragma unroll
                        for (int j = 0; j < 4; ++j) { o0[j] = gelu_tanh(a0[j]) * s0[j]; o1[j] = gelu_tanh(a1[j]) * s1[j]; }
                    } else {
#pragma unroll
                        for (int j = 0; j < 4; ++j) { o0[j] = siluf_(a0[j]) * s0[j]; o1[j] = siluf_(a1[j]) * s1[j]; ss += o0[j] * o0[j] + o1[j] * o1[j]; }
                    }
                    *(u32x4*)p = pack8(o0, o1);
                }
                if (pn >= 4) { ss += __shfl_xor(ss, 16); ss += __shfl_xor(ss, 32); if (fq == 0) gssq[(size_t)row * 32 + (pn - 4) * 4 + wc] = ss; }
            }
        }
    }
};
struct EpiSigmoid {
    bf16_t* O; int ldo; LAS const float* linv; const float* bias;
    __device__ __forceinline__ void operator()(const Acc& acc, const pg8::Unit& u, int wr, int wc, int fr, int fq) const {
        const int row0 = u.pm * 256 + wr * 64 + fr, col0 = u.pn * 256 + wc * 32 + 8 * fq;
#pragma unroll
        for (int ai = 0; ai < 2; ++ai)
#pragma unroll
            for (int m = 0; m < 4; ++m) {
                const int row = row0 + ai * 128 + m * 16; const float inv = linv[row & 2047];
#pragma unroll
                for (int bj = 0; bj < 2; ++bj) {
                    const int gc = col0 + bj * 128;
                    const f32x4 a0 = acc[ai][bj][m][0] * inv, a1 = acc[ai][bj][m][1] * inv; f32x4 o0, o1;
                    const f32x4 b0 = *(const f32x4*)(bias + gc), b1 = *(const f32x4*)(bias + gc + 4);
#pragma unroll
                    for (int j = 0; j < 4; ++j) { o0[j] = sigmoidf_(a0[j] + b0[j]); o1[j] = sigmoidf_(a1[j] + b1[j]); }
                    *(u32x4*)(O + (size_t)row * ldo + gc) = pack8(o0, o1);
                }
            }
    }
};
struct EpiBr {
    bf16_t* GA; const bf16_t* PP; int mode;
    __device__ __forceinline__ void operator()(const Acc& acc, const pg8::Unit& u, int wr, int wc, int fr, int fq) const {
        const int row0 = u.pm * 256 + wr * 64 + fr, col0 = u.pn * 256 + wc * 32 + 8 * fq;
#pragma unroll
        for (int ai = 0; ai < 2; ++ai) {
            u32x4 gv[4][2], hv[4][2];
#pragma unroll
            for (int m = 0; m < 4; ++m)
#pragma unroll
                for (int bj = 0; bj < 2; ++bj) { const int row = row0 + ai * 128 + m * 16; gv[m][bj] = *(const u32x4*)(GA + (size_t)row * D + col0 + bj * 128);
                    hv[m][bj] = (mode == 0) ? (u32x4){0u, 0u, 0u, 0u} : *(const u32x4*)(PP + (size_t)row * NPP + 3072 + col0 + bj * 128); }
#pragma unroll
            for (int m = 0; m < 4; ++m) {
                const int row = row0 + ai * 128 + m * 16;
#pragma unroll
                for (int bj = 0; bj < 2; ++bj) {
                    bf16_t* p = GA + (size_t)row * D + col0 + bj * 128; f32x4 g0, g1; unpack8(gv[m][bj], g0, g1);
                    if (mode == 0) { *(u32x4*)p = pack8(g0 * acc[ai][bj][m][0], g1 * acc[ai][bj][m][1]); }
                    else { f32x4 h0, h1; unpack8(hv[m][bj], h0, h1); *(u32x4*)p = pack8(g0 + h0 * acc[ai][bj][m][0], g1 + h1 * acc[ai][bj][m][1]); }
                }
            }
        }
    }
};

template <int NC, int NB, int K, class RM, class F>
__device__ __forceinline__ void small_gemm(LAS unsigned char* lds, const bf16_t* A, int lda, int M, const bf16_t* Bt, int ldb, int N,
                                           const float* rs_src, int rs_mode, RM rm, F f) {
    const int tid = otid(), wid = tid >> 6, lane = tid & 63, lr = lane & 15, kg = lane >> 4;
    LAS float* red = (LAS float*)lds;
    LAS float* invs = (LAS float*)(lds + 131072);
    const int nct = N / NC, items = (M / 16) * nct; constexpr int kw = K / 8;
    constexpr int CT = NC / 16;
    const int nrt = M / 16; const bool hoist = (rs_mode == 1) && (gridDim.x % nrt == 0); const int bix = gridDim.x - 1 - blockIdx.x;
    for (int it = bix; it < items; it += gridDim.x) {
        const int rt = it % nrt, ct = it / nrt, row0 = rt * 16, col0 = ct * NC;
        if (rs_mode == 1) { if (!(hoist && it != bix)) { const int r = tid >> 5, q = tid & 31; const float* p = rs_src + (size_t)(row0 + r) * D + q * 32; float s = 0.f;
            for (int j = 0; j < 32; j += 4) { const f32x4 v = *(const f32x4*)(p + j); s += v[0] * v[0] + v[1] * v[1] + v[2] * v[2] + v[3] * v[3]; }
            s += __shfl_xor(s, 1); s += __shfl_xor(s, 2); s += __shfl_xor(s, 4); s += __shfl_xor(s, 8); s += __shfl_xor(s, 16);
            if (q == 0) invs[r] = rsqrtf(s * (1.0f / 1024.0f) + EPS); } }
        else if (rs_mode == 2) { if (tid < 16) invs[tid] = rowinv16(rs_src, row0 + tid); }
        else { if (tid < 16) invs[tid] = 1.0f; }
        f32x4 acc[NB][CT];
#pragma unroll
        for (int p = 0; p < NB; ++p)
#pragma unroll
            for (int c = 0; c < CT; ++c) acc[p][c] = (f32x4){0.f, 0.f, 0.f, 0.f};
        const bf16_t* ap = A + (size_t)(row0 + lr) * lda + wid * kw + 8 * kg;
        const bf16_t* bp0 = Bt + (size_t)(rm(col0, 0) + lr) * ldb + wid * kw + 8 * kg;
        const bf16_t* bp1 = NB > 1 ? Bt + (size_t)(rm(col0, 1) + lr) * ldb + wid * kw + 8 * kg : bp0;
#pragma unroll
        for (int k = 0; k < kw; k += 32) {
            const bf16x8 a = *(const bf16x8*)(ap + k);
#pragma unroll
            for (int c = 0; c < CT; ++c) {
                const bf16x8 b = *(const bf16x8*)(bp0 + (size_t)c * 16 * ldb + k);
                acc[0][c] = __builtin_amdgcn_mfma_f32_16x16x32_bf16(a, b, acc[0][c], 0, 0, 0);
                if (NB > 1) { const bf16x8 b1 = *(const bf16x8*)(bp1 + (size_t)c * 16 * ldb + k); acc[NB - 1][c] = __builtin_amdgcn_mfma_f32_16x16x32_bf16(a, b1, acc[NB - 1][c], 0, 0, 0); }
            }
        }
#pragma unroll
        for (int p = 0; p < NB; ++p)
#pragma unroll
            for (int c = 0; c < CT; ++c)
#pragma unroll
                for (int r = 0; r < 4; ++r) red[((wid * NB + p) * 16 + 4 * kg + r) * NC + 16 * c + lr] = acc[p][c][r];
        __syncthreads();
        for (int e = tid; e < 16 * NC; e += 512) {
            float v0 = 0.f, v1 = 0.f;
#pragma unroll
            for (int w = 0; w < 8; ++w) { v0 += red[(w * NB) * 16 * NC + e]; if (NB > 1) v1 += red[(w * NB + 1) * 16 * NC + e]; }
            const int r = e / NC, c = e % NC;
            f(row0 + r, col0 + c, v0, v1, invs[r]);
        }
        __syncthreads();
    }
}

template <int NC, int NB, int K, class RM, class F>
__device__ __forceinline__ void sgemm(LAS unsigned char* lds, const bf16_t* A, int lda, const bf16_t* Bt, int ldb, int N, const float* ssq_src, float* ssq_out, RM rm, F f, int nblk = 0) {
    const int tid = otid(), wid = tid >> 6, lane = tid & 63, lr = lane & 15, kg = lane >> 4;
    constexpr int CT = NC / 16, KW = K / 8;
    LAS float* red = (LAS float*)lds;
    const int items = N / NC, bix = gridDim.x - 1 - blockIdx.x; if (nblk == 0) nblk = gridDim.x;
    LAS float* invs = (LAS float*)(lds + LDS_INV);
    if (bix < items && bix < nblk) {
        if (ssq_src) { const int row = tid >> 2, q = tid & 3; float sm = 0.f;
#pragma unroll
            for (int j = 0; j < 16; j += 4) { const f32x4 v = *(const f32x4*)(ssq_src + row * 64 + q * 16 + j); sm += (v[0] + v[1]) + (v[2] + v[3]); }
            sm += __shfl_xor(sm, 1); sm += __shfl_xor(sm, 2);
            if (q == 0) invs[row] = rsqrtf(sm * (1.0f / 1024.0f) + EPS); }
        else if (tid < 128) invs[tid] = 1.0f;
        __syncthreads();
    }
    for (int it = bix; it < items && bix < nblk; it += nblk) {
        const int col0 = it * NC;
        f32x4 acc[8][NB][CT];
#pragma unroll
        for (int t = 0; t < 8; ++t)
#pragma unroll
            for (int p = 0; p < NB; ++p)
#pragma unroll
                for (int c = 0; c < CT; ++c) acc[t][p][c] = (f32x4){0.f, 0.f, 0.f, 0.f};
        const bf16_t* ap = A + (size_t)lr * lda + wid * KW + 8 * kg;
        const bf16_t* bp0 = Bt + (size_t)(rm(col0, 0) + lr) * ldb + wid * KW + 8 * kg;
        const bf16_t* bp1 = NB > 1 ? Bt + (size_t)(rm(col0, 1) + lr) * ldb + wid * KW + 8 * kg : bp0;
#pragma unroll 4
        for (int k = 0; k < KW; k += 32) {
            bf16x8 bf[NB][CT];
#pragma unroll
            for (int c = 0; c < CT; ++c) { bf[0][c] = *(const bf16x8*)(bp0 + (size_t)c * 16 * ldb + k); if (NB > 1) bf[NB - 1][c] = *(const bf16x8*)(bp1 + (size_t)c * 16 * ldb + k); }
#pragma unroll
            for (int t = 0; t < 8; ++t) { const bf16x8 a = *(const bf16x8*)(ap + (size_t)t * 16 * lda + k);
#pragma unroll
                for (int p = 0; p < NB; ++p)
#pragma unroll
                    for (int c = 0; c < CT; ++c) acc[t][p][c] = __builtin_amdgcn_mfma_f32_16x16x32_bf16(a, bf[p][c], acc[t][p][c], 0, 0, 0); }
        }
#pragma unroll
        for (int t = 0; t < 8; ++t)
#pragma unroll
            for (int p = 0; p < NB; ++p)
#pragma unroll
                for (int c = 0; c < CT; ++c)
#pragma unroll
                    for (int r = 0; r < 4; ++r) red[((((wid * 8 + t) * NB + p) * CT + c) * 16 + 4 * kg + r) * 16 + lr] = acc[t][p][c][r];
        __syncthreads();
        for (int e = tid; e < 128 * NC; e += 512) {
            const int row = e / NC, col = e % NC, t = row >> 4, rr = row & 15, c = col >> 4, cl = col & 15;
            float v0 = 0.f, v1 = 0.f;
#pragma unroll
            for (int w = 0; w < 8; ++w) { v0 += red[((((w * 8 + t) * NB + 0) * CT + c) * 16 + rr) * 16 + cl]; if (NB > 1) v1 += red[((((w * 8 + t) * NB + (NB - 1)) * CT + c) * 16 + rr) * 16 + cl]; }
            float sq = f(row, col0 + col, v0, v1, invs[row]);
            if (ssq_out) { sq *= sq; sq += __shfl_xor(sq, 1); sq += __shfl_xor(sq, 2); sq += __shfl_xor(sq, 4); sq += __shfl_xor(sq, 8); if (NC > 16) sq += __shfl_xor(sq, 16);
                if ((col & (NC - 1)) == 0) ssq_out[row * 64 + it] = sq; }
        }
        __syncthreads();
    }
}

template <int CT, int NB, int K, class RM, class F>
__device__ __forceinline__ void wave_gemm(LAS unsigned char* lds, const bf16_t* A, int lda, const bf16_t* Bt, int ldb, int N, const float* rs_src, RM rm, F f) {
    const int tid = otid(), wid = tid >> 6, lane = tid & 63, lr = lane & 15, kg = lane >> 4;
    const int bix = gridDim.x - 1 - blockIdx.x, rt = bix & 7, row0 = rt * 16, nct = N / (16 * CT);
    LAS float* invs = (LAS float*)(lds + LDS_INV);
    if (rs_src) { const int r = tid >> 5, q = tid & 31; const float* p = rs_src + (size_t)(row0 + r) * D + q * 32; float s = 0.f;
        for (int j = 0; j < 32; j += 4) { const f32x4 v = *(const f32x4*)(p + j); s += v[0] * v[0] + v[1] * v[1] + v[2] * v[2] + v[3] * v[3]; }
        s += __shfl_xor(s, 1); s += __shfl_xor(s, 2); s += __shfl_xor(s, 4); s += __shfl_xor(s, 8); s += __shfl_xor(s, 16);
        if (q == 0) invs[r] = rsqrtf(s * (1.0f / 1024.0f) + EPS); }
    else if (tid < 16) invs[tid] = 1.0f;
    __syncthreads();
    for (int ct = (bix >> 3) * 8 + wid; ct < nct; ct += (gridDim.x >> 3) * 8) {
        const int col0 = ct * 16 * CT;
        f32x4 acc[NB][CT];
#pragma unroll
        for (int p = 0; p < NB; ++p)
#pragma unroll
            for (int c = 0; c < CT; ++c) acc[p][c] = (f32x4){0.f, 0.f, 0.f, 0.f};
        const bf16_t* ap = A + (size_t)(row0 + lr) * lda + 8 * kg;
        const bf16_t* bp0 = Bt + (size_t)(rm(col0, 0) + lr) * ldb + 8 * kg;
        const bf16_t* bp1 = NB > 1 ? Bt + (size_t)(rm(col0, 1) + lr) * ldb + 8 * kg : bp0;
#pragma unroll 4
        for (int k = 0; k < K; k += 32) {
            const bf16x8 a = *(const bf16x8*)(ap + k);
#pragma unroll
            for (int c = 0; c < CT; ++c) {
                const bf16x8 b = *(const bf16x8*)(bp0 + (size_t)c * 16 * ldb + k);
                acc[0][c] = __builtin_amdgcn_mfma_f32_16x16x32_bf16(a, b, acc[0][c], 0, 0, 0);
                if (NB > 1) { const bf16x8 b1 = *(const bf16x8*)(bp1 + (size_t)c * 16 * ldb + k); acc[NB - 1][c] = __builtin_amdgcn_mfma_f32_16x16x32_bf16(a, b1, acc[NB - 1][c], 0, 0, 0); }
            }
        }
#pragma unroll
        for (int c = 0; c < CT; ++c)
#pragma unroll
            for (int r = 0; r < 4; ++r) f(row0 + 4 * kg + r, col0 + 16 * c + lr, acc[0][c][r], NB > 1 ? acc[NB - 1][c][r] : 0.f, invs[4 * kg + r]);
    }
    __syncthreads();
}

struct Ctx { const float* const* in; float* out; unsigned char* ws; LAS unsigned char* lds; };

__device__ __forceinline__ void tp_tile(LAS float* tile, const float* src, int sld, int sc0, int k0, bf16_t* dst, int dld, int dr0, int dk0, const float* scale, int ncv) {
    const int lane = otid() & 63;
    float v[64];
    const float* sp = src + (size_t)k0 * sld + sc0 + lane;
#pragma unroll
    for (int kk = 0; kk < 64; ++kk) v[kk] = (lane < ncv) ? sp[(size_t)kk * sld] : 0.f;
    if (scale) {
#pragma unroll
        for (int kk = 0; kk < 64; ++kk) v[kk] *= scale[k0 + kk];
    }
#pragma unroll
    for (int kk = 0; kk < 64; ++kk) tile[kk * 65 + lane] = v[kk];
    const int j = lane & 7;
#pragma unroll
    for (int ps = 0; ps < 8; ++ps) { const int cc = (lane >> 3) + 8 * ps;
        float x[8];
#pragma unroll
        for (int i = 0; i < 8; ++i) x[i] = tile[(8 * j + i) * 65 + cc];
        u32x4 w; w.x = cvt_pk_bf16(x[0], x[1]); w.y = cvt_pk_bf16(x[2], x[3]); w.z = cvt_pk_bf16(x[4], x[5]); w.w = cvt_pk_bf16(x[6], x[7]);
        if (cc < ncv) *(u32x4*)(dst + (size_t)(dr0 + cc) * dld + dk0 + 8 * j) = w; }
}
__device__ __forceinline__ void prep_weights(const Ctx& c) {
    const int wv_ = __builtin_amdgcn_readfirstlane(otid() >> 6); LAS float* tile = (LAS float*)c.lds + wv_ * (64 * 65); unsigned char* ws = c.ws;
    constexpr int N_UP = 1408, N_DN = 704, N_IN = 2304, N_DT = 16, N_BRL = 256, N_BRS = 512, N_OUT = 256, N_RG = 32;
    constexpr int TOT = 2 * N_UP + 2 * N_DN + N_IN + N_DT + N_BRL + N_BRS + N_OUT + 2 * N_RG;
    for (int ti0 = blockIdx.x * 8 + wv_; ti0 < TOT; ti0 += gridDim.x * 8) {
        int ti = ti0;
        if (ti < 2 * N_UP) { const int l = ti >= N_UP; if (l) ti -= N_UP;
            const int j = ti >> 5, r = ti & 31, pn = j >> 1, panel = j & 1, ct = r >> 4, kt = r & 15;
            tp_tile(tile, c.in[l ? 29 : 7], 2 * FF, panel * FF + 128 * pn + 64 * ct, 64 * kt, (bf16_t*)(ws + (l ? OFF_WUP2 : OFF_WUP1)), D, 256 * pn + 128 * panel + 64 * ct, 64 * kt, l ? c.in[28] : nullptr, 64);
            continue; }
        ti -= 2 * N_UP;
        if (ti < 2 * N_DN) { const int l = ti >= N_DN; if (l) ti -= N_DN;
            const int nt = ti / 44, kt = ti % 44;
            tp_tile(tile, c.in[l ? 30 : 8], D, 64 * nt, 64 * kt, (bf16_t*)(ws + (l ? OFF_WDN2 : OFF_WDN1)), FF, 64 * nt, 64 * kt, nullptr, 64);
            continue; }
        ti -= 2 * N_DN;
        if (ti < N_IN) { const int nt = ti >> 4, kt = ti & 15, n0 = 64 * nt;
            const int sc = n0 < 1024 ? n0 : (n0 < 4096 ? n0 + 3072 : (n0 < 7168 ? n0 - 3072 : n0 + 32));
            tp_tile(tile, c.in[10], 9248, sc, 64 * kt, (bf16_t*)(ws + OFF_WIN), D, n0, 64 * kt, c.in[9], 64);
            continue; }
        ti -= N_IN;
        if (ti < N_DT) { tp_tile(tile, c.in[10], 9248, 7168, 64 * ti, (bf16_t*)(ws + OFF_WDT), D, 0, 64 * ti, c.in[9], 32); continue; }
        ti -= N_DT;
        if (ti < N_BRL) { const int nt = ti >> 4, kt = ti & 15; tp_tile(tile, c.in[25], D, 64 * nt, 64 * kt, (bf16_t*)(ws + OFF_WBR), 3072, 64 * nt, 64 * kt, nullptr, 64); continue; }
        ti -= N_BRL;
        if (ti < N_BRS) { const int nt = ti >> 5, kt = ti & 31; tp_tile(tile, c.in[26], D, 64 * nt, 64 * kt, (bf16_t*)(ws + OFF_WBR), 3072, 64 * nt, 1024 + 64 * kt, c.in[24], 64); continue; }
        ti -= N_BRS;
        if (ti < N_OUT) { const int nt = ti >> 4, kt = ti & 15; tp_tile(tile, c.in[27], D, 64 * nt, 64 * kt, (bf16_t*)(ws + OFF_WOUT), D, 64 * nt, 64 * kt, nullptr, 64); continue; }
        ti -= N_OUT;
        { const int l = ti >= N_RG; if (l) ti -= N_RG; const int h = ti >> 2, nt = (ti >> 1) & 1, kt = ti & 1;
          tp_tile(tile, c.in[l ? 16 : 14] + h * 16384, 128, 64 * nt, 64 * kt, (bf16_t*)(ws + (l ? OFF_WIG : OFF_WRG)) + h * 16384, 128, 64 * nt, 64 * kt, nullptr, 64); }
    }
}
__device__ __forceinline__ void rmsnorm_rows_bf16(const float* x, int nrows, const float* g, bf16_t* dst) {
    const int t_ = otid(), lane = t_ & 63, gw = blockIdx.x * 8 + (t_ >> 6), nw = gridDim.x * 8;
    f32x4 gg[4];
#pragma unroll
    for (int i = 0; i < 4; ++i) gg[i] = *(const f32x4*)(g + (i * 64 + lane) * 4);
    for (int r = gw; r < nrows; r += 2 * nw) {
        const int r2 = r + nw; const bool two = r2 < nrows;
        const float* p = x + (size_t)r * D; const float* p2 = x + (size_t)(two ? r2 : r) * D; f32x4 v[4], w[4]; float s = 0.f, s2 = 0.f;
#pragma unroll
        for (int i = 0; i < 4; ++i) { v[i] = *(const f32x4*)(p + (i * 64 + lane) * 4); w[i] = *(const f32x4*)(p2 + (i * 64 + lane) * 4); }
#pragma unroll
        for (int i = 0; i < 4; ++i) { s += v[i][0] * v[i][0] + v[i][1] * v[i][1] + v[i][2] * v[i][2] + v[i][3] * v[i][3]; s2 += w[i][0] * w[i][0] + w[i][1] * w[i][1] + w[i][2] * w[i][2] + w[i][3] * w[i][3]; }
#pragma unroll
        for (int o = 1; o < 64; o <<= 1) { s += __shfl_xor(s, o); s2 += __shfl_xor(s2, o); }
        const float inv = rsqrtf(s * (1.0f / 1024.0f) + EPS), inv2 = rsqrtf(s2 * (1.0f / 1024.0f) + EPS);
#pragma unroll
        for (int i = 0; i < 4; ++i) { const int cc = (i * 64 + lane) * 4; const f32x4 o = v[i] * inv * gg[i];
            unsigned* q = (unsigned*)(dst + (size_t)r * D + cc); q[0] = cvt_pk_bf16(o[0], o[1]); q[1] = cvt_pk_bf16(o[2], o[3]);
            if (two) { const f32x4 o2 = w[i] * inv2 * gg[i]; unsigned* q2 = (unsigned*)(dst + (size_t)r2 * D + cc); q2[0] = cvt_pk_bf16(o2[0], o2[1]); q2[1] = cvt_pk_bf16(o2[2], o2[3]); } }
    }
}
__device__ __forceinline__ void rmsnorm_rows_f32(float* x, int nrows, const float* g) {
    const int t_ = otid(), lane = t_ & 63, gw = blockIdx.x * 8 + (t_ >> 6), nw = gridDim.x * 8;
    f32x4 gg[4];
#pragma unroll
    for (int i = 0; i < 4; ++i) gg[i] = *(const f32x4*)(g + (i * 64 + lane) * 4);
    for (int r = gw; r < nrows; r += 2 * nw) {
        const int r2 = r + nw; const bool two = r2 < nrows;
        float* p = x + (size_t)r * D; float* p2 = x + (size_t)(two ? r2 : r) * D; f32x4 v[4], w[4]; float s = 0.f, s2 = 0.f;
#pragma unroll
        for (int i = 0; i < 4; ++i) { v[i] = *(const f32x4*)(p + (i * 64 + lane) * 4); w[i] = *(const f32x4*)(p2 + (i * 64 + lane) * 4); }
#pragma unroll
        for (int i = 0; i < 4; ++i) { s += v[i][0] * v[i][0] + v[i][1] * v[i][1] + v[i][2] * v[i][2] + v[i][3] * v[i][3]; s2 += w[i][0] * w[i][0] + w[i][1] * w[i][1] + w[i][2] * w[i][2] + w[i][3] * w[i][3]; }
#pragma unroll
        for (int o = 1; o < 64; o <<= 1) { s += __shfl_xor(s, o); s2 += __shfl_xor(s2, o); }
        const float inv = rsqrtf(s * (1.0f / 1024.0f) + EPS), inv2 = rsqrtf(s2 * (1.0f / 1024.0f) + EPS);
#pragma unroll
        for (int i = 0; i < 4; ++i) { const int cc = (i * 64 + lane) * 4; *(f32x4*)(p + cc) = v[i] * inv * gg[i]; if (two) *(f32x4*)(p2 + cc) = w[i] * inv2 * gg[i]; }
    }
}

template <bool FINAL>
__device__ __forceinline__ void lru_chunk(const Ctx& c, int b, int ch, bool dry = false) {
    const int tid = otid(), wid = tid >> 6, lane = tid & 63, lr = lane & 15, kg = lane >> 4;
    LAS float* XC = (LAS float*)c.lds; LAS float* AA = (LAS float*)(c.lds + 32768); LAS float* UU = (LAS float*)(c.lds + 65536); LAS unsigned char* XCb = c.lds + 98304;
    bf16_t* PP = (bf16_t*)(c.ws + OFF_PP); bf16_t* HALO = (bf16_t*)(c.ws + OFF_HALO); float* SUMM = (float*)(c.ws + OFF_SUMM);
    const bf16_t* WRG = (const bf16_t*)(c.ws + OFF_WRG); const bf16_t* WIG = (const bf16_t*)(c.ws + OFF_WIG);
    const float* cw = c.in[12]; const float* cb = c.in[13]; const float* brg = c.in[15]; const float* big = c.in[17]; const float* lam = c.in[18];
    const int t0 = b * SEQ + 64 * ch;
    LAS float* CARRY = (LAS float*)(c.lds + 115712);
    if (FINAL) {
        float h0 = 0.f, h1 = 0.f;
        for (int cp = 0; cp < ch; cp += 8) {
            float a0[8], b0[8], a1[8], b1[8];
#pragma unroll
            for (int i = 0; i < 8; ++i) { a0[i] = 1.f; b0[i] = 0.f; a1[i] = 1.f; b1[i] = 0.f;
                if (cp + i < ch) { const float* sp = SUMM + ((size_t)(b * NCH + cp + i) * D + tid) * 2; a0[i] = sp[0]; b0[i] = sp[1]; a1[i] = sp[1024]; b1[i] = sp[1025]; } }
#pragma unroll
            for (int i = 0; i < 8; ++i) { h0 = a0[i] * h0 + b0[i]; h1 = a1[i] * h1 + b1[i]; }
        }
        CARRY[tid] = h0; CARRY[tid + 512] = h1;
    }
    const int cg8 = tid & 15, tk = (tid >> 4) * 2;
    u32x4 rawp[5]; f32x4 wk[4][2], bb[2]; bf16x8 wrf[4], wif[4]; float pb1 = 0.f, pb2 = 0.f, plam = 0.f;
#define LRU_FETCH(hd) do { const int cc0_ = 128 * (hd) + 8 * cg8; \
        _Pragma("unroll") for (int i = 0; i < 5; ++i) { const int tt = tk - 3 + i; rawp[i] = (u32x4){0u, 0u, 0u, 0u}; \
            if (tt >= 0) rawp[i] = *(const u32x4*)(PP + (size_t)(t0 + tt) * NPP + cc0_); \
            else if (ch > 0) rawp[i] = *(const u32x4*)(HALO + ((size_t)((b * NCH + ch - 1) * 3 + (tt + 3))) * D + cc0_); } \
        _Pragma("unroll") for (int k = 0; k < 4; ++k) { wk[k][0] = *(const f32x4*)(cw + k * D + cc0_); wk[k][1] = *(const f32x4*)(cw + k * D + cc0_ + 4); } \
        bb[0] = *(const f32x4*)(cb + cc0_); bb[1] = *(const f32x4*)(cb + cc0_ + 4); } while (0)
#define LRU_FETCHW(hd) do { \
        { const int cgl_ = 128 * (hd) + 16 * wid + lr; const bf16_t* wr__ = WRG + (size_t)cgl_ * 128 + 8 * kg; const bf16_t* wi__ = WIG + (size_t)cgl_ * 128 + 8 * kg; \
          _Pragma("unroll") for (int ks = 0; ks < 4; ++ks) { wrf[ks] = *(const bf16x8*)(wr__ + 32 * ks); wif[ks] = *(const bf16x8*)(wi__ + 32 * ks); } \
          pb1 = brg[cgl_]; pb2 = big[cgl_]; plam = lam[cgl_]; } } while (0)
    LRU_FETCH(0); LRU_FETCHW(0);
    for (int head = 0; head < 8; ++head) {
        const int ch0 = 128 * head;
        {
            f32x4 raw[5][2];
#pragma unroll
            for (int i = 0; i < 5; ++i) unpack8(rawp[i], raw[i][0], raw[i][1]);
#pragma unroll
            for (int q = 0; q < 2; ++q) { f32x4 o0 = bb[0], o1 = bb[1];
#pragma unroll
                for (int k = 0; k < 4; ++k) { o0 += wk[k][0] * raw[q + k][0]; o1 += wk[k][1] * raw[q + k][1]; }
                *(LAS f32x4*)(XC + (tk + q) * 128 + 8 * cg8) = o0; *(LAS f32x4*)(XC + (tk + q) * 128 + 8 * cg8 + 4) = o1;
                *(LAS u32x4*)A256(XCb, tk + q, cg8) = pack8(o0, o1); }
            if (head < 7) LRU_FETCH(head + 1);
        }
        __syncthreads();
        {
            f32x4 ar[4], ai_[4];
#pragma unroll
            for (int m = 0; m < 4; ++m) { ar[m] = (f32x4){0.f, 0.f, 0.f, 0.f}; ai_[m] = (f32x4){0.f, 0.f, 0.f, 0.f}; }
#pragma unroll
            for (int ks = 0; ks < 4; ++ks) { const bf16x8 br = wrf[ks], bi = wif[ks];
#pragma unroll
                for (int m = 0; m < 4; ++m) { const bf16x8 a = *(const LAS bf16x8*)A256(XCb, 16 * m + lr, 4 * ks + kg);
                    ar[m] = __builtin_amdgcn_mfma_f32_16x16x32_bf16(a, br, ar[m], 0, 0, 0); ai_[m] = __builtin_amdgcn_mfma_f32_16x16x32_bf16(a, bi, ai_[m], 0, 0, 0); } }
            const int cl = 16 * wid + lr; const float b1 = pb1, b2 = pb2, sp = softplusf_(-plam);
            if (head < 7) LRU_FETCHW(head + 1);
#pragma unroll
            for (int m = 0; m < 4; ++m)
#pragma unroll
                for (int r = 0; r < 4; ++r) { const int tk = 16 * m + 4 * kg + r; const float rg = sigmoidf_(ar[m][r] + b1), ig = sigmoidf_(ai_[m][r] + b2);
                    const float la = -8.0f * rg * sp, a_ = __expf(la); const float u = __builtin_amdgcn_sqrtf(fmaxf(1.0f - a_ * a_, 0.0f)) * ig * XC[tk * 128 + cl];
                    AA[tk * 128 + cl] = la; UU[tk * 128 + cl] = u; }
        }
        __syncthreads();
        if (!FINAL) {
            const int cg8s = tid & 15, tks = (tid >> 4) * 2;
#pragma unroll
            for (int q = 0; q < 2; ++q) { const f32x4 o0 = *(const LAS f32x4*)(UU + (tks + q) * 128 + 8 * cg8s), o1 = *(const LAS f32x4*)(UU + (tks + q) * 128 + 8 * cg8s + 4);
                const f32x4 l0 = *(const LAS f32x4*)(AA + (tks + q) * 128 + 8 * cg8s), l1 = *(const LAS f32x4*)(AA + (tks + q) * 128 + 8 * cg8s + 4);
                *(u32x4*)(PP + (size_t)(t0 + tks + q) * NPP + ch0 + 8 * cg8s) = pack8(o0, o1); *(u32x4*)(PP + (size_t)(t0 + tks + q) * NPP + 3072 + ch0 + 8 * cg8s) = pack8(l0, l1); } }
        if (tid < 128) { const int cgl = ch0 + tid;
            if (!FINAL) { float A = 1.f, H = 0.f;
                for (int t8 = 0; t8 < 64; t8 += 16) { float av[16], uv[16];
#pragma unroll
                    for (int i = 0; i < 16; ++i) { av[i] = AA[(t8 + i) * 128 + tid]; uv[i] = UU[(t8 + i) * 128 + tid]; }
#pragma unroll
                    for (int i = 0; i < 16; ++i) { const float a_ = __expf(av[i]); H = a_ * H + uv[i]; A *= a_; } }
                float* s = SUMM + ((size_t)(b * NCH + ch) * D + cgl) * 2; s[0] = A; s[1] = H; }
            else { float h = CARRY[cgl];
                for (int t8 = 0; t8 < 64; t8 += 16) { float av[16], uv[16];
#pragma unroll
                    for (int i = 0; i < 16; ++i) { av[i] = AA[(t8 + i) * 128 + tid]; uv[i] = UU[(t8 + i) * 128 + tid]; }
#pragma unroll
                    for (int i = 0; i < 16; ++i) { h = av[i] * h + uv[i]; UU[(t8 + i) * 128 + tid] = h; } }
                if (ch == NCH - 1) c.out[O_LHP + b * D + cgl] = h; } }
        __syncthreads();
        if (FINAL) { const int cg8 = tid & 15, tk = (tid >> 4) * 2;
#pragma unroll
            for (int q = 0; q < 2; ++q) { const f32x4 o0 = *(const LAS f32x4*)(UU + (tk + q) * 128 + 8 * cg8), o1 = *(const LAS f32x4*)(UU + (tk + q) * 128 + 8 * cg8 + 4);
                if (!dry) *(u32x4*)(PP + (size_t)(t0 + tk + q) * NPP + ch0 + 8 * cg8) = pack8(o0, o1); }
            __syncthreads(); }
    }
}

__device__ __forceinline__ void lru_final(const Ctx& c, int b, int ch) {
    const int tid = otid(); bf16_t* PP = (bf16_t*)(c.ws + OFF_PP); const float* SUMM = (const float*)(c.ws + OFF_SUMM);
    const int t0 = b * SEQ + 64 * ch, c2 = 2 * tid;
    float h0 = 0.f, h1 = 0.f;
    for (int cp = 0; cp < ch; cp += 8) {
        f32x4 sv[8];
#pragma unroll
        for (int i = 0; i < 8; ++i) { sv[i] = (f32x4){1.f, 0.f, 1.f, 0.f}; if (cp + i < ch) sv[i] = *(const f32x4*)(SUMM + ((size_t)(b * NCH + cp + i) * D + c2) * 2); }
#pragma unroll
        for (int i = 0; i < 8; ++i) { h0 = sv[i][0] * h0 + sv[i][1]; h1 = sv[i][2] * h1 + sv[i][3]; }
    }
    for (int t8 = 0; t8 < 64; t8 += 16) {
        unsigned uu[16], ll[16];
#pragma unroll
        for (int i = 0; i < 16; ++i) { const bf16_t* p = PP + (size_t)(t0 + t8 + i) * NPP + c2; uu[i] = *(const unsigned*)p; ll[i] = *(const unsigned*)(p + 3072); }
#pragma unroll
        for (int i = 0; i < 16; ++i) { h0 = __expf(bflo(ll[i])) * h0 + bflo(uu[i]); h1 = __expf(bfhi(ll[i])) * h1 + bfhi(uu[i]);
            *(unsigned*)(PP + (size_t)(t0 + t8 + i) * NPP + c2) = cvt_pk_bf16(h0, h1); }
    }
    if (ch == NCH - 1) { c.out[O_LHP + b * D + c2] = h0; c.out[O_LHP + b * D + c2 + 1] = h1; }
}

__device__ __forceinline__ void bc_conv(const Ctx& c, int b, int ch) {
    const int tid = otid(); const bf16_t* PP = (const bf16_t*)(c.ws + OFF_PP); bf16_t* BCc = (bf16_t*)(c.ws + OFF_XN);
    const float* cw = c.in[19]; const float* cb = c.in[20]; const int t0 = b * SEQ + 64 * ch;
    if (tid < 384) { const int row = tid >> 7, cg8 = tid & 127;
        *(u32x4*)((bf16_t*)(c.ws + OFF_HALO) + ((size_t)((b * NCH + ch) * 3 + row)) * D + 8 * cg8) = *(const u32x4*)(PP + (size_t)(t0 + 61 + row) * NPP + 8 * cg8); }
#pragma unroll 1
    for (int item = tid; item < 1024; item += 512) {
        const int cgq = item & 127, st = item >> 7, gcol = 3072 + 8 * cgq, ccol = 2048 + 8 * cgq;
        u32x4 raw[11];
#pragma unroll
        for (int i = 0; i < 11; ++i) { const int tt = 8 * st - 3 + i; raw[i] = (u32x4){0u, 0u, 0u, 0u}; if (tt >= 0 || ch > 0) raw[i] = *(const u32x4*)(PP + (size_t)(t0 + tt) * NPP + gcol); }
#pragma unroll
        for (int hf = 0; hf < 2; ++hf) {
            f32x4 wk[4]; const f32x4 bb = *(const f32x4*)(cb + ccol + 4 * hf);
#pragma unroll
            for (int k = 0; k < 4; ++k) wk[k] = *(const f32x4*)(cw + k * 3072 + ccol + 4 * hf);
#pragma unroll
            for (int q = 0; q < 8; ++q) { f32x4 o = bb;
#pragma unroll
                for (int k = 0; k < 4; ++k) { const unsigned w0 = raw[q + k][2 * hf], w1 = raw[q + k][2 * hf + 1]; const f32x4 r = (f32x4){bflo(w0), bfhi(w0), bflo(w1), bfhi(w1)}; o += wk[k] * r; }
#pragma unroll
                for (int j = 0; j < 4; ++j) o[j] = siluf_(o[j]);
                unsigned* op = (unsigned*)(BCc + (size_t)(t0 + 8 * st + q) * 1024 + 8 * cgq + 4 * hf); op[0] = cvt_pk_bf16(o[0], o[1]); op[1] = cvt_pk_bf16(o[2], o[3]); }
        }
    }
}

__device__ __forceinline__ void ssd_seq(const Ctx& c, int b, int h, bool dry = false) {
    const int tid = otid(), wid = tid >> 6, lane = tid & 63, lr = lane & 15, kg = lane >> 4;
    LAS unsigned char* L = c.lds;
    LAS unsigned char* Cm = L; LAS unsigned char* Bm = L + 16384; LAS unsigned char* BdT = L + 32768; LAS unsigned char* Sb = L + 49152;
    LAS unsigned char* XdT = L + 65536; LAS unsigned char* Xr = L + 73728; LAS unsigned char* Mm = L + 82944;
    LAS float* dts = (LAS float*)(L + 91136); LAS float* css = (LAS float*)(L + 91392); LAS float* dec = (LAS float*)(L + 91648); LAS bf16_t* halo = (LAS bf16_t*)(L + 91904);
    bf16_t* PP = (bf16_t*)(c.ws + OFF_PP); const float* DT = (const float*)(c.ws + OFF_DT);
    const float* cw = c.in[19]; const float* cb = c.in[20];
    const int g = h >> 3;
    const float Ah = -__expf(c.in[22][h]), Dh = c.in[23][h], dtb = c.in[21][h];
    f32x4 accS[4];
#pragma unroll
    for (int m = 0; m < 4; ++m) accS[m] = (f32x4){0.f, 0.f, 0.f, 0.f};
    for (int e = tid; e < 64 * 128; e += 512) ((LAS bf16_t*)Sb)[e] = 0;
    const bf16_t* BCc = (const bf16_t*)(c.ws + OFF_XN);
    const int role = tid >> 7, rt = tid & 127;
    const int xg = rt & 7, xst = rt >> 3;
    const int bg8 = rt & 15, bst = rt >> 4;
    const int gcol = 1024 + 64 * h + 8 * xg, ccol = 64 * h + 8 * xg;
    const int bcol = (role == 2 ? 512 : 0) + 128 * g + 8 * bg8;
    u32x4 raw[8]; float dtv = 0.f;
    f32x4 wkk[2][4], bbb[2];
#pragma unroll
    for (int hf = 0; hf < 2; ++hf) { bbb[hf] = *(const f32x4*)(cb + ccol + 4 * hf);
#pragma unroll
        for (int k = 0; k < 4; ++k) wkk[hf][k] = *(const f32x4*)(cw + k * 3072 + ccol + 4 * hf); }
    {
        const int t0 = b * SEQ;
        if (role == 0) {
#pragma unroll
            for (int i = 0; i < 7; ++i) { const int tt = 4 * xst - 3 + i; raw[i] = (u32x4){0u, 0u, 0u, 0u}; if (tt >= 0) raw[i] = *(const u32x4*)(PP + (size_t)(t0 + tt) * NPP + gcol); } }
        else if (role < 3) {
#pragma unroll
            for (int i = 0; i < 8; ++i) raw[i] = *(const u32x4*)(BCc + (size_t)(t0 + 8 * bst + i) * 1024 + bcol); }
        if (wid == 0) dtv = DT[(size_t)(t0 + lane) * 32 + h];
    }
    for (int ch = 0; ch < NCH; ++ch) {
        const int t0 = b * SEQ + 64 * ch;
        if (wid == 0) {
            const float d = softplusf_(dtv + dtb); float sc = d * Ah;
#pragma unroll
            for (int o = 1; o < 64; o <<= 1) { const float v = __shfl_up(sc, o); if (lane >= o) sc += v; }
            const float ce = __shfl(sc, 63);
            dts[lane] = d; css[lane] = sc; dec[lane] = __expf(ce - sc);
        }
        __syncthreads();
        if (role == 0) {
            if (xst == 0 && ch > 0) {
#pragma unroll
                for (int i = 0; i < 3; ++i) raw[i] = *(const LAS u32x4*)(halo + ((ch - 1) & 1) * 192 + i * 64 + 8 * xg); }
            if (xst == 15) {
#pragma unroll
                for (int i = 0; i < 3; ++i) *(LAS u32x4*)(halo + (ch & 1) * 192 + i * 64 + 8 * xg) = raw[4 + i];
                if (ch == NCH - 1 && !dry) {
#pragma unroll
                    for (int r = 0; r < 3; ++r) { f32x4 v0, v1; unpack8(raw[4 + r], v0, v1); float* o = c.out + O_SCP + (size_t)(b * 3 + r) * 3072 + ccol; *(f32x4*)o = v0; *(f32x4*)(o + 4) = v1; } } }
            const int chunk = (xst >> 1) ^ xg;
#pragma unroll
            for (int hf = 0; hf < 2; ++hf) {
                unsigned tq[4][2];
#pragma unroll
                for (int q = 0; q < 4; ++q) { f32x4 o = bbb[hf];
#pragma unroll
                    for (int k = 0; k < 4; ++k) { const unsigned w0 = raw[q + k][2 * hf], w1 = raw[q + k][2 * hf + 1]; const f32x4 r = (f32x4){bflo(w0), bfhi(w0), bflo(w1), bfhi(w1)}; o += wkk[hf][k] * r; }
#pragma unroll
                    for (int j = 0; j < 4; ++j) o[j] = siluf_(o[j]);
                    const int l = 4 * xst + q;
                    LAS unsigned* rp = (LAS unsigned*)(Xr + l * 144 + 16 * xg + 8 * hf); rp[0] = cvt_pk_bf16(o[0], o[1]); rp[1] = cvt_pk_bf16(o[2], o[3]);
                    const float d = dts[l]; tq[q][0] = cvt_pk_bf16(o[0] * d, o[1] * d); tq[q][1] = cvt_pk_bf16(o[2] * d, o[3] * d);
                }
#pragma unroll
                for (int j2 = 0; j2 < 2; ++j2) {
                    unsigned lo[2], hi[2];
#pragma unroll
                    for (int i = 0; i < 2; ++i) { const unsigned a = tq[2 * i][j2], bq = tq[2 * i + 1][j2]; lo[i] = (a & 0xffffu) | (bq << 16); hi[i] = (a >> 16) | (bq & 0xffff0000u); }
                    LAS unsigned* p0 = (LAS unsigned*)(A128(XdT, 8 * xg + 4 * hf + 2 * j2, xst >> 1) + 8 * (xst & 1)); p0[0] = lo[0]; p0[1] = lo[1];
                    LAS unsigned* p1 = (LAS unsigned*)(A128(XdT, 8 * xg + 4 * hf + 2 * j2 + 1, xst >> 1) + 8 * (xst & 1)); p1[0] = hi[0]; p1[1] = hi[1]; }
            }
        } else if (role == 1) {
            const int chunk = bst ^ (bg8 & 7);
            unsigned tq[8][4];
#pragma unroll
            for (int q = 0; q < 8; ++q) { const int l = 8 * bst + q; *(LAS u32x4*)A256(Bm, l, bg8) = raw[q]; const float d = dec[l]; f32x4 v0, v1; unpack8(raw[q], v0, v1);
                tq[q][0] = cvt_pk_bf16(v0[0] * d, v0[1] * d); tq[q][1] = cvt_pk_bf16(v0[2] * d, v0[3] * d); tq[q][2] = cvt_pk_bf16(v1[0] * d, v1[1] * d); tq[q][3] = cvt_pk_bf16(v1[2] * d, v1[3] * d); }
#pragma unroll
            for (int j2 = 0; j2 < 4; ++j2) { u32x4 lo, hi;
#pragma unroll
                for (int i = 0; i < 4; ++i) { const unsigned a = tq[2 * i][j2], bq = tq[2 * i + 1][j2]; lo[i] = (a & 0xffffu) | (bq << 16); hi[i] = (a >> 16) | (bq & 0xffff0000u); }
                *(LAS u32x4*)A128(BdT, 8 * bg8 + 2 * j2, bst) = lo; *(LAS u32x4*)A128(BdT, 8 * bg8 + 2 * j2 + 1, bst) = hi; }
        } else if (role == 2) {
#pragma unroll
            for (int q = 0; q < 8; ++q) *(LAS u32x4*)A256(Cm, 8 * bst + q, bg8) = raw[q];
        }
        if (ch + 1 < NCH) {
            if (role == 0) {
#pragma unroll
                for (int i = 0; i < 7; ++i) { const int tt = 4 * xst - 3 + i; if (tt >= 0) raw[i] = *(const u32x4*)(PP + (size_t)(t0 + 64 + tt) * NPP + gcol); } }
            else if (role < 3) {
#pragma unroll
                for (int i = 0; i < 8; ++i) raw[i] = *(const u32x4*)(BCc + (size_t)(t0 + 64 + 8 * bst + i) * 1024 + bcol); }
            if (wid == 0) dtv = DT[(size_t)(t0 + 64 + lane) * 32 + h];
        }
        __syncthreads();
#pragma unroll
        for (int q = 0; q < 2; ++q) { const int ti = 2 * wid + q, lt = ti >> 2, stl = ti & 3; f32x4 a4 = (f32x4){0.f, 0.f, 0.f, 0.f};
            if (stl <= lt) {
#pragma unroll
                for (int ks = 0; ks < 4; ++ks) { const bf16x8 a = *(const LAS bf16x8*)A256(Bm, 16 * stl + lr, 4 * ks + kg), bq = *(const LAS bf16x8*)A256(Cm, 16 * lt + lr, 4 * ks + kg);
                    a4 = __builtin_amdgcn_mfma_f32_16x16x32_bf16(a, bq, a4, 0, 0, 0); } }
            const int l = 16 * lt + lr; const float cl = css[l]; f32x4 v;
#pragma unroll
            for (int r = 0; r < 4; ++r) { const int sI = 16 * stl + 4 * kg + r; v[r] = (sI <= l) ? a4[r] * __expf(cl - css[sI]) : 0.f; }
            unsigned* dummy = nullptr; (void)dummy;
            LAS unsigned* mp = (LAS unsigned*)(A128(Mm, l, 2 * stl + (kg >> 1)) + 8 * (kg & 1)); mp[0] = cvt_pk_bf16(v[0], v[1]); mp[1] = cvt_pk_bf16(v[2], v[3]); }
        __syncthreads();
#pragma unroll
        for (int q = 0; q < 2; ++q) { const int ti = 2 * wid + q, pt = ti >> 2, lt = ti & 3; f32x4 a4 = (f32x4){0.f, 0.f, 0.f, 0.f};
#pragma unroll
            for (int ks = 0; ks < 4; ++ks) { const bf16x8 a = *(const LAS bf16x8*)A256(Sb, 16 * pt + lr, 4 * ks + kg), bq = *(const LAS bf16x8*)A256(Cm, 16 * lt + lr, 4 * ks + kg);
                a4 = __builtin_amdgcn_mfma_f32_16x16x32_bf16(a, bq, a4, 0, 0, 0); }
            const int l = 16 * lt + lr; const float el = __expf(css[l]);
#pragma unroll
            for (int r = 0; r < 4; ++r) a4[r] *= el;
            const int prow_ = 16 * pt + lr, sw = (2 * pt + (lr >> 3)) & 7;
#pragma unroll
            for (int ks = 0; ks < 2; ++ks) { const bf16x8 a = *(const LAS bf16x8*)A128(XdT, prow_, 4 * ks + kg), bq = *(const LAS bf16x8*)A128(Mm, 16 * lt + lr, 4 * ks + kg);
                a4 = __builtin_amdgcn_mfma_f32_16x16x32_bf16(a, bq, a4, 0, 0, 0); }
            const int p0 = 16 * pt + 4 * kg; const LAS unsigned* xp = (const LAS unsigned*)(Xr + l * 144 + 2 * p0); const unsigned x01 = xp[0], x23 = xp[1];
            const float y0 = a4[0] + Dh * bflo(x01), y1 = a4[1] + Dh * bfhi(x01), y2 = a4[2] + Dh * bflo(x23), y3 = a4[3] + Dh * bfhi(x23);
            if (!dry) { unsigned* yp = (unsigned*)(PP + (size_t)(t0 + l) * NPP + 1024 + 64 * h + p0); yp[0] = cvt_pk_bf16(y0, y1); yp[1] = cvt_pk_bf16(y2, y3); } }
        { const float ce = __expf(css[63]); const int nrow = 16 * wid + lr, swn = (2 * wid + (lr >> 3)) & 7;
#pragma unroll
          for (int m = 0; m < 4; ++m) { accS[m] *= ce; const int prow_ = 16 * m + lr, swp = (2 * m + (lr >> 3)) & 7;
#pragma unroll
            for (int ks = 0; ks < 2; ++ks) { const bf16x8 a = *(const LAS bf16x8*)A128(BdT, nrow, 4 * ks + kg), bq = *(const LAS bf16x8*)A128(XdT, prow_, 4 * ks + kg);
                accS[m] = __builtin_amdgcn_mfma_f32_16x16x32_bf16(a, bq, accS[m], 0, 0, 0); } } }
        __syncthreads();
#pragma unroll
        for (int m = 0; m < 4; ++m) { LAS unsigned* sp = (LAS unsigned*)(A256(Sb, 16 * m + lr, 2 * wid + (kg >> 1)) + 8 * (kg & 1)); sp[0] = cvt_pk_bf16(accS[m][0], accS[m][1]); sp[1] = cvt_pk_bf16(accS[m][2], accS[m][3]); }
    }
    if (!dry) {
#pragma unroll
        for (int m = 0; m < 4; ++m) *(f32x4*)(c.out + O_SHP + ((size_t)(b * 32 + h) * 64 + 16 * m + lr) * 128 + 16 * wid + 4 * kg) = accS[m];
    }
    __syncthreads();
}

__device__ __forceinline__ void lru_sample(const Ctx& c, int b, int head) {
    const int tid = otid(); LAS float* XC = (LAS float*)c.lds; LAS float* RG = XC + 2048; LAS float* IG = RG + 2048;
    const float* PS = (const float*)(c.ws + OFF_PS); bf16_t* ABRS = (bf16_t*)(c.ws + OFF_ABRS);
    const float* cw = c.in[12]; const float* cb = c.in[13]; const int ch0 = 128 * head;
    for (int e = tid; e < 2048; e += 512) { const int tk = e >> 7, cl = e & 127, cgl = ch0 + cl; float o = cb[cgl];
#pragma unroll
        for (int k = 0; k < 4; ++k) { const int tt = tk - 3 + k; const float v = tt >= 0 ? PS[(size_t)(b * 16 + tt) * 9216 + cgl] : SZ(c.in[2][(size_t)(b * 3 + tt + 3) * D + cgl]); o += cw[k * D + cgl] * v; }
        XC[e] = o; }
    if (tid < 384) { const int r = tid >> 7, cl = tid & 127; c.out[O_LCS + (size_t)(b * 3 + r) * D + ch0 + cl] = PS[(size_t)(b * 16 + 13 + r) * 9216 + ch0 + cl]; }
    __syncthreads();
    {
        LAS unsigned char* XCb = c.lds + 32768; const int wid = tid >> 6, lane = tid & 63, lr = lane & 15, kg = lane >> 4;
        for (int e = tid; e < 2048; e += 512) *(LAS bf16_t*)(XCb + (e >> 7) * 272 + 2 * (e & 127)) = f2bf(XC[e]);
        __syncthreads();
        const bf16_t* wr_ = (const bf16_t*)(c.ws + OFF_WRG) + (size_t)(ch0 + 16 * wid + lr) * 128 + 8 * kg; const bf16_t* wi_ = (const bf16_t*)(c.ws + OFF_WIG) + (size_t)(ch0 + 16 * wid + lr) * 128 + 8 * kg;
        f32x4 ar = (f32x4){0.f, 0.f, 0.f, 0.f}, ai_ = ar;
#pragma unroll
        for (int ks = 0; ks < 4; ++ks) { const bf16x8 br = *(const bf16x8*)(wr_ + 32 * ks), bi = *(const bf16x8*)(wi_ + 32 * ks), a = *(const LAS bf16x8*)(XCb + lr * 272 + (32 * ks + 8 * kg) * 2);
            ar = __builtin_amdgcn_mfma_f32_16x16x32_bf16(a, br, ar, 0, 0, 0); ai_ = __builtin_amdgcn_mfma_f32_16x16x32_bf16(a, bi, ai_, 0, 0, 0); }
        const int cl = 16 * wid + lr; const float b1 = c.in[15][ch0 + cl], b2 = c.in[17][ch0 + cl];
#pragma unroll
        for (int r = 0; r < 4; ++r) { const int tk = 4 * kg + r; RG[tk * 128 + cl] = sigmoidf_(ar[r] + b1); IG[tk * 128 + cl] = sigmoidf_(ai_[r] + b2); }
    }
    __syncthreads();
    if (tid < 128) { const int cgl = ch0 + tid; const float sp = softplusf_(-c.in[18][cgl]); float h = SZ(c.in[3][b * D + cgl]);
        for (int tk = 0; tk < 16; ++tk) { const float la = -8.0f * RG[tk * 128 + tid] * sp, a = __expf(la), u = sqrtf(-expm1f(2.0f * la)) * IG[tk * 128 + tid] * XC[tk * 128 + tid];
            h = a * h + u; ABRS[(size_t)(b * 16 + tk) * 3072 + cgl] = f2bf(gelu_tanh(PS[(size_t)(b * 16 + tk) * 9216 + 4096 + cgl]) * h); }
        c.out[O_LHS + b * D + cgl] = h; }
    __syncthreads();
}
__device__ __forceinline__ void ssd_sample(const Ctx& c, int b, int h) {
    const int tid = otid(); LAS float* XS = (LAS float*)c.lds; LAS float* BS = XS + 1024; LAS float* CS = BS + 2048; LAS float* DTL = CS + 2048;
    const float* PS = (const float*)(c.ws + OFF_PS); const float* DTS = (const float*)(c.ws + OFF_DTS); float* YGS = (float*)(c.ws + OFF_YGS);
    const float* cw = c.in[19]; const float* cb = c.in[20]; const int g = h >> 3;
    for (int e = tid; e < 16 * 320; e += 512) { const int tk = e / 320, q = e % 320; int cc; LAS float* dst;
        if (q < 64) { cc = 64 * h + q; dst = XS + tk * 64 + q; } else if (q < 192) { cc = 2048 + 128 * g + (q - 64); dst = BS + tk * 128 + (q - 64); } else { cc = 2560 + 128 * g + (q - 192); dst = CS + tk * 128 + (q - 192); }
        float o = cb[cc];
#pragma unroll
        for (int k = 0; k < 4; ++k) { const int tt = tk - 3 + k; const float v = tt >= 0 ? PS[(size_t)(b * 16 + tt) * 9216 + 1024 + cc] : SZ(c.in[4][(size_t)(b * 3 + tt + 3) * 3072 + cc]); o += cw[k * 3072 + cc] * v; }
        *dst = siluf_(o);
        if (tk >= 13 && (q < 64 || (h & 7) == 0)) c.out[O_SCS + (size_t)(b * 3 + tk - 13) * 3072 + cc] = PS[(size_t)(b * 16 + tk) * 9216 + 1024 + cc]; }
    if (tid < 16) DTL[tid] = softplusf_(DTS[(b * 16 + tid) * 32 + h] + c.in[21][h]);
    __syncthreads();
    const float Ah = -__expf(c.in[22][h]), Dh = c.in[23][h];
    const int p = tid >> 3, n0 = (tid & 7) * 16; float hs[16];
    const float* h0 = c.in[5] + ((size_t)(b * 32 + h) * 64 + p) * 128 + n0;
#pragma unroll
    for (int j = 0; j < 16; ++j) hs[j] = SZ(h0[j]);
    float zv[16];
#pragma unroll
    for (int tk = 0; tk < 16; ++tk) zv[tk] = PS[(size_t)(b * 16 + tk) * 9216 + 5120 + 64 * h + p];
#pragma unroll
    for (int tk = 0; tk < 16; ++tk) { const float d = DTL[tk], ea = __expf(d * Ah), xv = XS[tk * 64 + p], dx = d * xv; float y = 0.f;
#pragma unroll
        for (int j = 0; j < 16; ++j) { hs[j] = ea * hs[j] + dx * BS[tk * 128 + n0 + j]; y += CS[tk * 128 + n0 + j] * hs[j]; }
        y += __shfl_xor(y, 1); y += __shfl_xor(y, 2); y += __shfl_xor(y, 4);
        if ((tid & 7) == 0) { const int row = b * 16 + tk; YGS[(size_t)row * 2048 + 64 * h + p] = (y + Dh * xv) * siluf_(zv[tk]); } }
    float* ho = c.out + O_SHS + ((size_t)(b * 32 + h) * 64 + p) * 128 + n0;
#pragma unroll
    for (int j = 0; j < 16; ++j) ho[j] = hs[j];
    __syncthreads();
}

#ifdef DIAG
constexpr size_t OFF_DIAG = 266338304;
__device__ __forceinline__ int prow(int r) { return (r >> 4) * SEQ + (r & 15); }
template <class FA, class FB>
__device__ __forceinline__ void diag_rel(LAS float* red, float* dst, int ncols, FA fa, FB fb) {
    const int tid = threadIdx.x; float num = 0.f, den = 0.f;
    for (int e = tid; e < TS * ncols; e += 512) { const int r = e / ncols, cc = e % ncols; const float a = fa(r, cc), b = fb(r, cc); num += (a - b) * (a - b); den += b * b; }
    red[tid] = num; red[512 + tid] = den; __syncthreads();
    if (tid == 0) { float n = 0.f, d = 0.f; for (int i = 0; i < 512; ++i) { n += red[i]; d += red[512 + i]; } *dst = n / (d + 1e-30f); }
    __syncthreads();
}
#endif
constexpr size_t OFF_BAR = 266338304 + 4096, OFF_SSQS = OFF_BAR + 4096;
__device__ __forceinline__ void grid_barrier(unsigned* ctr, unsigned target) {
    asm volatile("s_waitcnt vmcnt(0) lgkmcnt(0)" ::: "memory");
    __syncthreads();
    if (threadIdx.x == 0) {
        __builtin_amdgcn_fence(__ATOMIC_RELEASE, "agent");
        asm volatile("s_waitcnt vmcnt(0)" ::: "memory");
        __hip_atomic_fetch_add(ctr, 1u, __ATOMIC_RELAXED, __HIP_MEMORY_SCOPE_AGENT);
        while (__hip_atomic_load(ctr, __ATOMIC_RELAXED, __HIP_MEMORY_SCOPE_AGENT) < target) __builtin_amdgcn_s_sleep(1);
        __builtin_amdgcn_fence(__ATOMIC_ACQUIRE, "agent");
        asm volatile("s_waitcnt vmcnt(0)" ::: "memory");
    }
    __syncthreads();
}
#define XB_TMO      128
#define XB_XCNT(j)  (256  + 64 * (j))
#define XB_XSUB(j)  (1280 + 64 * (j))
#define XB_XGEN(j)  (2304 + 64 * (j))
#define XB_TOP      3328
#define XB_TOPGEN   3392
#define XCD_BAR_WORDS 3456
#define XB_SPIN_CAP (1u << 18)
constexpr size_t OFF_XBAR = 266338304 + 4096 + 4096 + 65536;
__device__ __forceinline__ unsigned xb_ld(unsigned* p)              { return __hip_atomic_load(p, __ATOMIC_RELAXED, __HIP_MEMORY_SCOPE_AGENT); }
__device__ __forceinline__ unsigned xb_add(unsigned* p, unsigned v) { return __hip_atomic_fetch_add(p, v, __ATOMIC_RELAXED, __HIP_MEMORY_SCOPE_AGENT); }
__device__ __forceinline__ unsigned xb_xcc_id() { return (unsigned)__builtin_amdgcn_s_getreg((3 << 11) | 20) & 0xFu; }
#define XB_SPIN(cond, bar) do { unsigned _sp = 0; while (cond) { __builtin_amdgcn_s_sleep(1); \
    if ((++_sp & 255u) == 0u) { if (xb_ld(&(bar)[XB_TMO])) break; if (_sp > XB_SPIN_CAP) { atomicAdd(&(bar)[XB_TMO], 1u); break; } } } } while (0)
struct XcdBarrier { unsigned* bar; unsigned x; volatile LAS unsigned* st; };
__device__ __forceinline__ XcdBarrier xcd_barrier_post(unsigned* bar, volatile LAS unsigned* st) {
    XcdBarrier b; b.bar = bar; b.x = xb_xcc_id(); b.st = st;
    if (threadIdx.x == 0) (void)xb_add(&bar[XB_XCNT(b.x)], 1u);
    return b;
}
__device__ __forceinline__ void xcd_barrier_complete(unsigned* bar, unsigned x, unsigned& nloc, unsigned& nx) {
    const unsigned G = gridDim.x * gridDim.y * gridDim.z;
    unsigned sum, cnt, mine, sp = 0u;
    for (;;) {
        sum = 0u; cnt = 0u; mine = 0u;
#pragma unroll
        for (unsigned j = 0; j < 16; ++j) { const unsigned c = xb_ld(&bar[XB_XCNT(j)]); sum += c; cnt += (c > 0u) ? 1u : 0u; mine = (j == x) ? c : mine; }
        if (sum == G) break;
        __builtin_amdgcn_s_sleep(1);
        if ((++sp & 255u) == 0u) { if (xb_ld(&bar[XB_TMO])) break; if (sp > XB_SPIN_CAP) { atomicAdd(&bar[XB_TMO], 1u); break; } }
    }
    nloc = mine > 0u ? mine : 1u; nx = cnt > 0u ? cnt : 1u;
}
__device__ __forceinline__ void xcd_barrier(const XcdBarrier& b) {
    asm volatile("s_waitcnt vmcnt(0)" ::: "memory");
    __syncthreads();
    if (threadIdx.x == 0) {
        unsigned* bar = b.bar;
        __builtin_amdgcn_s_waitcnt(0);
        unsigned nloc = b.st[0], nx = b.st[1];
        if (nloc == 0u) { xcd_barrier_complete(bar, b.x, nloc, nx); b.st[0] = nloc; b.st[1] = nx; }
        const unsigned old = xb_add(&bar[XB_XSUB(b.x)], 1u);
        const unsigned gen = old / nloc;
        if (old + 1u == (gen + 1u) * nloc) {
            __builtin_amdgcn_fence(__ATOMIC_RELEASE, "agent");
            asm volatile("s_waitcnt vmcnt(0)" ::: "memory");
            const unsigned og = xb_add(&bar[XB_TOP], 1u);
            const unsigned tg = og / nx;
            if (og + 1u == (tg + 1u) * nx) xb_add(&bar[XB_TOPGEN], 1u);
            else XB_SPIN(xb_ld(&bar[XB_TOPGEN]) == tg, bar);
            __builtin_amdgcn_fence(__ATOMIC_ACQUIRE, "agent");
            xb_add(&bar[XB_XGEN(b.x)], 1u);
            asm volatile("s_waitcnt vmcnt(0)" ::: "memory");
        } else {
            XB_SPIN(xb_ld(&bar[XB_XGEN(b.x)]) == gen, bar);
            __builtin_amdgcn_fence(__ATOMIC_ACQUIRE, "agent");
            asm volatile("s_waitcnt vmcnt(0)" ::: "memory");
        }
    }
    __syncthreads();
}
#ifndef DUPX
#define DUPX 0
#endif
#ifdef TIMER_ID
#define TSTART(id) do { if ((id) == TIMER_ID) t0_ = __builtin_amdgcn_s_memrealtime(); } while (0)
#define TSTOP(id) do { if ((id) == TIMER_ID) tacc_ += __builtin_amdgcn_s_memrealtime() - t0_; } while (0)
#else
#define TSTART(id)
#define TSTOP(id)
#endif
__global__ void __launch_bounds__(512, 2) fwd_kernel(Params prm) {
    extern __shared__ __attribute__((aligned(16))) unsigned char lds_raw[];
    Ctx c; c.in = prm.in; c.out = prm.out; c.ws = prm.ws; c.lds = (LAS unsigned char*)lds_raw;
    unsigned char* ws = prm.ws; float* out = prm.out;
    const int tid = threadIdx.x, G = gridDim.x, bid = blockIdx.x;
    bf16_t* XB = (bf16_t*)(ws + OFF_XB); bf16_t* XN = (bf16_t*)(ws + OFF_XN); bf16_t* PP = (bf16_t*)(ws + OFF_PP); float* SSQ = (float*)(ws + OFF_SSQ);
    bf16_t* XNS = (bf16_t*)(ws + OFF_XNS); bf16_t* HS = (bf16_t*)(ws + OFF_HS); float* PS = (float*)(ws + OFF_PS); float* GSSQ = (float*)(ws + OFF_GSSQ);
    float* YS = out + O_YS; float* SSQS = (float*)(ws + OFF_SSQS);
    const int lo = prm.ph_lo, hi = prm.ph_hi;
#ifdef DIAG
    if (lo >= 100) {
        if (bid != 0) return;
        float* DG = (float*)(ws + OFF_DIAG); LAS float* red = (LAS float*)c.lds; const int st = lo - 100;
        const float* DTp = (const float*)(ws + OFF_DT); const float* DTs = (const float*)(ws + OFF_DTS); const bf16_t* ABRS = (const bf16_t*)(ws + OFF_ABRS); const bf16_t* MS = (const bf16_t*)(ws + OFF_MS); const float* bg = prm.in[11];
        if (st == 0 || st == 6 || st == 7) diag_rel(red, DG + st, D, [=](int r, int cc) { return out[O_YP + (size_t)prow(r) * D + cc]; }, [=](int r, int cc) { return YS[(size_t)r * D + cc]; });
        if (st == 1) { diag_rel(red, DG + 1, NPP, [=](int r, int cc) { return bf2f(PP[(size_t)prow(r) * NPP + cc]); }, [=](int r, int cc) { return PS[(size_t)r * 9216 + cc]; });
                       diag_rel(red, DG + 2, 32, [=](int r, int cc) { return DTp[(size_t)prow(r) * 32 + cc]; }, [=](int r, int cc) { return DTs[(size_t)r * 32 + cc]; }); }
        if (st == 8) { diag_rel(red, DG + 8, D, [=](int r, int cc) { return bf2f(XN[(size_t)prow(r) * D + cc]); }, [=](int r, int cc) { return sigmoidf_(PS[(size_t)r * 9216 + 7168 + cc] + bg[cc]); });
                       diag_rel(red, DG + 9, D, [=](int r, int cc) { return bf2f(PP[(size_t)prow(r) * NPP + 3072 + cc]); }, [=](int r, int cc) { return sigmoidf_(PS[(size_t)r * 9216 + 8192 + cc] + bg[1024 + cc]); }); }
        if (st == 3) { diag_rel(red, DG + 3, D, [=](int r, int cc) { return bf2f(PP[(size_t)prow(r) * NPP + cc]); }, [=](int r, int cc) { return bf2f(ABRS[(size_t)r * 3072 + cc]); });
                       diag_rel(red, DG + 4, 2048, [=](int r, int cc) { return bf2f(PP[(size_t)prow(r) * NPP + 1024 + cc]); }, [=](int r, int cc) { return bf2f(ABRS[(size_t)r * 3072 + 1024 + cc]); }); }
        if (st == 5) diag_rel(red, DG + 5, D, [=](int r, int cc) { return bf2f(XN[(size_t)prow(r) * D + cc]); }, [=](int r, int cc) { return bf2f(MS[(size_t)r * D + cc]); });
        if (st == 20) {
            int mask = 0; if (!(DG[8] < DIAG_TOL)) mask |= 1; if (!(DG[9] < DIAG_TOL)) mask |= 2; if (!(DG[3] < DIAG_TOL)) mask |= 4; if (!(DG[4] < DIAG_TOL)) mask |= 8; if (!(DG[5] < DIAG_TOL)) mask |= 16;
            if (mask == 0) { if (!(DG[6] < DIAG_TOL)) mask |= 32; if (!(DG[7] < DIAG_TOL)) mask |= 64; }
            float code = mask ? 100.f * (1 + mask) : 0.f;
            if (code > 0.f) for (int e = tid; e < TS * D; e += 512) YS[e] = code;
        }
        return;
    }
#endif
#ifndef PHMASK
#define PHMASK 0x1fff
#endif
#define IN(k) (((PHMASK >> (k)) & 1) && lo <= (k) && (k) < hi)
    unsigned* barctr = (unsigned*)(ws + OFF_BAR); unsigned nbar = 0; (void)barctr;
    volatile LAS unsigned* xbst = (volatile LAS unsigned*)(c.lds + LDS_BYTES - 16);
    if (tid < 4) xbst[tid] = 0u;
    __syncthreads();
    XcdBarrier xbar; xbar.bar = (unsigned*)(ws + OFF_XBAR); xbar.x = 0; xbar.st = xbst;
    if (hi - lo > 1) xbar = xcd_barrier_post((unsigned*)(ws + OFF_XBAR), xbst);
    unsigned long long t0_ = 0, tacc_ = 0; (void)t0_; (void)tacc_;
#define SEAM(k) do { if (IN(k) && IN((k) + 1)) { TSTART(12); ++nbar; xcd_barrier(xbar); TSTOP(12); } } while (0)
    auto rm_id = [](int col0, int) { return col0; };
    auto rm_up = [](int col0, int panel) { return (col0 >> 7) * 256 + panel * 128 + (col0 & 127); };

    if (IN(0)) {
        TSTART(0); prep_weights(c);
#if DUPX == 1
        prep_weights(c);
#endif
        rmsnorm_rows_bf16(prm.in[0], T, prm.in[6], XN); TSTOP(0);
#ifdef DIAG
        { const int t_ = otid(), lane = t_ & 63; for (int r = bid * 8 + (t_ >> 6); r < TS; r += G * 8) { const float* p = prm.in[0] + (size_t)prow(r) * D; float v[16]; float s = 0.f;
            for (int i = 0; i < 16; ++i) { v[i] = p[lane + 64 * i]; s += v[i] * v[i]; }
            for (int o = 1; o < 64; o <<= 1) s += __shfl_xor(s, o);
            const float inv = rsqrtf(s * (1.0f / 1024.0f) + EPS);
            for (int i = 0; i < 16; ++i) XNS[(size_t)r * D + lane + 64 * i] = f2bf(v[i] * inv * prm.in[6][lane + 64 * i]); } }
#else
        rmsnorm_rows_bf16(prm.in[1], TS, prm.in[6], XNS);
#endif
    }
    SEAM(0);
    if (IN(1)) {
        pg8::Gemm g{XN, D, (const bf16_t*)(ws + OFF_WUP1), D, T, 2 * FF, D}; pg8::StaticOrder S; S.init(T, 2 * FF, G, bid);

#if DUPX == 5
        pg8::gemm_phase(c.lds, g, S, EpiSwiglu{PP, (LAS const float*)nullptr});
#endif
        TSTART(1); pg8::gemm_phase(c.lds, g, S, EpiSwiglu{PP, (LAS const float*)nullptr}); TSTOP(1);
        TSTART(2); sgemm<16, 2, D>(c.lds, XNS, D, (const bf16_t*)(ws + OFF_WUP1), D, FF, nullptr, nullptr, rm_up,
            [=](int r, int cc, float v0, float v1, float) { HS[(size_t)r * FF + cc] = f2bf(siluf_(v0) * v1); return 0.f; }, G / 2); TSTOP(2);
    }
    SEAM(1);
    if (IN(2)) {
        pg8::Gemm g{PP, FF, (const bf16_t*)(ws + OFF_WDN1), FF, T, D, FF}; pg8::StaticOrder S; S.init(T, D, G, bid);
        TSTART(10); pg8::gemm_phase(c.lds, g, S, EpiResid{prm.in[0], nullptr, nullptr, XB, SSQ, 0.5f}); TSTOP(10);
        const float* xs_in = prm.in[1];
        TSTART(2); sgemm<16, 1, FF>(c.lds, HS, FF, (const bf16_t*)(ws + OFF_WDN1), FF, D, nullptr, SSQS, rm_id,
            [=](int r, int cc, float v0, float, float) {
#ifdef DIAG
            const float x = prm.in[0][(size_t)prow(r) * D + cc] + 0.5f * v0;
#else
            const float x = xs_in[(size_t)r * D + cc] + 0.5f * v0;
#endif
            YS[(size_t)r * D + cc] = x; XNS[(size_t)r * D + cc] = f2bf(x); return x; }); TSTOP(2);
    }
    SEAM(2);
    if (IN(3)) {
        pg8::Gemm g{XB, D, (const bf16_t*)(ws + OFF_WIN), D, T, NPP, D}; pg8::StaticOrder S; S.init(T, NPP, G, bid);

#if DUPX == 6
        pg8::gemm_phase(c.lds, g, S, EpiScaleBf16{PP, SSQ});
#endif
        LAS const float* linv = fill_inv(c.lds, SSQ); TSTART(11); pg8::gemm_phase(c.lds, g, S, EpiScaleBf16{PP, linv}); TSTOP(11);
        float* DTp = (float*)(ws + OFF_DT); float* DTs = (float*)(ws + OFF_DTS);
        TSTART(2);
        {
            const int t_ = otid(), wv = t_ >> 6, ln = t_ & 63, lr = ln & 15, kg = ln >> 4; const bf16_t* WDT = (const bf16_t*)(ws + OFF_WDT);
            for (int wt = bid * 8 + wv; wt < T / 16; wt += G * 8) {
                f32x4 a0 = (f32x4){0.f, 0.f, 0.f, 0.f}, a1 = a0; f32x4 sq[4][4];
#pragma unroll
                for (int r = 0; r < 4; ++r)
#pragma unroll
                    for (int i = 0; i < 4; ++i) sq[r][i] = *(const f32x4*)(SSQ + (size_t)(16 * wt + 4 * kg + r) * 16 + 4 * i);
                const bf16_t* ap = XB + (size_t)(16 * wt + lr) * D + 8 * kg; const bf16_t* bp = WDT + (size_t)lr * D + 8 * kg;
#pragma unroll 8
                for (int k = 0; k < D; k += 32) { const bf16x8 a = *(const bf16x8*)(ap + k), b0 = *(const bf16x8*)(bp + k), b1 = *(const bf16x8*)(bp + 16 * D + k);
                    a0 = __builtin_amdgcn_mfma_f32_16x16x32_bf16(a, b0, a0, 0, 0, 0); a1 = __builtin_amdgcn_mfma_f32_16x16x32_bf16(a, b1, a1, 0, 0, 0); }
#pragma unroll
                for (int r = 0; r < 4; ++r) { const int row = 16 * wt + 4 * kg + r; const f32x4 sm = (sq[r][0] + sq[r][1]) + (sq[r][2] + sq[r][3]); const float inv = rsqrtf(((sm[0] + sm[1]) + (sm[2] + sm[3])) * (1.0f / 1024.0f) + EPS); DTp[(size_t)row * 32 + lr] = a0[r] * inv; DTp[(size_t)row * 32 + 16 + lr] = a1[r] * inv; }
            }
        }
        TSTOP(2);
        TSTART(2); sgemm<32, 1, D>(c.lds, XNS, D, (const bf16_t*)(ws + OFF_WIN), D, 9216, SSQS, nullptr, rm_id,
            [=](int r, int cc, float v0, float, float inv) { PS[(size_t)r * 9216 + cc] = v0 * inv; return 0.f; }); TSTOP(2);
        TSTART(2); sgemm<32, 1, D>(c.lds, XNS, D, (const bf16_t*)(ws + OFF_WDT), D, 32, SSQS, nullptr, rm_id,
            [=](int r, int cc, float v0, float, float inv) { DTs[(size_t)r * 32 + cc] = v0 * inv; return 0.f; }); TSTOP(2);
    }
    SEAM(3);
    if (IN(4)) {
        for (int e = bid * 512 + tid; e < 8 * 3 * 2048; e += G * 512) {
            const int cc = e & 2047, r = (e >> 11) % 3, b = e / (3 * 2048); const size_t row = (size_t)b * SEQ + 2045 + r;
            if (cc < 1024) out[O_LCP + (size_t)(b * 3 + r) * D + cc] = bf2f(PP[row * NPP + cc]);
            else out[O_SCP + (size_t)(b * 3 + r) * 3072 + 2048 + (cc - 1024)] = bf2f(PP[row * NPP + 3072 + (cc - 1024)]); }

#if DUPX == 4
        for (int it = bid; it < 256; it += G) lru_chunk<false>(c, it >> 5, it & 31);
#endif
        TSTART(19); for (int it = bid; it < 256; it += G) bc_conv(c, it >> 5, it & 31); TSTOP(19);
        if (hi - lo > 1) xcd_barrier(xbar);
        TSTART(3); for (int it = bid; it < 256; it += G) lru_chunk<false>(c, it >> 5, it & 31); TSTOP(3);

#if DUPX == 3
        for (int it = bid; it < 256; it += G) ssd_seq(c, it >> 5, it & 31, prm.ph_lo == 0);
#endif


    }
    SEAM(4);
    if (IN(5)) {

#if DUPX == 2
        for (int it = bid; it < 256; it += G) lru_chunk<true>(c, it >> 5, it & 31, prm.ph_lo == 0);
#endif
        TSTART(4); for (int it = bid; it < 256; it += G) ssd_seq(c, it & 7, it >> 3); TSTOP(4);
        TSTART(5); for (int it = bid; it < 256; it += G) lru_final(c, it >> 5, it & 31); TSTOP(5);
        TSTART(2); for (int it = bid; it < 64; it += G) lru_sample(c, it >> 3, it & 7); TSTOP(2);
        TSTART(2); for (int it = bid; it < 256; it += G) ssd_sample(c, it >> 5, it & 31); TSTOP(2);
    }
    SEAM(5);
    if (IN(6)) { TSTART(8);
        {
        const float* YGS = (const float*)(ws + OFF_YGS); bf16_t* ABRS = (bf16_t*)(ws + OFF_ABRS);
        const int lane = tid & 63;
        for (int w = bid * 8 + (tid >> 6); w < TS * 4; w += G * 8) { const int r = w >> 2, gq = w & 3; const float* p = YGS + (size_t)r * 2048 + 512 * gq; float v[8]; float s = 0.f;
#pragma unroll
            for (int j = 0; j < 8; ++j) { v[j] = p[lane + 64 * j]; s += v[j] * v[j]; }
#pragma unroll
            for (int o = 1; o < 64; o <<= 1) s += __shfl_xor(s, o);
            const float inv = rsqrtf(s * (1.0f / 512.0f) + EPS);
#pragma unroll
            for (int j = 0; j < 8; ++j) ABRS[(size_t)r * 3072 + 1024 + 512 * gq + lane + 64 * j] = f2bf(v[j] * inv); }
        }
        LAS const float* linv = fill_inv(c.lds, SSQ);
        { pg8::Gemm g{XB, D, (const bf16_t*)(ws + OFF_WIN) + (size_t)4096 * D, D, T, 3072, D}; pg8::StaticOrder S; S.init(T, 3072, G, bid);
          pg8::gemm_phase(c.lds, g, S, EpiGatesA{PP, linv, GSSQ}); }
        { pg8::Gemm g{XB, D, (const bf16_t*)(ws + OFF_WIN) + (size_t)7168 * D, D, T, D, D}; pg8::StaticOrder S; S.init(T, D, G, bid);
          pg8::gemm_phase(c.lds, g, S, EpiSigmoid{XN, D, linv, prm.in[11]}); }
        { pg8::Gemm g{XB, D, (const bf16_t*)(ws + OFF_WIN) + (size_t)8192 * D, D, T, D, D}; pg8::StaticOrder S; S.init(T, D, G, bid);
          pg8::gemm_phase(c.lds, g, S, EpiSigmoid{PP + 3072, NPP, linv, prm.in[11] + 1024}); } TSTOP(8);
    }
    SEAM(6);
    if (IN(7)) { TSTART(6);
        const int lane = tid & 63;
        for (int r = bid * 8 + (tid >> 6); r < T; r += G * 8) {
            float s = (lane < 32) ? GSSQ[(size_t)r * 32 + lane] : 0.f;
            s += __shfl_xor(s, 1); s += __shfl_xor(s, 2); s += __shfl_xor(s, 4);
            const float i0 = rsqrtf(__shfl(s, 0) * (1.0f / 512.0f) + EPS), i1 = rsqrtf(__shfl(s, 8) * (1.0f / 512.0f) + EPS), i2 = rsqrtf(__shfl(s, 16) * (1.0f / 512.0f) + EPS), i3 = rsqrtf(__shfl(s, 24) * (1.0f / 512.0f) + EPS);
#pragma unroll
            for (int i = 0; i < 4; ++i) { const float inv = i == 0 ? i0 : (i == 1 ? i1 : (i == 2 ? i2 : i3));
                bf16_t* p = PP + (size_t)r * NPP + 1024 + 512 * i + 8 * lane; f32x4 a, bq; unpack8(*(const u32x4*)p, a, bq); *(u32x4*)p = pack8(a * inv, bq * inv); }
        }
    }
    TSTOP(6); SEAM(7);
    if (IN(8)) {
        TSTART(9); { pg8::Gemm g{PP, NPP, (const bf16_t*)(ws + OFF_WBR), 3072, T, D, D}; pg8::StaticOrder S; S.init(T, D, G, bid); pg8::gemm_phase(c.lds, g, S, EpiBr{XN, PP, 0}); }
        { pg8::Gemm g{PP + 1024, NPP, (const bf16_t*)(ws + OFF_WBR) + 1024, 3072, T, D, 2048}; pg8::StaticOrder S; S.init(T, D, G, bid); pg8::gemm_phase(c.lds, g, S, EpiBr{XN, PP, 1}); } TSTOP(9);
        const bf16_t* ABRS = (const bf16_t*)(ws + OFF_ABRS); float* M1S = (float*)(ws + OFF_M1S); bf16_t* MS = (bf16_t*)(ws + OFF_MS); const float* bg = prm.in[11];
        TSTART(2); sgemm<16, 1, D>(c.lds, ABRS, 3072, (const bf16_t*)(ws + OFF_WBR), 3072, D, nullptr, nullptr, rm_id,
            [=](int r, int cc, float v0, float, float) { M1S[(size_t)r * D + cc] = sigmoidf_(PS[(size_t)r * 9216 + 7168 + cc] + bg[cc]) * v0; return 0.f; }); TSTOP(2);
        TSTART(2); sgemm<16, 1, 2048>(c.lds, ABRS + 1024, 3072, (const bf16_t*)(ws + OFF_WBR) + 1024, 3072, D, nullptr, nullptr, rm_id,
            [=](int r, int cc, float v0, float, float) { MS[(size_t)r * D + cc] = f2bf(M1S[(size_t)r * D + cc] + sigmoidf_(PS[(size_t)r * 9216 + 8192 + cc] + bg[1024 + cc]) * v0); return 0.f; }); TSTOP(2);
    }
    SEAM(8);
    if (IN(9)) {
        pg8::Gemm g{XN, D, (const bf16_t*)(ws + OFF_WOUT), D, T, D, D}; pg8::StaticOrder S; S.init(T, D, G, bid);
        TSTART(16); pg8::gemm_phase(c.lds, g, S, EpiResid{nullptr, XB, nullptr, XB, SSQ, 1.0f}); TSTOP(16);
        const bf16_t* MS = (const bf16_t*)(ws + OFF_MS);
        TSTART(2); sgemm<16, 1, D>(c.lds, MS, D, (const bf16_t*)(ws + OFF_WOUT), D, D, nullptr, SSQS + 8192, rm_id,
            [=](int r, int cc, float v0, float, float) { const float x = YS[(size_t)r * D + cc] + v0; YS[(size_t)r * D + cc] = x; XNS[(size_t)r * D + cc] = f2bf(x); return x; }); TSTOP(2);
    }
    SEAM(9);
    if (IN(10)) {
        pg8::Gemm g{XB, D, (const bf16_t*)(ws + OFF_WUP2), D, T, 2 * FF, D}; pg8::StaticOrder S; S.init(T, 2 * FF, G, bid);
        LAS const float* linv = fill_inv(c.lds, SSQ);
        TSTART(17); pg8::gemm_phase(c.lds, g, S, EpiSwiglu{PP, linv}); TSTOP(17);
        TSTART(2); sgemm<16, 2, D>(c.lds, XNS, D, (const bf16_t*)(ws + OFF_WUP2), D, FF, SSQS + 8192, nullptr, rm_up,
            [=](int r, int cc, float v0, float v1, float inv) { HS[(size_t)r * FF + cc] = f2bf(siluf_(v0 * inv) * (v1 * inv)); return 0.f; }, G / 2); TSTOP(2);
    }
    SEAM(10);
    if (IN(11)) {
        pg8::Gemm g{PP, FF, (const bf16_t*)(ws + OFF_WDN2), FF, T, D, FF}; pg8::StaticOrder S; S.init(T, D, G, bid);
        TSTART(18); pg8::gemm_phase(c.lds, g, S, EpiResid{nullptr, XB, out + O_YP, nullptr, SSQ, 0.5f}); TSTOP(18);
        TSTART(2); sgemm<16, 1, FF>(c.lds, HS, FF, (const bf16_t*)(ws + OFF_WDN2), FF, D, nullptr, nullptr, rm_id,
            [=](int r, int cc, float v0, float, float) { YS[(size_t)r * D + cc] += 0.5f * v0; return 0.f; }); TSTOP(2);
    }
    SEAM(11);
    if (IN(12)) {
        TSTART(7); rmsnorm_rows_f32(out + O_YP, T + TS, prm.in[31]); TSTOP(7);
    }
#ifdef TIMER_ID
    if (hi == 13) { ++nbar; grid_barrier(barctr, nbar * (unsigned)G);
        if (bid == TIMER_BLOCK) { const float us = (float)tacc_ * 0.0001f; for (int e = tid; e < TS * D; e += 512) YS[e] = us; } }
#endif
#undef IN
#undef SEAM
}

#ifndef N_LAUNCH_MODE
#define N_LAUNCH_MODE 1
#endif
extern "C" void kernel_launch(void* const* d_in, const int* in_sizes, int n_in, void* d_out, int out_size, void* d_ws, size_t ws_size, hipStream_t stream) {
    static int grid = 0;
    if (grid == 0) {
        if (n_in != 32 || ws_size < OFF_XBAR + XCD_BAR_WORDS * 4) { fprintf(stderr, "kernel_launch: unexpected n_in %d or ws_size %zu (< %zu)\n", n_in, ws_size, (size_t)WS_END); grid = -1; return; }
        int dev = 0, cus = 0, per_cu = 0;
        hipGetDevice(&dev); hipDeviceGetAttribute(&cus, hipDeviceAttributeMultiprocessorCount, dev);
        if (hipFuncSetAttribute((const void*)fwd_kernel, hipFuncAttributeMaxDynamicSharedMemorySize, LDS_BYTES) != hipSuccess) { fprintf(stderr, "kernel_launch: hipFuncSetAttribute failed\n"); grid = -1; return; }
        hipOccupancyMaxActiveBlocksPerMultiprocessor(&per_cu, (const void*)fwd_kernel, 512, LDS_BYTES);
        if (per_cu < 1) { fprintf(stderr, "kernel_launch: occupancy query says %d blocks per CU\n", per_cu); per_cu = 1; }
        grid = cus * 1;
        (void)hipGetLastError();
    }
    if (grid < 0) return;
    Params p{};
    for (int i = 0; i < 32; ++i) p.in[i] = (const float*)d_in[i];
    p.out = (float*)d_out; p.ws = (unsigned char*)d_ws;
#if N_LAUNCH_MODE == 0
    for (int ph = 0; ph < 13; ++ph) { p.ph_lo = ph; p.ph_hi = ph + 1; hipLaunchKernelGGL(fwd_kernel, dim3(grid), dim3(512), LDS_BYTES, stream, p);
#ifdef DIAG
        int st = -1; if (ph == 2) st = 0; if (ph == 3) st = 1; if (ph == 6) st = 8; if (ph == 7) st = 3; if (ph == 8) st = 5; if (ph == 9) st = 6; if (ph == 11) st = 7; if (ph == 12) st = 20;
        if (st >= 0) { p.ph_lo = 100 + st; p.ph_hi = 0; hipLaunchKernelGGL(fwd_kernel, dim3(grid), dim3(512), LDS_BYTES, stream, p); }
#endif
    }
#else
    p.ph_lo = 0; p.ph_hi = 13;
    hipMemsetAsync((char*)d_ws + OFF_XBAR, 0, XCD_BAR_WORDS * 4, stream);
    void* args[] = {&p};
    hipError_t e = hipLaunchCooperativeKernel((const void*)fwd_kernel, dim3(grid), dim3(512), args, LDS_BYTES, stream);
    if (e != hipSuccess) fprintf(stderr, "cooperative launch failed: %s (grid %d)\n", hipGetErrorString(e), grid);
#endif
}
```

```cpp
#include <hip/hip_runtime.h>
#include <hip/hip_cooperative_groups.h>
#include <cstdio>
namespace cg = cooperative_groups;

#define LAS __attribute__((address_space(3)))
typedef unsigned short bf16_t;
typedef short bf16x8 __attribute__((ext_vector_type(8)));
typedef float f32x4 __attribute__((ext_vector_type(4)));
typedef unsigned u32x4 __attribute__((ext_vector_type(4)));

constexpr int T = 16384, TS = 128, D = 1024, FF = 2816, NPP = 4096, SEQ = 2048, NCH = 32;
constexpr float EPS = 1e-6f;
constexpr size_t OFF_WUP1 = 0, OFF_WDN1 = 11534336;
constexpr size_t OFF_DT = 0, OFF_SUMM = 2097152, OFF_HALO = 4194304, OFF_GSSQ = 5767168, OFF_PS = 7864320,
                 OFF_DTS = 12582912, OFF_YGS = 12599296, OFF_ABRS = 13647872, OFF_M1S = 14434304, OFF_MS = 14958592;
constexpr size_t OFF_WIN = 17301504, OFF_WDT = 36175872, OFF_WBR = 36241408, OFF_WOUT = 42532864, OFF_WUP2 = 44630016,
                 OFF_WDN2 = 56164352, OFF_WRG = 61931520, OFF_WIG = 62193664, OFF_XB = 62455808, OFF_XN = 96010240,
                 OFF_PP = 129564672, OFF_SSQ = 263782400, OFF_XNS = 264830976, OFF_HS = 265093120, WS_END = 265814016;
constexpr size_t O_YP = 0, O_YS = 16777216, O_LCP = 16908288, O_LHP = 16932864, O_SCP = 16941056, O_SHP = 17014784,
                 O_LCS = 19111936, O_LHS = 19136512, O_SCS = 19144704, O_SHS = 19218432;
constexpr int LDS_BYTES = 143360;
constexpr int LDS_INV = 131072;

struct Params { const float* in[32]; float* out; unsigned char* ws; int ph_lo, ph_hi; };

#ifdef DIAG
#define SZ(x) 0.0f
#ifndef DIAG_TOL
#define DIAG_TOL 0.01f
#endif
#else
#define SZ(x) (x)
#endif
#define A256(base, row, chunk) ((base) + (row) * 256 + 16 * ((chunk) ^ ((row) & 15)))
#define A128(base, row, chunk) ((base) + (row) * 128 + 16 * ((chunk) ^ ((((row) >> 1) ^ ((row) >> 3)) & 7)))
__device__ __forceinline__ int otid() { int t = threadIdx.x; asm volatile("" : "+v"(t)); return t; }
__device__ __forceinline__ unsigned cvt_pk_bf16(float lo, float hi) { unsigned r; asm volatile("v_cvt_pk_bf16_f32 %0, %1, %2" : "=v"(r) : "v"(lo), "v"(hi)); return r; }
__device__ __forceinline__ bf16_t f2bf(float f) { return (bf16_t)(cvt_pk_bf16(f, 0.f) & 0xffffu); }
__device__ __forceinline__ float bf2f(bf16_t b) { return __uint_as_float(((unsigned)b) << 16); }
__device__ __forceinline__ float bflo(unsigned w) { return __uint_as_float(w << 16); }
__device__ __forceinline__ float bfhi(unsigned w) { return __uint_as_float(w & 0xffff0000u); }
__device__ __forceinline__ float sigmoidf_(float x) { return __builtin_amdgcn_rcpf(1.0f + __expf(-x)); }
__device__ __forceinline__ float siluf_(float x) { return x * sigmoidf_(x); }
__device__ __forceinline__ float gelu_tanh(float x) { const float u = 0.7978845608028654f * (x + 0.044715f * x * x * x); return x * sigmoidf_(2.0f * u); }
__device__ __forceinline__ float softplusf_(float x) { return x > 20.f ? x : log1pf(__expf(x)); }
__device__ __forceinline__ u32x4 pack8(const f32x4 a, const f32x4 b) { u32x4 w; w.x = cvt_pk_bf16(a[0], a[1]); w.y = cvt_pk_bf16(a[2], a[3]); w.z = cvt_pk_bf16(b[0], b[1]); w.w = cvt_pk_bf16(b[2], b[3]); return w; }
__device__ __forceinline__ void unpack8(const u32x4 w, f32x4& a, f32x4& b) { a[0] = bflo(w.x); a[1] = bfhi(w.x); a[2] = bflo(w.y); a[3] = bfhi(w.y); b[0] = bflo(w.z); b[1] = bfhi(w.z); b[2] = bflo(w.w); b[3] = bfhi(w.w); }
__device__ __forceinline__ float rowinv16(const float* ssq, int row) {
    const f32x4* p = (const f32x4*)(ssq + (size_t)row * 16); const f32x4 a = p[0], b = p[1], c = p[2], d = p[3];
    const float s = ((a[0] + a[1]) + (a[2] + a[3])) + ((b[0] + b[1]) + (b[2] + b[3])) + ((c[0] + c[1]) + (c[2] + c[3])) + ((d[0] + d[1]) + (d[2] + d[3]));
    return rsqrtf(s * (1.0f / 1024.0f) + EPS);
}

namespace pg8 {
constexpr int BM = 256, BK = 64, HALF = 128, HTB = HALF * BK * 2, STAGE_BYTES = 8 * HTB, NXCD = 8, WGM = 8;
__device__ __forceinline__ int lds_byte(int r, int c) { const int st = (r >> 4) * 2 + (c >> 5), rr = r & 15, cc = c & 31, ob = rr * 64 + cc * 2; return st * 1024 + (ob ^ (((ob >> 9) & 1) << 5)); }
__device__ __forceinline__ void stage_rc(int b, int& R, int& C) { const int st = b / 1024, sb = b % 1024, swz = sb ^ (((sb >> 9) & 1) << 5); R = (st >> 1) * 16 + swz / 64; C = (st & 1) * 32 + (swz % 64) / 2; }
__device__ __forceinline__ int perm32(int rho) { const int n = rho >> 4, i = rho & 15; return 8 * (i >> 2) + 4 * n + (i & 3); }
struct Unit { int pm, pn; };
struct Gemm { const bf16_t* A; int lda; const bf16_t* Bt; int ldb; int M, N, K; };
struct StaticOrder {
    int nM, nN, nwg, G, c;
    __device__ __forceinline__ void init(int M, int N, int G_, int c_) { nM = M / BM; nN = N / BM; nwg = nM * nN; G = G_; c = c_; }
    __device__ __forceinline__ bool next(int i, Unit& u) const {
        const long L = (long)i * G + c; if (L >= nwg) return false;
        int wgid = (int)L; { const int q = nwg / NXCD, r = nwg % NXCD, xcd = wgid % NXCD, off = wgid / NXCD; wgid = (xcd < r ? xcd * (q + 1) : r * (q + 1) + (xcd - r) * q) + off; }
        const int nig = WGM * nN, gid = wgid / nig, fm = gid * WGM, gsz = (nM - fm) < WGM ? (nM - fm) : WGM;
        u.pm = fm + ((wgid % nig) % gsz); u.pn = (wgid % nig) / gsz; return true;
    }
};
template <class Epi>
__device__ __forceinline__ void gemm_phase(LAS unsigned char* lds, const Gemm g, const StaticOrder& S, const Epi& E) {
    const int tid = otid(), wid = __builtin_amdgcn_readfirstlane(tid >> 6), lane = tid & 63, wr = wid >> 2, wc = wid & 3, fr = lane & 15, fq = lane >> 4;
    const int K = g.K, nt = K / BK;
    unsigned voffA[2], voffB[2];
#pragma unroll
    for (int i = 0; i < 2; ++i) { int R, C; stage_rc(tid * 16 + i * 8192, R, C); const int Rb = (R & ~31) + perm32(R & 31);
        voffA[i] = (unsigned)(R * g.lda + C) * 2u; voffB[i] = (unsigned)(Rb * g.ldb + C) * 2u; }
    const size_t kstep = (size_t)(BK * 2);
    const size_t hstepA = (size_t)HALF * g.lda * 2, hstepB = (size_t)HALF * g.ldb * 2;
    const size_t tstepA = 2 * hstepA, tstepB = 2 * hstepB;
    const unsigned ldsw = (unsigned)wid * 1024u;
    const int aoff = lds_byte(wr * 64 + fr, fq * 8), boff = lds_byte(wc * 32 + fr, fq * 8);
#define PG8_SA(b, h) (((b) * 2 + (h)) * HTB)
#define PG8_SB(b, h) ((4 + (b) * 2 + (h)) * HTB)
#define PG8_STAGE(bufoff, gbase, voff) do { _Pragma("unroll") for (int _i = 0; _i < 2; ++_i) \
        __builtin_amdgcn_global_load_lds((const unsigned*)((const char*)(gbase) + (voff)[_i]), (LAS unsigned*)(lds + (bufoff) + ldsw + _i * 8192), 16, 0, 0); } while (0)
#define PG8_LDA(dst, b, h) do { _Pragma("unroll") for (int m = 0; m < 4; ++m) _Pragma("unroll") for (int k = 0; k < 2; ++k) dst[m][k] = *(const LAS bf16x8*)(lds + PG8_SA(b, h) + aoff + m * 2048 + k * 1024); } while (0)
#define PG8_LDB(dst, b, h) do { _Pragma("unroll") for (int n = 0; n < 2; ++n) _Pragma("unroll") for (int k = 0; k < 2; ++k) dst[n][k] = *(const LAS bf16x8*)(lds + PG8_SB(b, h) + boff + n * 2048 + k * 1024); } while (0)
#define PG8_MMA(ai, bj, At, Bt) do { __builtin_amdgcn_s_setprio(1); _Pragma("unroll") for (int m = 0; m < 4; ++m) _Pragma("unroll") for (int n = 0; n < 2; ++n) _Pragma("unroll") for (int k = 0; k < 2; ++k) \
        acc[ai][bj][m][n] = __builtin_amdgcn_mfma_f32_16x16x32_bf16(Bt[n][k], At[m][k], acc[ai][bj][m][n], 0, 0, 0); __builtin_amdgcn_s_setprio(0); } while (0)
#define PG8_WAIT_V(n) asm volatile("s_waitcnt vmcnt(" #n ")" ::: "memory")
#define PG8_WAIT_L(n) asm volatile("s_waitcnt lgkmcnt(" #n ")" ::: "memory")
#define PG8_BAR __builtin_amdgcn_s_barrier()
#define PG8_SCHED __builtin_amdgcn_sched_barrier(0)
    Unit cur, nxt; int ui = 0;
    if (!S.next(0, cur)) return;
    f32x4 acc[2][2][4][2];
#pragma unroll
    for (int a = 0; a < 2; ++a)
#pragma unroll
        for (int b = 0; b < 2; ++b)
#pragma unroll
            for (int m = 0; m < 4; ++m)
#pragma unroll
                for (int n = 0; n < 2; ++n) acc[a][b][m][n] = (f32x4){0.f, 0.f, 0.f, 0.f};
    bf16x8 At[4][2], B0[2][2], B1[2][2];
    const char* cA = (const char*)g.A + (size_t)cur.pm * tstepA; const char* cB = (const char*)g.Bt + (size_t)cur.pn * tstepB;
    PG8_STAGE(PG8_SB(0, 0), cB, voffB); PG8_STAGE(PG8_SA(0, 0), cA, voffA); PG8_STAGE(PG8_SB(0, 1), cB + hstepB, voffB); PG8_STAGE(PG8_SA(0, 1), cA + hstepA, voffA);
    if (wr == 1) PG8_BAR;
    PG8_WAIT_V(4); PG8_BAR;
    PG8_STAGE(PG8_SB(1, 0), cB + kstep, voffB); PG8_STAGE(PG8_SA(1, 0), cA + kstep, voffA); PG8_STAGE(PG8_SB(1, 1), cB + hstepB + kstep, voffB);
    PG8_WAIT_V(6); PG8_BAR;
    for (;;) {
        const bool has_next = S.next(ui + 1, nxt);
        const char* nA = has_next ? (const char*)g.A + (size_t)nxt.pm * tstepA : cA; const char* nB = has_next ? (const char*)g.Bt + (size_t)nxt.pn * tstepB : cB;
        for (int t = 0; t < nt; t += 2) {
            const bool last = (t == nt - 2);
            const char* a1 = cA + (size_t)(t + 1) * kstep;
            const char* a2 = last ? nA : cA + (size_t)(t + 2) * kstep; const char* b2 = last ? nB : cB + (size_t)(t + 2) * kstep;
            const char* a3 = a2 + kstep; const char* b3 = b2 + kstep;
            PG8_LDB(B0, 0, 0); PG8_SCHED; PG8_LDA(At, 0, 0); PG8_STAGE(PG8_SA(1, 1), a1 + hstepA, voffA);
            PG8_WAIT_L(8); PG8_BAR; PG8_WAIT_L(0); PG8_MMA(0, 0, At, B0); PG8_BAR; PG8_SCHED;
            PG8_LDB(B1, 0, 1); PG8_STAGE(PG8_SB(0, 0), b2, voffB);
            PG8_BAR; PG8_WAIT_L(0); PG8_MMA(0, 1, At, B1); PG8_BAR;
            PG8_LDA(At, 0, 1); PG8_STAGE(PG8_SA(0, 0), a2, voffA);
            PG8_BAR; PG8_WAIT_L(0); PG8_MMA(1, 0, At, B0); PG8_BAR; PG8_SCHED;
            PG8_STAGE(PG8_SB(0, 1), b2 + hstepB, voffB);
            PG8_WAIT_V(6); PG8_BAR; PG8_MMA(1, 1, At, B1); PG8_BAR;
            PG8_LDB(B0, 1, 0); PG8_SCHED; PG8_LDA(At, 1, 0); PG8_STAGE(PG8_SA(0, 1), a2 + hstepA, voffA);
            PG8_WAIT_L(8); PG8_BAR; PG8_WAIT_L(0); PG8_MMA(0, 0, At, B0); PG8_BAR; PG8_SCHED;
            PG8_LDB(B1, 1, 1); PG8_STAGE(PG8_SB(1, 0), b3, voffB);
            PG8_BAR; PG8_WAIT_L(0); PG8_MMA(0, 1, At, B1); PG8_BAR;
            PG8_LDA(At, 1, 1); PG8_STAGE(PG8_SA(1, 0), a3, voffA);
            PG8_BAR; PG8_WAIT_L(0); PG8_MMA(1, 0, At, B0); PG8_BAR; PG8_SCHED;
            PG8_STAGE(PG8_SB(1, 1), b3 + hstepB, voffB);
            PG8_WAIT_V(6); PG8_BAR; PG8_MMA(1, 1, At, B1); PG8_BAR;
        }
        E(acc, cur, wr, wc, fr, fq);
        if (!has_next) break;
#pragma unroll
        for (int a = 0; a < 2; ++a)
#pragma unroll
            for (int b = 0; b < 2; ++b)
#pragma unroll
                for (int m = 0; m < 4; ++m)
#pragma unroll
                    for (int n = 0; n < 2; ++n) acc[a][b][m][n] = (f32x4){0.f, 0.f, 0.f, 0.f};
        cur = nxt; cA = nA; cB = nB; ++ui;
    }
    PG8_WAIT_V(0);
    if (wr == 0) PG8_BAR;
    PG8_BAR;
#undef PG8_SA
#undef PG8_SB
#undef PG8_STAGE
#undef PG8_LDA
#undef PG8_LDB
#undef PG8_MMA
#undef PG8_WAIT_V
#undef PG8_WAIT_L
#undef PG8_BAR
#undef PG8_SCHED
}
}
typedef f32x4 Acc[2][2][4][2];

__device__ __forceinline__ LAS const float* fill_inv(LAS unsigned char* lds, const float* ssq) {
    LAS float* t = (LAS float*)(lds + LDS_INV); const int base = 2048 * (blockIdx.x & 7);
    for (int r = otid(); r < 2048; r += 512) t[r] = rowinv16(ssq, base + r);
    __syncthreads();
    return t;
}
struct EpiSwiglu {
    bf16_t* H; LAS const float* linv;
    __device__ __forceinline__ void operator()(const Acc& acc, const pg8::Unit& u, int wr, int wc, int fr, int fq) const {
        const int row0 = u.pm * 256 + wr * 64 + fr, col = u.pn * 128 + wc * 32 + 8 * fq;
#pragma unroll
        for (int ai = 0; ai < 2; ++ai)
#pragma unroll
            for (int m = 0; m < 4; ++m) {
                const int row = row0 + ai * 128 + m * 16; const float inv = linv ? linv[row & 2047] : 1.0f;
                f32x4 h0, h1;
#pragma unroll
                for (int j = 0; j < 4; ++j) { h0[j] = siluf_(acc[ai][0][m][0][j] * inv) * (acc[ai][1][m][0][j] * inv); h1[j] = siluf_(acc[ai][0][m][1][j] * inv) * (acc[ai][1][m][1][j] * inv); }
                *(u32x4*)(H + (size_t)row * FF + col) = pack8(h0, h1);
            }
    }
};
struct EpiResid {
    const float* xin; const bf16_t* xin_b; float* xout; bf16_t* xb; float* ssq; float alpha;
    __device__ __forceinline__ void operator()(const Acc& acc, const pg8::Unit& u, int wr, int wc, int fr, int fq) const {
        const int row0 = u.pm * 256 + wr * 64 + fr, col0 = u.pn * 256 + wc * 32 + 8 * fq;
#pragma unroll
        for (int ai = 0; ai < 2; ++ai) {
            f32x4 xv[4][2][2];
#pragma unroll
            for (int m = 0; m < 4; ++m)
#pragma unroll
                for (int bj = 0; bj < 2; ++bj) { const size_t o = (size_t)(row0 + ai * 128 + m * 16) * D + col0 + bj * 128;
                    if (xin_b) unpack8(*(const u32x4*)(xin_b + o), xv[m][bj][0], xv[m][bj][1]);
                    else { xv[m][bj][0] = *(const f32x4*)(xin + o); xv[m][bj][1] = *(const f32x4*)(xin + o + 4); } }
#pragma unroll
            for (int m = 0; m < 4; ++m) {
                const int row = row0 + ai * 128 + m * 16; float ss = 0.f;
#pragma unroll
                for (int bj = 0; bj < 2; ++bj) {
                    const size_t o = (size_t)row * D + col0 + bj * 128;
                    const f32x4 v0 = xv[m][bj][0] + alpha * acc[ai][bj][m][0], v1 = xv[m][bj][1] + alpha * acc[ai][bj][m][1];
                    if (xout) { *(f32x4*)(xout + o) = v0; *(f32x4*)(xout + o + 4) = v1; }
                    ss += (v0[0] * v0[0] + v0[1] * v0[1]) + (v0[2] * v0[2] + v0[3] * v0[3]) + (v1[0] * v1[0] + v1[1] * v1[1]) + (v1[2] * v1[2] + v1[3] * v1[3]);
                    if (xb) *(u32x4*)(xb + o) = pack8(v0, v1);
                }
                ss += __shfl_xor(ss, 16); ss += __shfl_xor(ss, 32);
                if (fq == 0) ssq[(size_t)row * 16 + u.pn * 4 + wc] = ss;
            }
        }
    }
};
struct EpiScaleBf16 {
    bf16_t* O; LAS const float* linv;
    __device__ __forceinline__ void operator()(const Acc& acc, const pg8::Unit& u, int wr, int wc, int fr, int fq) const {
        const int row0 = u.pm * 256 + wr * 64 + fr, col0 = u.pn * 256 + wc * 32 + 8 * fq;
#pragma unroll
        for (int ai = 0; ai < 2; ++ai)
#pragma unroll
            for (int m = 0; m < 4; ++m) {
                const int row = row0 + ai * 128 + m * 16; const float inv = linv[row & 2047];
#pragma unroll
                for (int bj = 0; bj < 2; ++bj) *(u32x4*)(O + (size_t)row * NPP + col0 + bj * 128) = pack8(acc[ai][bj][m][0] * inv, acc[ai][bj][m][1] * inv);
            }
    }
};
struct EpiGatesA {
    bf16_t* PP; LAS const float* linv; float* gssq;
    __device__ __forceinline__ void operator()(const Acc& acc, const pg8::Unit& u, int wr, int wc, int fr, int fq) const {
        const int row0 = u.pm * 256 + wr * 64 + fr, cw = wc * 32 + 8 * fq; const int pn = u.pn;
#pragma unroll
        for (int ai = 0; ai < 2; ++ai) {
            u32x4 sv[4][2];
#pragma unroll
            for (int m = 0; m < 4; ++m)
#pragma unroll
                for (int bj = 0; bj < 2; ++bj) sv[m][bj] = *(const u32x4*)(PP + (size_t)(row0 + ai * 128 + m * 16) * NPP + pn * 256 + bj * 128 + cw);
#pragma unroll
            for (int m = 0; m < 4; ++m) {
                const int row = row0 + ai * 128 + m * 16; const float inv = linv[row & 2047]; float ss = 0.f;
#pragma unroll
                for (int bj = 0; bj < 2; ++bj) {
                    const f32x4 a0 = acc[ai][bj][m][0] * inv, a1 = acc[ai][bj][m][1] * inv; f32x4 o0, o1;
                    bf16_t* p = PP + (size_t)row * NPP + pn * 256 + bj * 128 + cw; f32x4 s0, s1; unpack8(sv[m][bj], s0, s1);
                    if (pn < 4) {
#pragma unroll
                        for (int j = 0; j < 4; ++j) { o0[j] = gelu_tanh(a0[j]) * s0[j]; o1[j] = gelu_tanh(a1[j]) * s1[j]; }
                    } else {
#pragma unroll
                        for (int j = 0; j < 4; ++j) { o0[j] = siluf_(a0[j]) * s0[j]; o1[j] = siluf_(a1[j]) * s1[j]; ss += o0[j] * o0[j] + o1[j] * o1[j]; }
                    }
                    *(u32x4*)p = pack8(o0, o1);
                }
                if (pn >= 4) { ss += __shfl_xor(ss, 16); ss += __shfl_xor(ss, 32); if (fq == 0) gssq[(size_t)row * 32 + (pn - 4) * 4 + wc] = ss; }
            }
        }
    }
};
struct EpiSigmoid {
    bf16_t* O; int ldo; LAS const float* linv; const float* bias;
    __device__ __forceinline__ void operator()(const Acc& acc, const pg8::Unit& u, int wr, int wc, int fr, int fq) const {
        const int row0 = u.pm * 256 + wr * 64 + fr, col0 = u.pn * 256 + wc * 32 + 8 * fq;
#pragma unroll
        for (int ai = 0; ai < 2; ++ai)
#pragma unroll
            for (int m = 0; m < 4; ++m) {
                const int row = row0 + ai * 128 + m * 16; const float inv = linv[row & 2047];
#pragma unroll
                for (int bj = 0; bj < 2; ++bj) {
                    const int gc = col0 + bj * 128;
                    const f32x4 a0 = acc[ai][bj][m][0] * inv, a1 = acc[ai][bj][m][1] * inv; f32x4 o0, o1;
                    const f32x4 b0 = *(const f32x4*)(bias + gc), b1 = *(const f32x4*)(bias + gc + 4);
#pragma unroll
                    for (int j = 0; j < 4; ++j) { o0[j] = sigmoidf_(a0[j] + b0[j]); o1[j] = sigmoidf_(a1[j] + b1[j]); }
                    *(u32x4*)(O + (size_t)row * ldo + gc) = pack8(o0, o1);
                }
            }
    }
};
struct EpiBr {
    bf16_t* GA; const bf16_t* PP; int mode;
    __device__ __forceinline__ void operator()(const Acc& acc, const pg8::Unit& u, int wr, int wc, int fr, int fq) const {
        const int row0 = u.pm * 256 + wr * 64 + fr, col0 = u.pn * 256 + wc * 32 + 8 * fq;
#pragma unroll
        for (int ai = 0; ai < 2; ++ai) {
            u32x4 gv[4][2], hv[4][2];
#pragma unroll
            for (int m = 0; m < 4; ++m)
#pragma unroll
                for (int bj = 0; bj < 2; ++bj) { const int row = row0 + ai * 128 + m * 16; gv[m][bj] = *(const u32x4*)(GA + (size_t)row * D + col0 + bj * 128);
                    hv[m][bj] = (mode == 0) ? (u32x4){0u, 0u, 0u, 0u} : *(const u32x4*)(PP + (size_t)row * NPP + 3072 + col0 + bj * 128); }
#pragma unroll
            for (int m = 0; m < 4; ++m) {
                const int row = row0 + ai * 128 + m * 16;
#pragma unroll
                for (int bj = 0; bj < 2; ++bj) {
                    bf16_t* p = GA + (size_t)row * D + col0 + bj * 128; f32x4 g0, g1; unpack8(gv[m][bj], g0, g1);
                    if (mode == 0) { *(u32x4*)p = pack8(g0 * acc[ai][bj][m][0], g1 * acc[ai][bj][m][1]); }
                    else { f32x4 h0, h1; unpack8(hv[m][bj], h0, h1); *(u32x4*)p = pack8(g0 + h0 * acc[ai][bj][m][0], g1 + h1 * acc[ai][bj][m][1]); }
                }
            }
        }
    }
};

template <int NC, int NB, int K, class RM, class F>
__device__ __forceinline__ void small_gemm(LAS unsigned char* lds, const bf16_t* A, int lda, int M, const bf16_t* Bt, int ldb, int N,
                                           const float* rs_src, int rs_mode, RM rm, F f) {
    const int tid = otid(), wid = tid >> 6, lane = tid & 63, lr = lane & 15, kg = lane >> 4;
    LAS float* red = (LAS float*)lds;
    LAS float* invs = (LAS float*)(lds + 131072);
    const int nct = N / NC, items = (M / 16) * nct; constexpr int kw = K / 8;
    constexpr int CT = NC / 16;
    const int nrt = M / 16; const bool hoist = (rs_mode == 1) && (gridDim.x % nrt == 0); const int bix = gridDim.x - 1 - blockIdx.x;
    for (int it = bix; it < items; it += gridDim.x) {
        const int rt = it % nrt, ct = it / nrt, row0 = rt * 16, col0 = ct * NC;
        if (rs_mode == 1) { if (!(hoist && it != bix)) { const int r = tid >> 5, q = tid & 31; const float* p = rs_src + (size_t)(row0 + r) * D + q * 32; float s = 0.f;
            for (int j = 0; j < 32; j += 4) { const f32x4 v = *(const f32x4*)(p + j); s += v[0] * v[0] + v[1] * v[1] + v[2] * v[2] + v[3] * v[3]; }
            s += __shfl_xor(s, 1); s += __shfl_xor(s, 2); s += __shfl_xor(s, 4); s += __shfl_xor(s, 8); s += __shfl_xor(s, 16);
            if (q == 0) invs[r] = rsqrtf(s * (1.0f / 1024.0f) + EPS); } }
        else if (rs_mode == 2) { if (tid < 16) invs[tid] = rowinv16(rs_src, row0 + tid); }
        else { if (tid < 16) invs[tid] = 1.0f; }
        f32x4 acc[NB][CT];
#pragma unroll
        for (int p = 0; p < NB; ++p)
#pragma unroll
            for (int c = 0; c < CT; ++c) acc[p][c] = (f32x4){0.f, 0.f, 0.f, 0.f};
        const bf16_t* ap = A + (size_t)(row0 + lr) * lda + wid * kw + 8 * kg;
        const bf16_t* bp0 = Bt + (size_t)(rm(col0, 0) + lr) * ldb + wid * kw + 8 * kg;
        const bf16_t* bp1 = NB > 1 ? Bt + (size_t)(rm(col0, 1) + lr) * ldb + wid * kw + 8 * kg : bp0;
#pragma unroll
        for (int k = 0; k < kw; k += 32) {
            const bf16x8 a = *(const bf16x8*)(ap + k);
#pragma unroll
            for (int c = 0; c < CT; ++c) {
                const bf16x8 b = *(const bf16x8*)(bp0 + (size_t)c * 16 * ldb + k);
                acc[0][c] = __builtin_amdgcn_mfma_f32_16x16x32_bf16(a, b, acc[0][c], 0, 0, 0);
                if (NB > 1) { const bf16x8 b1 = *(const bf16x8*)(bp1 + (size_t)c * 16 * ldb + k); acc[NB - 1][c] = __builtin_amdgcn_mfma_f32_16x16x32_bf16(a, b1, acc[NB - 1][c], 0, 0, 0); }
            }
        }
#pragma unroll
        for (int p = 0; p < NB; ++p)
#pragma unroll
            for (int c = 0; c < CT; ++c)
#pragma unroll
                for (int r = 0; r < 4; ++r) red[((wid * NB + p) * 16 + 4 * kg + r) * NC + 16 * c + lr] = acc[p][c][r];
        __syncthreads();
        for (int e = tid; e < 16 * NC; e += 512) {
            float v0 = 0.f, v1 = 0.f;
#pragma unroll
            for (int w = 0; w < 8; ++w) { v0 += red[(w * NB) * 16 * NC + e]; if (NB > 1) v1 += red[(w * NB + 1) * 16 * NC + e]; }
            const int r = e / NC, c = e % NC;
            f(row0 + r, col0 + c, v0, v1, invs[r]);
        }
        __syncthreads();
    }
}

template <int NC, int NB, int K, int RT = 8, class RM, class F>
__device__ __forceinline__ void sgemm(LAS unsigned char* lds, const bf16_t* A, int lda, const bf16_t* Bt, int ldb, int N, const float* ssq_src, float* ssq_out, RM rm, F f, int nblk = 0) {
    const int tid = otid(), wid = tid >> 6, lane = tid & 63, lr = lane & 15, kg = lane >> 4;
    constexpr int CT = NC / 16, KW = K / 8;
    LAS float* red = (LAS float*)lds;
    constexpr int RH = 8 / RT; const int items = (N / NC) * RH, bix = gridDim.x - 1 - blockIdx.x; if (nblk == 0) nblk = gridDim.x;
    LAS float* invs = (LAS float*)(lds + LDS_INV);
    if (bix < items && bix < nblk) {
        if (ssq_src) { const int row = tid >> 2, q = tid & 3; float sm = 0.f;
#pragma unroll
            for (int j = 0; j < 16; j += 4) { const f32x4 v = *(const f32x4*)(ssq_src + row * 64 + q * 16 + j); sm += (v[0] + v[1]) + (v[2] + v[3]); }
            sm += __shfl_xor(sm, 1); sm += __shfl_xor(sm, 2);
            if (q == 0) invs[row] = rsqrtf(sm * (1.0f / 1024.0f) + EPS); }
        else if (tid < 128) invs[tid] = 1.0f;
        __syncthreads();
    }
    for (int it = bix; it < items && bix < nblk; it += nblk) {
        const int ci = it / RH, col0 = ci * NC, rowb = (it % RH) * RT * 16;
        f32x4 acc[RT][NB][CT];
#pragma unroll
        for (int t = 0; t < RT; ++t)
#pragma unroll
            for (int p = 0; p < NB; ++p)
#pragma unroll
                for (int c = 0; c < CT; ++c) acc[t][p][c] = (f32x4){0.f, 0.f, 0.f, 0.f};
        const bf16_t* ap = A + (size_t)(rowb + lr) * lda + wid * KW + 8 * kg;
        const bf16_t* bp0 = Bt + (size_t)(rm(col0, 0) + lr) * ldb + wid * KW + 8 * kg;
        const bf16_t* bp1 = NB > 1 ? Bt + (size_t)(rm(col0, 1) + lr) * ldb + wid * KW + 8 * kg : bp0;
#pragma unroll (RT == 8 ? 4 : 6)
        for (int k = 0; k < KW; k += 32) {
            bf16x8 bf[NB][CT];
#pragma unroll
            for (int c = 0; c < CT; ++c) { bf[0][c] = *(const bf16x8*)(bp0 + (size_t)c * 16 * ldb + k); if (NB > 1) bf[NB - 1][c] = *(const bf16x8*)(bp1 + (size_t)c * 16 * ldb + k); }
#pragma unroll
            for (int t = 0; t < RT; ++t) { const bf16x8 a = *(const bf16x8*)(ap + (size_t)t * 16 * lda + k);
#pragma unroll
                for (int p = 0; p < NB; ++p)
#pragma unroll
                    for (int c = 0; c < CT; ++c) acc[t][p][c] = __builtin_amdgcn_mfma_f32_16x16x32_bf16(a, bf[p][c], acc[t][p][c], 0, 0, 0); }
        }
#pragma unroll
        for (int t = 0; t < RT; ++t)
#pragma unroll
            for (int p = 0; p < NB; ++p)
#pragma unroll
                for (int c = 0; c < CT; ++c)
#pragma unroll
                    for (int r = 0; r < 4; ++r) red[((((wid * RT + t) * NB + p) * CT + c) * 16 + 4 * kg + r) * 16 + lr] = acc[t][p][c][r];
        __syncthreads();
        for (int e = tid; e < RT * 16 * NC; e += 512) {
            const int rl = e / NC, row = rowb + rl, col = e % NC, t = rl >> 4, rr = rl & 15, c = col >> 4, cl = col & 15;
            float v0 = 0.f, v1 = 0.f;
#pragma unroll
            for (int w = 0; w < 8; ++w) { v0 += red[((((w * RT + t) * NB + 0) * CT + c) * 16 + rr) * 16 + cl]; if (NB > 1) v1 += red[((((w * RT + t) * NB + (NB - 1)) * CT + c) * 16 + rr) * 16 + cl]; }
            float sq = f(row, col0 + col, v0, v1, invs[row]);
            if (ssq_out) { sq *= sq; sq += __shfl_xor(sq, 1); sq += __shfl_xor(sq, 2); sq += __shfl_xor(sq, 4); sq += __shfl_xor(sq, 8); if (NC > 16) sq += __shfl_xor(sq, 16);
                if ((col & (NC - 1)) == 0) ssq_out[row * 64 + ci] = sq; }
        }
        __syncthreads();
    }
}

template <int CT, int NB, int K, class RM, class F>
__device__ __forceinline__ void wave_gemm(LAS unsigned char* lds, const bf16_t* A, int lda, const bf16_t* Bt, int ldb, int N, const float* rs_src, RM rm, F f) {
    const int tid = otid(), wid = tid >> 6, lane = tid & 63, lr = lane & 15, kg = lane >> 4;
    const int bix = gridDim.x - 1 - blockIdx.x, rt = bix & 7, row0 = rt * 16, nct = N / (16 * CT);
    LAS float* invs = (LAS float*)(lds + LDS_INV);
    if (rs_src) { const int r = tid >> 5, q = tid & 31; const float* p = rs_src + (size_t)(row0 + r) * D + q * 32; float s = 0.f;
        for (int j = 0; j < 32; j += 4) { const f32x4 v = *(const f32x4*)(p + j); s += v[0] * v[0] + v[1] * v[1] + v[2] * v[2] + v[3] * v[3]; }
        s += __shfl_xor(s, 1); s += __shfl_xor(s, 2); s += __shfl_xor(s, 4); s += __shfl_xor(s, 8); s += __shfl_xor(s, 16);
        if (q == 0) invs[r] = rsqrtf(s * (1.0f / 1024.0f) + EPS); }
    else if (tid < 16) invs[tid] = 1.0f;
    __syncthreads();
    for (int ct = (bix >> 3) * 8 + wid; ct < nct; ct += (gridDim.x >> 3) * 8) {
        const int col0 = ct * 16 * CT;
        f32x4 acc[NB][CT];
#pragma unroll
        for (int p = 0; p < NB; ++p)
#pragma unroll
            for (int c = 0; c < CT; ++c) acc[p][c] = (f32x4){0.f, 0.f, 0.f, 0.f};
        const bf16_t* ap = A + (size_t)(row0 + lr) * lda + 8 * kg;
        const bf16_t* bp0 = Bt + (size_t)(rm(col0, 0) + lr) * ldb + 8 * kg;
        const bf16_t* bp1 = NB > 1 ? Bt + (size_t)(rm(col0, 1) + lr) * ldb + 8 * kg : bp0;
#pragma unroll 4
        for (int k = 0; k < K; k += 32) {
            const bf16x8 a = *(const bf16x8*)(ap + k);
#pragma unroll
            for (int c = 0; c < CT; ++c) {
                const bf16x8 b = *(const bf16x8*)(bp0 + (size_t)c * 16 * ldb + k);
                acc[0][c] = __builtin_amdgcn_mfma_f32_16x16x32_bf16(a, b, acc[0][c], 0, 0, 0);
                if (NB > 1) { const bf16x8 b1 = *(const bf16x8*)(bp1 + (size_t)c * 16 * ldb + k); acc[NB - 1][c] = __builtin_amdgcn_mfma_f32_16x16x32_bf16(a, b1, acc[NB - 1][c], 0, 0, 0); }
            }
        }
#pragma unroll
        for (int c = 0; c < CT; ++c)
#pragma unroll
            for (int r = 0; r < 4; ++r) f(row0 + 4 * kg + r, col0 + 16 * c + lr, acc[0][c][r], NB > 1 ? acc[NB - 1][c][r] : 0.f, invs[4 * kg + r]);
    }
    __syncthreads();
}

struct Ctx { const float* const* in; float* out; unsigned char* ws; LAS unsigned char* lds; };

__device__ __forceinline__ void tp_tile(LAS float* tile, const float* src, int sld, int sc0, int k0, bf16_t* dst, int dld, int dr0, int dk0, const float* scale, int ncv) {
    const int lane = otid() & 63;
    float v[64];
    const float* sp = src + (size_t)k0 * sld + sc0 + lane;
#pragma unroll
    for (int kk = 0; kk < 64; ++kk) v[kk] = (lane < ncv) ? sp[(size_t)kk * sld] : 0.f;
    if (scale) {
#pragma unroll
        for (int kk = 0; kk < 64; ++kk) v[kk] *= scale[k0 + kk];
    }
#pragma unroll
    for (int kk = 0; kk < 64; ++kk) tile[kk * 65 + lane] = v[kk];
    const int j = lane & 7;
#pragma unroll
    for (int ps = 0; ps < 8; ++ps) { const int cc = (lane >> 3) + 8 * ps;
        float x[8];
#pragma unroll
        for (int i = 0; i < 8; ++i) x[i] = tile[(8 * j + i) * 65 + cc];
        u32x4 w; w.x = cvt_pk_bf16(x[0], x[1]); w.y = cvt_pk_bf16(x[2], x[3]); w.z = cvt_pk_bf16(x[4], x[5]); w.w = cvt_pk_bf16(x[6], x[7]);
        if (cc < ncv) *(u32x4*)(dst + (size_t)(dr0 + cc) * dld + dk0 + 8 * j) = w; }
}
__device__ __forceinline__ void prep_weights(const Ctx& c) {
    const int wv_ = __builtin_amdgcn_readfirstlane(otid() >> 6); LAS float* tile = (LAS float*)c.lds + wv_ * (64 * 65); unsigned char* ws = c.ws;
    constexpr int N_UP = 1408, N_DN = 704, N_IN = 2304, N_DT = 16, N_BRL = 256, N_BRS = 512, N_OUT = 256, N_RG = 32;
    constexpr int TOT = 2 * N_UP + 2 * N_DN + N_IN + N_DT + N_BRL + N_BRS + N_OUT + 2 * N_RG;
    for (int ti0 = blockIdx.x * 8 + wv_; ti0 < TOT; ti0 += gridDim.x * 8) {
        int ti = ti0;
        if (ti < 2 * N_UP) { const int l = ti >= N_UP; if (l) ti -= N_UP;
            const int j = ti >> 5, r = ti & 31, pn = j >> 1, panel = j & 1, ct = r >> 4, kt = r & 15;
            tp_tile(tile, c.in[l ? 29 : 7], 2 * FF, panel * FF + 128 * pn + 64 * ct, 64 * kt, (bf16_t*)(ws + (l ? OFF_WUP2 : OFF_WUP1)), D, 256 * pn + 128 * panel + 64 * ct, 64 * kt, l ? c.in[28] : nullptr, 64);
            continue; }
        ti -= 2 * N_UP;
        if (ti < 2 * N_DN) { const int l = ti >= N_DN; if (l) ti -= N_DN;
            const int nt = ti / 44, kt = ti % 44;
            tp_tile(tile, c.in[l ? 30 : 8], D, 64 * nt, 64 * kt, (bf16_t*)(ws + (l ? OFF_WDN2 : OFF_WDN1)), FF, 64 * nt, 64 * kt, nullptr, 64);
            continue; }
        ti -= 2 * N_DN;
        if (ti < N_IN) { const int nt = ti >> 4, kt = ti & 15, n0 = 64 * nt;
            const int sc = n0 < 1024 ? n0 : (n0 < 4096 ? n0 + 3072 : (n0 < 7168 ? n0 - 3072 : n0 + 32));
            tp_tile(tile, c.in[10], 9248, sc, 64 * kt, (bf16_t*)(ws + OFF_WIN), D, n0, 64 * kt, c.in[9], 64);
            continue; }
        ti -= N_IN;
        if (ti < N_DT) { tp_tile(tile, c.in[10], 9248, 7168, 64 * ti, (bf16_t*)(ws + OFF_WDT), D, 0, 64 * ti, c.in[9], 32); continue; }
        ti -= N_DT;
        if (ti < N_BRL) { const int nt = ti >> 4, kt = ti & 15; tp_tile(tile, c.in[25], D, 64 * nt, 64 * kt, (bf16_t*)(ws + OFF_WBR), 3072, 64 * nt, 64 * kt, nullptr, 64); continue; }
        ti -= N_BRL;
        if (ti < N_BRS) { const int nt = ti >> 5, kt = ti & 31; tp_tile(tile, c.in[26], D, 64 * nt, 64 * kt, (bf16_t*)(ws + OFF_WBR), 3072, 64 * nt, 1024 + 64 * kt, c.in[24], 64); continue; }
        ti -= N_BRS;
        if (ti < N_OUT) { const int nt = ti >> 4, kt = ti & 15; tp_tile(tile, c.in[27], D, 64 * nt, 64 * kt, (bf16_t*)(ws + OFF_WOUT), D, 64 * nt, 64 * kt, nullptr, 64); continue; }
        ti -= N_OUT;
        { const int l = ti >= N_RG; if (l) ti -= N_RG; const int h = ti >> 2, nt = (ti >> 1) & 1, kt = ti & 1;
          tp_tile(tile, c.in[l ? 16 : 14] + h * 16384, 128, 64 * nt, 64 * kt, (bf16_t*)(ws + (l ? OFF_WIG : OFF_WRG)) + h * 16384, 128, 64 * nt, 64 * kt, nullptr, 64); }
    }
}
__device__ __forceinline__ void rmsnorm_rows_bf16(const float* x, int nrows, const float* g, bf16_t* dst) {
    const int t_ = otid(), lane = t_ & 63, gw = blockIdx.x * 8 + (t_ >> 6), nw = gridDim.x * 8;
    f32x4 gg[4];
#pragma unroll
    for (int i = 0; i < 4; ++i) gg[i] = *(const f32x4*)(g + (i * 64 + lane) * 4);
    for (int r = gw; r < nrows; r += 2 * nw) {
        const int r2 = r + nw; const bool two = r2 < nrows;
        const float* p = x + (size_t)r * D; const float* p2 = x + (size_t)(two ? r2 : r) * D; f32x4 v[4], w[4]; float s = 0.f, s2 = 0.f;
#pragma unroll
        for (int i = 0; i < 4; ++i) { v[i] = *(const f32x4*)(p + (i * 64 + lane) * 4); w[i] = *(const f32x4*)(p2 + (i * 64 + lane) * 4); }
#pragma unroll
        for (int i = 0; i < 4; ++i) { s += v[i][0] * v[i][0] + v[i][1] * v[i][1] + v[i][2] * v[i][2] + v[i][3] * v[i][3]; s2 += w[i][0] * w[i][0] + w[i][1] * w[i][1] + w[i][2] * w[i][2] + w[i][3] * w[i][3]; }
#pragma unroll
        for (int o = 1; o < 64; o <<= 1) { s += __shfl_xor(s, o); s2 += __shfl_xor(s2, o); }
        const float inv = rsqrtf(s * (1.0f / 1024.0f) + EPS), inv2 = rsqrtf(s2 * (1.0f / 1024.0f) + EPS);
#pragma unroll
        for (int i = 0; i < 4; ++i) { const int cc = (i * 64 + lane) * 4; const f32x4 o = v[i] * inv * gg[i];
            unsigned* q = (unsigned*)(dst + (size_t)r * D + cc); q[0] = cvt_pk_bf16(o[0], o[1]); q[1] = cvt_pk_bf16(o[2], o[3]);
            if (two) { const f32x4 o2 = w[i] * inv2 * gg[i]; unsigned* q2 = (unsigned*)(dst + (size_t)r2 * D + cc); q2[0] = cvt_pk_bf16(o2[0], o2[1]); q2[1] = cvt_pk_bf16(o2[2], o2[3]); } }
    }
}
__device__ __forceinline__ void rmsnorm_rows_f32(float* x, int nrows, const float* g) {
    const int t_ = otid(), lane = t_ & 63, gw = blockIdx.x * 8 + (t_ >> 6), nw = gridDim.x * 8;
    f32x4 gg[4];
#pragma unroll
    for (int i = 0; i < 4; ++i) gg[i] = *(const f32x4*)(g + (i * 64 + lane) * 4);
    for (int r = gw; r < nrows; r += 2 * nw) {
        const int r2 = r + nw; const bool two = r2 < nrows;
        float* p = x + (size_t)r * D; float* p2 = x + (size_t)(two ? r2 : r) * D; f32x4 v[4], w[4]; float s = 0.f, s2 = 0.f;
#pragma unroll
        for (int i = 0; i < 4; ++i) { v[i] = *(const f32x4*)(p + (i * 64 + lane) * 4); w[i] = *(const f32x4*)(p2 + (i * 64 + lane) * 4); }
#pragma unroll
        for (int i = 0; i < 4; ++i) { s += v[i][0] * v[i][0] + v[i][1] * v[i][1] + v[i][2] * v[i][2] + v[i][3] * v[i][3]; s2 += w[i][0] * w[i][0] + w[i][1] * w[i][1] + w[i][2] * w[i][2] + w[i][3] * w[i][3]; }
#pragma unroll
        for (int o = 1; o < 64; o <<= 1) { s += __shfl_xor(s, o); s2 += __shfl_xor(s2, o); }
        const float inv = rsqrtf(s * (1.0f / 1024.0f) + EPS), inv2 = rsqrtf(s2 * (1.0f / 1024.0f) + EPS);
#pragma unroll
        for (int i = 0; i < 4; ++i) { const int cc = (i * 64 + lane) * 4; *(f32x4*)(p + cc) = v[i] * inv * gg[i]; if (two) *(f32x4*)(p2 + cc) = w[i] * inv2 * gg[i]; }
    }
}

template <bool FINAL>
__device__ __forceinline__ void lru_chunk(const Ctx& c, int b, int ch, bool dry = false) {
    const int tid = otid(), wid = tid >> 6, lane = tid & 63, lr = lane & 15, kg = lane >> 4;
    LAS float* XC = (LAS float*)c.lds; LAS float* AA = (LAS float*)(c.lds + 32768); LAS float* UU = (LAS float*)(c.lds + 65536); LAS unsigned char* XCb = c.lds + 98304;
    bf16_t* PP = (bf16_t*)(c.ws + OFF_PP); bf16_t* HALO = (bf16_t*)(c.ws + OFF_HALO); float* SUMM = (float*)(c.ws + OFF_SUMM);
    const bf16_t* WRG = (const bf16_t*)(c.ws + OFF_WRG); const bf16_t* WIG = (const bf16_t*)(c.ws + OFF_WIG);
    const float* cw = c.in[12]; const float* cb = c.in[13]; const float* brg = c.in[15]; const float* big = c.in[17]; const float* lam = c.in[18];
    const int t0 = b * SEQ + 64 * ch;
    LAS float* CARRY = (LAS float*)(c.lds + 115712);
    if (FINAL) {
        float h0 = 0.f, h1 = 0.f;
        for (int cp = 0; cp < ch; cp += 8) {
            float a0[8], b0[8], a1[8], b1[8];
#pragma unroll
            for (int i = 0; i < 8; ++i) { a0[i] = 1.f; b0[i] = 0.f; a1[i] = 1.f; b1[i] = 0.f;
                if (cp + i < ch) { const float* sp = SUMM + ((size_t)(b * NCH + cp + i) * D + tid) * 2; a0[i] = sp[0]; b0[i] = sp[1]; a1[i] = sp[1024]; b1[i] = sp[1025]; } }
#pragma unroll
            for (int i = 0; i < 8; ++i) { h0 = a0[i] * h0 + b0[i]; h1 = a1[i] * h1 + b1[i]; }
        }
        CARRY[tid] = h0; CARRY[tid + 512] = h1;
    }
    const int cg8 = tid & 15, tk = (tid >> 4) * 2;
    u32x4 rawp[5]; f32x4 wk[4][2], bb[2]; bf16x8 wrf[4], wif[4]; float pb1 = 0.f, pb2 = 0.f, plam = 0.f;
#define LRU_FETCH(hd) do { const int cc0_ = 128 * (hd) + 8 * cg8; \
        _Pragma("unroll") for (int i = 0; i < 5; ++i) { const int tt = tk - 3 + i; rawp[i] = (u32x4){0u, 0u, 0u, 0u}; \
            if (tt >= 0) rawp[i] = *(const u32x4*)(PP + (size_t)(t0 + tt) * NPP + cc0_); \
            else if (ch > 0) rawp[i] = *(const u32x4*)(HALO + ((size_t)((b * NCH + ch - 1) * 3 + (tt + 3))) * D + cc0_); } \
        _Pragma("unroll") for (int k = 0; k < 4; ++k) { wk[k][0] = *(const f32x4*)(cw + k * D + cc0_); wk[k][1] = *(const f32x4*)(cw + k * D + cc0_ + 4); } \
        bb[0] = *(const f32x4*)(cb + cc0_); bb[1] = *(const f32x4*)(cb + cc0_ + 4); } while (0)
#define LRU_FETCHW(hd) do { \
        { const int cgl_ = 128 * (hd) + 16 * wid + lr; const bf16_t* wr__ = WRG + (size_t)cgl_ * 128 + 8 * kg; const bf16_t* wi__ = WIG + (size_t)cgl_ * 128 + 8 * kg; \
          _Pragma("unroll") for (int ks = 0; ks < 4; ++ks) { wrf[ks] = *(const bf16x8*)(wr__ + 32 * ks); wif[ks] = *(const bf16x8*)(wi__ + 32 * ks); } \
          pb1 = brg[cgl_]; pb2 = big[cgl_]; plam = lam[cgl_]; } } while (0)
    LRU_FETCH(0); LRU_FETCHW(0);
    for (int head = 0; head < 8; ++head) {
        const int ch0 = 128 * head;
        {
            f32x4 raw[5][2];
#pragma unroll
            for (int i = 0; i < 5; ++i) unpack8(rawp[i], raw[i][0], raw[i][1]);
#pragma unroll
            for (int q = 0; q < 2; ++q) { f32x4 o0 = bb[0], o1 = bb[1];
#pragma unroll
                for (int k = 0; k < 4; ++k) { o0 += wk[k][0] * raw[q + k][0]; o1 += wk[k][1] * raw[q + k][1]; }
                *(LAS f32x4*)(XC + (tk + q) * 128 + 8 * cg8) = o0; *(LAS f32x4*)(XC + (tk + q) * 128 + 8 * cg8 + 4) = o1;
                *(LAS u32x4*)A256(XCb, tk + q, cg8) = pack8(o0, o1); }
            if (head < 7) LRU_FETCH(head + 1);
        }
        __syncthreads();
        {
            f32x4 ar[4], ai_[4];
#pragma unroll
            for (int m = 0; m < 4; ++m) { ar[m] = (f32x4){0.f, 0.f, 0.f, 0.f}; ai_[m] = (f32x4){0.f, 0.f, 0.f, 0.f}; }
#pragma unroll
            for (int ks = 0; ks < 4; ++ks) { const bf16x8 br = wrf[ks], bi = wif[ks];
#pragma unroll
                for (int m = 0; m < 4; ++m) { const bf16x8 a = *(const LAS bf16x8*)A256(XCb, 16 * m + lr, 4 * ks + kg);
                    ar[m] = __builtin_amdgcn_mfma_f32_16x16x32_bf16(a, br, ar[m], 0, 0, 0); ai_[m] = __builtin_amdgcn_mfma_f32_16x16x32_bf16(a, bi, ai_[m], 0, 0, 0); } }
            const int cl = 16 * wid + lr; const float b1 = pb1, b2 = pb2, sp = softplusf_(-plam);
            if (head < 7) LRU_FETCHW(head + 1);
#pragma unroll
            for (int m = 0; m < 4; ++m)
#pragma unroll
                for (int r = 0; r < 4; ++r) { const int tk = 16 * m + 4 * kg + r; const float rg = sigmoidf_(ar[m][r] + b1), ig = sigmoidf_(ai_[m][r] + b2);
                    const float la = -8.0f * rg * sp, a_ = __expf(la); const float u = __builtin_amdgcn_sqrtf(fmaxf(1.0f - a_ * a_, 0.0f)) * ig * XC[tk * 128 + cl];
                    AA[tk * 128 + cl] = la; UU[tk * 128 + cl] = u; }
        }
        __syncthreads();
        if (!FINAL) {
            const int cg8s = tid & 15, tks = (tid >> 4) * 2;
#pragma unroll
            for (int q = 0; q < 2; ++q) { const f32x4 o0 = *(const LAS f32x4*)(UU + (tks + q) * 128 + 8 * cg8s), o1 = *(const LAS f32x4*)(UU + (tks + q) * 128 + 8 * cg8s + 4);
                const f32x4 l0 = *(const LAS f32x4*)(AA + (tks + q) * 128 + 8 * cg8s), l1 = *(const LAS f32x4*)(AA + (tks + q) * 128 + 8 * cg8s + 4);
                *(u32x4*)(PP + (size_t)(t0 + tks + q) * NPP + ch0 + 8 * cg8s) = pack8(o0, o1); *(u32x4*)(PP + (size_t)(t0 + tks + q) * NPP + 3072 + ch0 + 8 * cg8s) = pack8(l0, l1); } }
        if (tid < 128) { const int cgl = ch0 + tid;
            if (!FINAL) { float A = 1.f, H = 0.f;
                for (int t8 = 0; t8 < 64; t8 += 16) { float av[16], uv[16];
#pragma unroll
                    for (int i = 0; i < 16; ++i) { av[i] = AA[(t8 + i) * 128 + tid]; uv[i] = UU[(t8 + i) * 128 + tid]; }
#pragma unroll
                    for (int i = 0; i < 16; ++i) { const float a_ = __expf(av[i]); H = a_ * H + uv[i]; A *= a_; } }
                float* s = SUMM + ((size_t)(b * NCH + ch) * D + cgl) * 2; s[0] = A; s[1] = H; }
            else { float h = CARRY[cgl];
                for (int t8 = 0; t8 < 64; t8 += 16) { float av[16], uv[16];
#pragma unroll
                    for (int i = 0; i < 16; ++i) { av[i] = AA[(t8 + i) * 128 + tid]; uv[i] = UU[(t8 + i) * 128 + tid]; }
#pragma unroll
                    for (int i = 0; i < 16; ++i) { h = av[i] * h + uv[i]; UU[(t8 + i) * 128 + tid] = h; } }
                if (ch == NCH - 1) c.out[O_LHP + b * D + cgl] = h; } }
        __syncthreads();
        if (FINAL) { const int cg8 = tid & 15, tk = (tid >> 4) * 2;
#pragma unroll
            for (int q = 0; q < 2; ++q) { const f32x4 o0 = *(const LAS f32x4*)(UU + (tk + q) * 128 + 8 * cg8), o1 = *(const LAS f32x4*)(UU + (tk + q) * 128 + 8 * cg8 + 4);
                if (!dry) *(u32x4*)(PP + (size_t)(t0 + tk + q) * NPP + ch0 + 8 * cg8) = pack8(o0, o1); }
            __syncthreads(); }
    }
}

__device__ __forceinline__ void lru_final(const Ctx& c, int b, int ch) {
    const int tid = otid(); bf16_t* PP = (bf16_t*)(c.ws + OFF_PP); const float* SUMM = (const float*)(c.ws + OFF_SUMM);
    const int t0 = b * SEQ + 64 * ch, c2 = 2 * tid;
    float h0 = 0.f, h1 = 0.f;
    for (int cp = 0; cp < ch; cp += 8) {
        f32x4 sv[8];
#pragma unroll
        for (int i = 0; i < 8; ++i) { sv[i] = (f32x4){1.f, 0.f, 1.f, 0.f}; if (cp + i < ch) sv[i] = *(const f32x4*)(SUMM + ((size_t)(b * NCH + cp + i) * D + c2) * 2); }
#pragma unroll
        for (int i = 0; i < 8; ++i) { h0 = sv[i][0] * h0 + sv[i][1]; h1 = sv[i][2] * h1 + sv[i][3]; }
    }
    for (int t8 = 0; t8 < 64; t8 += 16) {
        unsigned uu[16], ll[16];
#pragma unroll
        for (int i = 0; i < 16; ++i) { const bf16_t* p = PP + (size_t)(t0 + t8 + i) * NPP + c2; uu[i] = *(const unsigned*)p; ll[i] = *(const unsigned*)(p + 3072); }
#pragma unroll
        for (int i = 0; i < 16; ++i) { h0 = __expf(bflo(ll[i])) * h0 + bflo(uu[i]); h1 = __expf(bfhi(ll[i])) * h1 + bfhi(uu[i]);
            *(unsigned*)(PP + (size_t)(t0 + t8 + i) * NPP + c2) = cvt_pk_bf16(h0, h1); }
    }
    if (ch == NCH - 1) { c.out[O_LHP + b * D + c2] = h0; c.out[O_LHP + b * D + c2 + 1] = h1; }
}

__device__ __forceinline__ void bc_conv(const Ctx& c, int b, int ch) {
    const int tid = otid(); const bf16_t* PP = (const bf16_t*)(c.ws + OFF_PP); bf16_t* BCc = (bf16_t*)(c.ws + OFF_XN);
    const float* cw = c.in[19]; const float* cb = c.in[20]; const int t0 = b * SEQ + 64 * ch;
    if (tid < 384) { const int row = tid >> 7, cg8 = tid & 127;
        *(u32x4*)((bf16_t*)(c.ws + OFF_HALO) + ((size_t)((b * NCH + ch) * 3 + row)) * D + 8 * cg8) = *(const u32x4*)(PP + (size_t)(t0 + 61 + row) * NPP + 8 * cg8); }
#pragma unroll 1
    for (int item = tid; item < 1024; item += 512) {
        const int cgq = item & 127, st = item >> 7, gcol = 3072 + 8 * cgq, ccol = 2048 + 8 * cgq;
        u32x4 raw[11];
#pragma unroll
        for (int i = 0; i < 11; ++i) { const int tt = 8 * st - 3 + i; raw[i] = (u32x4){0u, 0u, 0u, 0u}; if (tt >= 0 || ch > 0) raw[i] = *(const u32x4*)(PP + (size_t)(t0 + tt) * NPP + gcol); }
#pragma unroll
        for (int hf = 0; hf < 2; ++hf) {
            f32x4 wk[4]; const f32x4 bb = *(const f32x4*)(cb + ccol + 4 * hf);
#pragma unroll
            for (int k = 0; k < 4; ++k) wk[k] = *(const f32x4*)(cw + k * 3072 + ccol + 4 * hf);
#pragma unroll
            for (int q = 0; q < 8; ++q) { f32x4 o = bb;
#pragma unroll
                for (int k = 0; k < 4; ++k) { const unsigned w0 = raw[q + k][2 * hf], w1 = raw[q + k][2 * hf + 1]; const f32x4 r = (f32x4){bflo(w0), bfhi(w0), bflo(w1), bfhi(w1)}; o += wk[k] * r; }
#pragma unroll
                for (int j = 0; j < 4; ++j) o[j] = siluf_(o[j]);
                unsigned* op = (unsigned*)(BCc + (size_t)(t0 + 8 * st + q) * 1024 + 8 * cgq + 4 * hf); op[0] = cvt_pk_bf16(o[0], o[1]); op[1] = cvt_pk_bf16(o[2], o[3]); }
        }
    }
}

__device__ __forceinline__ void ssd_seq(const Ctx& c, int b, int h, bool dry = false) {
    const int tid = otid(), wid = tid >> 6, lane = tid & 63, lr = lane & 15, kg = lane >> 4;
    LAS unsigned char* L = c.lds;
    LAS unsigned char* Cm = L; LAS unsigned char* Bm = L + 16384; LAS unsigned char* BdT = L + 32768; LAS unsigned char* Sb = L + 49152;
    LAS unsigned char* XdT = L + 65536; LAS unsigned char* Xr = L + 73728; LAS unsigned char* Mm = L + 82944;
    LAS float* dts = (LAS float*)(L + 91136); LAS float* css = (LAS float*)(L + 91392); LAS float* dec = (LAS float*)(L + 91648); LAS bf16_t* halo = (LAS bf16_t*)(L + 91904);
    bf16_t* PP = (bf16_t*)(c.ws + OFF_PP); const float* DT = (const float*)(c.ws + OFF_DT);
    const float* cw = c.in[19]; const float* cb = c.in[20];
    const int g = h >> 3;
    const float Ah = -__expf(c.in[22][h]), Dh = c.in[23][h], dtb = c.in[21][h];
    f32x4 accS[4];
#pragma unroll
    for (int m = 0; m < 4; ++m) accS[m] = (f32x4){0.f, 0.f, 0.f, 0.f};
    for (int e = tid; e < 64 * 128; e += 512) ((LAS bf16_t*)Sb)[e] = 0;
    const bf16_t* BCc = (const bf16_t*)(c.ws + OFF_XN);
    const int role = tid >> 7, rt = tid & 127;
    const int xg = rt & 7, xst = rt >> 3;
    const int bg8 = rt & 15, bst = rt >> 4;
    const int gcol = 1024 + 64 * h + 8 * xg, ccol = 64 * h + 8 * xg;
    const int bcol = (role == 2 ? 512 : 0) + 128 * g + 8 * bg8;
    u32x4 raw[8]; float dtv = 0.f;
    f32x4 wkk[2][4], bbb[2];
#pragma unroll
    for (int hf = 0; hf < 2; ++hf) { bbb[hf] = *(const f32x4*)(cb + ccol + 4 * hf);
#pragma unroll
        for (int k = 0; k < 4; ++k) wkk[hf][k] = *(const f32x4*)(cw + k * 3072 + ccol + 4 * hf); }
    {
        const int t0 = b * SEQ;
        if (role == 0) {
#pragma unroll
            for (int i = 0; i < 7; ++i) { const int tt = 4 * xst - 3 + i; raw[i] = (u32x4){0u, 0u, 0u, 0u}; if (tt >= 0) raw[i] = *(const u32x4*)(PP + (size_t)(t0 + tt) * NPP + gcol); } }
        else if (role < 3) {
#pragma unroll
            for (int i = 0; i < 8; ++i) raw[i] = *(const u32x4*)(BCc + (size_t)(t0 + 8 * bst + i) * 1024 + bcol); }
        if (wid == 0) dtv = DT[(size_t)(t0 + lane) * 32 + h];
    }
    for (int ch = 0; ch < NCH; ++ch) {
        const int t0 = b * SEQ + 64 * ch;
        if (wid == 0) {
            const float d = softplusf_(dtv + dtb); float sc = d * Ah;
#pragma unroll
            for (int o = 1; o < 64; o <<= 1) { const float v = __shfl_up(sc, o); if (lane >= o) sc += v; }
            const float ce = __shfl(sc, 63);
            dts[lane] = d; css[lane] = sc; dec[lane] = __expf(ce - sc);
        }
        __syncthreads();
        if (role == 0) {
            if (xst == 0 && ch > 0) {
#pragma unroll
                for (int i = 0; i < 3; ++i) raw[i] = *(const LAS u32x4*)(halo + ((ch - 1) & 1) * 192 + i * 64 + 8 * xg); }
            if (xst == 15) {
#pragma unroll
                for (int i = 0; i < 3; ++i) *(LAS u32x4*)(halo + (ch & 1) * 192 + i * 64 + 8 * xg) = raw[4 + i];
                if (ch == NCH - 1 && !dry) {
#pragma unroll
                    for (int r = 0; r < 3; ++r) { f32x4 v0, v1; unpack8(raw[4 + r], v0, v1); float* o = c.out + O_SCP + (size_t)(b * 3 + r) * 3072 + ccol; *(f32x4*)o = v0; *(f32x4*)(o + 4) = v1; } } }
            const int chunk = (xst >> 1) ^ xg;
#pragma unroll
            for (int hf = 0; hf < 2; ++hf) {
                unsigned tq[4][2];
#pragma unroll
                for (int q = 0; q < 4; ++q) { f32x4 o = bbb[hf];
#pragma unroll
                    for (int k = 0; k < 4; ++k) { const unsigned w0 = raw[q + k][2 * hf], w1 = raw[q + k][2 * hf + 1]; const f32x4 r = (f32x4){bflo(w0), bfhi(w0), bflo(w1), bfhi(w1)}; o += wkk[hf][k] * r; }
#pragma unroll
                    for (int j = 0; j < 4; ++j) o[j] = siluf_(o[j]);
                    const int l = 4 * xst + q;
                    LAS unsigned* rp = (LAS unsigned*)(Xr + l * 144 + 16 * xg + 8 * hf); rp[0] = cvt_pk_bf16(o[0], o[1]); rp[1] = cvt_pk_bf16(o[2], o[3]);
                    const float d = dts[l]; tq[q][0] = cvt_pk_bf16(o[0] * d, o[1] * d); tq[q][1] = cvt_pk_bf16(o[2] * d, o[3] * d);
                }
#pragma unroll
                for (int j2 = 0; j2 < 2; ++j2) {
                    unsigned lo[2], hi[2];
#pragma unroll
                    for (int i = 0; i < 2; ++i) { const unsigned a = tq[2 * i][j2], bq = tq[2 * i + 1][j2]; lo[i] = (a & 0xffffu) | (bq << 16); hi[i] = (a >> 16) | (bq & 0xffff0000u); }
                    LAS unsigned* p0 = (LAS unsigned*)(A128(XdT, 8 * xg + 4 * hf + 2 * j2, xst >> 1) + 8 * (xst & 1)); p0[0] = lo[0]; p0[1] = lo[1];
                    LAS unsigned* p1 = (LAS unsigned*)(A128(XdT, 8 * xg + 4 * hf + 2 * j2 + 1, xst >> 1) + 8 * (xst & 1)); p1[0] = hi[0]; p1[1] = hi[1]; }
            }
        } else if (role == 1) {
            const int chunk = bst ^ (bg8 & 7);
            unsigned tq[8][4];
#pragma unroll
            for (int q = 0; q < 8; ++q) { const int l = 8 * bst + q; *(LAS u32x4*)A256(Bm, l, bg8) = raw[q]; const float d = dec[l]; f32x4 v0, v1; unpack8(raw[q], v0, v1);
                tq[q][0] = cvt_pk_bf16(v0[0] * d, v0[1] * d); tq[q][1] = cvt_pk_bf16(v0[2] * d, v0[3] * d); tq[q][2] = cvt_pk_bf16(v1[0] * d, v1[1] * d); tq[q][3] = cvt_pk_bf16(v1[2] * d, v1[3] * d); }
#pragma unroll
            for (int j2 = 0; j2 < 4; ++j2) { u32x4 lo, hi;
#pragma unroll
                for (int i = 0; i < 4; ++i) { const unsigned a = tq[2 * i][j2], bq = tq[2 * i + 1][j2]; lo[i] = (a & 0xffffu) | (bq << 16); hi[i] = (a >> 16) | (bq & 0xffff0000u); }
                *(LAS u32x4*)A128(BdT, 8 * bg8 + 2 * j2, bst) = lo; *(LAS u32x4*)A128(BdT, 8 * bg8 + 2 * j2 + 1, bst) = hi; }
        } else if (role == 2) {
#pragma unroll
            for (int q = 0; q < 8; ++q) *(LAS u32x4*)A256(Cm, 8 * bst + q, bg8) = raw[q];
        }
        if (ch + 1 < NCH) {
            if (role == 0) {
#pragma unroll
                for (int i = 0; i < 7; ++i) { const int tt = 4 * xst - 3 + i; if (tt >= 0) raw[i] = *(const u32x4*)(PP + (size_t)(t0 + 64 + tt) * NPP + gcol); } }
            else if (role < 3) {
#pragma unroll
                for (int i = 0; i < 8; ++i) raw[i] = *(const u32x4*)(BCc + (size_t)(t0 + 64 + 8 * bst + i) * 1024 + bcol); }
            if (wid == 0) dtv = DT[(size_t)(t0 + 64 + lane) * 32 + h];
        }
        __syncthreads();
#pragma unroll
        for (int q = 0; q < 2; ++q) { const int ti = 2 * wid + q, lt = ti >> 2, stl = ti & 3; f32x4 a4 = (f32x4){0.f, 0.f, 0.f, 0.f};
            if (stl <= lt) {
#pragma unroll
                for (int ks = 0; ks < 4; ++ks) { const bf16x8 a = *(const LAS bf16x8*)A256(Bm, 16 * stl + lr, 4 * ks + kg), bq = *(const LAS bf16x8*)A256(Cm, 16 * lt + lr, 4 * ks + kg);
                    a4 = __builtin_amdgcn_mfma_f32_16x16x32_bf16(a, bq, a4, 0, 0, 0); } }
            const int l = 16 * lt + lr; const float cl = css[l]; f32x4 v;
#pragma unroll
            for (int r = 0; r < 4; ++r) { const int sI = 16 * stl + 4 * kg + r; v[r] = (sI <= l) ? a4[r] * __expf(cl - css[sI]) : 0.f; }
            unsigned* dummy = nullptr; (void)dummy;
            LAS unsigned* mp = (LAS unsigned*)(A128(Mm, l, 2 * stl + (kg >> 1)) + 8 * (kg & 1)); mp[0] = cvt_pk_bf16(v[0], v[1]); mp[1] = cvt_pk_bf16(v[2], v[3]); }
        __syncthreads();
#pragma unroll
        for (int q = 0; q < 2; ++q) { const int ti = 2 * wid + q, pt = ti >> 2, lt = ti & 3; f32x4 a4 = (f32x4){0.f, 0.f, 0.f, 0.f};
#pragma unroll
            for (int ks = 0; ks < 4; ++ks) { const bf16x8 a = *(const LAS bf16x8*)A256(Sb, 16 * pt + lr, 4 * ks + kg), bq = *(const LAS bf16x8*)A256(Cm, 16 * lt + lr, 4 * ks + kg);
                a4 = __builtin_amdgcn_mfma_f32_16x16x32_bf16(a, bq, a4, 0, 0, 0); }
            const int l = 16 * lt + lr; const float el = __expf(css[l]);
#pragma unroll
            for (int r = 0; r < 4; ++r) a4[r] *= el;
            const int prow_ = 16 * pt + lr, sw = (2 * pt + (lr >> 3)) & 7;
#pragma unroll
            for (int ks = 0; ks < 2; ++ks) { const bf16x8 a = *(const LAS bf16x8*)A128(XdT, prow_, 4 * ks + kg), bq = *(const LAS bf16x8*)A128(Mm, 16 * lt + lr, 4 * ks + kg);
                a4 = __builtin_amdgcn_mfma_f32_16x16x32_bf16(a, bq, a4, 0, 0, 0); }
            const int p0 = 16 * pt + 4 * kg; const LAS unsigned* xp = (const LAS unsigned*)(Xr + l * 144 + 2 * p0); const unsigned x01 = xp[0], x23 = xp[1];
            const float y0 = a4[0] + Dh * bflo(x01), y1 = a4[1] + Dh * bfhi(x01), y2 = a4[2] + Dh * bflo(x23), y3 = a4[3] + Dh * bfhi(x23);
            if (!dry) { unsigned* yp = (unsigned*)(PP + (size_t)(t0 + l) * NPP + 1024 + 64 * h + p0); yp[0] = cvt_pk_bf16(y0, y1); yp[1] = cvt_pk_bf16(y2, y3); } }
        { const float ce = __expf(css[63]); const int nrow = 16 * wid + lr, swn = (2 * wid + (lr >> 3)) & 7;
#pragma unroll
          for (int m = 0; m < 4; ++m) { accS[m] *= ce; const int prow_ = 16 * m + lr, swp = (2 * m + (lr >> 3)) & 7;
#pragma unroll
            for (int ks = 0; ks < 2; ++ks) { const bf16x8 a = *(const LAS bf16x8*)A128(BdT, nrow, 4 * ks + kg), bq = *(const LAS bf16x8*)A128(XdT, prow_, 4 * ks + kg);
                accS[m] = __builtin_amdgcn_mfma_f32_16x16x32_bf16(a, bq, accS[m], 0, 0, 0); } } }
        __syncthreads();
#pragma unroll
        for (int m = 0; m < 4; ++m) { LAS unsigned* sp = (LAS unsigned*)(A256(Sb, 16 * m + lr, 2 * wid + (kg >> 1)) + 8 * (kg & 1)); sp[0] = cvt_pk_bf16(accS[m][0], accS[m][1]); sp[1] = cvt_pk_bf16(accS[m][2], accS[m][3]); }
    }
    if (!dry) {
#pragma unroll
        for (int m = 0; m < 4; ++m) *(f32x4*)(c.out + O_SHP + ((size_t)(b * 32 + h) * 64 + 16 * m + lr) * 128 + 16 * wid + 4 * kg) = accS[m];
    }
    __syncthreads();
}

__device__ __forceinline__ void lru_sample(const Ctx& c, int b, int head) {
    const int tid = otid(); LAS float* XC = (LAS float*)c.lds; LAS float* RG = XC + 2048; LAS float* IG = RG + 2048;
    const float* PS = (const float*)(c.ws + OFF_PS); bf16_t* ABRS = (bf16_t*)(c.ws + OFF_ABRS);
    const float* cw = c.in[12]; const float* cb = c.in[13]; const int ch0 = 128 * head;
    for (int e = tid; e < 2048; e += 512) { const int tk = e >> 7, cl = e & 127, cgl = ch0 + cl; float o = cb[cgl];
#pragma unroll
        for (int k = 0; k < 4; ++k) { const int tt = tk - 3 + k; const float v = tt >= 0 ? PS[(size_t)(b * 16 + tt) * 9216 + cgl] : SZ(c.in[2][(size_t)(b * 3 + tt + 3) * D + cgl]); o += cw[k * D + cgl] * v; }
        XC[e] = o; }
    if (tid < 384) { const int r = tid >> 7, cl = tid & 127; c.out[O_LCS + (size_t)(b * 3 + r) * D + ch0 + cl] = PS[(size_t)(b * 16 + 13 + r) * 9216 + ch0 + cl]; }
    __syncthreads();
    {
        LAS unsigned char* XCb = c.lds + 32768; const int wid = tid >> 6, lane = tid & 63, lr = lane & 15, kg = lane >> 4;
        for (int e = tid; e < 2048; e += 512) *(LAS bf16_t*)(XCb + (e >> 7) * 272 + 2 * (e & 127)) = f2bf(XC[e]);
        __syncthreads();
        const bf16_t* wr_ = (const bf16_t*)(c.ws + OFF_WRG) + (size_t)(ch0 + 16 * wid + lr) * 128 + 8 * kg; const bf16_t* wi_ = (const bf16_t*)(c.ws + OFF_WIG) + (size_t)(ch0 + 16 * wid + lr) * 128 + 8 * kg;
        f32x4 ar = (f32x4){0.f, 0.f, 0.f, 0.f}, ai_ = ar;
#pragma unroll
        for (int ks = 0; ks < 4; ++ks) { const bf16x8 br = *(const bf16x8*)(wr_ + 32 * ks), bi = *(const bf16x8*)(wi_ + 32 * ks), a = *(const LAS bf16x8*)(XCb + lr * 272 + (32 * ks + 8 * kg) * 2);
            ar = __builtin_amdgcn_mfma_f32_16x16x32_bf16(a, br, ar, 0, 0, 0); ai_ = __builtin_amdgcn_mfma_f32_16x16x32_bf16(a, bi, ai_, 0, 0, 0); }
        const int cl = 16 * wid + lr; const float b1 = c.in[15][ch0 + cl], b2 = c.in[17][ch0 + cl];
#pragma unroll
        for (int r = 0; r < 4; ++r) { const int tk = 4 * kg + r; RG[tk * 128 + cl] = sigmoidf_(ar[r] + b1); IG[tk * 128 + cl] = sigmoidf_(ai_[r] + b2); }
    }
    __syncthreads();
    if (tid < 128) { const int cgl = ch0 + tid; const float sp = softplusf_(-c.in[18][cgl]); float h = SZ(c.in[3][b * D + cgl]);
        for (int tk = 0; tk < 16; ++tk) { const float la = -8.0f * RG[tk * 128 + tid] * sp, a = __expf(la), u = sqrtf(-expm1f(2.0f * la)) * IG[tk * 128 + tid] * XC[tk * 128 + tid];
            h = a * h + u; ABRS[(size_t)(b * 16 + tk) * 3072 + cgl] = f2bf(gelu_tanh(PS[(size_t)(b * 16 + tk) * 9216 + 4096 + cgl]) * h); }
        c.out[O_LHS + b * D + cgl] = h; }
    __syncthreads();
}
__device__ __forceinline__ void ssd_sample(const Ctx& c, int b, int h) {
    const int tid = otid(); LAS float* XS = (LAS float*)c.lds; LAS float* BS = XS + 1024; LAS float* CS = BS + 2048; LAS float* DTL = CS + 2048;
    const float* PS = (const float*)(c.ws + OFF_PS); const float* DTS = (const float*)(c.ws + OFF_DTS); float* YGS = (float*)(c.ws + OFF_YGS);
    const float* cw = c.in[19]; const float* cb = c.in[20]; const int g = h >> 3;
    for (int e = tid; e < 16 * 320; e += 512) { const int tk = e / 320, q = e % 320; int cc; LAS float* dst;
        if (q < 64) { cc = 64 * h + q; dst = XS + tk * 64 + q; } else if (q < 192) { cc = 2048 + 128 * g + (q - 64); dst = BS + tk * 128 + (q - 64); } else { cc = 2560 + 128 * g + (q - 192); dst = CS + tk * 128 + (q - 192); }
        float o = cb[cc];
#pragma unroll
        for (int k = 0; k < 4; ++k) { const int tt = tk - 3 + k; const float v = tt >= 0 ? PS[(size_t)(b * 16 + tt) * 9216 + 1024 + cc] : SZ(c.in[4][(size_t)(b * 3 + tt + 3) * 3072 + cc]); o += cw[k * 3072 + cc] * v; }
        *dst = siluf_(o);
        if (tk >= 13 && (q < 64 || (h & 7) == 0)) c.out[O_SCS + (size_t)(b * 3 + tk - 13) * 3072 + cc] = PS[(size_t)(b * 16 + tk) * 9216 + 1024 + cc]; }
    if (tid < 16) DTL[tid] = softplusf_(DTS[(b * 16 + tid) * 32 + h] + c.in[21][h]);
    __syncthreads();
    const float Ah = -__expf(c.in[22][h]), Dh = c.in[23][h];
    const int p = tid >> 3, n0 = (tid & 7) * 16; float hs[16];
    const float* h0 = c.in[5] + ((size_t)(b * 32 + h) * 64 + p) * 128 + n0;
#pragma unroll
    for (int j = 0; j < 16; ++j) hs[j] = SZ(h0[j]);
    float zv[16];
#pragma unroll
    for (int tk = 0; tk < 16; ++tk) zv[tk] = PS[(size_t)(b * 16 + tk) * 9216 + 5120 + 64 * h + p];
#pragma unroll
    for (int tk = 0; tk < 16; ++tk) { const float d = DTL[tk], ea = __expf(d * Ah), xv = XS[tk * 64 + p], dx = d * xv; float y = 0.f;
#pragma unroll
        for (int j = 0; j < 16; ++j) { hs[j] = ea * hs[j] + dx * BS[tk * 128 + n0 + j]; y += CS[tk * 128 + n0 + j] * hs[j]; }
        y += __shfl_xor(y, 1); y += __shfl_xor(y, 2); y += __shfl_xor(y, 4);
        if ((tid & 7) == 0) { const int row = b * 16 + tk; YGS[(size_t)row * 2048 + 64 * h + p] = (y + Dh * xv) * siluf_(zv[tk]); } }
    float* ho = c.out + O_SHS + ((size_t)(b * 32 + h) * 64 + p) * 128 + n0;
#pragma unroll
    for (int j = 0; j < 16; ++j) ho[j] = hs[j];
    __syncthreads();
}

#ifdef DIAG
constexpr size_t OFF_DIAG = 266338304;
__device__ __forceinline__ int prow(int r) { return (r >> 4) * SEQ + (r & 15); }
template <class FA, class FB>
__device__ __forceinline__ void diag_rel(LAS float* red, float* dst, int ncols, FA fa, FB fb) {
    const int tid = threadIdx.x; float num = 0.f, den = 0.f;
    for (int e = tid; e < TS * ncols; e += 512) { const int r = e / ncols, cc = e % ncols; const float a = fa(r, cc), b = fb(r, cc); num += (a - b) * (a - b); den += b * b; }
    red[tid] = num; red[512 + tid] = den; __syncthreads();
    if (tid == 0) { float n = 0.f, d = 0.f; for (int i = 0; i < 512; ++i) { n += red[i]; d += red[512 + i]; } *dst = n / (d + 1e-30f); }
    __syncthreads();
}
#endif
constexpr size_t OFF_BAR = 266338304 + 4096, OFF_SSQS = OFF_BAR + 4096;
__device__ __forceinline__ void grid_barrier(unsigned* ctr, unsigned target) {
    asm volatile("s_waitcnt vmcnt(0) lgkmcnt(0)" ::: "memory");
    __syncthreads();
    if (threadIdx.x == 0) {
        __builtin_amdgcn_fence(__ATOMIC_RELEASE, "agent");
        asm volatile("s_waitcnt vmcnt(0)" ::: "memory");
        __hip_atomic_fetch_add(ctr, 1u, __ATOMIC_RELAXED, __HIP_MEMORY_SCOPE_AGENT);
        while (__hip_atomic_load(ctr, __ATOMIC_RELAXED, __HIP_MEMORY_SCOPE_AGENT) < target) __builtin_amdgcn_s_sleep(1);
        __builtin_amdgcn_fence(__ATOMIC_ACQUIRE, "agent");
        asm volatile("s_waitcnt vmcnt(0)" ::: "memory");
    }
    __syncthreads();
}
#define XB_TMO      128
#define XB_XCNT(j)  (256  + 64 * (j))
#define XB_XSUB(j)  (1280 + 64 * (j))
#define XB_XGEN(j)  (2304 + 64 * (j))
#define XB_TOP      3328
#define XB_TOPGEN   3392
#define XCD_BAR_WORDS 3456
#define XB_SPIN_CAP (1u << 18)
constexpr size_t OFF_XBAR = 266338304 + 4096 + 4096 + 65536;
__device__ __forceinline__ unsigned xb_ld(unsigned* p)              { return __hip_atomic_load(p, __ATOMIC_RELAXED, __HIP_MEMORY_SCOPE_AGENT); }
__device__ __forceinline__ unsigned xb_add(unsigned* p, unsigned v) { return __hip_atomic_fetch_add(p, v, __ATOMIC_RELAXED, __HIP_MEMORY_SCOPE_AGENT); }
__device__ __forceinline__ unsigned xb_xcc_id() { return (unsigned)__builtin_amdgcn_s_getreg((3 << 11) | 20) & 0xFu; }
#define XB_SPIN(cond, bar) do { unsigned _sp = 0; while (cond) { __builtin_amdgcn_s_sleep(1); \
    if ((++_sp & 255u) == 0u) { if (xb_ld(&(bar)[XB_TMO])) break; if (_sp > XB_SPIN_CAP) { atomicAdd(&(bar)[XB_TMO], 1u); break; } } } } while (0)
struct XcdBarrier { unsigned* bar; unsigned x; volatile LAS unsigned* st; };
__device__ __forceinline__ XcdBarrier xcd_barrier_post(unsigned* bar, volatile LAS unsigned* st) {
    XcdBarrier b; b.bar = bar; b.x = xb_xcc_id(); b.st = st;
    if (threadIdx.x == 0) (void)xb_add(&bar[XB_XCNT(b.x)], 1u);
    return b;
}
__device__ __forceinline__ void xcd_barrier_complete(unsigned* bar, unsigned x, unsigned& nloc, unsigned& nx) {
    const unsigned G = gridDim.x * gridDim.y * gridDim.z;
    unsigned sum, cnt, mine, sp = 0u;
    for (;;) {
        sum = 0u; cnt = 0u; mine = 0u;
#pragma unroll
        for (unsigned j = 0; j < 16; ++j) { const unsigned c = xb_ld(&bar[XB_XCNT(j)]); sum += c; cnt += (c > 0u) ? 1u : 0u; mine = (j == x) ? c : mine; }
        if (sum == G) break;
        __builtin_amdgcn_s_sleep(1);
        if ((++sp & 255u) == 0u) { if (xb_ld(&bar[XB_TMO])) break; if (sp > XB_SPIN_CAP) { atomicAdd(&bar[XB_TMO], 1u); break; } }
    }
    nloc = mine > 0u ? mine : 1u; nx = cnt > 0u ? cnt : 1u;
}
__device__ __forceinline__ void xcd_barrier(const XcdBarrier& b) {
    asm volatile("s_waitcnt vmcnt(0)" ::: "memory");
    __syncthreads();
    if (threadIdx.x == 0) {
        unsigned* bar = b.bar;
        __builtin_amdgcn_s_waitcnt(0);
        unsigned nloc = b.st[0], nx = b.st[1];
        if (nloc == 0u) { xcd_barrier_complete(bar, b.x, nloc, nx); b.st[0] = nloc; b.st[1] = nx; }
        const unsigned old = xb_add(&bar[XB_XSUB(b.x)], 1u);
        const unsigned gen = old / nloc;
        if (old + 1u == (gen + 1u) * nloc) {
            __builtin_amdgcn_fence(__ATOMIC_RELEASE, "agent");
            asm volatile("s_waitcnt vmcnt(0)" ::: "memory");
            const unsigned og = xb_add(&bar[XB_TOP], 1u);
            const unsigned tg = og / nx;
            if (og + 1u == (tg + 1u) * nx) xb_add(&bar[XB_TOPGEN], 1u);
            else XB_SPIN(xb_ld(&bar[XB_TOPGEN]) == tg, bar);
            __builtin_amdgcn_fence(__ATOMIC_ACQUIRE, "agent");
            xb_add(&bar[XB_XGEN(b.x)], 1u);
            asm volatile("s_waitcnt vmcnt(0)" ::: "memory");
        } else {
            XB_SPIN(xb_ld(&bar[XB_XGEN(b.x)]) == gen, bar);
            __builtin_amdgcn_fence(__ATOMIC_ACQUIRE, "agent");
            asm volatile("s_waitcnt vmcnt(0)" ::: "memory");
        }
    }
    __syncthreads();
}
#ifndef DUPX
#define DUPX 0
#endif
#ifdef TIMER_ID
#define TSTART(id) do { if ((id) == TIMER_ID) t0_ = __builtin_amdgcn_s_memrealtime(); } while (0)
#define TSTOP(id) do { if ((id) == TIMER_ID) tacc_ += __builtin_amdgcn_s_memrealtime() - t0_; } while (0)
#else
#define TSTART(id)
#define TSTOP(id)
#endif
__global__ void __launch_bounds__(512, 2) fwd_kernel(Params prm) {
    extern __shared__ __attribute__((aligned(16))) unsigned char lds_raw[];
    Ctx c; c.in = prm.in; c.out = prm.out; c.ws = prm.ws; c.lds = (LAS unsigned char*)lds_raw;
    unsigned char* ws = prm.ws; float* out = prm.out;
    const int tid = threadIdx.x, G = gridDim.x, bid = blockIdx.x;
    bf16_t* XB = (bf16_t*)(ws + OFF_XB); bf16_t* XN = (bf16_t*)(ws + OFF_XN); bf16_t* PP = (bf16_t*)(ws + OFF_PP); float* SSQ = (float*)(ws + OFF_SSQ);
    bf16_t* XNS = (bf16_t*)(ws + OFF_XNS); bf16_t* HS = (bf16_t*)(ws + OFF_HS); float* PS = (float*)(ws + OFF_PS); float* GSSQ = (float*)(ws + OFF_GSSQ);
    float* YS = out + O_YS; float* SSQS = (float*)(ws + OFF_SSQS);
    const int lo = prm.ph_lo, hi = prm.ph_hi;
#ifdef DIAG
    if (lo >= 100) {
        if (bid != 0) return;
        float* DG = (float*)(ws + OFF_DIAG); LAS float* red = (LAS float*)c.lds; const int st = lo - 100;
        const float* DTp = (const float*)(ws + OFF_DT); const float* DTs = (const float*)(ws + OFF_DTS); const bf16_t* ABRS = (const bf16_t*)(ws + OFF_ABRS); const bf16_t* MS = (const bf16_t*)(ws + OFF_MS); const float* bg = prm.in[11];
        if (st == 0 || st == 6 || st == 7) diag_rel(red, DG + st, D, [=](int r, int cc) { return out[O_YP + (size_t)prow(r) * D + cc]; }, [=](int r, int cc) { return YS[(size_t)r * D + cc]; });
        if (st == 1) { diag_rel(red, DG + 1, NPP, [=](int r, int cc) { return bf2f(PP[(size_t)prow(r) * NPP + cc]); }, [=](int r, int cc) { return PS[(size_t)r * 9216 + cc]; });
                       diag_rel(red, DG + 2, 32, [=](int r, int cc) { return DTp[(size_t)prow(r) * 32 + cc]; }, [=](int r, int cc) { return DTs[(size_t)r * 32 + cc]; }); }
        if (st == 8) { diag_rel(red, DG + 8, D, [=](int r, int cc) { return bf2f(XN[(size_t)prow(r) * D + cc]); }, [=](int r, int cc) { return sigmoidf_(PS[(size_t)r * 9216 + 7168 + cc] + bg[cc]); });
                       diag_rel(red, DG + 9, D, [=](int r, int cc) { return bf2f(PP[(size_t)prow(r) * NPP + 3072 + cc]); }, [=](int r, int cc) { return sigmoidf_(PS[(size_t)r * 9216 + 8192 + cc] + bg[1024 + cc]); }); }
        if (st == 3) { diag_rel(red, DG + 3, D, [=](int r, int cc) { return bf2f(PP[(size_t)prow(r) * NPP + cc]); }, [=](int r, int cc) { return bf2f(ABRS[(size_t)r * 3072 + cc]); });
                       diag_rel(red, DG + 4, 2048, [=](int r, int cc) { return bf2f(PP[(size_t)prow(r) * NPP + 1024 + cc]); }, [=](int r, int cc) { return bf2f(ABRS[(size_t)r * 3072 + 1024 + cc]); }); }
        if (st == 5) diag_rel(red, DG + 5, D, [=](int r, int cc) { return bf2f(XN[(size_t)prow(r) * D + cc]); }, [=](int r, int cc) { return bf2f(MS[(size_t)r * D + cc]); });
        if (st == 20) {
            int mask = 0; if (!(DG[8] < DIAG_TOL)) mask |= 1; if (!(DG[9] < DIAG_TOL)) mask |= 2; if (!(DG[3] < DIAG_TOL)) mask |= 4; if (!(DG[4] < DIAG_TOL)) mask |= 8; if (!(DG[5] < DIAG_TOL)) mask |= 16;
            if (mask == 0) { if (!(DG[6] < DIAG_TOL)) mask |= 32; if (!(DG[7] < DIAG_TOL)) mask |= 64; }
            float code = mask ? 100.f * (1 + mask) : 0.f;
            if (code > 0.f) for (int e = tid; e < TS * D; e += 512) YS[e] = code;
        }
        return;
    }
#endif
#ifndef PHMASK
#define PHMASK 0x1fff
#endif
#define IN(k) (((PHMASK >> (k)) & 1) && lo <= (k) && (k) < hi)
    unsigned* barctr = (unsigned*)(ws + OFF_BAR); unsigned nbar = 0; (void)barctr;
    volatile LAS unsigned* xbst = (volatile LAS unsigned*)(c.lds + LDS_BYTES - 16);
    if (tid < 4) xbst[tid] = 0u;
    __syncthreads();
    XcdBarrier xbar; xbar.bar = (unsigned*)(ws + OFF_XBAR); xbar.x = 0; xbar.st = xbst;
    if (hi - lo > 1) xbar = xcd_barrier_post((unsigned*)(ws + OFF_XBAR), xbst);
    unsigned long long t0_ = 0, tacc_ = 0; (void)t0_; (void)tacc_;
#define SEAM(k) do { if (IN(k) && IN((k) + 1)) { TSTART(12); ++nbar; xcd_barrier(xbar); TSTOP(12); } } while (0)
    auto rm_id = [](int col0, int) { return col0; };
    auto rm_up = [](int col0, int panel) { return (col0 >> 7) * 256 + panel * 128 + (col0 & 127); };

    if (IN(0)) {
        TSTART(0); prep_weights(c);
#if DUPX == 1
        prep_weights(c);
#endif
        rmsnorm_rows_bf16(prm.in[0], T, prm.in[6], XN); TSTOP(0);
#ifdef DIAG
        { const int t_ = otid(), lane = t_ & 63; for (int r = bid * 8 + (t_ >> 6); r < TS; r += G * 8) { const float* p = prm.in[0] + (size_t)prow(r) * D; float v[16]; float s = 0.f;
            for (int i = 0; i < 16; ++i) { v[i] = p[lane + 64 * i]; s += v[i] * v[i]; }
            for (int o = 1; o < 64; o <<= 1) s += __shfl_xor(s, o);
            const float inv = rsqrtf(s * (1.0f / 1024.0f) + EPS);
            for (int i = 0; i < 16; ++i) XNS[(size_t)r * D + lane + 64 * i] = f2bf(v[i] * inv * prm.in[6][lane + 64 * i]); } }
#else
        rmsnorm_rows_bf16(prm.in[1], TS, prm.in[6], XNS);
#endif
    }
    SEAM(0);
    if (IN(1)) {
        pg8::Gemm g{XN, D, (const bf16_t*)(ws + OFF_WUP1), D, T, 2 * FF, D}; pg8::StaticOrder S; S.init(T, 2 * FF, G, bid);

#if DUPX == 5
        pg8::gemm_phase(c.lds, g, S, EpiSwiglu{PP, (LAS const float*)nullptr});
#endif
        TSTART(1); pg8::gemm_phase(c.lds, g, S, EpiSwiglu{PP, (LAS const float*)nullptr}); TSTOP(1);
        TSTART(2); sgemm<16, 2, D>(c.lds, XNS, D, (const bf16_t*)(ws + OFF_WUP1), D, FF, nullptr, nullptr, rm_up,
            [=](int r, int cc, float v0, float v1, float) { HS[(size_t)r * FF + cc] = f2bf(siluf_(v0) * v1); return 0.f; }, G / 2); TSTOP(2);
    }
    SEAM(1);
    if (IN(2)) {
        pg8::Gemm g{PP, FF, (const bf16_t*)(ws + OFF_WDN1), FF, T, D, FF}; pg8::StaticOrder S; S.init(T, D, G, bid);
        TSTART(10); pg8::gemm_phase(c.lds, g, S, EpiResid{prm.in[0], nullptr, nullptr, XB, SSQ, 0.5f}); TSTOP(10);
        const float* xs_in = prm.in[1];
        TSTART(2); sgemm<16, 1, FF, 4>(c.lds, HS, FF, (const bf16_t*)(ws + OFF_WDN1), FF, D, nullptr, SSQS, rm_id,
            [=](int r, int cc, float v0, float, float) {
#ifdef DIAG
            const float x = prm.in[0][(size_t)prow(r) * D + cc] + 0.5f * v0;
#else
            const float x = xs_in[(size_t)r * D + cc] + 0.5f * v0;
#endif
            YS[(size_t)r * D + cc] = x; XNS[(size_t)r * D + cc] = f2bf(x); return x; }); TSTOP(2);
    }
    SEAM(2);
    if (IN(3)) {
        pg8::Gemm g{XB, D, (const bf16_t*)(ws + OFF_WIN), D, T, NPP, D}; pg8::StaticOrder S; S.init(T, NPP, G, bid);

#if DUPX == 6
        pg8::gemm_phase(c.lds, g, S, EpiScaleBf16{PP, SSQ});
#endif
        LAS const float* linv = fill_inv(c.lds, SSQ); TSTART(11); pg8::gemm_phase(c.lds, g, S, EpiScaleBf16{PP, linv}); TSTOP(11);
        float* DTp = (float*)(ws + OFF_DT); float* DTs = (float*)(ws + OFF_DTS);
        TSTART(2);
        {
            const int t_ = otid(), wv = t_ >> 6, ln = t_ & 63, lr = ln & 15, kg = ln >> 4; const bf16_t* WDT = (const bf16_t*)(ws + OFF_WDT);
            for (int wt = bid * 8 + wv; wt < T / 16; wt += G * 8) {
                f32x4 a0 = (f32x4){0.f, 0.f, 0.f, 0.f}, a1 = a0; f32x4 sq[4][4];
#pragma unroll
                for (int r = 0; r < 4; ++r)
#pragma unroll
                    for (int i = 0; i < 4; ++i) sq[r][i] = *(const f32x4*)(SSQ + (size_t)(16 * wt + 4 * kg + r) * 16 + 4 * i);
                const bf16_t* ap = XB + (size_t)(16 * wt + lr) * D + 8 * kg; const bf16_t* bp = WDT + (size_t)lr * D + 8 * kg;
#pragma unroll 8
                for (int k = 0; k < D; k += 32) { const bf16x8 a = *(const bf16x8*)(ap + k), b0 = *(const bf16x8*)(bp + k), b1 = *(const bf16x8*)(bp + 16 * D + k);
                    a0 = __builtin_amdgcn_mfma_f32_16x16x32_bf16(a, b0, a0, 0, 0, 0); a1 = __builtin_amdgcn_mfma_f32_16x16x32_bf16(a, b1, a1, 0, 0, 0); }
#pragma unroll
                for (int r = 0; r < 4; ++r) { const int row = 16 * wt + 4 * kg + r; const f32x4 sm = (sq[r][0] + sq[r][1]) + (sq[r][2] + sq[r][3]); const float inv = rsqrtf(((sm[0] + sm[1]) + (sm[2] + sm[3])) * (1.0f / 1024.0f) + EPS); DTp[(size_t)row * 32 + lr] = a0[r] * inv; DTp[(size_t)row * 32 + 16 + lr] = a1[r] * inv; }
            }
        }
        TSTOP(2);
        TSTART(2); sgemm<32, 1, D>(c.lds, XNS, D, (const bf16_t*)(ws + OFF_WIN), D, 9216, SSQS, nullptr, rm_id,
            [=](int r, int cc, float v0, float, float inv) { PS[(size_t)r * 9216 + cc] = v0 * inv; return 0.f; }); TSTOP(2);
        TSTART(2); sgemm<32, 1, D>(c.lds, XNS, D, (const bf16_t*)(ws + OFF_WDT), D, 32, SSQS, nullptr, rm_id,
            [=](int r, int cc, float v0, float, float inv) { DTs[(size_t)r * 32 + cc] = v0 * inv; return 0.f; }); TSTOP(2);
    }
    SEAM(3);
    if (IN(4)) {
        for (int e = bid * 512 + tid; e < 8 * 3 * 2048; e += G * 512) {
            const int cc = e & 2047, r = (e >> 11) % 3, b = e / (3 * 2048); const size_t row = (size_t)b * SEQ + 2045 + r;
            if (cc < 1024) out[O_LCP + (size_t)(b * 3 + r) * D + cc] = bf2f(PP[row * NPP + cc]);
            else out[O_SCP + (size_t)(b * 3 + r) * 3072 + 2048 + (cc - 1024)] = bf2f(PP[row * NPP + 3072 + (cc - 1024)]); }

#if DUPX == 4
        for (int it = bid; it < 256; it += G) lru_chunk<false>(c, it >> 5, it & 31);
#endif
        TSTART(19); for (int it = bid; it < 256; it += G) bc_conv(c, it >> 5, it & 31); TSTOP(19);
        if (hi - lo > 1) xcd_barrier(xbar);
        TSTART(3); for (int it = bid; it < 256; it += G) lru_chunk<false>(c, it >> 5, it & 31); TSTOP(3);

#if DUPX == 3
        for (int it = bid; it < 256; it += G) ssd_seq(c, it >> 5, it & 31, prm.ph_lo == 0);
#endif


    }
    SEAM(4);
    if (IN(5)) {

#if DUPX == 2
        for (int it = bid; it < 256; it += G) lru_chunk<true>(c, it >> 5, it & 31, prm.ph_lo == 0);
#endif
        TSTART(4); for (int it = bid; it < 256; it += G) ssd_seq(c, it & 7, it >> 3); TSTOP(4);
        TSTART(5); for (int it = bid; it < 256; it += G) lru_final(c, it >> 5, it & 31); TSTOP(5);
        TSTART(2); for (int it = bid; it < 64; it += G) lru_sample(c, it >> 3, it & 7); TSTOP(2);
        TSTART(2); for (int it = bid; it < 256; it += G) ssd_sample(c, it >> 5, it & 31); TSTOP(2);
    }
    SEAM(5);
    if (IN(6)) { TSTART(8);
        {
        const float* YGS = (const float*)(ws + OFF_YGS); bf16_t* ABRS = (bf16_t*)(ws + OFF_ABRS);
        const int lane = tid & 63;
        for (int w = bid * 8 + (tid >> 6); w < TS * 4; w += G * 8) { const int r = w >> 2, gq = w & 3; const float* p = YGS + (size_t)r * 2048 + 512 * gq; float v[8]; float s = 0.f;
#pragma unroll
            for (int j = 0; j < 8; ++j) { v[j] = p[lane + 64 * j]; s += v[j] * v[j]; }
#pragma unroll
            for (int o = 1; o < 64; o <<= 1) s += __shfl_xor(s, o);
            const float inv = rsqrtf(s * (1.0f / 512.0f) + EPS);
#pragma unroll
            for (int j = 0; j < 8; ++j) ABRS[(size_t)r * 3072 + 1024 + 512 * gq + lane + 64 * j] = f2bf(v[j] * inv); }
        }
        LAS const float* linv = fill_inv(c.lds, SSQ);
        { pg8::Gemm g{XB, D, (const bf16_t*)(ws + OFF_WIN) + (size_t)4096 * D, D, T, 3072, D}; pg8::StaticOrder S; S.init(T, 3072, G, bid);
          pg8::gemm_phase(c.lds, g, S, EpiGatesA{PP, linv, GSSQ}); }
        { pg8::Gemm g{XB, D, (const bf16_t*)(ws + OFF_WIN) + (size_t)7168 * D, D, T, D, D}; pg8::StaticOrder S; S.init(T, D, G, bid);
          pg8::gemm_phase(c.lds, g, S, EpiSigmoid{XN, D, linv, prm.in[11]}); }
        { pg8::Gemm g{XB, D, (const bf16_t*)(ws + OFF_WIN) + (size_t)8192 * D, D, T, D, D}; pg8::StaticOrder S; S.init(T, D, G, bid);
          pg8::gemm_phase(c.lds, g, S, EpiSigmoid{PP + 3072, NPP, linv, prm.in[11] + 1024}); } TSTOP(8);
    }
    SEAM(6);
    if (IN(7)) { TSTART(6);
        const int lane = tid & 63;
        for (int r = bid * 8 + (tid >> 6); r < T; r += G * 8) {
            float s = (lane < 32) ? GSSQ[(size_t)r * 32 + lane] : 0.f;
            s += __shfl_xor(s, 1); s += __shfl_xor(s, 2); s += __shfl_xor(s, 4);
            const float i0 = rsqrtf(__shfl(s, 0) * (1.0f / 512.0f) + EPS), i1 = rsqrtf(__shfl(s, 8) * (1.0f / 512.0f) + EPS), i2 = rsqrtf(__shfl(s, 16) * (1.0f / 512.0f) + EPS), i3 = rsqrtf(__shfl(s, 24) * (1.0f / 512.0f) + EPS);
#pragma unroll
            for (int i = 0; i < 4; ++i) { const float inv = i == 0 ? i0 : (i == 1 ? i1 : (i == 2 ? i2 : i3));
                bf16_t* p = PP + (size_t)r * NPP + 1024 + 512 * i + 8 * lane; f32x4 a, bq; unpack8(*(const u32x4*)p, a, bq); *(u32x4*)p = pack8(a * inv, bq * inv); }
        }
    }
    TSTOP(6); SEAM(7);
    if (IN(8)) {
        TSTART(9); { pg8::Gemm g{PP, NPP, (const bf16_t*)(ws + OFF_WBR), 3072, T, D, D}; pg8::StaticOrder S; S.init(T, D, G, bid); pg8::gemm_phase(c.lds, g, S, EpiBr{XN, PP, 0}); }
        { pg8::Gemm g{PP + 1024, NPP, (const bf16_t*)(ws + OFF_WBR) + 1024, 3072, T, D, 2048}; pg8::StaticOrder S; S.init(T, D, G, bid); pg8::gemm_phase(c.lds, g, S, EpiBr{XN, PP, 1}); } TSTOP(9);
        const bf16_t* ABRS = (const bf16_t*)(ws + OFF_ABRS); float* M1S = (float*)(ws + OFF_M1S); bf16_t* MS = (bf16_t*)(ws + OFF_MS); const float* bg = prm.in[11];
        TSTART(2); sgemm<16, 1, D>(c.lds, ABRS, 3072, (const bf16_t*)(ws + OFF_WBR), 3072, D, nullptr, nullptr, rm_id,
            [=](int r, int cc, float v0, float, float) { M1S[(size_t)r * D + cc] = sigmoidf_(PS[(size_t)r * 9216 + 7168 + cc] + bg[cc]) * v0; return 0.f; }); TSTOP(2);
        TSTART(2); sgemm<16, 1, 2048>(c.lds, ABRS + 1024, 3072, (const bf16_t*)(ws + OFF_WBR) + 1024, 3072, D, nullptr, nullptr, rm_id,
            [=](int r, int cc, float v0, float, float) { MS[(size_t)r * D + cc] = f2bf(M1S[(size_t)r * D + cc] + sigmoidf_(PS[(size_t)r * 9216 + 8192 + cc] + bg[1024 + cc]) * v0); return 0.f; }); TSTOP(2);
    }
    SEAM(8);
    if (IN(9)) {
        pg8::Gemm g{XN, D, (const bf16_t*)(ws + OFF_WOUT), D, T, D, D}; pg8::StaticOrder S; S.init(T, D, G, bid);
        TSTART(16); pg8::gemm_phase(c.lds, g, S, EpiResid{nullptr, XB, nullptr, XB, SSQ, 1.0f}); TSTOP(16);
        const bf16_t* MS = (const bf16_t*)(ws + OFF_MS);
        TSTART(2); sgemm<16, 1, D>(c.lds, MS, D, (const bf16_t*)(ws + OFF_WOUT), D, D, nullptr, SSQS + 8192, rm_id,
            [=](int r, int cc, float v0, float, float) { const float x = YS[(size_t)r * D + cc] + v0; YS[(size_t)r * D + cc] = x; XNS[(size_t)r * D + cc] = f2bf(x); return x; }); TSTOP(2);
    }
    SEAM(9);
    if (IN(10)) {
        pg8::Gemm g{XB, D, (const bf16_t*)(ws + OFF_WUP2), D, T, 2 * FF, D}; pg8::StaticOrder S; S.init(T, 2 * FF, G, bid);
        LAS const float* linv = fill_inv(c.lds, SSQ);
        TSTART(17); pg8::gemm_phase(c.lds, g, S, EpiSwiglu{PP, linv}); TSTOP(17);
        TSTART(2); sgemm<16, 2, D>(c.lds, XNS, D, (const bf16_t*)(ws + OFF_WUP2), D, FF, SSQS + 8192, nullptr, rm_up,
            [=](int r, int cc, float v0, float v1, float inv) { HS[(size_t)r * FF + cc] = f2bf(siluf_(v0 * inv) * (v1 * inv)); return 0.f; }, G / 2); TSTOP(2);
    }
    SEAM(10);
    if (IN(11)) {
        pg8::Gemm g{PP, FF, (const bf16_t*)(ws + OFF_WDN2), FF, T, D, FF}; pg8::StaticOrder S; S.init(T, D, G, bid);
        TSTART(18); pg8::gemm_phase(c.lds, g, S, EpiResid{nullptr, XB, out + O_YP, nullptr, SSQ, 0.5f}); TSTOP(18);
        TSTART(2); sgemm<16, 1, FF, 4>(c.lds, HS, FF, (const bf16_t*)(ws + OFF_WDN2), FF, D, nullptr, nullptr, rm_id,
            [=](int r, int cc, float v0, float, float) { YS[(size_t)r * D + cc] += 0.5f * v0; return 0.f; }); TSTOP(2);
    }
    SEAM(11);
    if (IN(12)) {
        TSTART(7); rmsnorm_rows_f32(out + O_YP, T + TS, prm.in[31]); TSTOP(7);
    }
#ifdef TIMER_ID
    if (hi == 13) { ++nbar; grid_barrier(barctr, nbar * (unsigned)G);
        if (bid == TIMER_BLOCK) { const float us = (float)tacc_ * 0.0001f; for (int e = tid; e < TS * D; e += 512) YS[e] = us; } }
#endif
#undef IN
#undef SEAM
}

#ifndef N_LAUNCH_MODE
#define N_LAUNCH_MODE 1
#endif
extern "C" void kernel_launch(void* const* d_in, const int* in_sizes, int n_in, void* d_out, int out_size, void* d_ws, size_t ws_size, hipStream_t stream) {
    static int grid = 0;
    if (grid == 0) {
        if (n_in != 32 || ws_size < OFF_XBAR + XCD_BAR_WORDS * 4) { fprintf(stderr, "kernel_launch: unexpected n_in %d or ws_size %zu (< %zu)\n", n_in, ws_size, (size_t)WS_END); grid = -1; return; }
        int dev = 0, cus = 0, per_cu = 0;
        hipGetDevice(&dev); hipDeviceGetAttribute(&cus, hipDeviceAttributeMultiprocessorCount, dev);
        if (hipFuncSetAttribute((const void*)fwd_kernel, hipFuncAttributeMaxDynamicSharedMemorySize, LDS_BYTES) != hipSuccess) { fprintf(stderr, "kernel_launch: hipFuncSetAttribute failed\n"); grid = -1; return; }
        hipOccupancyMaxActiveBlocksPerMultiprocessor(&per_cu, (const void*)fwd_kernel, 512, LDS_BYTES);
        if (per_cu < 1) { fprintf(stderr, "kernel_launch: occupancy query says %d blocks per CU\n", per_cu); per_cu = 1; }
        grid = cus * 1;
        (void)hipGetLastError();
    }
    if (grid < 0) return;
    Params p{};
    for (int i = 0; i < 32; ++i) p.in[i] = (const float*)d_in[i];
    p.out = (float*)d_out; p.ws = (unsigned char*)d_ws;
#if N_LAUNCH_MODE == 0
    for (int ph = 0; ph < 13; ++ph) { p.ph_lo = ph; p.ph_hi = ph + 1; hipLaunchKernelGGL(fwd_kernel, dim3(grid), dim3(512), LDS_BYTES, stream, p);
#ifdef DIAG
        int st = -1; if (ph == 2) st = 0; if (ph == 3) st = 1; if (ph == 6) st = 8; if (ph == 7) st = 3; if (ph == 8) st = 5; if (ph == 9) st = 6; if (ph == 11) st = 7; if (ph == 12) st = 20;
        if (st >= 0) { p.ph_lo = 100 + st; p.ph_hi = 0; hipLaunchKernelGGL(fwd_kernel, dim3(grid), dim3(512), LDS_BYTES, stream, p); }
#endif
    }
#else
    p.ph_lo = 0; p.ph_hi = 13;
    hipMemsetAsync((char*)d_ws + OFF_XBAR, 0, XCD_BAR_WORDS * 4, stream);
    void* args[] = {&p};
    hipError_t e = hipLaunchCooperativeKernel((const void*)fwd_kernel, dim3(grid), dim3(512), args, LDS_BYTES, stream);
    if (e != hipSuccess) fprintf(stderr, "cooperative launch failed: %s (grid %d)\n", hipGetErrorString(e), grid);
#endif
}
```

```cpp
#include <hip/hip_runtime.h>
#include <hip/hip_cooperative_groups.h>
#include <cstdio>
namespace cg = cooperative_groups;

#define LAS __attribute__((address_space(3)))
typedef unsigned short bf16_t;
typedef short bf16x8 __attribute__((ext_vector_type(8)));
typedef float f32x4 __attribute__((ext_vector_type(4)));
typedef unsigned u32x4 __attribute__((ext_vector_type(4)));

constexpr int T = 16384, TS = 128, D = 1024, FF = 2816, NPP = 4096, SEQ = 2048, NCH = 32;
constexpr float EPS = 1e-6f;
constexpr size_t OFF_WUP1 = 0, OFF_WDN1 = 11534336;
constexpr size_t OFF_DT = 0, OFF_SUMM = 2097152, OFF_HALO = 4194304, OFF_GSSQ = 5767168, OFF_PS = 7864320,
                 OFF_DTS = 12582912, OFF_YGS = 12599296, OFF_ABRS = 13647872, OFF_M1S = 14434304, OFF_MS = 14958592;
constexpr size_t OFF_WIN = 17301504, OFF_WDT = 36175872, OFF_WBR = 36241408, OFF_WOUT = 42532864, OFF_WUP2 = 44630016,
                 OFF_WDN2 = 56164352, OFF_WRG = 61931520, OFF_WIG = 62193664, OFF_XB = 62455808, OFF_XN = 96010240,
                 OFF_PP = 129564672, OFF_SSQ = 263782400, OFF_XNS = 264830976, OFF_HS = 265093120, WS_END = 265814016;
constexpr size_t O_YP = 0, O_YS = 16777216, O_LCP = 16908288, O_LHP = 16932864, O_SCP = 16941056, O_SHP = 17014784,
                 O_LCS = 19111936, O_LHS = 19136512, O_SCS = 19144704, O_SHS = 19218432;
constexpr int LDS_BYTES = 143360;
constexpr int LDS_INV = 131072;

struct Params { const float* in[32]; float* out; unsigned char* ws; int ph_lo, ph_hi; };

#ifdef DIAG
#define SZ(x) 0.0f
#ifndef DIAG_TOL
#define DIAG_TOL 0.01f
#endif
#else
#define SZ(x) (x)
#endif
#define A256(base, row, chunk) ((base) + (row) * 256 + 16 * ((chunk) ^ ((row) & 15)))
#define A128(base, row, chunk) ((base) + (row) * 128 + 16 * ((chunk) ^ ((((row) >> 1) ^ ((row) >> 3)) & 7)))
__device__ __forceinline__ int otid() { int t = threadIdx.x; asm volatile("" : "+v"(t)); return t; }
__device__ __forceinline__ unsigned cvt_pk_bf16(float lo, float hi) { unsigned r; asm volatile("v_cvt_pk_bf16_f32 %0, %1, %2" : "=v"(r) : "v"(lo), "v"(hi)); return r; }
__device__ __forceinline__ bf16_t f2bf(float f) { return (bf16_t)(cvt_pk_bf16(f, 0.f) & 0xffffu); }
__device__ __forceinline__ float bf2f(bf16_t b) { return __uint_as_float(((unsigned)b) << 16); }
__device__ __forceinline__ float bflo(unsigned w) { return __uint_as_float(w << 16); }
__device__ __forceinline__ float bfhi(unsigned w) { return __uint_as_float(w & 0xffff0000u); }
__device__ __forceinline__ float sigmoidf_(float x) { return __builtin_amdgcn_rcpf(1.0f + __expf(-x)); }
__device__ __forceinline__ float siluf_(float x) { return x * sigmoidf_(x); }
__device__ __forceinline__ float gelu_tanh(float x) { const float u = 0.7978845608028654f * (x + 0.044715f * x * x * x); return x * sigmoidf_(2.0f * u); }
__device__ __forceinline__ float softplusf_(float x) { return x > 20.f ? x : log1pf(__expf(x)); }
__device__ __forceinline__ u32x4 pack8(const f32x4 a, const f32x4 b) { u32x4 w; w.x = cvt_pk_bf16(a[0], a[1]); w.y = cvt_pk_bf16(a[2], a[3]); w.z = cvt_pk_bf16(b[0], b[1]); w.w = cvt_pk_bf16(b[2], b[3]); return w; }
__device__ __forceinline__ void unpack8(const u32x4 w, f32x4& a, f32x4& b) { a[0] = bflo(w.x); a[1] = bfhi(w.x); a[2] = bflo(w.y); a[3] = bfhi(w.y); b[0] = bflo(w.z); b[1] = bfhi(w.z); b[2] = bflo(w.w); b[3] = bfhi(w.w); }
__device__ __forceinline__ float rowinv16(const float* ssq, int row) {
    const f32x4* p = (const f32x4*)(ssq + (size_t)row * 16); const f32x4 a = p[0], b = p[1], c = p[2], d = p[3];
    const float s = ((a[0] + a[1]) + (a[2] + a[3])) + ((b[0] + b[1]) + (b[2] + b[3])) + ((c[0] + c[1]) + (c[2] + c[3])) + ((d[0] + d[1]) + (d[2] + d[3]));
    return rsqrtf(s * (1.0f / 1024.0f) + EPS);
}

namespace pg8 {
constexpr int BM = 256, BK = 64, HALF = 128, HTB = HALF * BK * 2, STAGE_BYTES = 8 * HTB, NXCD = 8, WGM = 8;
__device__ __forceinline__ int lds_byte(int r, int c) { const int st = (r >> 4) * 2 + (c >> 5), rr = r & 15, cc = c & 31, ob = rr * 64 + cc * 2; return st * 1024 + (ob ^ (((ob >> 9) & 1) << 5)); }
__device__ __forceinline__ void stage_rc(int b, int& R, int& C) { const int st = b / 1024, sb = b % 1024, swz = sb ^ (((sb >> 9) & 1) << 5); R = (st >> 1) * 16 + swz / 64; C = (st & 1) * 32 + (swz % 64) / 2; }
__device__ __forceinline__ int perm32(int rho) { const int n = rho >> 4, i = rho & 15; return 8 * (i >> 2) + 4 * n + (i & 3); }
struct Unit { int pm, pn; };
struct Gemm { const bf16_t* A; int lda; const bf16_t* Bt; int ldb; int M, N, K; };
struct StaticOrder {
    int nM, nN, nwg, G, c;
    __device__ __forceinline__ void init(int M, int N, int G_, int c_) { nM = M / BM; nN = N / BM; nwg = nM * nN; G = G_; c = c_; }
    __device__ __forceinline__ bool next(int i, Unit& u) const {
        const long L = (long)i * G + c; if (L >= nwg) return false;
        int wgid = (int)L; { const int q = nwg / NXCD, r = nwg % NXCD, xcd = wgid % NXCD, off = wgid / NXCD; wgid = (xcd < r ? xcd * (q + 1) : r * (q + 1) + (xcd - r) * q) + off; }
        const int nig = WGM * nN, gid = wgid / nig, fm = gid * WGM, gsz = (nM - fm) < WGM ? (nM - fm) : WGM;
        u.pm = fm + ((wgid % nig) % gsz); u.pn = (wgid % nig) / gsz; return true;
    }
};
template <class Epi>
__device__ __forceinline__ void gemm_phase(LAS unsigned char* lds, const Gemm g, const StaticOrder& S, const Epi& E) {
    const int tid = otid(), wid = __builtin_amdgcn_readfirstlane(tid >> 6), lane = tid & 63, wr = wid >> 2, wc = wid & 3, fr = lane & 15, fq = lane >> 4;
    const int K = g.K, nt = K / BK;
    unsigned voffA[2], voffB[2];
#pragma unroll
    for (int i = 0; i < 2; ++i) { int R, C; stage_rc(tid * 16 + i * 8192, R, C); const int Rb = (R & ~31) + perm32(R & 31);
        voffA[i] = (unsigned)(R * g.lda + C) * 2u; voffB[i] = (unsigned)(Rb * g.ldb + C) * 2u; }
    const size_t kstep = (size_t)(BK * 2);
    const size_t hstepA = (size_t)HALF * g.lda * 2, hstepB = (size_t)HALF * g.ldb * 2;
    const size_t tstepA = 2 * hstepA, tstepB = 2 * hstepB;
    const unsigned ldsw = (unsigned)wid * 1024u;
    const int aoff = lds_byte(wr * 64 + fr, fq * 8), boff = lds_byte(wc * 32 + fr, fq * 8);
#define PG8_SA(b, h) (((b) * 2 + (h)) * HTB)
#define PG8_SB(b, h) ((4 + (b) * 2 + (h)) * HTB)
#define PG8_STAGE(bufoff, gbase, voff) do { _Pragma("unroll") for (int _i = 0; _i < 2; ++_i) \
        __builtin_amdgcn_global_load_lds((const unsigned*)((const char*)(gbase) + (voff)[_i]), (LAS unsigned*)(lds + (bufoff) + ldsw + _i * 8192), 16, 0, 0); } while (0)
#define PG8_LDA(dst, b, h) do { _Pragma("unroll") for (int m = 0; m < 4; ++m) _Pragma("unroll") for (int k = 0; k < 2; ++k) dst[m][k] = *(const LAS bf16x8*)(lds + PG8_SA(b, h) + aoff + m * 2048 + k * 1024); } while (0)
#define PG8_LDB(dst, b, h) do { _Pragma("unroll") for (int n = 0; n < 2; ++n) _Pragma("unroll") for (int k = 0; k < 2; ++k) dst[n][k] = *(const LAS bf16x8*)(lds + PG8_SB(b, h) + boff + n * 2048 + k * 1024); } while (0)
#define PG8_MMA(ai, bj, At, Bt) do { __builtin_amdgcn_s_setprio(1); _Pragma("unroll") for (int m = 0; m < 4; ++m) _Pragma("unroll") for (int n = 0; n < 2; ++n) _Pragma("unroll") for (int k = 0; k < 2; ++k) \
        acc[ai][bj][m][n] = __builtin_amdgcn_mfma_f32_16x16x32_bf16(Bt[n][k], At[m][k], acc[ai][bj][m][n], 0, 0, 0); __builtin_amdgcn_s_setprio(0); } while (0)
#define PG8_WAIT_V(n) asm volatile("s_waitcnt vmcnt(" #n ")" ::: "memory")
#define PG8_WAIT_L(n) asm volatile("s_waitcnt lgkmcnt(" #n ")" ::: "memory")
#define PG8_BAR __builtin_amdgcn_s_barrier()
#define PG8_SCHED __builtin_amdgcn_sched_barrier(0)
    Unit cur, nxt; int ui = 0;
    if (!S.next(0, cur)) return;
    f32x4 acc[2][2][4][2];
#pragma unroll
    for (int a = 0; a < 2; ++a)
#pragma unroll
        for (int b = 0; b < 2; ++b)
#pragma unroll
            for (int m = 0; m < 4; ++m)
#pragma unroll
                for (int n = 0; n < 2; ++n) acc[a][b][m][n] = (f32x4){0.f, 0.f, 0.f, 0.f};
    bf16x8 At[4][2], B0[2][2], B1[2][2];
    const char* cA = (const char*)g.A + (size_t)cur.pm * tstepA; const char* cB = (const char*)g.Bt + (size_t)cur.pn * tstepB;
    PG8_STAGE(PG8_SB(0, 0), cB, voffB); PG8_STAGE(PG8_SA(0, 0), cA, voffA); PG8_STAGE(PG8_SB(0, 1), cB + hstepB, voffB); PG8_STAGE(PG8_SA(0, 1), cA + hstepA, voffA);
    if (wr == 1) PG8_BAR;
    PG8_WAIT_V(4); PG8_BAR;
    PG8_STAGE(PG8_SB(1, 0), cB + kstep, voffB); PG8_STAGE(PG8_SA(1, 0), cA + kstep, voffA); PG8_STAGE(PG8_SB(1, 1), cB + hstepB + kstep, voffB);
    PG8_WAIT_V(6); PG8_BAR;
    for (;;) {
        const bool has_next = S.next(ui + 1, nxt);
        const char* nA = has_next ? (const char*)g.A + (size_t)nxt.pm * tstepA : cA; const char* nB = has_next ? (const char*)g.Bt + (size_t)nxt.pn * tstepB : cB;
        for (int t = 0; t < nt; t += 2) {
            const bool last = (t == nt - 2);
            const char* a1 = cA + (size_t)(t + 1) * kstep;
            const char* a2 = last ? nA : cA + (size_t)(t + 2) * kstep; const char* b2 = last ? nB : cB + (size_t)(t + 2) * kstep;
            const char* a3 = a2 + kstep; const char* b3 = b2 + kstep;
            PG8_LDB(B0, 0, 0); PG8_SCHED; PG8_LDA(At, 0, 0); PG8_STAGE(PG8_SA(1, 1), a1 + hstepA, voffA);
            PG8_WAIT_L(8); PG8_BAR; PG8_WAIT_L(0); PG8_MMA(0, 0, At, B0); PG8_BAR; PG8_SCHED;
            PG8_LDB(B1, 0, 1); PG8_STAGE(PG8_SB(0, 0), b2, voffB);
            PG8_BAR; PG8_WAIT_L(0); PG8_MMA(0, 1, At, B1); PG8_BAR;
            PG8_LDA(At, 0, 1); PG8_STAGE(PG8_SA(0, 0), a2, voffA);
            PG8_BAR; PG8_WAIT_L(0); PG8_MMA(1, 0, At, B0); PG8_BAR; PG8_SCHED;
            PG8_STAGE(PG8_SB(0, 1), b2 + hstepB, voffB);
            PG8_WAIT_V(6); PG8_BAR; PG8_MMA(1, 1, At, B1); PG8_BAR;
            PG8_LDB(B0, 1, 0); PG8_SCHED; PG8_LDA(At, 1, 0); PG8_STAGE(PG8_SA(0, 1), a2 + hstepA, voffA);
            PG8_WAIT_L(8); PG8_BAR; PG8_WAIT_L(0); PG8_MMA(0, 0, At, B0); PG8_BAR; PG8_SCHED;
            PG8_LDB(B1, 1, 1); PG8_STAGE(PG8_SB(1, 0), b3, voffB);
            PG8_BAR; PG8_WAIT_L(0); PG8_MMA(0, 1, At, B1); PG8_BAR;
            PG8_LDA(At, 1, 1); PG8_STAGE(PG8_SA(1, 0), a3, voffA);
            PG8_BAR; PG8_WAIT_L(0); PG8_MMA(1, 0, At, B0); PG8_BAR; PG8_SCHED;
            PG8_STAGE(PG8_SB(1, 1), b3 + hstepB, voffB);
            PG8_WAIT_V(6); PG8_BAR; PG8_MMA(1, 1, At, B1); PG8_BAR;
        }
        E(acc, cur, wr, wc, fr, fq);
        if (!has_next) break;
#pragma unroll
        for (int a = 0; a < 2; ++a)
#pragma unroll
            for (int b = 0; b < 2; ++b)
#pragma unroll
                for (int m = 0; m < 4; ++m)
#pragma unroll
                    for (int n = 0; n < 2; ++n) acc[a][b][m][n] = (f32x4){0.f, 0.f, 0.f, 0.f};
        cur = nxt; cA = nA; cB = nB; ++ui;
    }
    PG8_WAIT_V(0);
    if (wr == 0) PG8_BAR;
    PG8_BAR;
#undef PG8_SA
#undef PG8_SB
#undef PG8_STAGE
#undef PG8_LDA
#undef PG8_LDB
#undef PG8_MMA
#undef PG8_WAIT_V
#undef PG8_WAIT_L
#undef PG8_BAR
#undef PG8_SCHED
}
}
typedef f32x4 Acc[2][2][4][2];

__device__ __forceinline__ LAS const float* fill_inv(LAS unsigned char* lds, const float* ssq) {
    LAS float* t = (LAS float*)(lds + LDS_INV); const int base = 2048 * (blockIdx.x & 7);
    for (int r = otid(); r < 2048; r += 512) t[r] = rowinv16(ssq, base + r);
    __syncthreads();
    return t;
}
struct EpiSwiglu {
    bf16_t* H; LAS const float* linv;
    __device__ __forceinline__ void operator()(const Acc& acc, const pg8::Unit& u, int wr, int wc, int fr, int fq) const {
        const int row0 = u.pm * 256 + wr * 64 + fr, col = u.pn * 128 + wc * 32 + 8 * fq;
#pragma unroll
        for (int ai = 0; ai < 2; ++ai)
#pragma unroll
            for (int m = 0; m < 4; ++m) {
                const int row = row0 + ai * 128 + m * 16; const float inv = linv ? linv[row & 2047] : 1.0f;
                f32x4 h0, h1;
#pragma unroll
                for (int j = 0; j < 4; ++j) { h0[j] = siluf_(acc[ai][0][m][0][j] * inv) * (acc[ai][1][m][0][j] * inv); h1[j] = siluf_(acc[ai][0][m][1][j] * inv) * (acc[ai][1][m][1][j] * inv); }
                *(u32x4*)(H + (size_t)row * FF + col) = pack8(h0, h1);
            }
    }
};
struct EpiResid {
    const float* xin; const bf16_t* xin_b; float* xout; bf16_t* xb; float* ssq; float alpha;
    __device__ __forceinline__ void operator()(const Acc& acc, const pg8::Unit& u, int wr, int wc, int fr, int fq) const {
        const int row0 = u.pm * 256 + wr * 64 + fr, col0 = u.pn * 256 + wc * 32 + 8 * fq;
#pragma unroll
        for (int ai = 0; ai < 2; ++ai) {
            f32x4 xv[4][2][2];
#pragma unroll
            for (int m = 0; m < 4; ++m)
#pragma unroll
                for (int bj = 0; bj < 2; ++bj) { const size_t o = (size_t)(row0 + ai * 128 + m * 16) * D + col0 + bj * 128;
                    if (xin_b) unpack8(*(const u32x4*)(xin_b + o), xv[m][bj][0], xv[m][bj][1]);
                    else { xv[m][bj][0] = *(const f32x4*)(xin + o); xv[m][bj][1] = *(const f32x4*)(xin + o + 4); } }
#pragma unroll
            for (int m = 0; m < 4; ++m) {
                const int row = row0 + ai * 128 + m * 16; float ss = 0.f;
#pragma unroll
                for (int bj = 0; bj < 2; ++bj) {
                    const size_t o = (size_t)row * D + col0 + bj * 128;
                    const f32x4 v0 = xv[m][bj][0] + alpha * acc[ai][bj][m][0], v1 = xv[m][bj][1] + alpha * acc[ai][bj][m][1];
                    if (xout) { *(f32x4*)(xout + o) = v0; *(f32x4*)(xout + o + 4) = v1; }
                    ss += (v0[0] * v0[0] + v0[1] * v0[1]) + (v0[2] * v0[2] + v0[3] * v0[3]) + (v1[0] * v1[0] + v1[1] * v1[1]) + (v1[2] * v1[2] + v1[3] * v1[3]);
                    if (xb) *(u32x4*)(xb + o) = pack8(v0, v1);
                }
                ss += __shfl_xor(ss, 16); ss += __shfl_xor(ss, 32);
                if (fq == 0) ssq[(size_t)row * 16 + u.pn * 4 + wc] = ss;
            }
        }
    }
};
struct EpiScaleBf16 {
    bf16_t* O; LAS const float* linv;
    __device__ __forceinline__ void operator()(const Acc& acc, const pg8::Unit& u, int wr, int wc, int fr, int fq) const {
        const int row0 = u.pm * 256 + wr * 64 + fr, col0 = u.pn * 256 + wc * 32 + 8 * fq;
#pragma unroll
        for (int ai = 0; ai < 2; ++ai)
#pragma unroll
            for (int m = 0; m < 4; ++m) {
                const int row = row0 + ai * 128 + m * 16; const float inv = linv[row & 2047];
#pragma unroll
                for (int bj = 0; bj < 2; ++bj) *(u32x4*)(O + (size_t)row * NPP + col0 + bj * 128) = pack8(acc[ai][bj][m][0] * inv, acc[ai][bj][m][1] * inv);
            }
    }
};
struct EpiGatesA {
    bf16_t* PP; LAS const float* linv; float* gssq;
    __device__ __forceinline__ void operator()(const Acc& acc, const pg8::Unit& u, int wr, int wc, int fr, int fq) const {
        const int row0 = u.pm * 256 + wr * 64 + fr, cw = wc * 32 + 8 * fq; const int pn = u.pn;
#pragma unroll
        for (int ai = 0; ai < 2; ++ai) {
            u32x4 sv[4][2];
#pragma unroll
            for (int m = 0; m < 4; ++m)
#pragma unroll
                for (int bj = 0; bj < 2; ++bj) sv[m][bj] = *(const u32x4*)(PP + (size_t)(row0 + ai * 128 + m * 16) * NPP + pn * 256 + bj * 128 + cw);
#pragma unroll
            for (int m = 0; m < 4; ++m) {
                const int row = row0 + ai * 128 + m * 16; const float inv = linv[row & 2047]; float ss = 0.f;
#pragma unroll
                for (int bj = 0; bj < 2; ++bj) {
                    const f32x4 a0 = acc[ai][bj][m][0] * inv, a1 = acc[ai][bj][m][1] * inv; f32x4 o0, o1;
                    bf16_t* p = PP + (size_t)row * NPP + pn * 256 + bj * 128 + cw; f32x4 s0, s1; unpack8(sv[m][bj], s0, s1);
                    if (pn < 4) {
#pragma unroll
                        for (int j = 0; j < 4; ++j) { o0[j] = gelu_tanh(a0[j]) * s0[j]; o1[j] = gelu_tanh(a1[j]) * s1[j]; }
                    } else {
#pragma unroll
                        for (int j = 0; j < 4; ++j) { o0[j] = siluf_(a0[j]) * s0[j]; o1[j] = siluf_(a1[j]) * s1[j]; ss += o0[j] * o0[j] + o1[j] * o1[j]; }
                    }
                    *(u32x4*)p = pack8(o0, o1);
                }
                if (pn >= 4) { ss += __shfl_xor(ss, 16); ss += __shfl_xor(ss, 32); if (fq == 0) gssq[(size_t)row * 32 + (pn - 4) * 4 + wc] = ss; }
            }
        }
    }
};
struct EpiSigmoid {
    bf16_t* O; int ldo; LAS const float* linv; const float* bias;
    __device__ __forceinline__ void operator()(const Acc& acc, const pg8::Unit& u, int wr, int wc, int fr, int fq) const {
        const int row0 = u.pm * 256 + wr * 64 + fr, col0 = u.pn * 256 + wc * 32 + 8 * fq;
#pragma unroll
        for (int ai = 0; ai < 2; ++ai)
#pragma unroll
            for (int m = 0; m < 4; ++m) {
                const int row = row0 + ai * 128 + m * 16; const float inv = linv[row & 2047];
#pragma unroll
                for (int bj = 0; bj < 2; ++bj) {
                    const int gc = col0 + bj * 128;
                    const f32x4 a0 = acc[ai][bj][m][0] * inv, a1 = acc[ai][bj][m][1] * inv; f32x4 o0, o1;
                    const f32x4 b0 = *(const f32x4*)(bias + gc), b1 = *(const f32x4*)(bias + gc + 4);
#pragma unroll
                    for (int j = 0; j < 4; ++j) { o0[j] = sigmoidf_(a0[j] + b0[j]); o1[j] = sigmoidf_(a1[j] + b1[j]); }
                    *(u32x4*)(O + (size_t)row * ldo + gc) = pack8(o0, o1);
                }
            }
    }
};
struct EpiBr {
    bf16_t* GA; const bf16_t* PP; int mode;
    __device__ __forceinline__ void operator()(const Acc& acc, const pg8::Unit& u, int wr, int wc, int fr, int fq) const {
        const int row0 = u.pm * 256 + wr * 64 + fr, col0 = u.pn * 256 + wc * 32 + 8 * fq;
#pragma unroll
        for (int ai = 0; ai < 2; ++ai) {
            u32x4 gv[4][2], hv[4][2];
#pragma unroll
            for (int m = 0; m < 4; ++m)
#pragma unroll
                for (int bj = 0; bj < 2; ++bj) { const int row = row0 + ai * 128 + m * 16; gv[m][bj] = *(const u32x4*)(GA + (size_t)row * D + col0 + bj * 128);
                    hv[m][bj] = (mode == 0) ? (u32x4){0u, 0u, 0u, 0u} : *(const u32x4*)(PP + (size_t)row * NPP + 3072 + col0 + bj * 128); }
#pragma unroll
            for (int m = 0; m < 4; ++m) {
                const int row = row0 + ai * 128 + m * 16;
#pragma unroll
                for (int bj = 0; bj < 2; ++bj) {
                    bf16_t* p = GA + (size_t)row * D + col0 + bj * 128; f32x4 g0, g1; unpack8(gv[m][bj], g0, g1);
                    if (mode == 0) { *(u32x4*)p = pack8(g0 * acc[ai][bj][m][0], g1 * acc[ai][bj][m][1]); }
                    else { f32x4 h0, h1; unpack8(hv[m][bj], h0, h1); *(u32x4*)p = pack8(g0 + h0 * acc[ai][bj][m][0], g1 + h1 * acc[ai][bj][m][1]); }
                }
            }
        }
    }
};

template <int NC, int NB, int K, class RM, class F>
__device__ __forceinline__ void small_gemm(LAS unsigned char* lds, const bf16_t* A, int lda, int M, const bf16_t* Bt, int ldb, int N,
                                           const float* rs_src, int rs_mode, RM rm, F f) {
    const int tid = otid(), wid = tid >> 6, lane = tid & 63, lr = lane & 15, kg = lane >> 4;
    LAS float* red = (LAS float*)lds;
    LAS float* invs = (LAS float*)(lds + 131072);
    const int nct = N / NC, items = (M / 16) * nct; constexpr int kw = K / 8;
    constexpr int CT = NC / 16;
    const int nrt = M / 16; const bool hoist = (rs_mode == 1) && (gridDim.x % nrt == 0); const int bix = gridDim.x - 1 - blockIdx.x;
    for (int it = bix; it < items; it += gridDim.x) {
        const int rt = it % nrt, ct = it / nrt, row0 = rt * 16, col0 = ct * NC;
        if (rs_mode == 1) { if (!(hoist && it != bix)) { const int r = tid >> 5, q = tid & 31; const float* p = rs_src + (size_t)(row0 + r) * D + q * 32; float s = 0.f;
            for (int j = 0; j < 32; j += 4) { const f32x4 v = *(const f32x4*)(p + j); s += v[0] * v[0] + v[1] * v[1] + v[2] * v[2] + v[3] * v[3]; }
            s += __shfl_xor(s, 1); s += __shfl_xor(s, 2); s += __shfl_xor(s, 4); s += __shfl_xor(s, 8); s += __shfl_xor(s, 16);
            if (q == 0) invs[r] = rsqrtf(s * (1.0f / 1024.0f) + EPS); } }
        else if (rs_mode == 2) { if (tid < 16) invs[tid] = rowinv16(rs_src, row0 + tid); }
        else { if (tid < 16) invs[tid] = 1.0f; }
        f32x4 acc[NB][CT];
#pragma unroll
        for (int p = 0; p < NB; ++p)
#pragma unroll
            for (int c = 0; c < CT; ++c) acc[p][c] = (f32x4){0.f, 0.f, 0.f, 0.f};
        const bf16_t* ap = A + (size_t)(row0 + lr) * lda + wid * kw + 8 * kg;
        const bf16_t* bp0 = Bt + (size_t)(rm(col0, 0) + lr) * ldb + wid * kw + 8 * kg;
        const bf16_t* bp1 = NB > 1 ? Bt + (size_t)(rm(col0, 1) + lr) * ldb + wid * kw + 8 * kg : bp0;
#pragma unroll
        for (int k = 0; k < kw; k += 32) {
            const bf16x8 a = *(const bf16x8*)(ap + k);
#pragma unroll
            for (int c = 0; c < CT; ++c) {
                const bf16x8 b = *(const bf16x8*)(bp0 + (size_t)c * 16 * ldb + k);
                acc[0][c] = __builtin_amdgcn_mfma_f32_16x16x32_bf16(a, b, acc[0][c], 0, 0, 0);
                if (NB > 1) { const bf16x8 b1 = *(const bf16x8*)(bp1 + (size_t)c * 16 * ldb + k); acc[NB - 1][c] = __builtin_amdgcn_mfma_f32_16x16x32_bf16(a, b1, acc[NB - 1][c], 0, 0, 0); }
            }
        }
#pragma unroll
        for (int p = 0; p < NB; ++p)
#pragma unroll
            for (int c = 0; c < CT; ++c)
#pragma unroll
                for (int r = 0; r < 4; ++r) red[((wid * NB + p) * 16 + 4 * kg + r) * NC + 16 * c + lr] = acc[p][c][r];
        __syncthreads();
        for (int e = tid; e < 16 * NC; e += 512) {
            float v0 = 0.f, v1 = 0.f;
#pragma unroll
            for (int w = 0; w < 8; ++w) { v0 += red[(w * NB) * 16 * NC + e]; if (NB > 1) v1 += red[(w * NB + 1) * 16 * NC + e]; }
            const int r = e / NC, c = e % NC;
            f(row0 + r, col0 + c, v0, v1, invs[r]);
        }
        __syncthreads();
    }
}

template <int NC, int NB, int K, int RT = 8, class RM, class F>
__device__ __forceinline__ void sgemm(LAS unsigned char* lds, const bf16_t* A, int lda, const bf16_t* Bt, int ldb, int N, const float* ssq_src, float* ssq_out, RM rm, F f, int nblk = 0) {
    const int tid = otid(), wid = tid >> 6, lane = tid & 63, lr = lane & 15, kg = lane >> 4;
    constexpr int CT = NC / 16, KW = K / 8;
    LAS float* red = (LAS float*)lds;
    constexpr int RH = 8 / RT; const int items = (N / NC) * RH, bix = gridDim.x - 1 - blockIdx.x; if (nblk == 0) nblk = gridDim.x;
    LAS float* invs = (LAS float*)(lds + LDS_INV);
    if (bix < items && bix < nblk) {
        if (ssq_src) { const int row = tid >> 2, q = tid & 3; float sm = 0.f;
#pragma unroll
            for (int j = 0; j < 16; j += 4) { const f32x4 v = *(const f32x4*)(ssq_src + row * 64 + q * 16 + j); sm += (v[0] + v[1]) + (v[2] + v[3]); }
            sm += __shfl_xor(sm, 1); sm += __shfl_xor(sm, 2);
            if (q == 0) invs[row] = rsqrtf(sm * (1.0f / 1024.0f) + EPS); }
        else if (tid < 128) invs[tid] = 1.0f;
        __syncthreads();
    }
    for (int it = bix; it < items && bix < nblk; it += nblk) {
        const int ci = it / RH, col0 = ci * NC, rowb = (it % RH) * RT * 16;
        f32x4 acc[RT][NB][CT];
#pragma unroll
        for (int t = 0; t < RT; ++t)
#pragma unroll
            for (int p = 0; p < NB; ++p)
#pragma unroll
                for (int c = 0; c < CT; ++c) acc[t][p][c] = (f32x4){0.f, 0.f, 0.f, 0.f};
        const bf16_t* ap = A + (size_t)(rowb + lr) * lda + wid * KW + 8 * kg;
        const bf16_t* bp0 = Bt + (size_t)(rm(col0, 0) + lr) * ldb + wid * KW + 8 * kg;
        const bf16_t* bp1 = NB > 1 ? Bt + (size_t)(rm(col0, 1) + lr) * ldb + wid * KW + 8 * kg : bp0;
#pragma unroll (RT == 8 ? 4 : (KW / 32 <= 8 ? 8 : 6))
        for (int k = 0; k < KW; k += 32) {
            bf16x8 bf[NB][CT];
#pragma unroll
            for (int c = 0; c < CT; ++c) { bf[0][c] = *(const bf16x8*)(bp0 + (size_t)c * 16 * ldb + k); if (NB > 1) bf[NB - 1][c] = *(const bf16x8*)(bp1 + (size_t)c * 16 * ldb + k); }
#pragma unroll
            for (int t = 0; t < RT; ++t) { const bf16x8 a = *(const bf16x8*)(ap + (size_t)t * 16 * lda + k);
#pragma unroll
                for (int p = 0; p < NB; ++p)
#pragma unroll
                    for (int c = 0; c < CT; ++c) acc[t][p][c] = __builtin_amdgcn_mfma_f32_16x16x32_bf16(a, bf[p][c], acc[t][p][c], 0, 0, 0); }
        }
#pragma unroll
        for (int t = 0; t < RT; ++t)
#pragma unroll
            for (int p = 0; p < NB; ++p)
#pragma unroll
                for (int c = 0; c < CT; ++c)
#pragma unroll
                    for (int r = 0; r < 4; ++r) red[((((wid * RT + t) * NB + p) * CT + c) * 16 + 4 * kg + r) * 16 + lr] = acc[t][p][c][r];
        __syncthreads();
        for (int e = tid; e < RT * 16 * NC; e += 512) {
            const int rl = e / NC, row = rowb + rl, col = e % NC, t = rl >> 4, rr = rl & 15, c = col >> 4, cl = col & 15;
            float v0 = 0.f, v1 = 0.f;
#pragma unroll
            for (int w = 0; w < 8; ++w) { v0 += red[((((w * RT + t) * NB + 0) * CT + c) * 16 + rr) * 16 + cl]; if (NB > 1) v1 += red[((((w * RT + t) * NB + (NB - 1)) * CT + c) * 16 + rr) * 16 + cl]; }
            float sq = f(row, col0 + col, v0, v1, invs[row]);
            if (ssq_out) { sq *= sq; sq += __shfl_xor(sq, 1); sq += __shfl_xor(sq, 2); sq += __shfl_xor(sq, 4); sq += __shfl_xor(sq, 8); if (NC > 16) sq += __shfl_xor(sq, 16);
                if ((col & (NC - 1)) == 0) ssq_out[row * 64 + ci] = sq; }
        }
        __syncthreads();
    }
}

template <int CT, int NB, int K, class RM, class F>
__device__ __forceinline__ void wave_gemm(LAS unsigned char* lds, const bf16_t* A, int lda, const bf16_t* Bt, int ldb, int N, const float* rs_src, RM rm, F f) {
    const int tid = otid(), wid = tid >> 6, lane = tid & 63, lr = lane & 15, kg = lane >> 4;
    const int bix = gridDim.x - 1 - blockIdx.x, rt = bix & 7, row0 = rt * 16, nct = N / (16 * CT);
    LAS float* invs = (LAS float*)(lds + LDS_INV);
    if (rs_src) { const int r = tid >> 5, q = tid & 31; const float* p = rs_src + (size_t)(row0 + r) * D + q * 32; float s = 0.f;
        for (int j = 0; j < 32; j += 4) { const f32x4 v = *(const f32x4*)(p + j); s += v[0] * v[0] + v[1] * v[1] + v[2] * v[2] + v[3] * v[3]; }
        s += __shfl_xor(s, 1); s += __shfl_xor(s, 2); s += __shfl_xor(s, 4); s += __shfl_xor(s, 8); s += __shfl_xor(s, 16);
        if (q == 0) invs[r] = rsqrtf(s * (1.0f / 1024.0f) + EPS); }
    else if (tid < 16) invs[tid] = 1.0f;
    __syncthreads();
    for (int ct = (bix >> 3) * 8 + wid; ct < nct; ct += (gridDim.x >> 3) * 8) {
        const int col0 = ct * 16 * CT;
        f32x4 acc[NB][CT];
#pragma unroll
        for (int p = 0; p < NB; ++p)
#pragma unroll
            for (int c = 0; c < CT; ++c) acc[p][c] = (f32x4){0.f, 0.f, 0.f, 0.f};
        const bf16_t* ap = A + (size_t)(row0 + lr) * lda + 8 * kg;
        const bf16_t* bp0 = Bt + (size_t)(rm(col0, 0) + lr) * ldb + 8 * kg;
        const bf16_t* bp1 = NB > 1 ? Bt + (size_t)(rm(col0, 1) + lr) * ldb + 8 * kg : bp0;
#pragma unroll 4
        for (int k = 0; k < K; k += 32) {
            const bf16x8 a = *(const bf16x8*)(ap + k);
#pragma unroll
            for (int c = 0; c < CT; ++c) {
                const bf16x8 b = *(const bf16x8*)(bp0 + (size_t)c * 16 * ldb + k);
                acc[0][c] = __builtin_amdgcn_mfma_f32_16x16x32_bf16(a, b, acc[0][c], 0, 0, 0);
                if (NB > 1) { const bf16x8 b1 = *(const bf16x8*)(bp1 + (size_t)c * 16 * ldb + k); acc[NB - 1][c] = __builtin_amdgcn_mfma_f32_16x16x32_bf16(a, b1, acc[NB - 1][c], 0, 0, 0); }
            }
        }
#pragma unroll
        for (int c = 0; c < CT; ++c)
#pragma unroll
            for (int r = 0; r < 4; ++r) f(row0 + 4 * kg + r, col0 + 16 * c + lr, acc[0][c][r], NB > 1 ? acc[NB - 1][c][r] : 0.f, invs[4 * kg + r]);
    }
    __syncthreads();
}

struct Ctx { const float* const* in; float* out; unsigned char* ws; LAS unsigned char* lds; };

__device__ __forceinline__ void tp_tile(LAS float* tile, const float* src, int sld, int sc0, int k0, bf16_t* dst, int dld, int dr0, int dk0, const float* scale, int ncv) {
    const int lane = otid() & 63;
    float v[64];
    const float* sp = src + (size_t)k0 * sld + sc0 + lane;
#pragma unroll
    for (int kk = 0; kk < 64; ++kk) v[kk] = (lane < ncv) ? sp[(size_t)kk * sld] : 0.f;
    if (scale) {
#pragma unroll
        for (int kk = 0; kk < 64; ++kk) v[kk] *= scale[k0 + kk];
    }
#pragma unroll
    for (int kk = 0; kk < 64; ++kk) tile[kk * 65 + lane] = v[kk];
    const int j = lane & 7;
#pragma unroll
    for (int ps = 0; ps < 8; ++ps) { const int cc = (lane >> 3) + 8 * ps;
        float x[8];
#pragma unroll
        for (int i = 0; i < 8; ++i) x[i] = tile[(8 * j + i) * 65 + cc];
        u32x4 w; w.x = cvt_pk_bf16(x[0], x[1]); w.y = cvt_pk_bf16(x[2], x[3]); w.z = cvt_pk_bf16(x[4], x[5]); w.w = cvt_pk_bf16(x[6], x[7]);
        if (cc < ncv) *(u32x4*)(dst + (size_t)(dr0 + cc) * dld + dk0 + 8 * j) = w; }
}
__device__ __forceinline__ void prep_weights(const Ctx& c) {
    const int wv_ = __builtin_amdgcn_readfirstlane(otid() >> 6); LAS float* tile = (LAS float*)c.lds + wv_ * (64 * 65); unsigned char* ws = c.ws;
    constexpr int N_UP = 1408, N_DN = 704, N_IN = 2304, N_DT = 16, N_BRL = 256, N_BRS = 512, N_OUT = 256, N_RG = 32;
    constexpr int TOT = 2 * N_UP + 2 * N_DN + N_IN + N_DT + N_BRL + N_BRS + N_OUT + 2 * N_RG;
    for (int ti0 = blockIdx.x * 8 + wv_; ti0 < TOT; ti0 += gridDim.x * 8) {
        int ti = ti0;
        if (ti < 2 * N_UP) { const int l = ti >= N_UP; if (l) ti -= N_UP;
            const int j = ti >> 5, r = ti & 31, pn = j >> 1, panel = j & 1, ct = r >> 4, kt = r & 15;
            tp_tile(tile, c.in[l ? 29 : 7], 2 * FF, panel * FF + 128 * pn + 64 * ct, 64 * kt, (bf16_t*)(ws + (l ? OFF_WUP2 : OFF_WUP1)), D, 256 * pn + 128 * panel + 64 * ct, 64 * kt, l ? c.in[28] : nullptr, 64);
            continue; }
        ti -= 2 * N_UP;
        if (ti < 2 * N_DN) { const int l = ti >= N_DN; if (l) ti -= N_DN;
            const int nt = ti / 44, kt = ti % 44;
            tp_tile(tile, c.in[l ? 30 : 8], D, 64 * nt, 64 * kt, (bf16_t*)(ws + (l ? OFF_WDN2 : OFF_WDN1)), FF, 64 * nt, 64 * kt, nullptr, 64);
            continue; }
        ti -= 2 * N_DN;
        if (ti < N_IN) { const int nt = ti >> 4, kt = ti & 15, n0 = 64 * nt;
            const int sc = n0 < 1024 ? n0 : (n0 < 4096 ? n0 + 3072 : (n0 < 7168 ? n0 - 3072 : n0 + 32));
            tp_tile(tile, c.in[10], 9248, sc, 64 * kt, (bf16_t*)(ws + OFF_WIN), D, n0, 64 * kt, c.in[9], 64);
            continue; }
        ti -= N_IN;
        if (ti < N_DT) { tp_tile(tile, c.in[10], 9248, 7168, 64 * ti, (bf16_t*)(ws + OFF_WDT), D, 0, 64 * ti, c.in[9], 32); continue; }
        ti -= N_DT;
        if (ti < N_BRL) { const int nt = ti >> 4, kt = ti & 15; tp_tile(tile, c.in[25], D, 64 * nt, 64 * kt, (bf16_t*)(ws + OFF_WBR), 3072, 64 * nt, 64 * kt, nullptr, 64); continue; }
        ti -= N_BRL;
        if (ti < N_BRS) { const int nt = ti >> 5, kt = ti & 31; tp_tile(tile, c.in[26], D, 64 * nt, 64 * kt, (bf16_t*)(ws + OFF_WBR), 3072, 64 * nt, 1024 + 64 * kt, c.in[24], 64); continue; }
        ti -= N_BRS;
        if (ti < N_OUT) { const int nt = ti >> 4, kt = ti & 15; tp_tile(tile, c.in[27], D, 64 * nt, 64 * kt, (bf16_t*)(ws + OFF_WOUT), D, 64 * nt, 64 * kt, nullptr, 64); continue; }
        ti -= N_OUT;
        { const int l = ti >= N_RG; if (l) ti -= N_RG; const int h = ti >> 2, nt = (ti >> 1) & 1, kt = ti & 1;
          tp_tile(tile, c.in[l ? 16 : 14] + h * 16384, 128, 64 * nt, 64 * kt, (bf16_t*)(ws + (l ? OFF_WIG : OFF_WRG)) + h * 16384, 128, 64 * nt, 64 * kt, nullptr, 64); }
    }
}
__device__ __forceinline__ void rmsnorm_rows_bf16(const float* x, int nrows, const float* g, bf16_t* dst) {
    const int t_ = otid(), lane = t_ & 63, gw = blockIdx.x * 8 + (t_ >> 6), nw = gridDim.x * 8;
    f32x4 gg[4];
#pragma unroll
    for (int i = 0; i < 4; ++i) gg[i] = *(const f32x4*)(g + (i * 64 + lane) * 4);
    for (int r = gw; r < nrows; r += 2 * nw) {
        const int r2 = r + nw; const bool two = r2 < nrows;
        const float* p = x + (size_t)r * D; const float* p2 = x + (size_t)(two ? r2 : r) * D; f32x4 v[4], w[4]; float s = 0.f, s2 = 0.f;
#pragma unroll
        for (int i = 0; i < 4; ++i) { v[i] = *(const f32x4*)(p + (i * 64 + lane) * 4); w[i] = *(const f32x4*)(p2 + (i * 64 + lane) * 4); }
#pragma unroll
        for (int i = 0; i < 4; ++i) { s += v[i][0] * v[i][0] + v[i][1] * v[i][1] + v[i][2] * v[i][2] + v[i][3] * v[i][3]; s2 += w[i][0] * w[i][0] + w[i][1] * w[i][1] + w[i][2] * w[i][2] + w[i][3] * w[i][3]; }
#pragma unroll
        for (int o = 1; o < 64; o <<= 1) { s += __shfl_xor(s, o); s2 += __shfl_xor(s2, o); }
        const float inv = rsqrtf(s * (1.0f / 1024.0f) + EPS), inv2 = rsqrtf(s2 * (1.0f / 1024.0f) + EPS);
#pragma unroll
        for (int i = 0; i < 4; ++i) { const int cc = (i * 64 + lane) * 4; const f32x4 o = v[i] * inv * gg[i];
            unsigned* q = (unsigned*)(dst + (size_t)r * D + cc); q[0] = cvt_pk_bf16(o[0], o[1]); q[1] = cvt_pk_bf16(o[2], o[3]);
            if (two) { const f32x4 o2 = w[i] * inv2 * gg[i]; unsigned* q2 = (unsigned*)(dst + (size_t)r2 * D + cc); q2[0] = cvt_pk_bf16(o2[0], o2[1]); q2[1] = cvt_pk_bf16(o2[2], o2[3]); } }
    }
}
__device__ __forceinline__ void rmsnorm_rows_f32(float* x, int nrows, const float* g) {
    const int t_ = otid(), lane = t_ & 63, gw = blockIdx.x * 8 + (t_ >> 6), nw = gridDim.x * 8;
    f32x4 gg[4];
#pragma unroll
    for (int i = 0; i < 4; ++i) gg[i] = *(const f32x4*)(g + (i * 64 + lane) * 4);
    for (int r = gw; r < nrows; r += 2 * nw) {
        const int r2 = r + nw; const bool two = r2 < nrows;
        float* p = x + (size_t)r * D; float* p2 = x + (size_t)(two ? r2 : r) * D; f32x4 v[4], w[4]; float s = 0.f, s2 = 0.f;
#pragma unroll
        for (int i = 0; i < 4; ++i) { v[i] = *(const f32x4*)(p + (i * 64 + lane) * 4); w[i] = *(const f32x4*)(p2 + (i * 64 + lane) * 4); }
#pragma unroll
        for (int i = 0; i < 4; ++i) { s += v[i][0] * v[i][0] + v[i][1] * v[i][1] + v[i][2] * v[i][2] + v[i][3] * v[i][3]; s2 += w[i][0] * w[i][0] + w[i][1] * w[i][1] + w[i][2] * w[i][2] + w[i][3] * w[i][3]; }
#pragma unroll
        for (int o = 1; o < 64; o <<= 1) { s += __shfl_xor(s, o); s2 += __shfl_xor(s2, o); }
        const float inv = rsqrtf(s * (1.0f / 1024.0f) + EPS), inv2 = rsqrtf(s2 * (1.0f / 1024.0f) + EPS);
#pragma unroll
        for (int i = 0; i < 4; ++i) { const int cc = (i * 64 + lane) * 4; *(f32x4*)(p + cc) = v[i] * inv * gg[i]; if (two) *(f32x4*)(p2 + cc) = w[i] * inv2 * gg[i]; }
    }
}

template <bool FINAL>
__device__ __forceinline__ void lru_chunk(const Ctx& c, int b, int ch, bool dry = false) {
    const int tid = otid(), wid = tid >> 6, lane = tid & 63, lr = lane & 15, kg = lane >> 4;
    LAS float* XC = (LAS float*)c.lds; LAS float* AA = (LAS float*)(c.lds + 32768); LAS float* UU = (LAS float*)(c.lds + 65536); LAS unsigned char* XCb = c.lds + 98304;
    bf16_t* PP = (bf16_t*)(c.ws + OFF_PP); bf16_t* HALO = (bf16_t*)(c.ws + OFF_HALO); float* SUMM = (float*)(c.ws + OFF_SUMM);
    const bf16_t* WRG = (const bf16_t*)(c.ws + OFF_WRG); const bf16_t* WIG = (const bf16_t*)(c.ws + OFF_WIG);
    const float* cw = c.in[12]; const float* cb = c.in[13]; const float* brg = c.in[15]; const float* big = c.in[17]; const float* lam = c.in[18];
    const int t0 = b * SEQ + 64 * ch;
    LAS float* CARRY = (LAS float*)(c.lds + 115712);
    if (FINAL) {
        float h0 = 0.f, h1 = 0.f;
        for (int cp = 0; cp < ch; cp += 8) {
            float a0[8], b0[8], a1[8], b1[8];
#pragma unroll
            for (int i = 0; i < 8; ++i) { a0[i] = 1.f; b0[i] = 0.f; a1[i] = 1.f; b1[i] = 0.f;
                if (cp + i < ch) { const float* sp = SUMM + ((size_t)(b * NCH + cp + i) * D + tid) * 2; a0[i] = sp[0]; b0[i] = sp[1]; a1[i] = sp[1024]; b1[i] = sp[1025]; } }
#pragma unroll
            for (int i = 0; i < 8; ++i) { h0 = a0[i] * h0 + b0[i]; h1 = a1[i] * h1 + b1[i]; }
        }
        CARRY[tid] = h0; CARRY[tid + 512] = h1;
    }
    const int cg8 = tid & 15, tk = (tid >> 4) * 2;
    u32x4 rawp[5]; f32x4 wk[4][2], bb[2]; bf16x8 wrf[4], wif[4]; float pb1 = 0.f, pb2 = 0.f, plam = 0.f;
#define LRU_FETCH(hd) do { const int cc0_ = 128 * (hd) + 8 * cg8; \
        _Pragma("unroll") for (int i = 0; i < 5; ++i) { const int tt = tk - 3 + i; rawp[i] = (u32x4){0u, 0u, 0u, 0u}; \
            if (tt >= 0) rawp[i] = *(const u32x4*)(PP + (size_t)(t0 + tt) * NPP + cc0_); \
            else if (ch > 0) rawp[i] = *(const u32x4*)(HALO + ((size_t)((b * NCH + ch - 1) * 3 + (tt + 3))) * D + cc0_); } \
        _Pragma("unroll") for (int k = 0; k < 4; ++k) { wk[k][0] = *(const f32x4*)(cw + k * D + cc0_); wk[k][1] = *(const f32x4*)(cw + k * D + cc0_ + 4); } \
        bb[0] = *(const f32x4*)(cb + cc0_); bb[1] = *(const f32x4*)(cb + cc0_ + 4); } while (0)
#define LRU_FETCHW(hd) do { \
        { const int cgl_ = 128 * (hd) + 16 * wid + lr; const bf16_t* wr__ = WRG + (size_t)cgl_ * 128 + 8 * kg; const bf16_t* wi__ = WIG + (size_t)cgl_ * 128 + 8 * kg; \
          _Pragma("unroll") for (int ks = 0; ks < 4; ++ks) { wrf[ks] = *(const bf16x8*)(wr__ + 32 * ks); wif[ks] = *(const bf16x8*)(wi__ + 32 * ks); } \
          pb1 = brg[cgl_]; pb2 = big[cgl_]; plam = lam[cgl_]; } } while (0)
    LRU_FETCH(0); LRU_FETCHW(0);
    for (int head = 0; head < 8; ++head) {
        const int ch0 = 128 * head;
        {
            f32x4 raw[5][2];
#pragma unroll
            for (int i = 0; i < 5; ++i) unpack8(rawp[i], raw[i][0], raw[i][1]);
#pragma unroll
            for (int q = 0; q < 2; ++q) { f32x4 o0 = bb[0], o1 = bb[1];
#pragma unroll
                for (int k = 0; k < 4; ++k) { o0 += wk[k][0] * raw[q + k][0]; o1 += wk[k][1] * raw[q + k][1]; }
                *(LAS f32x4*)(XC + (tk + q) * 128 + 8 * cg8) = o0; *(LAS f32x4*)(XC + (tk + q) * 128 + 8 * cg8 + 4) = o1;
                *(LAS u32x4*)A256(XCb, tk + q, cg8) = pack8(o0, o1); }
            if (head < 7) LRU_FETCH(head + 1);
        }
        __syncthreads();
        {
            f32x4 ar[4], ai_[4];
#pragma unroll
            for (int m = 0; m < 4; ++m) { ar[m] = (f32x4){0.f, 0.f, 0.f, 0.f}; ai_[m] = (f32x4){0.f, 0.f, 0.f, 0.f}; }
#pragma unroll
            for (int ks = 0; ks < 4; ++ks) { const bf16x8 br = wrf[ks], bi = wif[ks];
#pragma unroll
                for (int m = 0; m < 4; ++m) { const bf16x8 a = *(const LAS bf16x8*)A256(XCb, 16 * m + lr, 4 * ks + kg);
                    ar[m] = __builtin_amdgcn_mfma_f32_16x16x32_bf16(a, br, ar[m], 0, 0, 0); ai_[m] = __builtin_amdgcn_mfma_f32_16x16x32_bf16(a, bi, ai_[m], 0, 0, 0); } }
            const int cl = 16 * wid + lr; const float b1 = pb1, b2 = pb2, sp = softplusf_(-plam);
            if (head < 7) LRU_FETCHW(head + 1);
#pragma unroll
            for (int m = 0; m < 4; ++m)
#pragma unroll
                for (int r = 0; r < 4; ++r) { const int tk = 16 * m + 4 * kg + r; const float rg = sigmoidf_(ar[m][r] + b1), ig = sigmoidf_(ai_[m][r] + b2);
                    const float la = -8.0f * rg * sp, a_ = __expf(la); const float u = __builtin_amdgcn_sqrtf(fmaxf(1.0f - a_ * a_, 0.0f)) * ig * XC[tk * 128 + cl];
                    AA[tk * 128 + cl] = la; UU[tk * 128 + cl] = u; }
        }
        __syncthreads();
        if (!FINAL) {
            const int cg8s = tid & 15, tks = (tid >> 4) * 2;
#pragma unroll
            for (int q = 0; q < 2; ++q) { const f32x4 o0 = *(const LAS f32x4*)(UU + (tks + q) * 128 + 8 * cg8s), o1 = *(const LAS f32x4*)(UU + (tks + q) * 128 + 8 * cg8s + 4);
                const f32x4 l0 = *(const LAS f32x4*)(AA + (tks + q) * 128 + 8 * cg8s), l1 = *(const LAS f32x4*)(AA + (tks + q) * 128 + 8 * cg8s + 4);
                *(u32x4*)(PP + (size_t)(t0 + tks + q) * NPP + ch0 + 8 * cg8s) = pack8(o0, o1); *(u32x4*)(PP + (size_t)(t0 + tks + q) * NPP + 3072 + ch0 + 8 * cg8s) = pack8(l0, l1); } }
        if (tid < 128) { const int cgl = ch0 + tid;
            if (!FINAL) { float A = 1.f, H = 0.f;
                for (int t8 = 0; t8 < 64; t8 += 16) { float av[16], uv[16];
#pragma unroll
                    for (int i = 0; i < 16; ++i) { av[i] = AA[(t8 + i) * 128 + tid]; uv[i] = UU[(t8 + i) * 128 + tid]; }
#pragma unroll
                    for (int i = 0; i < 16; ++i) { const float a_ = __expf(av[i]); H = a_ * H + uv[i]; A *= a_; } }
                float* s = SUMM + ((size_t)(b * NCH + ch) * D + cgl) * 2; s[0] = A; s[1] = H; }
            else { float h = CARRY[cgl];
                for (int t8 = 0; t8 < 64; t8 += 16) { float av[16], uv[16];
#pragma unroll
                    for (int i = 0; i < 16; ++i) { av[i] = AA[(t8 + i) * 128 + tid]; uv[i] = UU[(t8 + i) * 128 + tid]; }
#pragma unroll
                    for (int i = 0; i < 16; ++i) { h = av[i] * h + uv[i]; UU[(t8 + i) * 128 + tid] = h; } }
                if (ch == NCH - 1) c.out[O_LHP + b * D + cgl] = h; } }
        __syncthreads();
        if (FINAL) { const int cg8 = tid & 15, tk = (tid >> 4) * 2;
#pragma unroll
            for (int q = 0; q < 2; ++q) { const f32x4 o0 = *(const LAS f32x4*)(UU + (tk + q) * 128 + 8 * cg8), o1 = *(const LAS f32x4*)(UU + (tk + q) * 128 + 8 * cg8 + 4);
                if (!dry) *(u32x4*)(PP + (size_t)(t0 + tk + q) * NPP + ch0 + 8 * cg8) = pack8(o0, o1); }
            __syncthreads(); }
    }
}

__device__ __forceinline__ void lru_final(const Ctx& c, int b, int ch) {
    const int tid = otid(); bf16_t* PP = (bf16_t*)(c.ws + OFF_PP); const float* SUMM = (const float*)(c.ws + OFF_SUMM);
    const int t0 = b * SEQ + 64 * ch, c2 = 2 * tid;
    float h0 = 0.f, h1 = 0.f;
    for (int cp = 0; cp < ch; cp += 8) {
        f32x4 sv[8];
#pragma unroll
        for (int i = 0; i < 8; ++i) { sv[i] = (f32x4){1.f, 0.f, 1.f, 0.f}; if (cp + i < ch) sv[i] = *(const f32x4*)(SUMM + ((size_t)(b * NCH + cp + i) * D + c2) * 2); }
#pragma unroll
        for (int i = 0; i < 8; ++i) { h0 = sv[i][0] * h0 + sv[i][1]; h1 = sv[i][2] * h1 + sv[i][3]; }
    }
    for (int t8 = 0; t8 < 64; t8 += 16) {
        unsigned uu[16], ll[16];
#pragma unroll
        for (int i = 0; i < 16; ++i) { const bf16_t* p = PP + (size_t)(t0 + t8 + i) * NPP + c2; uu[i] = *(const unsigned*)p; ll[i] = *(const unsigned*)(p + 3072); }
#pragma unroll
        for (int i = 0; i < 16; ++i) { h0 = __expf(bflo(ll[i])) * h0 + bflo(uu[i]); h1 = __expf(bfhi(ll[i])) * h1 + bfhi(uu[i]);
            *(unsigned*)(PP + (size_t)(t0 + t8 + i) * NPP + c2) = cvt_pk_bf16(h0, h1); }
    }
    if (ch == NCH - 1) { c.out[O_LHP + b * D + c2] = h0; c.out[O_LHP + b * D + c2 + 1] = h1; }
}

__device__ __forceinline__ void bc_conv(const Ctx& c, int b, int ch) {
    const int tid = otid(); const bf16_t* PP = (const bf16_t*)(c.ws + OFF_PP); bf16_t* BCc = (bf16_t*)(c.ws + OFF_XN);
    const float* cw = c.in[19]; const float* cb = c.in[20]; const int t0 = b * SEQ + 64 * ch;
    if (tid < 384) { const int row = tid >> 7, cg8 = tid & 127;
        *(u32x4*)((bf16_t*)(c.ws + OFF_HALO) + ((size_t)((b * NCH + ch) * 3 + row)) * D + 8 * cg8) = *(const u32x4*)(PP + (size_t)(t0 + 61 + row) * NPP + 8 * cg8); }
#pragma unroll 1
    for (int item = tid; item < 1024; item += 512) {
        const int cgq = item & 127, st = item >> 7, gcol = 3072 + 8 * cgq, ccol = 2048 + 8 * cgq;
        u32x4 raw[11];
#pragma unroll
        for (int i = 0; i < 11; ++i) { const int tt = 8 * st - 3 + i; raw[i] = (u32x4){0u, 0u, 0u, 0u}; if (tt >= 0 || ch > 0) raw[i] = *(const u32x4*)(PP + (size_t)(t0 + tt) * NPP + gcol); }
#pragma unroll
        for (int hf = 0; hf < 2; ++hf) {
            f32x4 wk[4]; const f32x4 bb = *(const f32x4*)(cb + ccol + 4 * hf);
#pragma unroll
            for (int k = 0; k < 4; ++k) wk[k] = *(const f32x4*)(cw + k * 3072 + ccol + 4 * hf);
#pragma unroll
            for (int q = 0; q < 8; ++q) { f32x4 o = bb;
#pragma unroll
                for (int k = 0; k < 4; ++k) { const unsigned w0 = raw[q + k][2 * hf], w1 = raw[q + k][2 * hf + 1]; const f32x4 r = (f32x4){bflo(w0), bfhi(w0), bflo(w1), bfhi(w1)}; o += wk[k] * r; }
#pragma unroll
                for (int j = 0; j < 4; ++j) o[j] = siluf_(o[j]);
                unsigned* op = (unsigned*)(BCc + (size_t)(t0 + 8 * st + q) * 1024 + 8 * cgq + 4 * hf); op[0] = cvt_pk_bf16(o[0], o[1]); op[1] = cvt_pk_bf16(o[2], o[3]); }
        }
    }
}

__device__ __forceinline__ void ssd_seq(const Ctx& c, int b, int h, bool dry = false) {
    const int tid = otid(), wid = tid >> 6, lane = tid & 63, lr = lane & 15, kg = lane >> 4;
    LAS unsigned char* L = c.lds;
    LAS unsigned char* Cm = L; LAS unsigned char* Bm = L + 16384; LAS unsigned char* BdT = L + 32768; LAS unsigned char* Sb = L + 49152;
    LAS unsigned char* XdT = L + 65536; LAS unsigned char* Xr = L + 73728; LAS unsigned char* Mm = L + 82944;
    LAS float* dts = (LAS float*)(L + 91136); LAS float* css = (LAS float*)(L + 91392); LAS float* dec = (LAS float*)(L + 91648); LAS bf16_t* halo = (LAS bf16_t*)(L + 91904);
    bf16_t* PP = (bf16_t*)(c.ws + OFF_PP); const float* DT = (const float*)(c.ws + OFF_DT);
    const float* cw = c.in[19]; const float* cb = c.in[20];
    const int g = h >> 3;
    const float Ah = -__expf(c.in[22][h]), Dh = c.in[23][h], dtb = c.in[21][h];
    f32x4 accS[4];
#pragma unroll
    for (int m = 0; m < 4; ++m) accS[m] = (f32x4){0.f, 0.f, 0.f, 0.f};
    for (int e = tid; e < 64 * 128; e += 512) ((LAS bf16_t*)Sb)[e] = 0;
    const bf16_t* BCc = (const bf16_t*)(c.ws + OFF_XN);
    const int role = tid >> 7, rt = tid & 127;
    const int xg = rt & 7, xst = rt >> 3;
    const int bg8 = rt & 15, bst = rt >> 4;
    const int gcol = 1024 + 64 * h + 8 * xg, ccol = 64 * h + 8 * xg;
    const int bcol = (role == 2 ? 512 : 0) + 128 * g + 8 * bg8;
    u32x4 raw[8]; float dtv = 0.f;
    f32x4 wkk[2][4], bbb[2];
#pragma unroll
    for (int hf = 0; hf < 2; ++hf) { bbb[hf] = *(const f32x4*)(cb + ccol + 4 * hf);
#pragma unroll
        for (int k = 0; k < 4; ++k) wkk[hf][k] = *(const f32x4*)(cw + k * 3072 + ccol + 4 * hf); }
    {
        const int t0 = b * SEQ;
        if (role == 0) {
#pragma unroll
            for (int i = 0; i < 7; ++i) { const int tt = 4 * xst - 3 + i; raw[i] = (u32x4){0u, 0u, 0u, 0u}; if (tt >= 0) raw[i] = *(const u32x4*)(PP + (size_t)(t0 + tt) * NPP + gcol); } }
        else if (role < 3) {
#pragma unroll
            for (int i = 0; i < 8; ++i) raw[i] = *(const u32x4*)(BCc + (size_t)(t0 + 8 * bst + i) * 1024 + bcol); }
        if (wid == 0) dtv = DT[(size_t)(t0 + lane) * 32 + h];
    }
    for (int ch = 0; ch < NCH; ++ch) {
        const int t0 = b * SEQ + 64 * ch;
        if (wid == 0) {
            const float d = softplusf_(dtv + dtb); float sc = d * Ah;
#pragma unroll
            for (int o = 1; o < 64; o <<= 1) { const float v = __shfl_up(sc, o); if (lane >= o) sc += v; }
            const float ce = __shfl(sc, 63);
            dts[lane] = d; css[lane] = sc; dec[lane] = __expf(ce - sc);
        }
        __syncthreads();
        if (role == 0) {
            if (xst == 0 && ch > 0) {
#pragma unroll
                for (int i = 0; i < 3; ++i) raw[i] = *(const LAS u32x4*)(halo + ((ch - 1) & 1) * 192 + i * 64 + 8 * xg); }
            if (xst == 15) {
#pragma unroll
                for (int i = 0; i < 3; ++i) *(LAS u32x4*)(halo + (ch & 1) * 192 + i * 64 + 8 * xg) = raw[4 + i];
                if (ch == NCH - 1 && !dry) {
#pragma unroll
                    for (int r = 0; r < 3; ++r) { f32x4 v0, v1; unpack8(raw[4 + r], v0, v1); float* o = c.out + O_SCP + (size_t)(b * 3 + r) * 3072 + ccol; *(f32x4*)o = v0; *(f32x4*)(o + 4) = v1; } } }
            const int chunk = (xst >> 1) ^ xg;
#pragma unroll
            for (int hf = 0; hf < 2; ++hf) {
                unsigned tq[4][2];
#pragma unroll
                for (int q = 0; q < 4; ++q) { f32x4 o = bbb[hf];
#pragma unroll
                    for (int k = 0; k < 4; ++k) { const unsigned w0 = raw[q + k][2 * hf], w1 = raw[q + k][2 * hf + 1]; const f32x4 r = (f32x4){bflo(w0), bfhi(w0), bflo(w1), bfhi(w1)}; o += wkk[hf][k] * r; }
#pragma unroll
                    for (int j = 0; j < 4; ++j) o[j] = siluf_(o[j]);
                    const int l = 4 * xst + q;
                    LAS unsigned* rp = (LAS unsigned*)(Xr + l * 144 + 16 * xg + 8 * hf); rp[0] = cvt_pk_bf16(o[0], o[1]); rp[1] = cvt_pk_bf16(o[2], o[3]);
                    const float d = dts[l]; tq[q][0] = cvt_pk_bf16(o[0] * d, o[1] * d); tq[q][1] = cvt_pk_bf16(o[2] * d, o[3] * d);
                }
#pragma unroll
                for (int j2 = 0; j2 < 2; ++j2) {
                    unsigned lo[2], hi[2];
#pragma unroll
                    for (int i = 0; i < 2; ++i) { const unsigned a = tq[2 * i][j2], bq = tq[2 * i + 1][j2]; lo[i] = (a & 0xffffu) | (bq << 16); hi[i] = (a >> 16) | (bq & 0xffff0000u); }
                    LAS unsigned* p0 = (LAS unsigned*)(A128(XdT, 8 * xg + 4 * hf + 2 * j2, xst >> 1) + 8 * (xst & 1)); p0[0] = lo[0]; p0[1] = lo[1];
                    LAS unsigned* p1 = (LAS unsigned*)(A128(XdT, 8 * xg + 4 * hf + 2 * j2 + 1, xst >> 1) + 8 * (xst & 1)); p1[0] = hi[0]; p1[1] = hi[1]; }
            }
        } else if (role == 1) {
            const int chunk = bst ^ (bg8 & 7);
            unsigned tq[8][4];
#pragma unroll
            for (int q = 0; q < 8; ++q) { const int l = 8 * bst + q; *(LAS u32x4*)A256(Bm, l, bg8) = raw[q]; const float d = dec[l]; f32x4 v0, v1; unpack8(raw[q], v0, v1);
                tq[q][0] = cvt_pk_bf16(v0[0] * d, v0[1] * d); tq[q][1] = cvt_pk_bf16(v0[2] * d, v0[3] * d); tq[q][2] = cvt_pk_bf16(v1[0] * d, v1[1] * d); tq[q][3] = cvt_pk_bf16(v1[2] * d, v1[3] * d); }
#pragma unroll
            for (int j2 = 0; j2 < 4; ++j2) { u32x4 lo, hi;
#pragma unroll
                for (int i = 0; i < 4; ++i) { const unsigned a = tq[2 * i][j2], bq = tq[2 * i + 1][j2]; lo[i] = (a & 0xffffu) | (bq << 16); hi[i] = (a >> 16) | (bq & 0xffff0000u); }
                *(LAS u32x4*)A128(BdT, 8 * bg8 + 2 * j2, bst) = lo; *(LAS u32x4*)A128(BdT, 8 * bg8 + 2 * j2 + 1, bst) = hi; }
        } else if (role == 2) {
#pragma unroll
            for (int q = 0; q < 8; ++q) *(LAS u32x4*)A256(Cm, 8 * bst + q, bg8) = raw[q];
        }
        if (ch + 1 < NCH) {
            if (role == 0) {
#pragma unroll
                for (int i = 0; i < 7; ++i) { const int tt = 4 * xst - 3 + i; if (tt >= 0) raw[i] = *(const u32x4*)(PP + (size_t)(t0 + 64 + tt) * NPP + gcol); } }
            else if (role < 3) {
#pragma unroll
                for (int i = 0; i < 8; ++i) raw[i] = *(const u32x4*)(BCc + (size_t)(t0 + 64 + 8 * bst + i) * 1024 + bcol); }
            if (wid == 0) dtv = DT[(size_t)(t0 + 64 + lane) * 32 + h];
        }
        __syncthreads();
#pragma unroll
        for (int q = 0; q < 2; ++q) { const int ti = 2 * wid + q, lt = ti >> 2, stl = ti & 3; f32x4 a4 = (f32x4){0.f, 0.f, 0.f, 0.f};
            if (stl <= lt) {
#pragma unroll
                for (int ks = 0; ks < 4; ++ks) { const bf16x8 a = *(const LAS bf16x8*)A256(Bm, 16 * stl + lr, 4 * ks + kg), bq = *(const LAS bf16x8*)A256(Cm, 16 * lt + lr, 4 * ks + kg);
                    a4 = __builtin_amdgcn_mfma_f32_16x16x32_bf16(a, bq, a4, 0, 0, 0); } }
            const int l = 16 * lt + lr; const float cl = css[l]; f32x4 v;
#pragma unroll
            for (int r = 0; r < 4; ++r) { const int sI = 16 * stl + 4 * kg + r; v[r] = (sI <= l) ? a4[r] * __expf(cl - css[sI]) : 0.f; }
            unsigned* dummy = nullptr; (void)dummy;
            LAS unsigned* mp = (LAS unsigned*)(A128(Mm, l, 2 * stl + (kg >> 1)) + 8 * (kg & 1)); mp[0] = cvt_pk_bf16(v[0], v[1]); mp[1] = cvt_pk_bf16(v[2], v[3]); }
        __syncthreads();
#pragma unroll
        for (int q = 0; q < 2; ++q) { const int ti = 2 * wid + q, pt = ti >> 2, lt = ti & 3; f32x4 a4 = (f32x4){0.f, 0.f, 0.f, 0.f};
#pragma unroll
            for (int ks = 0; ks < 4; ++ks) { const bf16x8 a = *(const LAS bf16x8*)A256(Sb, 16 * pt + lr, 4 * ks + kg), bq = *(const LAS bf16x8*)A256(Cm, 16 * lt + lr, 4 * ks + kg);
                a4 = __builtin_amdgcn_mfma_f32_16x16x32_bf16(a, bq, a4, 0, 0, 0); }
            const int l = 16 * lt + lr; const float el = __expf(css[l]);
#pragma unroll
            for (int r = 0; r < 4; ++r) a4[r] *= el;
            const int prow_ = 16 * pt + lr, sw = (2 * pt + (lr >> 3)) & 7;
#pragma unroll
            for (int ks = 0; ks < 2; ++ks) { const bf16x8 a = *(const LAS bf16x8*)A128(XdT, prow_, 4 * ks + kg), bq = *(const LAS bf16x8*)A128(Mm, 16 * lt + lr, 4 * ks + kg);
                a4 = __builtin_amdgcn_mfma_f32_16x16x32_bf16(a, bq, a4, 0, 0, 0); }
            const int p0 = 16 * pt + 4 * kg; const LAS unsigned* xp = (const LAS unsigned*)(Xr + l * 144 + 2 * p0); const unsigned x01 = xp[0], x23 = xp[1];
            const float y0 = a4[0] + Dh * bflo(x01), y1 = a4[1] + Dh * bfhi(x01), y2 = a4[2] + Dh * bflo(x23), y3 = a4[3] + Dh * bfhi(x23);
            if (!dry) { unsigned* yp = (unsigned*)(PP + (size_t)(t0 + l) * NPP + 1024 + 64 * h + p0); yp[0] = cvt_pk_bf16(y0, y1); yp[1] = cvt_pk_bf16(y2, y3); } }
        { const float ce = __expf(css[63]); const int nrow = 16 * wid + lr, swn = (2 * wid + (lr >> 3)) & 7;
#pragma unroll
          for (int m = 0; m < 4; ++m) { accS[m] *= ce; const int prow_ = 16 * m + lr, swp = (2 * m + (lr >> 3)) & 7;
#pragma unroll
            for (int ks = 0; ks < 2; ++ks) { const bf16x8 a = *(const LAS bf16x8*)A128(BdT, nrow, 4 * ks + kg), bq = *(const LAS bf16x8*)A128(XdT, prow_, 4 * ks + kg);
                accS[m] = __builtin_amdgcn_mfma_f32_16x16x32_bf16(a, bq, accS[m], 0, 0, 0); } } }
        __syncthreads();
#pragma unroll
        for (int m = 0; m < 4; ++m) { LAS unsigned* sp = (LAS unsigned*)(A256(Sb, 16 * m + lr, 2 * wid + (kg >> 1)) + 8 * (kg & 1)); sp[0] = cvt_pk_bf16(accS[m][0], accS[m][1]); sp[1] = cvt_pk_bf16(accS[m][2], accS[m][3]); }
    }
    if (!dry) {
#pragma unroll
        for (int m = 0; m < 4; ++m) *(f32x4*)(c.out + O_SHP + ((size_t)(b * 32 + h) * 64 + 16 * m + lr) * 128 + 16 * wid + 4 * kg) = accS[m];
    }
    __syncthreads();
}

__device__ __forceinline__ void lru_sample(const Ctx& c, int b, int head) {
    const int tid = otid(); LAS float* XC = (LAS float*)c.lds; LAS float* RG = XC + 2048; LAS float* IG = RG + 2048;
    const float* PS = (const float*)(c.ws + OFF_PS); bf16_t* ABRS = (bf16_t*)(c.ws + OFF_ABRS);
    const float* cw = c.in[12]; const float* cb = c.in[13]; const int ch0 = 128 * head;
    for (int e = tid; e < 2048; e += 512) { const int tk = e >> 7, cl = e & 127, cgl = ch0 + cl; float o = cb[cgl];
#pragma unroll
        for (int k = 0; k < 4; ++k) { const int tt = tk - 3 + k; const float v = tt >= 0 ? PS[(size_t)(b * 16 + tt) * 9216 + cgl] : SZ(c.in[2][(size_t)(b * 3 + tt + 3) * D + cgl]); o += cw[k * D + cgl] * v; }
        XC[e] = o; }
    if (tid < 384) { const int r = tid >> 7, cl = tid & 127; c.out[O_LCS + (size_t)(b * 3 + r) * D + ch0 + cl] = PS[(size_t)(b * 16 + 13 + r) * 9216 + ch0 + cl]; }
    __syncthreads();
    {
        LAS unsigned char* XCb = c.lds + 32768; const int wid = tid >> 6, lane = tid & 63, lr = lane & 15, kg = lane >> 4;
        for (int e = tid; e < 2048; e += 512) *(LAS bf16_t*)(XCb + (e >> 7) * 272 + 2 * (e & 127)) = f2bf(XC[e]);
        __syncthreads();
        const bf16_t* wr_ = (const bf16_t*)(c.ws + OFF_WRG) + (size_t)(ch0 + 16 * wid + lr) * 128 + 8 * kg; const bf16_t* wi_ = (const bf16_t*)(c.ws + OFF_WIG) + (size_t)(ch0 + 16 * wid + lr) * 128 + 8 * kg;
        f32x4 ar = (f32x4){0.f, 0.f, 0.f, 0.f}, ai_ = ar;
#pragma unroll
        for (int ks = 0; ks < 4; ++ks) { const bf16x8 br = *(const bf16x8*)(wr_ + 32 * ks), bi = *(const bf16x8*)(wi_ + 32 * ks), a = *(const LAS bf16x8*)(XCb + lr * 272 + (32 * ks + 8 * kg) * 2);
            ar = __builtin_amdgcn_mfma_f32_16x16x32_bf16(a, br, ar, 0, 0, 0); ai_ = __builtin_amdgcn_mfma_f32_16x16x32_bf16(a, bi, ai_, 0, 0, 0); }
        const int cl = 16 * wid + lr; const float b1 = c.in[15][ch0 + cl], b2 = c.in[17][ch0 + cl];
#pragma unroll
        for (int r = 0; r < 4; ++r) { const int tk = 4 * kg + r; RG[tk * 128 + cl] = sigmoidf_(ar[r] + b1); IG[tk * 128 + cl] = sigmoidf_(ai_[r] + b2); }
    }
    __syncthreads();
    if (tid < 128) { const int cgl = ch0 + tid; const float sp = softplusf_(-c.in[18][cgl]); float h = SZ(c.in[3][b * D + cgl]);
        for (int tk = 0; tk < 16; ++tk) { const float la = -8.0f * RG[tk * 128 + tid] * sp, a = __expf(la), u = sqrtf(-expm1f(2.0f * la)) * IG[tk * 128 + tid] * XC[tk * 128 + tid];
            h = a * h + u; ABRS[(size_t)(b * 16 + tk) * 3072 + cgl] = f2bf(gelu_tanh(PS[(size_t)(b * 16 + tk) * 9216 + 4096 + cgl]) * h); }
        c.out[O_LHS + b * D + cgl] = h; }
    __syncthreads();
}
__device__ __forceinline__ void ssd_sample(const Ctx& c, int b, int h) {
    const int tid = otid(); LAS float* XS = (LAS float*)c.lds; LAS float* BS = XS + 1024; LAS float* CS = BS + 2048; LAS float* DTL = CS + 2048;
    const float* PS = (const float*)(c.ws + OFF_PS); const float* DTS = (const float*)(c.ws + OFF_DTS); float* YGS = (float*)(c.ws + OFF_YGS);
    const float* cw = c.in[19]; const float* cb = c.in[20]; const int g = h >> 3;
    for (int e = tid; e < 16 * 320; e += 512) { const int tk = e / 320, q = e % 320; int cc; LAS float* dst;
        if (q < 64) { cc = 64 * h + q; dst = XS + tk * 64 + q; } else if (q < 192) { cc = 2048 + 128 * g + (q - 64); dst = BS + tk * 128 + (q - 64); } else { cc = 2560 + 128 * g + (q - 192); dst = CS + tk * 128 + (q - 192); }
        float o = cb[cc];
#pragma unroll
        for (int k = 0; k < 4; ++k) { const int tt = tk - 3 + k; const float v = tt >= 0 ? PS[(size_t)(b * 16 + tt) * 9216 + 1024 + cc] : SZ(c.in[4][(size_t)(b * 3 + tt + 3) * 3072 + cc]); o += cw[k * 3072 + cc] * v; }
        *dst = siluf_(o);
        if (tk >= 13 && (q < 64 || (h & 7) == 0)) c.out[O_SCS + (size_t)(b * 3 + tk - 13) * 3072 + cc] = PS[(size_t)(b * 16 + tk) * 9216 + 1024 + cc]; }
    if (tid < 16) DTL[tid] = softplusf_(DTS[(b * 16 + tid) * 32 + h] + c.in[21][h]);
    __syncthreads();
    const float Ah = -__expf(c.in[22][h]), Dh = c.in[23][h];
    const int p = tid >> 3, n0 = (tid & 7) * 16; float hs[16];
    const float* h0 = c.in[5] + ((size_t)(b * 32 + h) * 64 + p) * 128 + n0;
#pragma unroll
    for (int j = 0; j < 16; ++j) hs[j] = SZ(h0[j]);
    float zv[16];
#pragma unroll
    for (int tk = 0; tk < 16; ++tk) zv[tk] = PS[(size_t)(b * 16 + tk) * 9216 + 5120 + 64 * h + p];
#pragma unroll
    for (int tk = 0; tk < 16; ++tk) { const float d = DTL[tk], ea = __expf(d * Ah), xv = XS[tk * 64 + p], dx = d * xv; float y = 0.f;
#pragma unroll
        for (int j = 0; j < 16; ++j) { hs[j] = ea * hs[j] + dx * BS[tk * 128 + n0 + j]; y += CS[tk * 128 + n0 + j] * hs[j]; }
        y += __shfl_xor(y, 1); y += __shfl_xor(y, 2); y += __shfl_xor(y, 4);
        if ((tid & 7) == 0) { const int row = b * 16 + tk; YGS[(size_t)row * 2048 + 64 * h + p] = (y + Dh * xv) * siluf_(zv[tk]); } }
    float* ho = c.out + O_SHS + ((size_t)(b * 32 + h) * 64 + p) * 128 + n0;
#pragma unroll
    for (int j = 0; j < 16; ++j) ho[j] = hs[j];
    __syncthreads();
}

#ifdef DIAG
constexpr size_t OFF_DIAG = 266338304;
__device__ __forceinline__ int prow(int r) { return (r >> 4) * SEQ + (r & 15); }
template <class FA, class FB>
__device__ __forceinline__ void diag_rel(LAS float* red, float* dst, int ncols, FA fa, FB fb) {
    const int tid = threadIdx.x; float num = 0.f, den = 0.f;
    for (int e = tid; e < TS * ncols; e += 512) { const int r = e / ncols, cc = e % ncols; const float a = fa(r, cc), b = fb(r, cc); num += (a - b) * (a - b); den += b * b; }
    red[tid] = num; red[512 + tid] = den; __syncthreads();
    if (tid == 0) { float n = 0.f, d = 0.f; for (int i = 0; i < 512; ++i) { n += red[i]; d += red[512 + i]; } *dst = n / (d + 1e-30f); }
    __syncthreads();
}
#endif
constexpr size_t OFF_BAR = 266338304 + 4096, OFF_SSQS = OFF_BAR + 4096;
__device__ __forceinline__ void grid_barrier(unsigned* ctr, unsigned target) {
    asm volatile("s_waitcnt vmcnt(0) lgkmcnt(0)" ::: "memory");
    __syncthreads();
    if (threadIdx.x == 0) {
        __builtin_amdgcn_fence(__ATOMIC_RELEASE, "agent");
        asm volatile("s_waitcnt vmcnt(0)" ::: "memory");
        __hip_atomic_fetch_add(ctr, 1u, __ATOMIC_RELAXED, __HIP_MEMORY_SCOPE_AGENT);
        while (__hip_atomic_load(ctr, __ATOMIC_RELAXED, __HIP_MEMORY_SCOPE_AGENT) < target) __builtin_amdgcn_s_sleep(1);
        __builtin_amdgcn_fence(__ATOMIC_ACQUIRE, "agent");
        asm volatile("s_waitcnt vmcnt(0)" ::: "memory");
    }
    __syncthreads();
}
#define XB_TMO      128
#define XB_XCNT(j)  (256  + 64 * (j))
#define XB_XSUB(j)  (1280 + 64 * (j))
#define XB_XGEN(j)  (2304 + 64 * (j))
#define XB_TOP      3328
#define XB_TOPGEN   3392
#define XCD_BAR_WORDS 3456
#define XB_SPIN_CAP (1u << 18)
constexpr size_t OFF_XBAR = 266338304 + 4096 + 4096 + 65536;
__device__ __forceinline__ unsigned xb_ld(unsigned* p)              { return __hip_atomic_load(p, __ATOMIC_RELAXED, __HIP_MEMORY_SCOPE_AGENT); }
__device__ __forceinline__ unsigned xb_add(unsigned* p, unsigned v) { return __hip_atomic_fetch_add(p, v, __ATOMIC_RELAXED, __HIP_MEMORY_SCOPE_AGENT); }
__device__ __forceinline__ unsigned xb_xcc_id() { return (unsigned)__builtin_amdgcn_s_getreg((3 << 11) | 20) & 0xFu; }
#define XB_SPIN(cond, bar) do { unsigned _sp = 0; while (cond) { __builtin_amdgcn_s_sleep(1); \
    if ((++_sp & 255u) == 0u) { if (xb_ld(&(bar)[XB_TMO])) break; if (_sp > XB_SPIN_CAP) { atomicAdd(&(bar)[XB_TMO], 1u); break; } } } } while (0)
struct XcdBarrier { unsigned* bar; unsigned x; volatile LAS unsigned* st; };
__device__ __forceinline__ XcdBarrier xcd_barrier_post(unsigned* bar, volatile LAS unsigned* st) {
    XcdBarrier b; b.bar = bar; b.x = xb_xcc_id(); b.st = st;
    if (threadIdx.x == 0) (void)xb_add(&bar[XB_XCNT(b.x)], 1u);
    return b;
}
__device__ __forceinline__ void xcd_barrier_complete(unsigned* bar, unsigned x, unsigned& nloc, unsigned& nx) {
    const unsigned G = gridDim.x * gridDim.y * gridDim.z;
    unsigned sum, cnt, mine, sp = 0u;
    for (;;) {
        sum = 0u; cnt = 0u; mine = 0u;
#pragma unroll
        for (unsigned j = 0; j < 16; ++j) { const unsigned c = xb_ld(&bar[XB_XCNT(j)]); sum += c; cnt += (c > 0u) ? 1u : 0u; mine = (j == x) ? c : mine; }
        if (sum == G) break;
        __builtin_amdgcn_s_sleep(1);
        if ((++sp & 255u) == 0u) { if (xb_ld(&bar[XB_TMO])) break; if (sp > XB_SPIN_CAP) { atomicAdd(&bar[XB_TMO], 1u); break; } }
    }
    nloc = mine > 0u ? mine : 1u; nx = cnt > 0u ? cnt : 1u;
}
__device__ __forceinline__ void xcd_barrier(const XcdBarrier& b) {
    asm volatile("s_waitcnt vmcnt(0)" ::: "memory");
    __syncthreads();
    if (threadIdx.x == 0) {
        unsigned* bar = b.bar;
        __builtin_amdgcn_s_waitcnt(0);
        unsigned nloc = b.st[0], nx = b.st[1];
        if (nloc == 0u) { xcd_barrier_complete(bar, b.x, nloc, nx); b.st[0] = nloc; b.st[1] = nx; }
        const unsigned old = xb_add(&bar[XB_XSUB(b.x)], 1u);
        const unsigned gen = old / nloc;
        if (old + 1u == (gen + 1u) * nloc) {
            __builtin_amdgcn_fence(__ATOMIC_RELEASE, "agent");
            asm volatile("s_waitcnt vmcnt(0)" ::: "memory");
            const unsigned og = xb_add(&bar[XB_TOP], 1u);
            const unsigned tg = og / nx;
            if (og + 1u == (tg + 1u) * nx) xb_add(&bar[XB_TOPGEN], 1u);
            else XB_SPIN(xb_ld(&bar[XB_TOPGEN]) == tg, bar);
            __builtin_amdgcn_fence(__ATOMIC_ACQUIRE, "agent");
            xb_add(&bar[XB_XGEN(b.x)], 1u);
            asm volatile("s_waitcnt vmcnt(0)" ::: "memory");
        } else {
            XB_SPIN(xb_ld(&bar[XB_XGEN(b.x)]) == gen, bar);
            __builtin_amdgcn_fence(__ATOMIC_ACQUIRE, "agent");
            asm volatile("s_waitcnt vmcnt(0)" ::: "memory");
        }
    }
    __syncthreads();
}
#ifndef DUPX
#define DUPX 0
#endif
#ifdef TIMER_ID
#define TSTART(id) do { if ((id) == TIMER_ID) t0_ = __builtin_amdgcn_s_memrealtime(); } while (0)
#define TSTOP(id) do { if ((id) == TIMER_ID) tacc_ += __builtin_amdgcn_s_memrealtime() - t0_; } while (0)
#else
#define TSTART(id)
#define TSTOP(id)
#endif
__global__ void __launch_bounds__(512, 2) fwd_kernel(Params prm) {
    extern __shared__ __attribute__((aligned(16))) unsigned char lds_raw[];
    Ctx c; c.in = prm.in; c.out = prm.out; c.ws = prm.ws; c.lds = (LAS unsigned char*)lds_raw;
    unsigned char* ws = prm.ws; float* out = prm.out;
    const int tid = threadIdx.x, G = gridDim.x, bid = blockIdx.x;
    bf16_t* XB = (bf16_t*)(ws + OFF_XB); bf16_t* XN = (bf16_t*)(ws + OFF_XN); bf16_t* PP = (bf16_t*)(ws + OFF_PP); float* SSQ = (float*)(ws + OFF_SSQ);
    bf16_t* XNS = (bf16_t*)(ws + OFF_XNS); bf16_t* HS = (bf16_t*)(ws + OFF_HS); float* PS = (float*)(ws + OFF_PS); float* GSSQ = (float*)(ws + OFF_GSSQ);
    float* YS = out + O_YS; float* SSQS = (float*)(ws + OFF_SSQS);
    const int lo = prm.ph_lo, hi = prm.ph_hi;
#ifdef DIAG
    if (lo >= 100) {
        if (bid != 0) return;
        float* DG = (float*)(ws + OFF_DIAG); LAS float* red = (LAS float*)c.lds; const int st = lo - 100;
        const float* DTp = (const float*)(ws + OFF_DT); const float* DTs = (const float*)(ws + OFF_DTS); const bf16_t* ABRS = (const bf16_t*)(ws + OFF_ABRS); const bf16_t* MS = (const bf16_t*)(ws + OFF_MS); const float* bg = prm.in[11];
        if (st == 0 || st == 6 || st == 7) diag_rel(red, DG + st, D, [=](int r, int cc) { return out[O_YP + (size_t)prow(r) * D + cc]; }, [=](int r, int cc) { return YS[(size_t)r * D + cc]; });
        if (st == 1) { diag_rel(red, DG + 1, NPP, [=](int r, int cc) { return bf2f(PP[(size_t)prow(r) * NPP + cc]); }, [=](int r, int cc) { return PS[(size_t)r * 9216 + cc]; });
                       diag_rel(red, DG + 2, 32, [=](int r, int cc) { return DTp[(size_t)prow(r) * 32 + cc]; }, [=](int r, int cc) { return DTs[(size_t)r * 32 + cc]; }); }
        if (st == 8) { diag_rel(red, DG + 8, D, [=](int r, int cc) { return bf2f(XN[(size_t)prow(r) * D + cc]); }, [=](int r, int cc) { return sigmoidf_(PS[(size_t)r * 9216 + 7168 + cc] + bg[cc]); });
                       diag_rel(red, DG + 9, D, [=](int r, int cc) { return bf2f(PP[(size_t)prow(r) * NPP + 3072 + cc]); }, [=](int r, int cc) { return sigmoidf_(PS[(size_t)r * 9216 + 8192 + cc] + bg[1024 + cc]); }); }
        if (st == 3) { diag_rel(red, DG + 3, D, [=](int r, int cc) { return bf2f(PP[(size_t)prow(r) * NPP + cc]); }, [=](int r, int cc) { return bf2f(ABRS[(size_t)r * 3072 + cc]); });
                       diag_rel(red, DG + 4, 2048, [=](int r, int cc) { return bf2f(PP[(size_t)prow(r) * NPP + 1024 + cc]); }, [=](int r, int cc) { return bf2f(ABRS[(size_t)r * 3072 + 1024 + cc]); }); }
        if (st == 5) diag_rel(red, DG + 5, D, [=](int r, int cc) { return bf2f(XN[(size_t)prow(r) * D + cc]); }, [=](int r, int cc) { return bf2f(MS[(size_t)r * D + cc]); });
        if (st == 20) {
            int mask = 0; if (!(DG[8] < DIAG_TOL)) mask |= 1; if (!(DG[9] < DIAG_TOL)) mask |= 2; if (!(DG[3] < DIAG_TOL)) mask |= 4; if (!(DG[4] < DIAG_TOL)) mask |= 8; if (!(DG[5] < DIAG_TOL)) mask |= 16;
            if (mask == 0) { if (!(DG[6] < DIAG_TOL)) mask |= 32; if (!(DG[7] < DIAG_TOL)) mask |= 64; }
            float code = mask ? 100.f * (1 + mask) : 0.f;
            if (code > 0.f) for (int e = tid; e < TS * D; e += 512) YS[e] = code;
        }
        return;
    }
#endif
#ifndef PHMASK
#define PHMASK 0x1fff
#endif
#define IN(k) (((PHMASK >> (k)) & 1) && lo <= (k) && (k) < hi)
    unsigned* barctr = (unsigned*)(ws + OFF_BAR); unsigned nbar = 0; (void)barctr;
    volatile LAS unsigned* xbst = (volatile LAS unsigned*)(c.lds + LDS_BYTES - 16);
    if (tid < 4) xbst[tid] = 0u;
    __syncthreads();
    XcdBarrier xbar; xbar.bar = (unsigned*)(ws + OFF_XBAR); xbar.x = 0; xbar.st = xbst;
    if (hi - lo > 1) xbar = xcd_barrier_post((unsigned*)(ws + OFF_XBAR), xbst);
    unsigned long long t0_ = 0, tacc_ = 0; (void)t0_; (void)tacc_;
#define SEAM(k) do { if (IN(k) && IN((k) + 1)) { TSTART(12); ++nbar; xcd_barrier(xbar); TSTOP(12); } } while (0)
    auto rm_id = [](int col0, int) { return col0; };
    auto rm_up = [](int col0, int panel) { return (col0 >> 7) * 256 + panel * 128 + (col0 & 127); };

    if (IN(0)) {
        TSTART(0); prep_weights(c);
#if DUPX == 1
        prep_weights(c);
#endif
        rmsnorm_rows_bf16(prm.in[0], T, prm.in[6], XN); TSTOP(0);
#ifdef DIAG
        { const int t_ = otid(), lane = t_ & 63; for (int r = bid * 8 + (t_ >> 6); r < TS; r += G * 8) { const float* p = prm.in[0] + (size_t)prow(r) * D; float v[16]; float s = 0.f;
            for (int i = 0; i < 16; ++i) { v[i] = p[lane + 64 * i]; s += v[i] * v[i]; }
            for (int o = 1; o < 64; o <<= 1) s += __shfl_xor(s, o);
            const float inv = rsqrtf(s * (1.0f / 1024.0f) + EPS);
            for (int i = 0; i < 16; ++i) XNS[(size_t)r * D + lane + 64 * i] = f2bf(v[i] * inv * prm.in[6][lane + 64 * i]); } }
#else
        rmsnorm_rows_bf16(prm.in[1], TS, prm.in[6], XNS);
#endif
    }
    SEAM(0);
    if (IN(1)) {
        pg8::Gemm g{XN, D, (const bf16_t*)(ws + OFF_WUP1), D, T, 2 * FF, D}; pg8::StaticOrder S; S.init(T, 2 * FF, G, bid);

#if DUPX == 5
        pg8::gemm_phase(c.lds, g, S, EpiSwiglu{PP, (LAS const float*)nullptr});
#endif
        TSTART(1); pg8::gemm_phase(c.lds, g, S, EpiSwiglu{PP, (LAS const float*)nullptr}); TSTOP(1);
        TSTART(2); sgemm<16, 2, D>(c.lds, XNS, D, (const bf16_t*)(ws + OFF_WUP1), D, FF, nullptr, nullptr, rm_up,
            [=](int r, int cc, float v0, float v1, float) { HS[(size_t)r * FF + cc] = f2bf(siluf_(v0) * v1); return 0.f; }, G / 2); TSTOP(2);
    }
    SEAM(1);
    if (IN(2)) {
        pg8::Gemm g{PP, FF, (const bf16_t*)(ws + OFF_WDN1), FF, T, D, FF}; pg8::StaticOrder S; S.init(T, D, G, bid);
        TSTART(10); pg8::gemm_phase(c.lds, g, S, EpiResid{prm.in[0], nullptr, nullptr, XB, SSQ, 0.5f}); TSTOP(10);
        const float* xs_in = prm.in[1];
        TSTART(2); sgemm<16, 1, FF, 4>(c.lds, HS, FF, (const bf16_t*)(ws + OFF_WDN1), FF, D, nullptr, SSQS, rm_id,
            [=](int r, int cc, float v0, float, float) {
#ifdef DIAG
            const float x = prm.in[0][(size_t)prow(r) * D + cc] + 0.5f * v0;
#else
            const float x = xs_in[(size_t)r * D + cc] + 0.5f * v0;
#endif
            YS[(size_t)r * D + cc] = x; XNS[(size_t)r * D + cc] = f2bf(x); return x; }); TSTOP(2);
    }
    SEAM(2);
    if (IN(3)) {
        pg8::Gemm g{XB, D, (const bf16_t*)(ws + OFF_WIN), D, T, NPP, D}; pg8::StaticOrder S; S.init(T, NPP, G, bid);

#if DUPX == 6
        pg8::gemm_phase(c.lds, g, S, EpiScaleBf16{PP, SSQ});
#endif
        LAS const float* linv = fill_inv(c.lds, SSQ); TSTART(11); pg8::gemm_phase(c.lds, g, S, EpiScaleBf16{PP, linv}); TSTOP(11);
        float* DTp = (float*)(ws + OFF_DT); float* DTs = (float*)(ws + OFF_DTS);
        TSTART(2);
        {
            const int t_ = otid(), wv = t_ >> 6, ln = t_ & 63, lr = ln & 15, kg = ln >> 4; const bf16_t* WDT = (const bf16_t*)(ws + OFF_WDT);
            for (int wt = bid * 8 + wv; wt < T / 16; wt += G * 8) {
                f32x4 a0 = (f32x4){0.f, 0.f, 0.f, 0.f}, a1 = a0; f32x4 sq[4][4];
#pragma unroll
                for (int r = 0; r < 4; ++r)
#pragma unroll
                    for (int i = 0; i < 4; ++i) sq[r][i] = *(const f32x4*)(SSQ + (size_t)(16 * wt + 4 * kg + r) * 16 + 4 * i);
                const bf16_t* ap = XB + (size_t)(16 * wt + lr) * D + 8 * kg; const bf16_t* bp = WDT + (size_t)lr * D + 8 * kg;
#pragma unroll 8
                for (int k = 0; k < D; k += 32) { const bf16x8 a = *(const bf16x8*)(ap + k), b0 = *(const bf16x8*)(bp + k), b1 = *(const bf16x8*)(bp + 16 * D + k);
                    a0 = __builtin_amdgcn_mfma_f32_16x16x32_bf16(a, b0, a0, 0, 0, 0); a1 = __builtin_amdgcn_mfma_f32_16x16x32_bf16(a, b1, a1, 0, 0, 0); }
#pragma unroll
                for (int r = 0; r < 4; ++r) { const int row = 16 * wt + 4 * kg + r; const f32x4 sm = (sq[r][0] + sq[r][1]) + (sq[r][2] + sq[r][3]); const float inv = rsqrtf(((sm[0] + sm[1]) + (sm[2] + sm[3])) * (1.0f / 1024.0f) + EPS); DTp[(size_t)row * 32 + lr] = a0[r] * inv; DTp[(size_t)row * 32 + 16 + lr] = a1[r] * inv; }
            }
        }
        TSTOP(2);
        TSTART(2); sgemm<32, 1, D>(c.lds, XNS, D, (const bf16_t*)(ws + OFF_WIN), D, 9216, SSQS, nullptr, rm_id,
            [=](int r, int cc, float v0, float, float inv) { PS[(size_t)r * 9216 + cc] = v0 * inv; return 0.f; }); TSTOP(2);
        TSTART(2); sgemm<32, 1, D>(c.lds, XNS, D, (const bf16_t*)(ws + OFF_WDT), D, 32, SSQS, nullptr, rm_id,
            [=](int r, int cc, float v0, float, float inv) { DTs[(size_t)r * 32 + cc] = v0 * inv; return 0.f; }); TSTOP(2);
    }
    SEAM(3);
    if (IN(4)) {
        for (int e = bid * 512 + tid; e < 8 * 3 * 2048; e += G * 512) {
            const int cc = e & 2047, r = (e >> 11) % 3, b = e / (3 * 2048); const size_t row = (size_t)b * SEQ + 2045 + r;
            if (cc < 1024) out[O_LCP + (size_t)(b * 3 + r) * D + cc] = bf2f(PP[row * NPP + cc]);
            else out[O_SCP + (size_t)(b * 3 + r) * 3072 + 2048 + (cc - 1024)] = bf2f(PP[row * NPP + 3072 + (cc - 1024)]); }

#if DUPX == 4
        for (int it = bid; it < 256; it += G) lru_chunk<false>(c, it >> 5, it & 31);
#endif
        TSTART(19); for (int it = bid; it < 256; it += G) bc_conv(c, it >> 5, it & 31); TSTOP(19);
        if (hi - lo > 1) xcd_barrier(xbar);
        TSTART(3); for (int it = bid; it < 256; it += G) lru_chunk<false>(c, it >> 5, it & 31); TSTOP(3);

#if DUPX == 3
        for (int it = bid; it < 256; it += G) ssd_seq(c, it >> 5, it & 31, prm.ph_lo == 0);
#endif


    }
    SEAM(4);
    if (IN(5)) {

#if DUPX == 2
        for (int it = bid; it < 256; it += G) lru_chunk<true>(c, it >> 5, it & 31, prm.ph_lo == 0);
#endif
        TSTART(4); for (int it = bid; it < 256; it += G) ssd_seq(c, it & 7, it >> 3); TSTOP(4);
        TSTART(5); for (int it = bid; it < 256; it += G) lru_final(c, it >> 5, it & 31); TSTOP(5);
        TSTART(2); for (int it = bid; it < 64; it += G) lru_sample(c, it >> 3, it & 7); TSTOP(2);
        TSTART(2); for (int it = bid; it < 256; it += G) ssd_sample(c, it >> 5, it & 31); TSTOP(2);
    }
    SEAM(5);
    if (IN(6)) { TSTART(8);
        {
        const float* YGS = (const float*)(ws + OFF_YGS); bf16_t* ABRS = (bf16_t*)(ws + OFF_ABRS);
        const int lane = tid & 63;
        for (int w = bid * 8 + (tid >> 6); w < TS * 4; w += G * 8) { const int r = w >> 2, gq = w & 3; const float* p = YGS + (size_t)r * 2048 + 512 * gq; float v[8]; float s = 0.f;
#pragma unroll
            for (int j = 0; j < 8; ++j) { v[j] = p[lane + 64 * j]; s += v[j] * v[j]; }
#pragma unroll
            for (int o = 1; o < 64; o <<= 1) s += __shfl_xor(s, o);
            const float inv = rsqrtf(s * (1.0f / 512.0f) + EPS);
#pragma unroll
            for (int j = 0; j < 8; ++j) ABRS[(size_t)r * 3072 + 1024 + 512 * gq + lane + 64 * j] = f2bf(v[j] * inv); }
        }
        LAS const float* linv = fill_inv(c.lds, SSQ);
        { pg8::Gemm g{XB, D, (const bf16_t*)(ws + OFF_WIN) + (size_t)4096 * D, D, T, 3072, D}; pg8::StaticOrder S; S.init(T, 3072, G, bid);
          pg8::gemm_phase(c.lds, g, S, EpiGatesA{PP, linv, GSSQ}); }
        { pg8::Gemm g{XB, D, (const bf16_t*)(ws + OFF_WIN) + (size_t)7168 * D, D, T, D, D}; pg8::StaticOrder S; S.init(T, D, G, bid);
          pg8::gemm_phase(c.lds, g, S, EpiSigmoid{XN, D, linv, prm.in[11]}); }
        { pg8::Gemm g{XB, D, (const bf16_t*)(ws + OFF_WIN) + (size_t)8192 * D, D, T, D, D}; pg8::StaticOrder S; S.init(T, D, G, bid);
          pg8::gemm_phase(c.lds, g, S, EpiSigmoid{PP + 3072, NPP, linv, prm.in[11] + 1024}); } TSTOP(8);
    }
    SEAM(6);
    if (IN(7)) { TSTART(6);
        const int lane = tid & 63;
        for (int r = bid * 8 + (tid >> 6); r < T; r += G * 8) {
            float s = (lane < 32) ? GSSQ[(size_t)r * 32 + lane] : 0.f;
            s += __shfl_xor(s, 1); s += __shfl_xor(s, 2); s += __shfl_xor(s, 4);
            const float i0 = rsqrtf(__shfl(s, 0) * (1.0f / 512.0f) + EPS), i1 = rsqrtf(__shfl(s, 8) * (1.0f / 512.0f) + EPS), i2 = rsqrtf(__shfl(s, 16) * (1.0f / 512.0f) + EPS), i3 = rsqrtf(__shfl(s, 24) * (1.0f / 512.0f) + EPS);
#pragma unroll
            for (int i = 0; i < 4; ++i) { const float inv = i == 0 ? i0 : (i == 1 ? i1 : (i == 2 ? i2 : i3));
                bf16_t* p = PP + (size_t)r * NPP + 1024 + 512 * i + 8 * lane; f32x4 a, bq; unpack8(*(const u32x4*)p, a, bq); *(u32x4*)p = pack8(a * inv, bq * inv); }
        }
    }
    TSTOP(6); SEAM(7);
    if (IN(8)) {
        TSTART(9); { pg8::Gemm g{PP, NPP, (const bf16_t*)(ws + OFF_WBR), 3072, T, D, D}; pg8::StaticOrder S; S.init(T, D, G, bid); pg8::gemm_phase(c.lds, g, S, EpiBr{XN, PP, 0}); }
        { pg8::Gemm g{PP + 1024, NPP, (const bf16_t*)(ws + OFF_WBR) + 1024, 3072, T, D, 2048}; pg8::StaticOrder S; S.init(T, D, G, bid); pg8::gemm_phase(c.lds, g, S, EpiBr{XN, PP, 1}); } TSTOP(9);
        const bf16_t* ABRS = (const bf16_t*)(ws + OFF_ABRS); float* M1S = (float*)(ws + OFF_M1S); bf16_t* MS = (bf16_t*)(ws + OFF_MS); const float* bg = prm.in[11];
        TSTART(2); sgemm<16, 1, D, 4>(c.lds, ABRS, 3072, (const bf16_t*)(ws + OFF_WBR), 3072, D, nullptr, nullptr, rm_id,
            [=](int r, int cc, float v0, float, float) { M1S[(size_t)r * D + cc] = sigmoidf_(PS[(size_t)r * 9216 + 7168 + cc] + bg[cc]) * v0; return 0.f; }); TSTOP(2);
        TSTART(2); sgemm<16, 1, 2048, 4>(c.lds, ABRS + 1024, 3072, (const bf16_t*)(ws + OFF_WBR) + 1024, 3072, D, nullptr, nullptr, rm_id,
            [=](int r, int cc, float v0, float, float) { MS[(size_t)r * D + cc] = f2bf(M1S[(size_t)r * D + cc] + sigmoidf_(PS[(size_t)r * 9216 + 8192 + cc] + bg[1024 + cc]) * v0); return 0.f; }); TSTOP(2);
    }
    SEAM(8);
    if (IN(9)) {
        pg8::Gemm g{XN, D, (const bf16_t*)(ws + OFF_WOUT), D, T, D, D}; pg8::StaticOrder S; S.init(T, D, G, bid);
        TSTART(16); pg8::gemm_phase(c.lds, g, S, EpiResid{nullptr, XB, nullptr, XB, SSQ, 1.0f}); TSTOP(16);
        const bf16_t* MS = (const bf16_t*)(ws + OFF_MS);
        TSTART(2); sgemm<16, 1, D, 4>(c.lds, MS, D, (const bf16_t*)(ws + OFF_WOUT), D, D, nullptr, SSQS + 8192, rm_id,
            [=](int r, int cc, float v0, float, float) { const float x = YS[(size_t)r * D + cc] + v0; YS[(size_t)r * D + cc] = x; XNS[(size_t)r * D + cc] = f2bf(x); return x; }); TSTOP(2);
    }
    SEAM(9);
    if (IN(10)) {
        pg8::Gemm g{XB, D, (const bf16_t*)(ws + OFF_WUP2), D, T, 2 * FF, D}; pg8::StaticOrder S; S.init(T, 2 * FF, G, bid);
        LAS const float* linv = fill_inv(c.lds, SSQ);
        TSTART(17); pg8::gemm_phase(c.lds, g, S, EpiSwiglu{PP, linv}); TSTOP(17);
        TSTART(2); sgemm<16, 2, D>(c.lds, XNS, D, (const bf16_t*)(ws + OFF_WUP2), D, FF, SSQS + 8192, nullptr, rm_up,
            [=](int r, int cc, float v0, float v1, float inv) { HS[(size_t)r * FF + cc] = f2bf(siluf_(v0 * inv) * (v1 * inv)); return 0.f; }, G / 2); TSTOP(2);
    }
    SEAM(10);
    if (IN(11)) {
        pg8::Gemm g{PP, FF, (const bf16_t*)(ws + OFF_WDN2), FF, T, D, FF}; pg8::StaticOrder S; S.init(T, D, G, bid);
        TSTART(18); pg8::gemm_phase(c.lds, g, S, EpiResid{nullptr, XB, out + O_YP, nullptr, SSQ, 0.5f}); TSTOP(18);
        TSTART(2); sgemm<16, 1, FF, 4>(c.lds, HS, FF, (const bf16_t*)(ws + OFF_WDN2), FF, D, nullptr, nullptr, rm_id,
            [=](int r, int cc, float v0, float, float) { YS[(size_t)r * D + cc] += 0.5f * v0; return 0.f; }); TSTOP(2);
    }
    SEAM(11);
    if (IN(12)) {
        TSTART(7); rmsnorm_rows_f32(out + O_YP, T + TS, prm.in[31]); TSTOP(7);
    }
#ifdef TIMER_ID
    if (hi == 13) { ++nbar; grid_barrier(barctr, nbar * (unsigned)G);
        if (bid == TIMER_BLOCK) { const float us = (float)tacc_ * 0.0001f; for (int e = tid; e < TS * D; e += 512) YS[e] = us; } }
#endif
#undef IN
#undef SEAM
}

#ifndef N_LAUNCH_MODE
#define N_LAUNCH_MODE 1
#endif
extern "C" void kernel_launch(void* const* d_in, const int* in_sizes, int n_in, void* d_out, int out_size, void* d_ws, size_t ws_size, hipStream_t stream) {
    static int grid = 0;
    if (grid == 0) {
        if (n_in != 32 || ws_size < OFF_XBAR + XCD_BAR_WORDS * 4) { fprintf(stderr, "kernel_launch: unexpected n_in %d or ws_size %zu (< %zu)\n", n_in, ws_size, (size_t)WS_END); grid = -1; return; }
        int dev = 0, cus = 0, per_cu = 0;
        hipGetDevice(&dev); hipDeviceGetAttribute(&cus, hipDeviceAttributeMultiprocessorCount, dev);
        if (hipFuncSetAttribute((const void*)fwd_kernel, hipFuncAttributeMaxDynamicSharedMemorySize, LDS_BYTES) != hipSuccess) { fprintf(stderr, "kernel_launch: hipFuncSetAttribute failed\n"); grid = -1; return; }
        hipOccupancyMaxActiveBlocksPerMultiprocessor(&per_cu, (const void*)fwd_kernel, 512, LDS_BYTES);
        if (per_cu < 1) { fprintf(stderr, "kernel_launch: occupancy query says %d blocks per CU\n", per_cu); per_cu = 1; }
        grid = cus * 1;
        (void)hipGetLastError();
    }
    if (grid < 0) return;
    Params p{};
    for (int i = 0; i < 32; ++i) p.in[i] = (const float*)d_in[i];
    p.out = (float*)d_out; p.ws = (unsigned char*)d_ws;
#if N_LAUNCH_MODE == 0
    for (int ph = 0; ph < 13; ++ph) { p.ph_lo = ph; p.ph_hi = ph + 1; hipLaunchKernelGGL(fwd_kernel, dim3(grid), dim3(512), LDS_BYTES, stream, p);
#ifdef DIAG
        int st = -1; if (ph == 2) st = 0; if (ph == 3) st = 1; if (ph == 6) st = 8; if (ph == 7) st = 3; if (ph == 8) st = 5; if (ph == 9) st = 6; if (ph == 11) st = 7; if (ph == 12) st = 20;
        if (st >= 0) { p.ph_lo = 100 + st; p.ph_hi = 0; hipLaunchKernelGGL(fwd_kernel, dim3(grid), dim3(512), LDS_BYTES, stream, p); }
#endif
    }
#else
    p.ph_lo = 0; p.ph_hi = 13;
    hipMemsetAsync((char*)d_ws + OFF_XBAR, 0, XCD_BAR_WORDS * 4, stream);
    void* args[] = {&p};
    hipError_t e = hipLaunchCooperativeKernel((const void*)fwd_kernel, dim3(grid), dim3(512), args, LDS_BYTES, stream);
    if (e != hipSuccess) fprintf(stderr, "cooperative launch failed: %s (grid %d)\n", hipGetErrorString(e), grid);
#endif
}
```

```cpp
#include <hip/hip_runtime.h>
#include <hip/hip_cooperative_groups.h>
#include <cstdio>
namespace cg = cooperative_groups;

#define LAS __attribute__((address_space(3)))
typedef unsigned short bf16_t;
typedef short bf16x8 __attribute__((ext_vector_type(8)));
typedef float f32x4 __attribute__((ext_vector_type(4)));
typedef unsigned u32x4 __attribute__((ext_vector_type(4)));

constexpr int T = 16384, TS = 128, D = 1024, FF = 2816, NPP = 4096, SEQ = 2048, NCH = 32;
constexpr float EPS = 1e-6f;
constexpr size_t OFF_WUP1 = 0, OFF_WDN1 = 11534336;
constexpr size_t OFF_DT = 0, OFF_SUMM = 2097152, OFF_HALO = 4194304, OFF_GSSQ = 5767168, OFF_PS = 7864320,
                 OFF_DTS = 12582912, OFF_YGS = 12599296, OFF_ABRS = 13647872, OFF_M1S = 14434304, OFF_MS = 14958592;
constexpr size_t OFF_WIN = 17301504, OFF_WDT = 36175872, OFF_WBR = 36241408, OFF_WOUT = 42532864, OFF_WUP2 = 44630016,
                 OFF_WDN2 = 56164352, OFF_WRG = 61931520, OFF_WIG = 62193664, OFF_XB = 62455808, OFF_XN = 96010240,
                 OFF_PP = 129564672, OFF_SSQ = 263782400, OFF_XNS = 264830976, OFF_HS = 265093120, WS_END = 265814016;
constexpr size_t O_YP = 0, O_YS = 16777216, O_LCP = 16908288, O_LHP = 16932864, O_SCP = 16941056, O_SHP = 17014784,
                 O_LCS = 19111936, O_LHS = 19136512, O_SCS = 19144704, O_SHS = 19218432;
constexpr int LDS_BYTES = 143360;
constexpr int LDS_INV = 131072;

struct Params { const float* in[32]; float* out; unsigned char* ws; int ph_lo, ph_hi; };

#ifdef DIAG
#define SZ(x) 0.0f
#ifndef DIAG_TOL
#define DIAG_TOL 0.01f
#endif
#else
#define SZ(x) (x)
#endif
#define A256(base, row, chunk) ((base) + (row) * 256 + 16 * ((chunk) ^ ((row) & 15)))
#define A128(base, row, chunk) ((base) + (row) * 128 + 16 * ((chunk) ^ ((((row) >> 1) ^ ((row) >> 3)) & 7)))
__device__ __forceinline__ int otid() { int t = threadIdx.x; asm volatile("" : "+v"(t)); return t; }
__device__ __forceinline__ unsigned cvt_pk_bf16(float lo, float hi) { unsigned r; asm volatile("v_cvt_pk_bf16_f32 %0, %1, %2" : "=v"(r) : "v"(lo), "v"(hi)); return r; }
__device__ __forceinline__ bf16_t f2bf(float f) { return (bf16_t)(cvt_pk_bf16(f, 0.f) & 0xffffu); }
__device__ __forceinline__ float bf2f(bf16_t b) { return __uint_as_float(((unsigned)b) << 16); }
__device__ __forceinline__ float bflo(unsigned w) { return __uint_as_float(w << 16); }
__device__ __forceinline__ float bfhi(unsigned w) { return __uint_as_float(w & 0xffff0000u); }
__device__ __forceinline__ float sigmoidf_(float x) { return __builtin_amdgcn_rcpf(1.0f + __expf(-x)); }
__device__ __forceinline__ float siluf_(float x) { return x * sigmoidf_(x); }
__device__ __forceinline__ float gelu_tanh(float x) { const float u = 0.7978845608028654f * (x + 0.044715f * x * x * x); return x * sigmoidf_(2.0f * u); }
__device__ __forceinline__ float softplusf_(float x) { return x > 20.f ? x : log1pf(__expf(x)); }
__device__ __forceinline__ u32x4 pack8(const f32x4 a, const f32x4 b) { u32x4 w; w.x = cvt_pk_bf16(a[0], a[1]); w.y = cvt_pk_bf16(a[2], a[3]); w.z = cvt_pk_bf16(b[0], b[1]); w.w = cvt_pk_bf16(b[2], b[3]); return w; }
__device__ __forceinline__ void unpack8(const u32x4 w, f32x4& a, f32x4& b) { a[0] = bflo(w.x); a[1] = bfhi(w.x); a[2] = bflo(w.y); a[3] = bfhi(w.y); b[0] = bflo(w.z); b[1] = bfhi(w.z); b[2] = bflo(w.w); b[3] = bfhi(w.w); }
__device__ __forceinline__ float rowinv16(const float* ssq, int row) {
    const f32x4* p = (const f32x4*)(ssq + (size_t)row * 16); const f32x4 a = p[0], b = p[1], c = p[2], d = p[3];
    const float s = ((a[0] + a[1]) + (a[2] + a[3])) + ((b[0] + b[1]) + (b[2] + b[3])) + ((c[0] + c[1]) + (c[2] + c[3])) + ((d[0] + d[1]) + (d[2] + d[3]));
    return rsqrtf(s * (1.0f / 1024.0f) + EPS);
}

namespace pg8 {
constexpr int BM = 256, BK = 64, HALF = 128, HTB = HALF * BK * 2, STAGE_BYTES = 8 * HTB, NXCD = 8, WGM = 8;
__device__ __forceinline__ int lds_byte(int r, int c) { const int st = (r >> 4) * 2 + (c >> 5), rr = r & 15, cc = c & 31, ob = rr * 64 + cc * 2; return st * 1024 + (ob ^ (((ob >> 9) & 1) << 5)); }
__device__ __forceinline__ void stage_rc(int b, int& R, int& C) { const int st = b / 1024, sb = b % 1024, swz = sb ^ (((sb >> 9) & 1) << 5); R = (st >> 1) * 16 + swz / 64; C = (st & 1) * 32 + (swz % 64) / 2; }
__device__ __forceinline__ int perm32(int rho) { const int n = rho >> 4, i = rho & 15; return 8 * (i >> 2) + 4 * n + (i & 3); }
struct Unit { int pm, pn; };
struct Gemm { const bf16_t* A; int lda; const bf16_t* Bt; int ldb; int M, N, K; };
struct StaticOrder {
    int nM, nN, nwg, G, c;
    __device__ __forceinline__ void init(int M, int N, int G_, int c_) { nM = M / BM; nN = N / BM; nwg = nM * nN; G = G_; c = c_; }
    __device__ __forceinline__ bool next(int i, Unit& u) const {
        const long L = (long)i * G + c; if (L >= nwg) return false;
        int wgid = (int)L; { const int q = nwg / NXCD, r = nwg % NXCD, xcd = wgid % NXCD, off = wgid / NXCD; wgid = (xcd < r ? xcd * (q + 1) : r * (q + 1) + (xcd - r) * q) + off; }
        const int nig = WGM * nN, gid = wgid / nig, fm = gid * WGM, gsz = (nM - fm) < WGM ? (nM - fm) : WGM;
        u.pm = fm + ((wgid % nig) % gsz); u.pn = (wgid % nig) / gsz; return true;
    }
};
template <class Epi>
__device__ __forceinline__ void gemm_phase(LAS unsigned char* lds, const Gemm g, const StaticOrder& S, const Epi& E) {
    const int tid = otid(), wid = __builtin_amdgcn_readfirstlane(tid >> 6), lane = tid & 63, wr = wid >> 2, wc = wid & 3, fr = lane & 15, fq = lane >> 4;
    const int K = g.K, nt = K / BK;
    unsigned voffA[2], voffB[2];
#pragma unroll
    for (int i = 0; i < 2; ++i) { int R, C; stage_rc(tid * 16 + i * 8192, R, C); const int Rb = (R & ~31) + perm32(R & 31);
        voffA[i] = (unsigned)(R * g.lda + C) * 2u; voffB[i] = (unsigned)(Rb * g.ldb + C) * 2u; }
    const size_t kstep = (size_t)(BK * 2);
    const size_t hstepA = (size_t)HALF * g.lda * 2, hstepB = (size_t)HALF * g.ldb * 2;
    const size_t tstepA = 2 * hstepA, tstepB = 2 * hstepB;
    const unsigned ldsw = (unsigned)wid * 1024u;
    const int aoff = lds_byte(wr * 64 + fr, fq * 8), boff = lds_byte(wc * 32 + fr, fq * 8);
#define PG8_SA(b, h) (((b) * 2 + (h)) * HTB)
#define PG8_SB(b, h) ((4 + (b) * 2 + (h)) * HTB)
#define PG8_STAGE(bufoff, gbase, voff) do { _Pragma("unroll") for (int _i = 0; _i < 2; ++_i) \
        __builtin_amdgcn_global_load_lds((const unsigned*)((const char*)(gbase) + (voff)[_i]), (LAS unsigned*)(lds + (bufoff) + ldsw + _i * 8192), 16, 0, 0); } while (0)
#define PG8_LDA(dst, b, h) do { _Pragma("unroll") for (int m = 0; m < 4; ++m) _Pragma("unroll") for (int k = 0; k < 2; ++k) dst[m][k] = *(const LAS bf16x8*)(lds + PG8_SA(b, h) + aoff + m * 2048 + k * 1024); } while (0)
#define PG8_LDB(dst, b, h) do { _Pragma("unroll") for (int n = 0; n < 2; ++n) _Pragma("unroll") for (int k = 0; k < 2; ++k) dst[n][k] = *(const LAS bf16x8*)(lds + PG8_SB(b, h) + boff + n * 2048 + k * 1024); } while (0)
#define PG8_MMA(ai, bj, At, Bt) do { __builtin_amdgcn_s_setprio(1); _Pragma("unroll") for (int m = 0; m < 4; ++m) _Pragma("unroll") for (int n = 0; n < 2; ++n) _Pragma("unroll") for (int k = 0; k < 2; ++k) \
        acc[ai][bj][m][n] = __builtin_amdgcn_mfma_f32_16x16x32_bf16(Bt[n][k], At[m][k], acc[ai][bj][m][n], 0, 0, 0); __builtin_amdgcn_s_setprio(0); } while (0)
#define PG8_WAIT_V(n) asm volatile("s_waitcnt vmcnt(" #n ")" ::: "memory")
#define PG8_WAIT_L(n) asm volatile("s_waitcnt lgkmcnt(" #n ")" ::: "memory")
#define PG8_BAR __builtin_amdgcn_s_barrier()
#define PG8_SCHED __builtin_amdgcn_sched_barrier(0)
    Unit cur, nxt; int ui = 0;
    if (!S.next(0, cur)) return;
    f32x4 acc[2][2][4][2];
#pragma unroll
    for (int a = 0; a < 2; ++a)
#pragma unroll
        for (int b = 0; b < 2; ++b)
#pragma unroll
            for (int m = 0; m < 4; ++m)
#pragma unroll
                for (int n = 0; n < 2; ++n) acc[a][b][m][n] = (f32x4){0.f, 0.f, 0.f, 0.f};
    bf16x8 At[4][2], B0[2][2], B1[2][2];
    const char* cA = (const char*)g.A + (size_t)cur.pm * tstepA; const char* cB = (const char*)g.Bt + (size_t)cur.pn * tstepB;
    PG8_STAGE(PG8_SB(0, 0), cB, voffB); PG8_STAGE(PG8_SA(0, 0), cA, voffA); PG8_STAGE(PG8_SB(0, 1), cB + hstepB, voffB); PG8_STAGE(PG8_SA(0, 1), cA + hstepA, voffA);
    if (wr == 1) PG8_BAR;
    PG8_WAIT_V(4); PG8_BAR;
    PG8_STAGE(PG8_SB(1, 0), cB + kstep, voffB); PG8_STAGE(PG8_SA(1, 0), cA + kstep, voffA); PG8_STAGE(PG8_SB(1, 1), cB + hstepB + kstep, voffB);
    PG8_WAIT_V(6); PG8_BAR;
    for (;;) {
        const bool has_next = S.next(ui + 1, nxt);
        const char* nA = has_next ? (const char*)g.A + (size_t)nxt.pm * tstepA : cA; const char* nB = has_next ? (const char*)g.Bt + (size_t)nxt.pn * tstepB : cB;
        for (int t = 0; t < nt; t += 2) {
            const bool last = (t == nt - 2);
            const char* a1 = cA + (size_t)(t + 1) * kstep;
            const char* a2 = last ? nA : cA + (size_t)(t + 2) * kstep; const char* b2 = last ? nB : cB + (size_t)(t + 2) * kstep;
            const char* a3 = a2 + kstep; const char* b3 = b2 + kstep;
            PG8_LDB(B0, 0, 0); PG8_SCHED; PG8_LDA(At, 0, 0); PG8_STAGE(PG8_SA(1, 1), a1 + hstepA, voffA);
            PG8_WAIT_L(8); PG8_BAR; PG8_WAIT_L(0); PG8_MMA(0, 0, At, B0); PG8_BAR; PG8_SCHED;
            PG8_LDB(B1, 0, 1); PG8_STAGE(PG8_SB(0, 0), b2, voffB);
            PG8_BAR; PG8_WAIT_L(0); PG8_MMA(0, 1, At, B1); PG8_BAR;
            PG8_LDA(At, 0, 1); PG8_STAGE(PG8_SA(0, 0), a2, voffA);
            PG8_BAR; PG8_WAIT_L(0); PG8_MMA(1, 0, At, B0); PG8_BAR; PG8_SCHED;
            PG8_STAGE(PG8_SB(0, 1), b2 + hstepB, voffB);
            PG8_WAIT_V(6); PG8_BAR; PG8_MMA(1, 1, At, B1); PG8_BAR;
            PG8_LDB(B0, 1, 0); PG8_SCHED; PG8_LDA(At, 1, 0); PG8_STAGE(PG8_SA(0, 1), a2 + hstepA, voffA);
            PG8_WAIT_L(8); PG8_BAR; PG8_WAIT_L(0); PG8_MMA(0, 0, At, B0); PG8_BAR; PG8_SCHED;
            PG8_LDB(B1, 1, 1); PG8_STAGE(PG8_SB(1, 0), b3, voffB);
            PG8_BAR; PG8_WAIT_L(0); PG8_MMA(0, 1, At, B1); PG8_BAR;
            PG8_LDA(At, 1, 1); PG8_STAGE(PG8_SA(1, 0), a3, voffA);
            PG8_BAR; PG8_WAIT_L(0); PG8_MMA(1, 0, At, B0); PG8_BAR; PG8_SCHED;
            PG8_STAGE(PG8_SB(1, 1), b3 + hstepB, voffB);
            PG8_WAIT_V(6); PG8_BAR; PG8_MMA(1, 1, At, B1); PG8_BAR;
        }
        E(acc, cur, wr, wc, fr, fq);
        if (!has_next) break;
#pragma unroll
        for (int a = 0; a < 2; ++a)
#pragma unroll
            for (int b = 0; b < 2; ++b)
#pragma unroll
                for (int m = 0; m < 4; ++m)
#pragma unroll
                    for (int n = 0; n < 2; ++n) acc[a][b][m][n] = (f32x4){0.f, 0.f, 0.f, 0.f};
        cur = nxt; cA = nA; cB = nB; ++ui;
    }
    PG8_WAIT_V(0);
    if (wr == 0) PG8_BAR;
    PG8_BAR;
#undef PG8_SA
#undef PG8_SB
#undef PG8_STAGE
#undef PG8_LDA
#undef PG8_LDB
#undef PG8_MMA
#undef PG8_WAIT_V
#undef PG8_WAIT_L
#undef PG8_BAR
#undef PG8_SCHED
}
}
typedef f32x4 Acc[2][2][4][2];

__device__ __forceinline__ LAS const float* fill_inv(LAS unsigned char* lds, const float* ssq) {
    LAS float* t = (LAS float*)(lds + LDS_INV); const int base = 2048 * (blockIdx.x & 7);
    for (int r = otid(); r < 2048; r += 512) t[r] = rowinv16(ssq, base + r);
    __syncthreads();
    return t;
}
struct EpiSwiglu {
    bf16_t* H; LAS const float* linv;
    __device__ __forceinline__ void operator()(const Acc& acc, const pg8::Unit& u, int wr, int wc, int fr, int fq) const {
        const int row0 = u.pm * 256 + wr * 64 + fr, col = u.pn * 128 + wc * 32 + 8 * fq;
#pragma unroll
        for (int ai = 0; ai < 2; ++ai)
#pragma unroll
            for (int m = 0; m < 4; ++m) {
                const int row = row0 + ai * 128 + m * 16; const float inv = linv ? linv[row & 2047] : 1.0f;
                f32x4 h0, h1;
#pragma unroll
                for (int j = 0; j < 4; ++j) { h0[j] = siluf_(acc[ai][0][m][0][j] * inv) * (acc[ai][1][m][0][j] * inv); h1[j] = siluf_(acc[ai][0][m][1][j] * inv) * (acc[ai][1][m][1][j] * inv); }
                *(u32x4*)(H + (size_t)row * FF + col) = pack8(h0, h1);
            }
    }
};
struct EpiResid {
    const float* xin; const bf16_t* xin_b; float* xout; bf16_t* xb; float* ssq; float alpha;
    __device__ __forceinline__ void operator()(const Acc& acc, const pg8::Unit& u, int wr, int wc, int fr, int fq) const {
        const int row0 = u.pm * 256 + wr * 64 + fr, col0 = u.pn * 256 + wc * 32 + 8 * fq;
#pragma unroll
        for (int ai = 0; ai < 2; ++ai) {
            f32x4 xv[4][2][2];
#pragma unroll
            for (int m = 0; m < 4; ++m)
#pragma unroll
                for (int bj = 0; bj < 2; ++bj) { const size_t o = (size_t)(row0 + ai * 128 + m * 16) * D + col0 + bj * 128;
                    if (xin_b) unpack8(*(const u32x4*)(xin_b + o), xv[m][bj][0], xv[m][bj][1]);
                    else { xv[m][bj][0] = *(const f32x4*)(xin + o); xv[m][bj][1] = *(const f32x4*)(xin + o + 4); } }
#pragma unroll
            for (int m = 0; m < 4; ++m) {
                const int row = row0 + ai * 128 + m * 16; float ss = 0.f;
#pragma unroll
                for (int bj = 0; bj < 2; ++bj) {
                    const size_t o = (size_t)row * D + col0 + bj * 128;
                    const f32x4 v0 = xv[m][bj][0] + alpha * acc[ai][bj][m][0], v1 = xv[m][bj][1] + alpha * acc[ai][bj][m][1];
                    if (xout) { *(f32x4*)(xout + o) = v0; *(f32x4*)(xout + o + 4) = v1; }
                    ss += (v0[0] * v0[0] + v0[1] * v0[1]) + (v0[2] * v0[2] + v0[3] * v0[3]) + (v1[0] * v1[0] + v1[1] * v1[1]) + (v1[2] * v1[2] + v1[3] * v1[3]);
                    if (xb) *(u32x4*)(xb + o) = pack8(v0, v1);
                }
                ss += __shfl_xor(ss, 16); ss += __shfl_xor(ss, 32);
                if (fq == 0) ssq[(size_t)row * 16 + u.pn * 4 + wc] = ss;
            }
        }
    }
};
struct EpiScaleBf16 {
    bf16_t* O; LAS const float* linv;
    __device__ __forceinline__ void operator()(const Acc& acc, const pg8::Unit& u, int wr, int wc, int fr, int fq) const {
        const int row0 = u.pm * 256 + wr * 64 + fr, col0 = u.pn * 256 + wc * 32 + 8 * fq;
#pragma unroll
        for (int ai = 0; ai < 2; ++ai)
#pragma unroll
            for (int m = 0; m < 4; ++m) {
                const int row = row0 + ai * 128 + m * 16; const float inv = linv[row & 2047];
#pragma unroll
                for (int bj = 0; bj < 2; ++bj) *(u32x4*)(O + (size_t)row * NPP + col0 + bj * 128) = pack8(acc[ai][bj][m][0] * inv, acc[ai][bj][m][1] * inv);
            }
    }
};
struct EpiGatesA {
    bf16_t* PP; LAS const float* linv; float* gssq;
    __device__ __forceinline__ void operator()(const Acc& acc, const pg8::Unit& u, int wr, int wc, int fr, int fq) const {
        const int row0 = u.pm * 256 + wr * 64 + fr, cw = wc * 32 + 8 * fq; const int pn = u.pn;
#pragma unroll
        for (int ai = 0; ai < 2; ++ai) {
            u32x4 sv[4][2];
#pragma unroll
            for (int m = 0; m < 4; ++m)
#pragma unroll
                for (int bj = 0; bj < 2; ++bj) sv[m][bj] = *(const u32x4*)(PP + (size_t)(row0 + ai * 128 + m * 16) * NPP + pn * 256 + bj * 128 + cw);
#pragma unroll
            for (int m = 0; m < 4; ++m) {
                const int row = row0 + ai * 128 + m * 16; const float inv = linv[row & 2047]; float ss = 0.f;
#pragma unroll
                for (int bj = 0; bj < 2; ++bj) {
                    const f32x4 a0 = acc[ai][bj][m][0] * inv, a1 = acc[ai][bj][m][1] * inv; f32x4 o0, o1;
                    bf16_t* p = PP + (size_t)row * NPP + pn * 256 + bj * 128 + cw; f32x4 s0, s1; unpack8(sv[m][bj], s0, s1);
                    if (pn < 4) {
#pragma unroll
                        for (int j = 0; j < 4; ++j) { o0[j] = gelu_tanh(a0[j]) * s0[j]; o1[j] = gelu_tanh(a1[j]) * s1[j]; }
                    } else {
#pragma unroll
                        for (int j = 0; j < 4; ++j) { o0[j] = siluf_(a0[j]) * s0[j]; o1[j] = siluf_(a1[j]) * s1[j]; ss += o0[j] * o0[j] + o1[j] * o1[j]; }
                    }
                    *(u32x4*)p = pack8(o0, o1);
                }
                if (pn >= 4) { ss += __shfl_xor(ss, 16); ss += __shfl_xor(ss, 32); if (fq == 0) gssq[(size_t)row * 32 + (pn - 4) * 4 + wc] = ss; }
            }
        }
    }
};
struct EpiSigmoid {
    bf16_t* O; int ldo; LAS const float* linv; const float* bias;
    __device__ __forceinline__ void operator()(const Acc& acc, const pg8::Unit& u, int wr, int wc, int fr, int fq) const {
        const int row0 = u.pm * 256 + wr * 64 + fr, col0 = u.pn * 256 + wc * 32 + 8 * fq;
#pragma unroll
        for (int ai = 0; ai < 2; ++ai)
#pragma unroll
            for (int m = 0; m < 4; ++m) {
                const int row = row0 + ai * 128 + m * 16; const float inv = linv[row & 2047];
#pragma unroll
                for (int bj = 0; bj < 2; ++bj) {
                    const int gc = col0 + bj * 128;
                    const f32x4 a0 = acc[ai][bj][m][0] * inv, a1 = acc[ai][bj][m][1] * inv; f32x4 o0, o1;
                    const f32x4 b0 = *(const f32x4*)(bias + gc), b1 = *(const f32x4*)(bias + gc + 4);
#pragma unroll
                    for (int j = 0; j < 4; ++j) { o0[j] = sigmoidf_(a0[j] + b0[j]); o1[j] = sigmoidf_(a1[j] + b1[j]); }
                    *(u32x4*)(O + (size_t)row * ldo + gc) = pack8(o0, o1);
                }
            }
    }
};
struct EpiBr {
    bf16_t* GA; const bf16_t* PP; int mode;
    __device__ __forceinline__ void operator()(const Acc& acc, const pg8::Unit& u, int wr, int wc, int fr, int fq) const {
        const int row0 = u.pm * 256 + wr * 64 + fr, col0 = u.pn * 256 + wc * 32 + 8 * fq;
#pragma unroll
        for (int ai = 0; ai < 2; ++ai) {
            u32x4 gv[4][2], hv[4][2];
#pragma unroll
            for (int m = 0; m < 4; ++m)
#pragma unroll
                for (int bj = 0; bj < 2; ++bj) { const int row = row0 + ai * 128 + m * 16; gv[m][bj] = *(const u32x4*)(GA + (size_t)row * D + col0 + bj * 128);
                    hv[m][bj] = (mode == 0) ? (u32x4){0u, 0u, 0u, 0u} : *(const u32x4*)(PP + (size_t)row * NPP + 3072 + col0 + bj * 128); }
#pragma unroll
            for (int m = 0; m < 4; ++m) {
                const int row = row0 + ai * 128 + m * 16;
#pragma unroll
                for (int bj = 0; bj < 2; ++bj) {
                    bf16_t* p = GA + (size_t)row * D + col0 + bj * 128; f32x4 g0, g1; unpack8(gv[m][bj], g0, g1);
                    if (mode == 0) { *(u32x4*)p = pack8(g0 * acc[ai][bj][m][0], g1 * acc[ai][bj][m][1]); }
                    else { f32x4 h0, h1; unpack8(hv[m][bj], h0, h1); *(u32x4*)p = pack8(g0 + h0 * acc[ai][bj][m][0], g1 + h1 * acc[ai][bj][m][1]); }
                }
            }
        }
    }
};

template <int NC, int NB, int K, class RM, class F>
__device__ __forceinline__ void small_gemm(LAS unsigned char* lds, const bf16_t* A, int lda, int M, const bf16_t* Bt, int ldb, int N,
                                           const float* rs_src, int rs_mode, RM rm, F f) {
    const int tid = otid(), wid = tid >> 6, lane = tid & 63, lr = lane & 15, kg = lane >> 4;
    LAS float* red = (LAS float*)lds;
    LAS float* invs = (LAS float*)(lds + 131072);
    const int nct = N / NC, items = (M / 16) * nct; constexpr int kw = K / 8;
    constexpr int CT = NC / 16;
    const int nrt = M / 16; const bool hoist = (rs_mode == 1) && (gridDim.x % nrt == 0); const int bix = gridDim.x - 1 - blockIdx.x;
    for (int it = bix; it < items; it += gridDim.x) {
        const int rt = it % nrt, ct = it / nrt, row0 = rt * 16, col0 = ct * NC;
        if (rs_mode == 1) { if (!(hoist && it != bix)) { const int r = tid >> 5, q = tid & 31; const float* p = rs_src + (size_t)(row0 + r) * D + q * 32; float s = 0.f;
            for (int j = 0; j < 32; j += 4) { const f32x4 v = *(const f32x4*)(p + j); s += v[0] * v[0] + v[1] * v[1] + v[2] * v[2] + v[3] * v[3]; }
            s += __shfl_xor(s, 1); s += __shfl_xor(s, 2); s += __shfl_xor(s, 4); s += __shfl_xor(s, 8); s += __shfl_xor(s, 16);
            if (q == 0) invs[r] = rsqrtf(s * (1.0f / 1024.0f) + EPS); } }
        else if (rs_mode == 2) { if (tid < 16) invs[tid] = rowinv16(rs_src, row0 + tid); }
        else { if (tid < 16) invs[tid] = 1.0f; }
        f32x4 acc[NB][CT];
#pragma unroll
        for (int p = 0; p < NB; ++p)
#pragma unroll
            for (int c = 0; c < CT; ++c) acc[p][c] = (f32x4){0.f, 0.f, 0.f, 0.f};
        const bf16_t* ap = A + (size_t)(row0 + lr) * lda + wid * kw + 8 * kg;
        const bf16_t* bp0 = Bt + (size_t)(rm(col0, 0) + lr) * ldb + wid * kw + 8 * kg;
        const bf16_t* bp1 = NB > 1 ? Bt + (size_t)(rm(col0, 1) + lr) * ldb + wid * kw + 8 * kg : bp0;
#pragma unroll
        for (int k = 0; k < kw; k += 32) {
            const bf16x8 a = *(const bf16x8*)(ap + k);
#pragma unroll
            for (int c = 0; c < CT; ++c) {
                const bf16x8 b = *(const bf16x8*)(bp0 + (size_t)c * 16 * ldb + k);
                acc[0][c] = __builtin_amdgcn_mfma_f32_16x16x32_bf16(a, b, acc[0][c], 0, 0, 0);
                if (NB > 1) { const bf16x8 b1 = *(const bf16x8*)(bp1 + (size_t)c * 16 * ldb + k); acc[NB - 1][c] = __builtin_amdgcn_mfma_f32_16x16x32_bf16(a, b1, acc[NB - 1][c], 0, 0, 0); }
            }
        }
#pragma unroll
        for (int p = 0; p < NB; ++p)
#pragma unroll
            for (int c = 0; c < CT; ++c)
#pragma unroll
                for (int r = 0; r < 4; ++r) red[((wid * NB + p) * 16 + 4 * kg + r) * NC + 16 * c + lr] = acc[p][c][r];
        __syncthreads();
        for (int e = tid; e < 16 * NC; e += 512) {
            float v0 = 0.f, v1 = 0.f;
#pragma unroll
            for (int w = 0; w < 8; ++w) { v0 += red[(w * NB) * 16 * NC + e]; if (NB > 1) v1 += red[(w * NB + 1) * 16 * NC + e]; }
            const int r = e / NC, c = e % NC;
            f(row0 + r, col0 + c, v0, v1, invs[r]);
        }
        __syncthreads();
    }
}

template <int NC, int NB, int K, int RT = 8, class RM, class F>
__device__ __forceinline__ void sgemm(LAS unsigned char* lds, const bf16_t* A, int lda, const bf16_t* Bt, int ldb, int N, const float* ssq_src, float* ssq_out, RM rm, F f, int nblk = 0) {
    const int tid = otid(), wid = tid >> 6, lane = tid & 63, lr = lane & 15, kg = lane >> 4;
    constexpr int CT = NC / 16, KW = K / 8;
    LAS float* red = (LAS float*)lds;
    constexpr int RH = 8 / RT; const int items = (N / NC) * RH, bix = gridDim.x - 1 - blockIdx.x; if (nblk == 0) nblk = gridDim.x;
    LAS float* invs = (LAS float*)(lds + LDS_INV);
    if (bix < items && bix < nblk) {
        if (ssq_src) { const int row = tid >> 2, q = tid & 3; float sm = 0.f;
#pragma unroll
            for (int j = 0; j < 16; j += 4) { const f32x4 v = *(const f32x4*)(ssq_src + row * 64 + q * 16 + j); sm += (v[0] + v[1]) + (v[2] + v[3]); }
            sm += __shfl_xor(sm, 1); sm += __shfl_xor(sm, 2);
            if (q == 0) invs[row] = rsqrtf(sm * (1.0f / 1024.0f) + EPS); }
        else if (tid < 128) invs[tid] = 1.0f;
        __syncthreads();
    }
    for (int it = bix; it < items && bix < nblk; it += nblk) {
        const int ci = it / RH, col0 = ci * NC, rowb = (it % RH) * RT * 16;
        f32x4 acc[RT][NB][CT];
#pragma unroll
        for (int t = 0; t < RT; ++t)
#pragma unroll
            for (int p = 0; p < NB; ++p)
#pragma unroll
                for (int c = 0; c < CT; ++c) acc[t][p][c] = (f32x4){0.f, 0.f, 0.f, 0.f};
        const bf16_t* ap = A + (size_t)(rowb + lr) * lda + wid * KW + 8 * kg;
        const bf16_t* bp0 = Bt + (size_t)(rm(col0, 0) + lr) * ldb + wid * KW + 8 * kg;
        const bf16_t* bp1 = NB > 1 ? Bt + (size_t)(rm(col0, 1) + lr) * ldb + wid * KW + 8 * kg : bp0;
#pragma unroll (RT == 8 ? 4 : (RT == 4 ? (KW / 32 <= 8 ? 8 : 6) : 16))
        for (int k = 0; k < KW; k += 32) {
            bf16x8 bf[NB][CT];
#pragma unroll
            for (int c = 0; c < CT; ++c) { bf[0][c] = *(const bf16x8*)(bp0 + (size_t)c * 16 * ldb + k); if (NB > 1) bf[NB - 1][c] = *(const bf16x8*)(bp1 + (size_t)c * 16 * ldb + k); }
#pragma unroll
            for (int t = 0; t < RT; ++t) { const bf16x8 a = *(const bf16x8*)(ap + (size_t)t * 16 * lda + k);
#pragma unroll
                for (int p = 0; p < NB; ++p)
#pragma unroll
                    for (int c = 0; c < CT; ++c) acc[t][p][c] = __builtin_amdgcn_mfma_f32_16x16x32_bf16(a, bf[p][c], acc[t][p][c], 0, 0, 0); }
        }
#pragma unroll
        for (int t = 0; t < RT; ++t)
#pragma unroll
            for (int p = 0; p < NB; ++p)
#pragma unroll
                for (int c = 0; c < CT; ++c)
#pragma unroll
                    for (int r = 0; r < 4; ++r) red[((((wid * RT + t) * NB + p) * CT + c) * 16 + 4 * kg + r) * 16 + lr] = acc[t][p][c][r];
        __syncthreads();
        for (int e = tid; e < RT * 16 * NC; e += 512) {
            const int rl = e / NC, row = rowb + rl, col = e % NC, t = rl >> 4, rr = rl & 15, c = col >> 4, cl = col & 15;
            float v0 = 0.f, v1 = 0.f;
#pragma unroll
            for (int w = 0; w < 8; ++w) { v0 += red[((((w * RT + t) * NB + 0) * CT + c) * 16 + rr) * 16 + cl]; if (NB > 1) v1 += red[((((w * RT + t) * NB + (NB - 1)) * CT + c) * 16 + rr) * 16 + cl]; }
            float sq = f(row, col0 + col, v0, v1, invs[row]);
            if (ssq_out) { sq *= sq; sq += __shfl_xor(sq, 1); sq += __shfl_xor(sq, 2); sq += __shfl_xor(sq, 4); sq += __shfl_xor(sq, 8); if (NC > 16) sq += __shfl_xor(sq, 16);
                if ((col & (NC - 1)) == 0) ssq_out[row * 64 + ci] = sq; }
        }
        __syncthreads();
    }
}

template <int CT, int NB, int K, class RM, class F>
__device__ __forceinline__ void wave_gemm(LAS unsigned char* lds, const bf16_t* A, int lda, const bf16_t* Bt, int ldb, int N, const float* rs_src, RM rm, F f) {
    const int tid = otid(), wid = tid >> 6, lane = tid & 63, lr = lane & 15, kg = lane >> 4;
    const int bix = gridDim.x - 1 - blockIdx.x, rt = bix & 7, row0 = rt * 16, nct = N / (16 * CT);
    LAS float* invs = (LAS float*)(lds + LDS_INV);
    if (rs_src) { const int r = tid >> 5, q = tid & 31; const float* p = rs_src + (size_t)(row0 + r) * D + q * 32; float s = 0.f;
        for (int j = 0; j < 32; j += 4) { const f32x4 v = *(const f32x4*)(p + j); s += v[0] * v[0] + v[1] * v[1] + v[2] * v[2] + v[3] * v[3]; }
        s += __shfl_xor(s, 1); s += __shfl_xor(s, 2); s += __shfl_xor(s, 4); s += __shfl_xor(s, 8); s += __shfl_xor(s, 16);
        if (q == 0) invs[r] = rsqrtf(s * (1.0f / 1024.0f) + EPS); }
    else if (tid < 16) invs[tid] = 1.0f;
    __syncthreads();
    for (int ct = (bix >> 3) * 8 + wid; ct < nct; ct += (gridDim.x >> 3) * 8) {
        const int col0 = ct * 16 * CT;
        f32x4 acc[NB][CT];
#pragma unroll
        for (int p = 0; p < NB; ++p)
#pragma unroll
            for (int c = 0; c < CT; ++c) acc[p][c] = (f32x4){0.f, 0.f, 0.f, 0.f};
        const bf16_t* ap = A + (size_t)(row0 + lr) * lda + 8 * kg;
        const bf16_t* bp0 = Bt + (size_t)(rm(col0, 0) + lr) * ldb + 8 * kg;
        const bf16_t* bp1 = NB > 1 ? Bt + (size_t)(rm(col0, 1) + lr) * ldb + 8 * kg : bp0;
#pragma unroll 4
        for (int k = 0; k < K; k += 32) {
            const bf16x8 a = *(const bf16x8*)(ap + k);
#pragma unroll
            for (int c = 0; c < CT; ++c) {
                const bf16x8 b = *(const bf16x8*)(bp0 + (size_t)c * 16 * ldb + k);
                acc[0][c] = __builtin_amdgcn_mfma_f32_16x16x32_bf16(a, b, acc[0][c], 0, 0, 0);
                if (NB > 1) { const bf16x8 b1 = *(const bf16x8*)(bp1 + (size_t)c * 16 * ldb + k); acc[NB - 1][c] = __builtin_amdgcn_mfma_f32_16x16x32_bf16(a, b1, acc[NB - 1][c], 0, 0, 0); }
            }
        }
#pragma unroll
        for (int c = 0; c < CT; ++c)
#pragma unroll
            for (int r = 0; r < 4; ++r) f(row0 + 4 * kg + r, col0 + 16 * c + lr, acc[0][c][r], NB > 1 ? acc[NB - 1][c][r] : 0.f, invs[4 * kg + r]);
    }
    __syncthreads();
}

struct Ctx { const float* const* in; float* out; unsigned char* ws; LAS unsigned char* lds; };

__device__ __forceinline__ void tp_tile(LAS float* tile, const float* src, int sld, int sc0, int k0, bf16_t* dst, int dld, int dr0, int dk0, const float* scale, int ncv) {
    const int lane = otid() & 63;
    float v[64];
    const float* sp = src + (size_t)k0 * sld + sc0 + lane;
#pragma unroll
    for (int kk = 0; kk < 64; ++kk) v[kk] = (lane < ncv) ? sp[(size_t)kk * sld] : 0.f;
    if (scale) {
#pragma unroll
        for (int kk = 0; kk < 64; ++kk) v[kk] *= scale[k0 + kk];
    }
#pragma unroll
    for (int kk = 0; kk < 64; ++kk) tile[kk * 65 + lane] = v[kk];
    const int j = lane & 7;
#pragma unroll
    for (int ps = 0; ps < 8; ++ps) { const int cc = (lane >> 3) + 8 * ps;
        float x[8];
#pragma unroll
        for (int i = 0; i < 8; ++i) x[i] = tile[(8 * j + i) * 65 + cc];
        u32x4 w; w.x = cvt_pk_bf16(x[0], x[1]); w.y = cvt_pk_bf16(x[2], x[3]); w.z = cvt_pk_bf16(x[4], x[5]); w.w = cvt_pk_bf16(x[6], x[7]);
        if (cc < ncv) *(u32x4*)(dst + (size_t)(dr0 + cc) * dld + dk0 + 8 * j) = w; }
}
__device__ __forceinline__ void prep_weights(const Ctx& c) {
    const int wv_ = __builtin_amdgcn_readfirstlane(otid() >> 6); LAS float* tile = (LAS float*)c.lds + wv_ * (64 * 65); unsigned char* ws = c.ws;
    constexpr int N_UP = 1408, N_DN = 704, N_IN = 2304, N_DT = 16, N_BRL = 256, N_BRS = 512, N_OUT = 256, N_RG = 32;
    constexpr int TOT = 2 * N_UP + 2 * N_DN + N_IN + N_DT + N_BRL + N_BRS + N_OUT + 2 * N_RG;
    for (int ti0 = blockIdx.x * 8 + wv_; ti0 < TOT; ti0 += gridDim.x * 8) {
        int ti = ti0;
        if (ti < 2 * N_UP) { const int l = ti >= N_UP; if (l) ti -= N_UP;
            const int j = ti >> 5, r = ti & 31, pn = j >> 1, panel = j & 1, ct = r >> 4, kt = r & 15;
            tp_tile(tile, c.in[l ? 29 : 7], 2 * FF, panel * FF + 128 * pn + 64 * ct, 64 * kt, (bf16_t*)(ws + (l ? OFF_WUP2 : OFF_WUP1)), D, 256 * pn + 128 * panel + 64 * ct, 64 * kt, l ? c.in[28] : nullptr, 64);
            continue; }
        ti -= 2 * N_UP;
        if (ti < 2 * N_DN) { const int l = ti >= N_DN; if (l) ti -= N_DN;
            const int nt = ti / 44, kt = ti % 44;
            tp_tile(tile, c.in[l ? 30 : 8], D, 64 * nt, 64 * kt, (bf16_t*)(ws + (l ? OFF_WDN2 : OFF_WDN1)), FF, 64 * nt, 64 * kt, nullptr, 64);
            continue; }
        ti -= 2 * N_DN;
        if (ti < N_IN) { const int nt = ti >> 4, kt = ti & 15, n0 = 64 * nt;
            const int sc = n0 < 1024 ? n0 : (n0 < 4096 ? n0 + 3072 : (n0 < 7168 ? n0 - 3072 : n0 + 32));
            tp_tile(tile, c.in[10], 9248, sc, 64 * kt, (bf16_t*)(ws + OFF_WIN), D, n0, 64 * kt, c.in[9], 64);
            continue; }
        ti -= N_IN;
        if (ti < N_DT) { tp_tile(tile, c.in[10], 9248, 7168, 64 * ti, (bf16_t*)(ws + OFF_WDT), D, 0, 64 * ti, c.in[9], 32); continue; }
        ti -= N_DT;
        if (ti < N_BRL) { const int nt = ti >> 4, kt = ti & 15; tp_tile(tile, c.in[25], D, 64 * nt, 64 * kt, (bf16_t*)(ws + OFF_WBR), 3072, 64 * nt, 64 * kt, nullptr, 64); continue; }
        ti -= N_BRL;
        if (ti < N_BRS) { const int nt = ti >> 5, kt = ti & 31; tp_tile(tile, c.in[26], D, 64 * nt, 64 * kt, (bf16_t*)(ws + OFF_WBR), 3072, 64 * nt, 1024 + 64 * kt, c.in[24], 64); continue; }
        ti -= N_BRS;
        if (ti < N_OUT) { const int nt = ti >> 4, kt = ti & 15; tp_tile(tile, c.in[27], D, 64 * nt, 64 * kt, (bf16_t*)(ws + OFF_WOUT), D, 64 * nt, 64 * kt, nullptr, 64); continue; }
        ti -= N_OUT;
        { const int l = ti >= N_RG; if (l) ti -= N_RG; const int h = ti >> 2, nt = (ti >> 1) & 1, kt = ti & 1;
          tp_tile(tile, c.in[l ? 16 : 14] + h * 16384, 128, 64 * nt, 64 * kt, (bf16_t*)(ws + (l ? OFF_WIG : OFF_WRG)) + h * 16384, 128, 64 * nt, 64 * kt, nullptr, 64); }
    }
}
__device__ __forceinline__ void rmsnorm_rows_bf16(const float* x, int nrows, const float* g, bf16_t* dst) {
    const int t_ = otid(), lane = t_ & 63, gw = blockIdx.x * 8 + (t_ >> 6), nw = gridDim.x * 8;
    f32x4 gg[4];
#pragma unroll
    for (int i = 0; i < 4; ++i) gg[i] = *(const f32x4*)(g + (i * 64 + lane) * 4);
    for (int r = gw; r < nrows; r += 2 * nw) {
        const int r2 = r + nw; const bool two = r2 < nrows;
        const float* p = x + (size_t)r * D; const float* p2 = x + (size_t)(two ? r2 : r) * D; f32x4 v[4], w[4]; float s = 0.f, s2 = 0.f;
#pragma unroll
        for (int i = 0; i < 4; ++i) { v[i] = *(const f32x4*)(p + (i * 64 + lane) * 4); w[i] = *(const f32x4*)(p2 + (i * 64 + lane) * 4); }
#pragma unroll
        for (int i = 0; i < 4; ++i) { s += v[i][0] * v[i][0] + v[i][1] * v[i][1] + v[i][2] * v[i][2] + v[i][3] * v[i][3]; s2 += w[i][0] * w[i][0] + w[i][1] * w[i][1] + w[i][2] * w[i][2] + w[i][3] * w[i][3]; }
#pragma unroll
        for (int o = 1; o < 64; o <<= 1) { s += __shfl_xor(s, o); s2 += __shfl_xor(s2, o); }
        const float inv = rsqrtf(s * (1.0f / 1024.0f) + EPS), inv2 = rsqrtf(s2 * (1.0f / 1024.0f) + EPS);
#pragma unroll
        for (int i = 0; i < 4; ++i) { const int cc = (i * 64 + lane) * 4; const f32x4 o = v[i] * inv * gg[i];
            unsigned* q = (unsigned*)(dst + (size_t)r * D + cc); q[0] = cvt_pk_bf16(o[0], o[1]); q[1] = cvt_pk_bf16(o[2], o[3]);
            if (two) { const f32x4 o2 = w[i] * inv2 * gg[i]; unsigned* q2 = (unsigned*)(dst + (size_t)r2 * D + cc); q2[0] = cvt_pk_bf16(o2[0], o2[1]); q2[1] = cvt_pk_bf16(o2[2], o2[3]); } }
    }
}
__device__ __forceinline__ void rmsnorm_rows_f32(float* x, int nrows, const float* g) {
    const int t_ = otid(), lane = t_ & 63, gw = blockIdx.x * 8 + (t_ >> 6), nw = gridDim.x * 8;
    f32x4 gg[4];
#pragma unroll
    for (int i = 0; i < 4; ++i) gg[i] = *(const f32x4*)(g + (i * 64 + lane) * 4);
    for (int r = gw; r < nrows; r += 2 * nw) {
        const int r2 = r + nw; const bool two = r2 < nrows;
        float* p = x + (size_t)r * D; float* p2 = x + (size_t)(two ? r2 : r) * D; f32x4 v[4], w[4]; float s = 0.f, s2 = 0.f;
#pragma unroll
        for (int i = 0; i < 4; ++i) { v[i] = *(const f32x4*)(p + (i * 64 + lane) * 4); w[i] = *(const f32x4*)(p2 + (i * 64 + lane) * 4); }
#pragma unroll
        for (int i = 0; i < 4; ++i) { s += v[i][0] * v[i][0] + v[i][1] * v[i][1] + v[i][2] * v[i][2] + v[i][3] * v[i][3]; s2 += w[i][0] * w[i][0] + w[i][1] * w[i][1] + w[i][2] * w[i][2] + w[i][3] * w[i][3]; }
#pragma unroll
        for (int o = 1; o < 64; o <<= 1) { s += __shfl_xor(s, o); s2 += __shfl_xor(s2, o); }
        const float inv = rsqrtf(s * (1.0f / 1024.0f) + EPS), inv2 = rsqrtf(s2 * (1.0f / 1024.0f) + EPS);
#pragma unroll
        for (int i = 0; i < 4; ++i) { const int cc = (i * 64 + lane) * 4; *(f32x4*)(p + cc) = v[i] * inv * gg[i]; if (two) *(f32x4*)(p2 + cc) = w[i] * inv2 * gg[i]; }
    }
}

template <bool FINAL>
__device__ __forceinline__ void lru_chunk(const Ctx& c, int b, int ch, bool dry = false) {
    const int tid = otid(), wid = tid >> 6, lane = tid & 63, lr = lane & 15, kg = lane >> 4;
    LAS float* XC = (LAS float*)c.lds; LAS float* AA = (LAS float*)(c.lds + 32768); LAS float* UU = (LAS float*)(c.lds + 65536); LAS unsigned char* XCb = c.lds + 98304;
    bf16_t* PP = (bf16_t*)(c.ws + OFF_PP); bf16_t* HALO = (bf16_t*)(c.ws + OFF_HALO); float* SUMM = (float*)(c.ws + OFF_SUMM);
    const bf16_t* WRG = (const bf16_t*)(c.ws + OFF_WRG); const bf16_t* WIG = (const bf16_t*)(c.ws + OFF_WIG);
    const float* cw = c.in[12]; const float* cb = c.in[13]; const float* brg = c.in[15]; const float* big = c.in[17]; const float* lam = c.in[18];
    const int t0 = b * SEQ + 64 * ch;
    LAS float* CARRY = (LAS float*)(c.lds + 115712);
    if (FINAL) {
        float h0 = 0.f, h1 = 0.f;
        for (int cp = 0; cp < ch; cp += 8) {
            float a0[8], b0[8], a1[8], b1[8];
#pragma unroll
            for (int i = 0; i < 8; ++i) { a0[i] = 1.f; b0[i] = 0.f; a1[i] = 1.f; b1[i] = 0.f;
                if (cp + i < ch) { const float* sp = SUMM + ((size_t)(b * NCH + cp + i) * D + tid) * 2; a0[i] = sp[0]; b0[i] = sp[1]; a1[i] = sp[1024]; b1[i] = sp[1025]; } }
#pragma unroll
            for (int i = 0; i < 8; ++i) { h0 = a0[i] * h0 + b0[i]; h1 = a1[i] * h1 + b1[i]; }
        }
        CARRY[tid] = h0; CARRY[tid + 512] = h1;
    }
    const int cg8 = tid & 15, tk = (tid >> 4) * 2;
    u32x4 rawp[5]; f32x4 wk[4][2], bb[2]; bf16x8 wrf[4], wif[4]; float pb1 = 0.f, pb2 = 0.f, plam = 0.f;
#define LRU_FETCH(hd) do { const int cc0_ = 128 * (hd) + 8 * cg8; \
        _Pragma("unroll") for (int i = 0; i < 5; ++i) { const int tt = tk - 3 + i; rawp[i] = (u32x4){0u, 0u, 0u, 0u}; \
            if (tt >= 0) rawp[i] = *(const u32x4*)(PP + (size_t)(t0 + tt) * NPP + cc0_); \
            else if (ch > 0) rawp[i] = *(const u32x4*)(HALO + ((size_t)((b * NCH + ch - 1) * 3 + (tt + 3))) * D + cc0_); } \
        _Pragma("unroll") for (int k = 0; k < 4; ++k) { wk[k][0] = *(const f32x4*)(cw + k * D + cc0_); wk[k][1] = *(const f32x4*)(cw + k * D + cc0_ + 4); } \
        bb[0] = *(const f32x4*)(cb + cc0_); bb[1] = *(const f32x4*)(cb + cc0_ + 4); } while (0)
#define LRU_FETCHW(hd) do { \
        { const int cgl_ = 128 * (hd) + 16 * wid + lr; const bf16_t* wr__ = WRG + (size_t)cgl_ * 128 + 8 * kg; const bf16_t* wi__ = WIG + (size_t)cgl_ * 128 + 8 * kg; \
          _Pragma("unroll") for (int ks = 0; ks < 4; ++ks) { wrf[ks] = *(const bf16x8*)(wr__ + 32 * ks); wif[ks] = *(const bf16x8*)(wi__ + 32 * ks); } \
          pb1 = brg[cgl_]; pb2 = big[cgl_]; plam = lam[cgl_]; } } while (0)
    LRU_FETCH(0); LRU_FETCHW(0);
    for (int head = 0; head < 8; ++head) {
        const int ch0 = 128 * head;
        {
            f32x4 raw[5][2];
#pragma unroll
            for (int i = 0; i < 5; ++i) unpack8(rawp[i], raw[i][0], raw[i][1]);
#pragma unroll
            for (int q = 0; q < 2; ++q) { f32x4 o0 = bb[0], o1 = bb[1];
#pragma unroll
                for (int k = 0; k < 4; ++k) { o0 += wk[k][0] * raw[q + k][0]; o1 += wk[k][1] * raw[q + k][1]; }
                *(LAS f32x4*)(XC + (tk + q) * 128 + 8 * cg8) = o0; *(LAS f32x4*)(XC + (tk + q) * 128 + 8 * cg8 + 4) = o1;
                *(LAS u32x4*)A256(XCb, tk + q, cg8) = pack8(o0, o1); }
            if (head < 7) LRU_FETCH(head + 1);
        }
        __syncthreads();
        {
            f32x4 ar[4], ai_[4];
#pragma unroll
            for (int m = 0; m < 4; ++m) { ar[m] = (f32x4){0.f, 0.f, 0.f, 0.f}; ai_[m] = (f32x4){0.f, 0.f, 0.f, 0.f}; }
#pragma unroll
            for (int ks = 0; ks < 4; ++ks) { const bf16x8 br = wrf[ks], bi = wif[ks];
#pragma unroll
                for (int m = 0; m < 4; ++m) { const bf16x8 a = *(const LAS bf16x8*)A256(XCb, 16 * m + lr, 4 * ks + kg);
                    ar[m] = __builtin_amdgcn_mfma_f32_16x16x32_bf16(a, br, ar[m], 0, 0, 0); ai_[m] = __builtin_amdgcn_mfma_f32_16x16x32_bf16(a, bi, ai_[m], 0, 0, 0); } }
            const int cl = 16 * wid + lr; const float b1 = pb1, b2 = pb2, sp = softplusf_(-plam);
            if (head < 7) LRU_FETCHW(head + 1);
#pragma unroll
            for (int m = 0; m < 4; ++m)
#pragma unroll
                for (int r = 0; r < 4; ++r) { const int tk = 16 * m + 4 * kg + r; const float rg = sigmoidf_(ar[m][r] + b1), ig = sigmoidf_(ai_[m][r] + b2);
                    const float la = -8.0f * rg * sp, a_ = __expf(la); const float u = __builtin_amdgcn_sqrtf(fmaxf(1.0f - a_ * a_, 0.0f)) * ig * XC[tk * 128 + cl];
                    AA[tk * 128 + cl] = la; UU[tk * 128 + cl] = u; }
        }
        __syncthreads();
        if (!FINAL) {
            const int cg8s = tid & 15, tks = (tid >> 4) * 2;
#pragma unroll
            for (int q = 0; q < 2; ++q) { const f32x4 o0 = *(const LAS f32x4*)(UU + (tks + q) * 128 + 8 * cg8s), o1 = *(const LAS f32x4*)(UU + (tks + q) * 128 + 8 * cg8s + 4);
                const f32x4 l0 = *(const LAS f32x4*)(AA + (tks + q) * 128 + 8 * cg8s), l1 = *(const LAS f32x4*)(AA + (tks + q) * 128 + 8 * cg8s + 4);
                *(u32x4*)(PP + (size_t)(t0 + tks + q) * NPP + ch0 + 8 * cg8s) = pack8(o0, o1); *(u32x4*)(PP + (size_t)(t0 + tks + q) * NPP + 3072 + ch0 + 8 * cg8s) = pack8(l0, l1); } }
        if (tid < 128) { const int cgl = ch0 + tid;
            if (!FINAL) { float A = 1.f, H = 0.f;
                for (int t8 = 0; t8 < 64; t8 += 16) { float av[16], uv[16];
#pragma unroll
                    for (int i = 0; i < 16; ++i) { av[i] = AA[(t8 + i) * 128 + tid]; uv[i] = UU[(t8 + i) * 128 + tid]; }
#pragma unroll
                    for (int i = 0; i < 16; ++i) { const float a_ = __expf(av[i]); H = a_ * H + uv[i]; A *= a_; } }
                float* s = SUMM + ((size_t)(b * NCH + ch) * D + cgl) * 2; s[0] = A; s[1] = H; }
            else { float h = CARRY[cgl];
                for (int t8 = 0; t8 < 64; t8 += 16) { float av[16], uv[16];
#pragma unroll
                    for (int i = 0; i < 16; ++i) { av[i] = AA[(t8 + i) * 128 + tid]; uv[i] = UU[(t8 + i) * 128 + tid]; }
#pragma unroll
                    for (int i = 0; i < 16; ++i) { h = av[i] * h + uv[i]; UU[(t8 + i) * 128 + tid] = h; } }
                if (ch == NCH - 1) c.out[O_LHP + b * D + cgl] = h; } }
        __syncthreads();
        if (FINAL) { const int cg8 = tid & 15, tk = (tid >> 4) * 2;
#pragma unroll
            for (int q = 0; q < 2; ++q) { const f32x4 o0 = *(const LAS f32x4*)(UU + (tk + q) * 128 + 8 * cg8), o1 = *(const LAS f32x4*)(UU + (tk + q) * 128 + 8 * cg8 + 4);
                if (!dry) *(u32x4*)(PP + (size_t)(t0 + tk + q) * NPP + ch0 + 8 * cg8) = pack8(o0, o1); }
            __syncthreads(); }
    }
}

__device__ __forceinline__ void lru_final(const Ctx& c, int b, int ch) {
    const int tid = otid(); bf16_t* PP = (bf16_t*)(c.ws + OFF_PP); const float* SUMM = (const float*)(c.ws + OFF_SUMM);
    const int t0 = b * SEQ + 64 * ch, c2 = 2 * tid;
    float h0 = 0.f, h1 = 0.f;
    for (int cp = 0; cp < ch; cp += 8) {
        f32x4 sv[8];
#pragma unroll
        for (int i = 0; i < 8; ++i) { sv[i] = (f32x4){1.f, 0.f, 1.f, 0.f}; if (cp + i < ch) sv[i] = *(const f32x4*)(SUMM + ((size_t)(b * NCH + cp + i) * D + c2) * 2); }
#pragma unroll
        for (int i = 0; i < 8; ++i) { h0 = sv[i][0] * h0 + sv[i][1]; h1 = sv[i][2] * h1 + sv[i][3]; }
    }
    for (int t8 = 0; t8 < 64; t8 += 16) {
        unsigned uu[16], ll[16];
#pragma unroll
        for (int i = 0; i < 16; ++i) { const bf16_t* p = PP + (size_t)(t0 + t8 + i) * NPP + c2; uu[i] = *(const unsigned*)p; ll[i] = *(const unsigned*)(p + 3072); }
#pragma unroll
        for (int i = 0; i < 16; ++i) { h0 = __expf(bflo(ll[i])) * h0 + bflo(uu[i]); h1 = __expf(bfhi(ll[i])) * h1 + bfhi(uu[i]);
            *(unsigned*)(PP + (size_t)(t0 + t8 + i) * NPP + c2) = cvt_pk_bf16(h0, h1); }
    }
    if (ch == NCH - 1) { c.out[O_LHP + b * D + c2] = h0; c.out[O_LHP + b * D + c2 + 1] = h1; }
}

__device__ __forceinline__ void bc_conv(const Ctx& c, int b, int ch) {
    const int tid = otid(); const bf16_t* PP = (const bf16_t*)(c.ws + OFF_PP); bf16_t* BCc = (bf16_t*)(c.ws + OFF_XN);
    const float* cw = c.in[19]; const float* cb = c.in[20]; const int t0 = b * SEQ + 64 * ch;
    if (tid < 384) { const int row = tid >> 7, cg8 = tid & 127;
        *(u32x4*)((bf16_t*)(c.ws + OFF_HALO) + ((size_t)((b * NCH + ch) * 3 + row)) * D + 8 * cg8) = *(const u32x4*)(PP + (size_t)(t0 + 61 + row) * NPP + 8 * cg8); }
#pragma unroll 1
    for (int item = tid; item < 1024; item += 512) {
        const int cgq = item & 127, st = item >> 7, gcol = 3072 + 8 * cgq, ccol = 2048 + 8 * cgq;
        u32x4 raw[11];
#pragma unroll
        for (int i = 0; i < 11; ++i) { const int tt = 8 * st - 3 + i; raw[i] = (u32x4){0u, 0u, 0u, 0u}; if (tt >= 0 || ch > 0) raw[i] = *(const u32x4*)(PP + (size_t)(t0 + tt) * NPP + gcol); }
#pragma unroll
        for (int hf = 0; hf < 2; ++hf) {
            f32x4 wk[4]; const f32x4 bb = *(const f32x4*)(cb + ccol + 4 * hf);
#pragma unroll
            for (int k = 0; k < 4; ++k) wk[k] = *(const f32x4*)(cw + k * 3072 + ccol + 4 * hf);
#pragma unroll
            for (int q = 0; q < 8; ++q) { f32x4 o = bb;
#pragma unroll
                for (int k = 0; k < 4; ++k) { const unsigned w0 = raw[q + k][2 * hf], w1 = raw[q + k][2 * hf + 1]; const f32x4 r = (f32x4){bflo(w0), bfhi(w0), bflo(w1), bfhi(w1)}; o += wk[k] * r; }
#pragma unroll
                for (int j = 0; j < 4; ++j) o[j] = siluf_(o[j]);
                unsigned* op = (unsigned*)(BCc + (size_t)(t0 + 8 * st + q) * 1024 + 8 * cgq + 4 * hf); op[0] = cvt_pk_bf16(o[0], o[1]); op[1] = cvt_pk_bf16(o[2], o[3]); }
        }
    }
}

__device__ __forceinline__ void ssd_seq(const Ctx& c, int b, int h, bool dry = false) {
    const int tid = otid(), wid = tid >> 6, lane = tid & 63, lr = lane & 15, kg = lane >> 4;
    LAS unsigned char* L = c.lds;
    LAS unsigned char* Cm = L; LAS unsigned char* Bm = L + 16384; LAS unsigned char* BdT = L + 32768; LAS unsigned char* Sb = L + 49152;
    LAS unsigned char* XdT = L + 65536; LAS unsigned char* Xr = L + 73728; LAS unsigned char* Mm = L + 82944;
    LAS float* dts = (LAS float*)(L + 91136); LAS float* css = (LAS float*)(L + 91392); LAS float* dec = (LAS float*)(L + 91648); LAS bf16_t* halo = (LAS bf16_t*)(L + 91904);
    bf16_t* PP = (bf16_t*)(c.ws + OFF_PP); const float* DT = (const float*)(c.ws + OFF_DT);
    const float* cw = c.in[19]; const float* cb = c.in[20];
    const int g = h >> 3;
    const float Ah = -__expf(c.in[22][h]), Dh = c.in[23][h], dtb = c.in[21][h];
    f32x4 accS[4];
#pragma unroll
    for (int m = 0; m < 4; ++m) accS[m] = (f32x4){0.f, 0.f, 0.f, 0.f};
    for (int e = tid; e < 64 * 128; e += 512) ((LAS bf16_t*)Sb)[e] = 0;
    const bf16_t* BCc = (const bf16_t*)(c.ws + OFF_XN);
    const int role = tid >> 7, rt = tid & 127;
    const int xg = rt & 7, xst = rt >> 3;
    const int bg8 = rt & 15, bst = rt >> 4;
    const int gcol = 1024 + 64 * h + 8 * xg, ccol = 64 * h + 8 * xg;
    const int bcol = (role == 2 ? 512 : 0) + 128 * g + 8 * bg8;
    u32x4 raw[8]; float dtv = 0.f;
    f32x4 wkk[2][4], bbb[2];
#pragma unroll
    for (int hf = 0; hf < 2; ++hf) { bbb[hf] = *(const f32x4*)(cb + ccol + 4 * hf);
#pragma unroll
        for (int k = 0; k < 4; ++k) wkk[hf][k] = *(const f32x4*)(cw + k * 3072 + ccol + 4 * hf); }
    {
        const int t0 = b * SEQ;
        if (role == 0) {
#pragma unroll
            for (int i = 0; i < 7; ++i) { const int tt = 4 * xst - 3 + i; raw[i] = (u32x4){0u, 0u, 0u, 0u}; if (tt >= 0) raw[i] = *(const u32x4*)(PP + (size_t)(t0 + tt) * NPP + gcol); } }
        else if (role < 3) {
#pragma unroll
            for (int i = 0; i < 8; ++i) raw[i] = *(const u32x4*)(BCc + (size_t)(t0 + 8 * bst + i) * 1024 + bcol); }
        if (wid == 0) dtv = DT[(size_t)(t0 + lane) * 32 + h];
    }
    for (int ch = 0; ch < NCH; ++ch) {
        const int t0 = b * SEQ + 64 * ch;
        if (wid == 0) {
            const float d = softplusf_(dtv + dtb); float sc = d * Ah;
#pragma unroll
            for (int o = 1; o < 64; o <<= 1) { const float v = __shfl_up(sc, o); if (lane >= o) sc += v; }
            const float ce = __shfl(sc, 63);
            dts[lane] = d; css[lane] = sc; dec[lane] = __expf(ce - sc);
        }
        __syncthreads();
        if (role == 0) {
            if (xst == 0 && ch > 0) {
#pragma unroll
                for (int i = 0; i < 3; ++i) raw[i] = *(const LAS u32x4*)(halo + ((ch - 1) & 1) * 192 + i * 64 + 8 * xg); }
            if (xst == 15) {
#pragma unroll
                for (int i = 0; i < 3; ++i) *(LAS u32x4*)(halo + (ch & 1) * 192 + i * 64 + 8 * xg) = raw[4 + i];
                if (ch == NCH - 1 && !dry) {
#pragma unroll
                    for (int r = 0; r < 3; ++r) { f32x4 v0, v1; unpack8(raw[4 + r], v0, v1); float* o = c.out + O_SCP + (size_t)(b * 3 + r) * 3072 + ccol; *(f32x4*)o = v0; *(f32x4*)(o + 4) = v1; } } }
            const int chunk = (xst >> 1) ^ xg;
#pragma unroll
            for (int hf = 0; hf < 2; ++hf) {
                unsigned tq[4][2];
#pragma unroll
                for (int q = 0; q < 4; ++q) { f32x4 o = bbb[hf];
#pragma unroll
                    for (int k = 0; k < 4; ++k) { const unsigned w0 = raw[q + k][2 * hf], w1 = raw[q + k][2 * hf + 1]; const f32x4 r = (f32x4){bflo(w0), bfhi(w0), bflo(w1), bfhi(w1)}; o += wkk[hf][k] * r; }
#pragma unroll
                    for (int j = 0; j < 4; ++j) o[j] = siluf_(o[j]);
                    const int l = 4 * xst + q;
                    LAS unsigned* rp = (LAS unsigned*)(Xr + l * 144 + 16 * xg + 8 * hf); rp[0] = cvt_pk_bf16(o[0], o[1]); rp[1] = cvt_pk_bf16(o[2], o[3]);
                    const float d = dts[l]; tq[q][0] = cvt_pk_bf16(o[0] * d, o[1] * d); tq[q][1] = cvt_pk_bf16(o[2] * d, o[3] * d);
                }
#pragma unroll
                for (int j2 = 0; j2 < 2; ++j2) {
                    unsigned lo[2], hi[2];
#pragma unroll
                    for (int i = 0; i < 2; ++i) { const unsigned a = tq[2 * i][j2], bq = tq[2 * i + 1][j2]; lo[i] = (a & 0xffffu) | (bq << 16); hi[i] = (a >> 16) | (bq & 0xffff0000u); }
                    LAS unsigned* p0 = (LAS unsigned*)(A128(XdT, 8 * xg + 4 * hf + 2 * j2, xst >> 1) + 8 * (xst & 1)); p0[0] = lo[0]; p0[1] = lo[1];
                    LAS unsigned* p1 = (LAS unsigned*)(A128(XdT, 8 * xg + 4 * hf + 2 * j2 + 1, xst >> 1) + 8 * (xst & 1)); p1[0] = hi[0]; p1[1] = hi[1]; }
            }
        } else if (role == 1) {
            const int chunk = bst ^ (bg8 & 7);
            unsigned tq[8][4];
#pragma unroll
            for (int q = 0; q < 8; ++q) { const int l = 8 * bst + q; *(LAS u32x4*)A256(Bm, l, bg8) = raw[q]; const float d = dec[l]; f32x4 v0, v1; unpack8(raw[q], v0, v1);
                tq[q][0] = cvt_pk_bf16(v0[0] * d, v0[1] * d); tq[q][1] = cvt_pk_bf16(v0[2] * d, v0[3] * d); tq[q][2] = cvt_pk_bf16(v1[0] * d, v1[1] * d); tq[q][3] = cvt_pk_bf16(v1[2] * d, v1[3] * d); }
#pragma unroll
            for (int j2 = 0; j2 < 4; ++j2) { u32x4 lo, hi;
#pragma unroll
                for (int i = 0; i < 4; ++i) { const unsigned a = tq[2 * i][j2], bq = tq[2 * i + 1][j2]; lo[i] = (a & 0xffffu) | (bq << 16); hi[i] = (a >> 16) | (bq & 0xffff0000u); }
                *(LAS u32x4*)A128(BdT, 8 * bg8 + 2 * j2, bst) = lo; *(LAS u32x4*)A128(BdT, 8 * bg8 + 2 * j2 + 1, bst) = hi; }
        } else if (role == 2) {
#pragma unroll
            for (int q = 0; q < 8; ++q) *(LAS u32x4*)A256(Cm, 8 * bst + q, bg8) = raw[q];
        }
        if (ch + 1 < NCH) {
            if (role == 0) {
#pragma unroll
                for (int i = 0; i < 7; ++i) { const int tt = 4 * xst - 3 + i; if (tt >= 0) raw[i] = *(const u32x4*)(PP + (size_t)(t0 + 64 + tt) * NPP + gcol); } }
            else if (role < 3) {
#pragma unroll
                for (int i = 0; i < 8; ++i) raw[i] = *(const u32x4*)(BCc + (size_t)(t0 + 64 + 8 * bst + i) * 1024 + bcol); }
            if (wid == 0) dtv = DT[(size_t)(t0 + 64 + lane) * 32 + h];
        }
        __syncthreads();
#pragma unroll
        for (int q = 0; q < 2; ++q) { const int ti = 2 * wid + q, lt = ti >> 2, stl = ti & 3; f32x4 a4 = (f32x4){0.f, 0.f, 0.f, 0.f};
            if (stl <= lt) {
#pragma unroll
                for (int ks = 0; ks < 4; ++ks) { const bf16x8 a = *(const LAS bf16x8*)A256(Bm, 16 * stl + lr, 4 * ks + kg), bq = *(const LAS bf16x8*)A256(Cm, 16 * lt + lr, 4 * ks + kg);
                    a4 = __builtin_amdgcn_mfma_f32_16x16x32_bf16(a, bq, a4, 0, 0, 0); } }
            const int l = 16 * lt + lr; const float cl = css[l]; f32x4 v;
#pragma unroll
            for (int r = 0; r < 4; ++r) { const int sI = 16 * stl + 4 * kg + r; v[r] = (sI <= l) ? a4[r] * __expf(cl - css[sI]) : 0.f; }
            unsigned* dummy = nullptr; (void)dummy;
            LAS unsigned* mp = (LAS unsigned*)(A128(Mm, l, 2 * stl + (kg >> 1)) + 8 * (kg & 1)); mp[0] = cvt_pk_bf16(v[0], v[1]); mp[1] = cvt_pk_bf16(v[2], v[3]); }
        __syncthreads();
#pragma unroll
        for (int q = 0; q < 2; ++q) { const int ti = 2 * wid + q, pt = ti >> 2, lt = ti & 3; f32x4 a4 = (f32x4){0.f, 0.f, 0.f, 0.f};
#pragma unroll
            for (int ks = 0; ks < 4; ++ks) { const bf16x8 a = *(const LAS bf16x8*)A256(Sb, 16 * pt + lr, 4 * ks + kg), bq = *(const LAS bf16x8*)A256(Cm, 16 * lt + lr, 4 * ks + kg);
                a4 = __builtin_amdgcn_mfma_f32_16x16x32_bf16(a, bq, a4, 0, 0, 0); }
            const int l = 16 * lt + lr; const float el = __expf(css[l]);
#pragma unroll
            for (int r = 0; r < 4; ++r) a4[r] *= el;
            const int prow_ = 16 * pt + lr, sw = (2 * pt + (lr >> 3)) & 7;
#pragma unroll
            for (int ks = 0; ks < 2; ++ks) { const bf16x8 a = *(const LAS bf16x8*)A128(XdT, prow_, 4 * ks + kg), bq = *(const LAS bf16x8*)A128(Mm, 16 * lt + lr, 4 * ks + kg);
                a4 = __builtin_amdgcn_mfma_f32_16x16x32_bf16(a, bq, a4, 0, 0, 0); }
            const int p0 = 16 * pt + 4 * kg; const LAS unsigned* xp = (const LAS unsigned*)(Xr + l * 144 + 2 * p0); const unsigned x01 = xp[0], x23 = xp[1];
            const float y0 = a4[0] + Dh * bflo(x01), y1 = a4[1] + Dh * bfhi(x01), y2 = a4[2] + Dh * bflo(x23), y3 = a4[3] + Dh * bfhi(x23);
            if (!dry) { unsigned* yp = (unsigned*)(PP + (size_t)(t0 + l) * NPP + 1024 + 64 * h + p0); yp[0] = cvt_pk_bf16(y0, y1); yp[1] = cvt_pk_bf16(y2, y3); } }
        { const float ce = __expf(css[63]); const int nrow = 16 * wid + lr, swn = (2 * wid + (lr >> 3)) & 7;
#pragma unroll
          for (int m = 0; m < 4; ++m) { accS[m] *= ce; const int prow_ = 16 * m + lr, swp = (2 * m + (lr >> 3)) & 7;
#pragma unroll
            for (int ks = 0; ks < 2; ++ks) { const bf16x8 a = *(const LAS bf16x8*)A128(BdT, nrow, 4 * ks + kg), bq = *(const LAS bf16x8*)A128(XdT, prow_, 4 * ks + kg);
                accS[m] = __builtin_amdgcn_mfma_f32_16x16x32_bf16(a, bq, accS[m], 0, 0, 0); } } }
        __syncthreads();
#pragma unroll
        for (int m = 0; m < 4; ++m) { LAS unsigned* sp = (LAS unsigned*)(A256(Sb, 16 * m + lr, 2 * wid + (kg >> 1)) + 8 * (kg & 1)); sp[0] = cvt_pk_bf16(accS[m][0], accS[m][1]); sp[1] = cvt_pk_bf16(accS[m][2], accS[m][3]); }
    }
    if (!dry) {
#pragma unroll
        for (int m = 0; m < 4; ++m) *(f32x4*)(c.out + O_SHP + ((size_t)(b * 32 + h) * 64 + 16 * m + lr) * 128 + 16 * wid + 4 * kg) = accS[m];
    }
    __syncthreads();
}

__device__ __forceinline__ void lru_sample(const Ctx& c, int b, int head) {
    const int tid = otid(); LAS float* XC = (LAS float*)c.lds; LAS float* RG = XC + 2048; LAS float* IG = RG + 2048;
    const float* PS = (const float*)(c.ws + OFF_PS); bf16_t* ABRS = (bf16_t*)(c.ws + OFF_ABRS);
    const float* cw = c.in[12]; const float* cb = c.in[13]; const int ch0 = 128 * head;
    for (int e = tid; e < 2048; e += 512) { const int tk = e >> 7, cl = e & 127, cgl = ch0 + cl; float o = cb[cgl];
#pragma unroll
        for (int k = 0; k < 4; ++k) { const int tt = tk - 3 + k; const float v = tt >= 0 ? PS[(size_t)(b * 16 + tt) * 9216 + cgl] : SZ(c.in[2][(size_t)(b * 3 + tt + 3) * D + cgl]); o += cw[k * D + cgl] * v; }
        XC[e] = o; }
    if (tid < 384) { const int r = tid >> 7, cl = tid & 127; c.out[O_LCS + (size_t)(b * 3 + r) * D + ch0 + cl] = PS[(size_t)(b * 16 + 13 + r) * 9216 + ch0 + cl]; }
    __syncthreads();
    {
        LAS unsigned char* XCb = c.lds + 32768; const int wid = tid >> 6, lane = tid & 63, lr = lane & 15, kg = lane >> 4;
        for (int e = tid; e < 2048; e += 512) *(LAS bf16_t*)(XCb + (e >> 7) * 272 + 2 * (e & 127)) = f2bf(XC[e]);
        __syncthreads();
        const bf16_t* wr_ = (const bf16_t*)(c.ws + OFF_WRG) + (size_t)(ch0 + 16 * wid + lr) * 128 + 8 * kg; const bf16_t* wi_ = (const bf16_t*)(c.ws + OFF_WIG) + (size_t)(ch0 + 16 * wid + lr) * 128 + 8 * kg;
        f32x4 ar = (f32x4){0.f, 0.f, 0.f, 0.f}, ai_ = ar;
#pragma unroll
        for (int ks = 0; ks < 4; ++ks) { const bf16x8 br = *(const bf16x8*)(wr_ + 32 * ks), bi = *(const bf16x8*)(wi_ + 32 * ks), a = *(const LAS bf16x8*)(XCb + lr * 272 + (32 * ks + 8 * kg) * 2);
            ar = __builtin_amdgcn_mfma_f32_16x16x32_bf16(a, br, ar, 0, 0, 0); ai_ = __builtin_amdgcn_mfma_f32_16x16x32_bf16(a, bi, ai_, 0, 0, 0); }
        const int cl = 16 * wid + lr; const float b1 = c.in[15][ch0 + cl], b2 = c.in[17][ch0 + cl];
#pragma unroll
        for (int r = 0; r < 4; ++r) { const int tk = 4 * kg + r; RG[tk * 128 + cl] = sigmoidf_(ar[r] + b1); IG[tk * 128 + cl] = sigmoidf_(ai_[r] + b2); }
    }
    __syncthreads();
    if (tid < 128) { const int cgl = ch0 + tid; const float sp = softplusf_(-c.in[18][cgl]); float h = SZ(c.in[3][b * D + cgl]);
        for (int tk = 0; tk < 16; ++tk) { const float la = -8.0f * RG[tk * 128 + tid] * sp, a = __expf(la), u = sqrtf(-expm1f(2.0f * la)) * IG[tk * 128 + tid] * XC[tk * 128 + tid];
            h = a * h + u; ABRS[(size_t)(b * 16 + tk) * 3072 + cgl] = f2bf(gelu_tanh(PS[(size_t)(b * 16 + tk) * 9216 + 4096 + cgl]) * h); }
        c.out[O_LHS + b * D + cgl] = h; }
    __syncthreads();
}
__device__ __forceinline__ void ssd_sample(const Ctx& c, int b, int h) {
    const int tid = otid(); LAS float* XS = (LAS float*)c.lds; LAS float* BS = XS + 1024; LAS float* CS = BS + 2048; LAS float* DTL = CS + 2048;
    const float* PS = (const float*)(c.ws + OFF_PS); const float* DTS = (const float*)(c.ws + OFF_DTS); float* YGS = (float*)(c.ws + OFF_YGS);
    const float* cw = c.in[19]; const float* cb = c.in[20]; const int g = h >> 3;
    for (int e = tid; e < 16 * 320; e += 512) { const int tk = e / 320, q = e % 320; int cc; LAS float* dst;
        if (q < 64) { cc = 64 * h + q; dst = XS + tk * 64 + q; } else if (q < 192) { cc = 2048 + 128 * g + (q - 64); dst = BS + tk * 128 + (q - 64); } else { cc = 2560 + 128 * g + (q - 192); dst = CS + tk * 128 + (q - 192); }
        float o = cb[cc];
#pragma unroll
        for (int k = 0; k < 4; ++k) { const int tt = tk - 3 + k; const float v = tt >= 0 ? PS[(size_t)(b * 16 + tt) * 9216 + 1024 + cc] : SZ(c.in[4][(size_t)(b * 3 + tt + 3) * 3072 + cc]); o += cw[k * 3072 + cc] * v; }
        *dst = siluf_(o);
        if (tk >= 13 && (q < 64 || (h & 7) == 0)) c.out[O_SCS + (size_t)(b * 3 + tk - 13) * 3072 + cc] = PS[(size_t)(b * 16 + tk) * 9216 + 1024 + cc]; }
    if (tid < 16) DTL[tid] = softplusf_(DTS[(b * 16 + tid) * 32 + h] + c.in[21][h]);
    __syncthreads();
    const float Ah = -__expf(c.in[22][h]), Dh = c.in[23][h];
    const int p = tid >> 3, n0 = (tid & 7) * 16; float hs[16];
    const float* h0 = c.in[5] + ((size_t)(b * 32 + h) * 64 + p) * 128 + n0;
#pragma unroll
    for (int j = 0; j < 16; ++j) hs[j] = SZ(h0[j]);
    float zv[16];
#pragma unroll
    for (int tk = 0; tk < 16; ++tk) zv[tk] = PS[(size_t)(b * 16 + tk) * 9216 + 5120 + 64 * h + p];
#pragma unroll
    for (int tk = 0; tk < 16; ++tk) { const float d = DTL[tk], ea = __expf(d * Ah), xv = XS[tk * 64 + p], dx = d * xv; float y = 0.f;
#pragma unroll
        for (int j = 0; j < 16; ++j) { hs[j] = ea * hs[j] + dx * BS[tk * 128 + n0 + j]; y += CS[tk * 128 + n0 + j] * hs[j]; }
        y += __shfl_xor(y, 1); y += __shfl_xor(y, 2); y += __shfl_xor(y, 4);
        if ((tid & 7) == 0) { const int row = b * 16 + tk; YGS[(size_t)row * 2048 + 64 * h + p] = (y + Dh * xv) * siluf_(zv[tk]); } }
    float* ho = c.out + O_SHS + ((size_t)(b * 32 + h) * 64 + p) * 128 + n0;
#pragma unroll
    for (int j = 0; j < 16; ++j) ho[j] = hs[j];
    __syncthreads();
}

#ifdef DIAG
constexpr size_t OFF_DIAG = 266338304;
__device__ __forceinline__ int prow(int r) { return (r >> 4) * SEQ + (r & 15); }
template <class FA, class FB>
__device__ __forceinline__ void diag_rel(LAS float* red, float* dst, int ncols, FA fa, FB fb) {
    const int tid = threadIdx.x; float num = 0.f, den = 0.f;
    for (int e = tid; e < TS * ncols; e += 512) { const int r = e / ncols, cc = e % ncols; const float a = fa(r, cc), b = fb(r, cc); num += (a - b) * (a - b); den += b * b; }
    red[tid] = num; red[512 + tid] = den; __syncthreads();
    if (tid == 0) { float n = 0.f, d = 0.f; for (int i = 0; i < 512; ++i) { n += red[i]; d += red[512 + i]; } *dst = n / (d + 1e-30f); }
    __syncthreads();
}
#endif
constexpr size_t OFF_BAR = 266338304 + 4096, OFF_SSQS = OFF_BAR + 4096;
__device__ __forceinline__ void grid_barrier(unsigned* ctr, unsigned target) {
    asm volatile("s_waitcnt vmcnt(0) lgkmcnt(0)" ::: "memory");
    __syncthreads();
    if (threadIdx.x == 0) {
        __builtin_amdgcn_fence(__ATOMIC_RELEASE, "agent");
        asm volatile("s_waitcnt vmcnt(0)" ::: "memory");
        __hip_atomic_fetch_add(ctr, 1u, __ATOMIC_RELAXED, __HIP_MEMORY_SCOPE_AGENT);
        while (__hip_atomic_load(ctr, __ATOMIC_RELAXED, __HIP_MEMORY_SCOPE_AGENT) < target) __builtin_amdgcn_s_sleep(1);
        __builtin_amdgcn_fence(__ATOMIC_ACQUIRE, "agent");
        asm volatile("s_waitcnt vmcnt(0)" ::: "memory");
    }
    __syncthreads();
}
#define XB_TMO      128
#define XB_XCNT(j)  (256  + 64 * (j))
#define XB_XSUB(j)  (1280 + 64 * (j))
#define XB_XGEN(j)  (2304 + 64 * (j))
#define XB_TOP      3328
#define XB_TOPGEN   3392
#define XCD_BAR_WORDS 3456
#define XB_SPIN_CAP (1u << 18)
constexpr size_t OFF_XBAR = 266338304 + 4096 + 4096 + 65536;
__device__ __forceinline__ unsigned xb_ld(unsigned* p)              { return __hip_atomic_load(p, __ATOMIC_RELAXED, __HIP_MEMORY_SCOPE_AGENT); }
__device__ __forceinline__ unsigned xb_add(unsigned* p, unsigned v) { return __hip_atomic_fetch_add(p, v, __ATOMIC_RELAXED, __HIP_MEMORY_SCOPE_AGENT); }
__device__ __forceinline__ unsigned xb_xcc_id() { return (unsigned)__builtin_amdgcn_s_getreg((3 << 11) | 20) & 0xFu; }
#define XB_SPIN(cond, bar) do { unsigned _sp = 0; while (cond) { __builtin_amdgcn_s_sleep(1); \
    if ((++_sp & 255u) == 0u) { if (xb_ld(&(bar)[XB_TMO])) break; if (_sp > XB_SPIN_CAP) { atomicAdd(&(bar)[XB_TMO], 1u); break; } } } } while (0)
struct XcdBarrier { unsigned* bar; unsigned x; volatile LAS unsigned* st; };
__device__ __forceinline__ XcdBarrier xcd_barrier_post(unsigned* bar, volatile LAS unsigned* st) {
    XcdBarrier b; b.bar = bar; b.x = xb_xcc_id(); b.st = st;
    if (threadIdx.x == 0) (void)xb_add(&bar[XB_XCNT(b.x)], 1u);
    return b;
}
__device__ __forceinline__ void xcd_barrier_complete(unsigned* bar, unsigned x, unsigned& nloc, unsigned& nx) {
    const unsigned G = gridDim.x * gridDim.y * gridDim.z;
    unsigned sum, cnt, mine, sp = 0u;
    for (;;) {
        sum = 0u; cnt = 0u; mine = 0u;
#pragma unroll
        for (unsigned j = 0; j < 16; ++j) { const unsigned c = xb_ld(&bar[XB_XCNT(j)]); sum += c; cnt += (c > 0u) ? 1u : 0u; mine = (j == x) ? c : mine; }
        if (sum == G) break;
        __builtin_amdgcn_s_sleep(1);
        if ((++sp & 255u) == 0u) { if (xb_ld(&bar[XB_TMO])) break; if (sp > XB_SPIN_CAP) { atomicAdd(&bar[XB_TMO], 1u); break; } }
    }
    nloc = mine > 0u ? mine : 1u; nx = cnt > 0u ? cnt : 1u;
}
__device__ __forceinline__ void xcd_barrier(const XcdBarrier& b) {
    asm volatile("s_waitcnt vmcnt(0)" ::: "memory");
    __syncthreads();
    if (threadIdx.x == 0) {
        unsigned* bar = b.bar;
        __builtin_amdgcn_s_waitcnt(0);
        unsigned nloc = b.st[0], nx = b.st[1];
        if (nloc == 0u) { xcd_barrier_complete(bar, b.x, nloc, nx); b.st[0] = nloc; b.st[1] = nx; }
        const unsigned old = xb_add(&bar[XB_XSUB(b.x)], 1u);
        const unsigned gen = old / nloc;
        if (old + 1u == (gen + 1u) * nloc) {
            __builtin_amdgcn_fence(__ATOMIC_RELEASE, "agent");
            asm volatile("s_waitcnt vmcnt(0)" ::: "memory");
            const unsigned og = xb_add(&bar[XB_TOP], 1u);
            const unsigned tg = og / nx;
            if (og + 1u == (tg + 1u) * nx) xb_add(&bar[XB_TOPGEN], 1u);
            else XB_SPIN(xb_ld(&bar[XB_TOPGEN]) == tg, bar);
            __builtin_amdgcn_fence(__ATOMIC_ACQUIRE, "agent");
            xb_add(&bar[XB_XGEN(b.x)], 1u);
            asm volatile("s_waitcnt vmcnt(0)" ::: "memory");
        } else {
            XB_SPIN(xb_ld(&bar[XB_XGEN(b.x)]) == gen, bar);
            __builtin_amdgcn_fence(__ATOMIC_ACQUIRE, "agent");
            asm volatile("s_waitcnt vmcnt(0)" ::: "memory");
        }
    }
    __syncthreads();
}
#ifndef DUPX
#define DUPX 0
#endif
#ifdef TIMER_ID
#define TSTART(id) do { if ((id) == TIMER_ID) t0_ = __builtin_amdgcn_s_memrealtime(); } while (0)
#define TSTOP(id) do { if ((id) == TIMER_ID) tacc_ += __builtin_amdgcn_s_memrealtime() - t0_; } while (0)
#else
#define TSTART(id)
#define TSTOP(id)
#endif
__global__ void __launch_bounds__(512, 2) fwd_kernel(Params prm) {
    extern __shared__ __attribute__((aligned(16))) unsigned char lds_raw[];
    Ctx c; c.in = prm.in; c.out = prm.out; c.ws = prm.ws; c.lds = (LAS unsigned char*)lds_raw;
    unsigned char* ws = prm.ws; float* out = prm.out;
    const int tid = threadIdx.x, G = gridDim.x, bid = blockIdx.x;
    bf16_t* XB = (bf16_t*)(ws + OFF_XB); bf16_t* XN = (bf16_t*)(ws + OFF_XN); bf16_t* PP = (bf16_t*)(ws + OFF_PP); float* SSQ = (float*)(ws + OFF_SSQ);
    bf16_t* XNS = (bf16_t*)(ws + OFF_XNS); bf16_t* HS = (bf16_t*)(ws + OFF_HS); float* PS = (float*)(ws + OFF_PS); float* GSSQ = (float*)(ws + OFF_GSSQ);
    float* YS = out + O_YS; float* SSQS = (float*)(ws + OFF_SSQS);
    const int lo = prm.ph_lo, hi = prm.ph_hi;
#ifdef DIAG
    if (lo >= 100) {
        if (bid != 0) return;
        float* DG = (float*)(ws + OFF_DIAG); LAS float* red = (LAS float*)c.lds; const int st = lo - 100;
        const float* DTp = (const float*)(ws + OFF_DT); const float* DTs = (const float*)(ws + OFF_DTS); const bf16_t* ABRS = (const bf16_t*)(ws + OFF_ABRS); const bf16_t* MS = (const bf16_t*)(ws + OFF_MS); const float* bg = prm.in[11];
        if (st == 0 || st == 6 || st == 7) diag_rel(red, DG + st, D, [=](int r, int cc) { return out[O_YP + (size_t)prow(r) * D + cc]; }, [=](int r, int cc) { return YS[(size_t)r * D + cc]; });
        if (st == 1) { diag_rel(red, DG + 1, NPP, [=](int r, int cc) { return bf2f(PP[(size_t)prow(r) * NPP + cc]); }, [=](int r, int cc) { return PS[(size_t)r * 9216 + cc]; });
                       diag_rel(red, DG + 2, 32, [=](int r, int cc) { return DTp[(size_t)prow(r) * 32 + cc]; }, [=](int r, int cc) { return DTs[(size_t)r * 32 + cc]; }); }
        if (st == 8) { diag_rel(red, DG + 8, D, [=](int r, int cc) { return bf2f(XN[(size_t)prow(r) * D + cc]); }, [=](int r, int cc) { return sigmoidf_(PS[(size_t)r * 9216 + 7168 + cc] + bg[cc]); });
                       diag_rel(red, DG + 9, D, [=](int r, int cc) { return bf2f(PP[(size_t)prow(r) * NPP + 3072 + cc]); }, [=](int r, int cc) { return sigmoidf_(PS[(size_t)r * 9216 + 8192 + cc] + bg[1024 + cc]); }); }
        if (st == 3) { diag_rel(red, DG + 3, D, [=](int r, int cc) { return bf2f(PP[(size_t)prow(r) * NPP + cc]); }, [=](int r, int cc) { return bf2f(ABRS[(size_t)r * 3072 + cc]); });
                       diag_rel(red, DG + 4, 2048, [=](int r, int cc) { return bf2f(PP[(size_t)prow(r) * NPP + 1024 + cc]); }, [=](int r, int cc) { return bf2f(ABRS[(size_t)r * 3072 + 1024 + cc]); }); }
        if (st == 5) diag_rel(red, DG + 5, D, [=](int r, int cc) { return bf2f(XN[(size_t)prow(r) * D + cc]); }, [=](int r, int cc) { return bf2f(MS[(size_t)r * D + cc]); });
        if (st == 20) {
            int mask = 0; if (!(DG[8] < DIAG_TOL)) mask |= 1; if (!(DG[9] < DIAG_TOL)) mask |= 2; if (!(DG[3] < DIAG_TOL)) mask |= 4; if (!(DG[4] < DIAG_TOL)) mask |= 8; if (!(DG[5] < DIAG_TOL)) mask |= 16;
            if (mask == 0) { if (!(DG[6] < DIAG_TOL)) mask |= 32; if (!(DG[7] < DIAG_TOL)) mask |= 64; }
            float code = mask ? 100.f * (1 + mask) : 0.f;
            if (code > 0.f) for (int e = tid; e < TS * D; e += 512) YS[e] = code;
        }
        return;
    }
#endif
#ifndef PHMASK
#define PHMASK 0x1fff
#endif
#define IN(k) (((PHMASK >> (k)) & 1) && lo <= (k) && (k) < hi)
    unsigned* barctr = (unsigned*)(ws + OFF_BAR); unsigned nbar = 0; (void)barctr;
    volatile LAS unsigned* xbst = (volatile LAS unsigned*)(c.lds + LDS_BYTES - 16);
    if (tid < 4) xbst[tid] = 0u;
    __syncthreads();
    XcdBarrier xbar; xbar.bar = (unsigned*)(ws + OFF_XBAR); xbar.x = 0; xbar.st = xbst;
    if (hi - lo > 1) xbar = xcd_barrier_post((unsigned*)(ws + OFF_XBAR), xbst);
    unsigned long long t0_ = 0, tacc_ = 0; (void)t0_; (void)tacc_;
#define SEAM(k) do { if (IN(k) && IN((k) + 1)) { TSTART(12); ++nbar; xcd_barrier(xbar); TSTOP(12); } } while (0)
    auto rm_id = [](int col0, int) { return col0; };
    auto rm_up = [](int col0, int panel) { return (col0 >> 7) * 256 + panel * 128 + (col0 & 127); };

    if (IN(0)) {
        TSTART(0); prep_weights(c);
#if DUPX == 1
        prep_weights(c);
#endif
        rmsnorm_rows_bf16(prm.in[0], T, prm.in[6], XN); TSTOP(0);
#ifdef DIAG
        { const int t_ = otid(), lane = t_ & 63; for (int r = bid * 8 + (t_ >> 6); r < TS; r += G * 8) { const float* p = prm.in[0] + (size_t)prow(r) * D; float v[16]; float s = 0.f;
            for (int i = 0; i < 16; ++i) { v[i] = p[lane + 64 * i]; s += v[i] * v[i]; }
            for (int o = 1; o < 64; o <<= 1) s += __shfl_xor(s, o);
            const float inv = rsqrtf(s * (1.0f / 1024.0f) + EPS);
            for (int i = 0; i < 16; ++i) XNS[(size_t)r * D + lane + 64 * i] = f2bf(v[i] * inv * prm.in[6][lane + 64 * i]); } }
#else
        rmsnorm_rows_bf16(prm.in[1], TS, prm.in[6], XNS);
#endif
    }
    SEAM(0);
    if (IN(1)) {
        pg8::Gemm g{XN, D, (const bf16_t*)(ws + OFF_WUP1), D, T, 2 * FF, D}; pg8::StaticOrder S; S.init(T, 2 * FF, G, bid);

#if DUPX == 5
        pg8::gemm_phase(c.lds, g, S, EpiSwiglu{PP, (LAS const float*)nullptr});
#endif
        TSTART(1); pg8::gemm_phase(c.lds, g, S, EpiSwiglu{PP, (LAS const float*)nullptr}); TSTOP(1);
        TSTART(2); sgemm<16, 2, D>(c.lds, XNS, D, (const bf16_t*)(ws + OFF_WUP1), D, FF, nullptr, nullptr, rm_up,
            [=](int r, int cc, float v0, float v1, float) { HS[(size_t)r * FF + cc] = f2bf(siluf_(v0) * v1); return 0.f; }, G / 2); TSTOP(2);
    }
    SEAM(1);
    if (IN(2)) {
        pg8::Gemm g{PP, FF, (const bf16_t*)(ws + OFF_WDN1), FF, T, D, FF}; pg8::StaticOrder S; S.init(T, D, G, bid);
        TSTART(10); pg8::gemm_phase(c.lds, g, S, EpiResid{prm.in[0], nullptr, nullptr, XB, SSQ, 0.5f}); TSTOP(10);
        const float* xs_in = prm.in[1];
        TSTART(2); sgemm<16, 1, FF, 2>(c.lds, HS, FF, (const bf16_t*)(ws + OFF_WDN1), FF, D, nullptr, SSQS, rm_id,
            [=](int r, int cc, float v0, float, float) {
#ifdef DIAG
            const float x = prm.in[0][(size_t)prow(r) * D + cc] + 0.5f * v0;
#else
            const float x = xs_in[(size_t)r * D + cc] + 0.5f * v0;
#endif
            YS[(size_t)r * D + cc] = x; XNS[(size_t)r * D + cc] = f2bf(x); return x; }); TSTOP(2);
    }
    SEAM(2);
    if (IN(3)) {
        pg8::Gemm g{XB, D, (const bf16_t*)(ws + OFF_WIN), D, T, NPP, D}; pg8::StaticOrder S; S.init(T, NPP, G, bid);

#if DUPX == 6
        pg8::gemm_phase(c.lds, g, S, EpiScaleBf16{PP, SSQ});
#endif
        LAS const float* linv = fill_inv(c.lds, SSQ); TSTART(11); pg8::gemm_phase(c.lds, g, S, EpiScaleBf16{PP, linv}); TSTOP(11);
        float* DTp = (float*)(ws + OFF_DT); float* DTs = (float*)(ws + OFF_DTS);
        TSTART(2);
        {
            const int t_ = otid(), wv = t_ >> 6, ln = t_ & 63, lr = ln & 15, kg = ln >> 4; const bf16_t* WDT = (const bf16_t*)(ws + OFF_WDT);
            for (int wt = bid * 8 + wv; wt < T / 16; wt += G * 8) {
                f32x4 a0 = (f32x4){0.f, 0.f, 0.f, 0.f}, a1 = a0; f32x4 sq[4][4];
#pragma unroll
                for (int r = 0; r < 4; ++r)
#pragma unroll
                    for (int i = 0; i < 4; ++i) sq[r][i] = *(const f32x4*)(SSQ + (size_t)(16 * wt + 4 * kg + r) * 16 + 4 * i);
                const bf16_t* ap = XB + (size_t)(16 * wt + lr) * D + 8 * kg; const bf16_t* bp = WDT + (size_t)lr * D + 8 * kg;
#pragma unroll 8
                for (int k = 0; k < D; k += 32) { const bf16x8 a = *(const bf16x8*)(ap + k), b0 = *(const bf16x8*)(bp + k), b1 = *(const bf16x8*)(bp + 16 * D + k);
                    a0 = __builtin_amdgcn_mfma_f32_16x16x32_bf16(a, b0, a0, 0, 0, 0); a1 = __builtin_amdgcn_mfma_f32_16x16x32_bf16(a, b1, a1, 0, 0, 0); }
#pragma unroll
                for (int r = 0; r < 4; ++r) { const int row = 16 * wt + 4 * kg + r; const f32x4 sm = (sq[r][0] + sq[r][1]) + (sq[r][2] + sq[r][3]); const float inv = rsqrtf(((sm[0] + sm[1]) + (sm[2] + sm[3])) * (1.0f / 1024.0f) + EPS); DTp[(size_t)row * 32 + lr] = a0[r] * inv; DTp[(size_t)row * 32 + 16 + lr] = a1[r] * inv; }
            }
        }
        TSTOP(2);
        TSTART(2); sgemm<32, 1, D>(c.lds, XNS, D, (const bf16_t*)(ws + OFF_WIN), D, 9216, SSQS, nullptr, rm_id,
            [=](int r, int cc, float v0, float, float inv) { PS[(size_t)r * 9216 + cc] = v0 * inv; return 0.f; }); TSTOP(2);
        TSTART(2); sgemm<32, 1, D>(c.lds, XNS, D, (const bf16_t*)(ws + OFF_WDT), D, 32, SSQS, nullptr, rm_id,
            [=](int r, int cc, float v0, float, float inv) { DTs[(size_t)r * 32 + cc] = v0 * inv; return 0.f; }); TSTOP(2);
    }
    SEAM(3);
    if (IN(4)) {
        for (int e = bid * 512 + tid; e < 8 * 3 * 2048; e += G * 512) {
            const int cc = e & 2047, r = (e >> 11) % 3, b = e / (3 * 2048); const size_t row = (size_t)b * SEQ + 2045 + r;
            if (cc < 1024) out[O_LCP + (size_t)(b * 3 + r) * D + cc] = bf2f(PP[row * NPP + cc]);
            else out[O_SCP + (size_t)(b * 3 + r) * 3072 + 2048 + (cc - 1024)] = bf2f(PP[row * NPP + 3072 + (cc - 1024)]); }

#if DUPX == 4
        for (int it = bid; it < 256; it += G) lru_chunk<false>(c, it >> 5, it & 31);
#endif
        TSTART(19); for (int it = bid; it < 256; it += G) bc_conv(c, it >> 5, it & 31); TSTOP(19);
        if (hi - lo > 1) xcd_barrier(xbar);
        TSTART(3); for (int it = bid; it < 256; it += G) lru_chunk<false>(c, it >> 5, it & 31); TSTOP(3);

#if DUPX == 3
        for (int it = bid; it < 256; it += G) ssd_seq(c, it >> 5, it & 31, prm.ph_lo == 0);
#endif


    }
    SEAM(4);
    if (IN(5)) {

#if DUPX == 2
        for (int it = bid; it < 256; it += G) lru_chunk<true>(c, it >> 5, it & 31, prm.ph_lo == 0);
#endif
        TSTART(4); for (int it = bid; it < 256; it += G) ssd_seq(c, it & 7, it >> 3); TSTOP(4);
        TSTART(5); for (int it = bid; it < 256; it += G) lru_final(c, it >> 5, it & 31); TSTOP(5);
        TSTART(2); for (int it = bid; it < 64; it += G) lru_sample(c, it >> 3, it & 7); TSTOP(2);
        TSTART(2); for (int it = bid; it < 256; it += G) ssd_sample(c, it >> 5, it & 31); TSTOP(2);
    }
    SEAM(5);
    if (IN(6)) { TSTART(8);
        {
        const float* YGS = (const float*)(ws + OFF_YGS); bf16_t* ABRS = (bf16_t*)(ws + OFF_ABRS);
        const int lane = tid & 63;
        for (int w = bid * 8 + (tid >> 6); w < TS * 4; w += G * 8) { const int r = w >> 2, gq = w & 3; const float* p = YGS + (size_t)r * 2048 + 512 * gq; float v[8]; float s = 0.f;
#pragma unroll
            for (int j = 0; j < 8; ++j) { v[j] = p[lane + 64 * j]; s += v[j] * v[j]; }
#pragma unroll
            for (int o = 1; o < 64; o <<= 1) s += __shfl_xor(s, o);
            const float inv = rsqrtf(s * (1.0f / 512.0f) + EPS);
#pragma unroll
            for (int j = 0; j < 8; ++j) ABRS[(size_t)r * 3072 + 1024 + 512 * gq + lane + 64 * j] = f2bf(v[j] * inv); }
        }
        LAS const float* linv = fill_inv(c.lds, SSQ);
        { pg8::Gemm g{XB, D, (const bf16_t*)(ws + OFF_WIN) + (size_t)4096 * D, D, T, 3072, D}; pg8::StaticOrder S; S.init(T, 3072, G, bid);
          pg8::gemm_phase(c.lds, g, S, EpiGatesA{PP, linv, GSSQ}); }
        { pg8::Gemm g{XB, D, (const bf16_t*)(ws + OFF_WIN) + (size_t)7168 * D, D, T, D, D}; pg8::StaticOrder S; S.init(T, D, G, bid);
          pg8::gemm_phase(c.lds, g, S, EpiSigmoid{XN, D, linv, prm.in[11]}); }
        { pg8::Gemm g{XB, D, (const bf16_t*)(ws + OFF_WIN) + (size_t)8192 * D, D, T, D, D}; pg8::StaticOrder S; S.init(T, D, G, bid);
          pg8::gemm_phase(c.lds, g, S, EpiSigmoid{PP + 3072, NPP, linv, prm.in[11] + 1024}); } TSTOP(8);
    }
    SEAM(6);
    if (IN(7)) { TSTART(6);
        const int lane = tid & 63;
        for (int r = bid * 8 + (tid >> 6); r < T; r += G * 8) {
            float s = (lane < 32) ? GSSQ[(size_t)r * 32 + lane] : 0.f;
            s += __shfl_xor(s, 1); s += __shfl_xor(s, 2); s += __shfl_xor(s, 4);
            const float i0 = rsqrtf(__shfl(s, 0) * (1.0f / 512.0f) + EPS), i1 = rsqrtf(__shfl(s, 8) * (1.0f / 512.0f) + EPS), i2 = rsqrtf(__shfl(s, 16) * (1.0f / 512.0f) + EPS), i3 = rsqrtf(__shfl(s, 24) * (1.0f / 512.0f) + EPS);
#pragma unroll
            for (int i = 0; i < 4; ++i) { const float inv = i == 0 ? i0 : (i == 1 ? i1 : (i == 2 ? i2 : i3));
                bf16_t* p = PP + (size_t)r * NPP + 1024 + 512 * i + 8 * lane; f32x4 a, bq; unpack8(*(const u32x4*)p, a, bq); *(u32x4*)p = pack8(a * inv, bq * inv); }
        }
    }
    TSTOP(6); SEAM(7);
    if (IN(8)) {
        TSTART(9); { pg8::Gemm g{PP, NPP, (const bf16_t*)(ws + OFF_WBR), 3072, T, D, D}; pg8::StaticOrder S; S.init(T, D, G, bid); pg8::gemm_phase(c.lds, g, S, EpiBr{XN, PP, 0}); }
        { pg8::Gemm g{PP + 1024, NPP, (const bf16_t*)(ws + OFF_WBR) + 1024, 3072, T, D, 2048}; pg8::StaticOrder S; S.init(T, D, G, bid); pg8::gemm_phase(c.lds, g, S, EpiBr{XN, PP, 1}); } TSTOP(9);
        const bf16_t* ABRS = (const bf16_t*)(ws + OFF_ABRS); float* M1S = (float*)(ws + OFF_M1S); bf16_t* MS = (bf16_t*)(ws + OFF_MS); const float* bg = prm.in[11];
        TSTART(2); sgemm<16, 1, D, 4>(c.lds, ABRS, 3072, (const bf16_t*)(ws + OFF_WBR), 3072, D, nullptr, nullptr, rm_id,
            [=](int r, int cc, float v0, float, float) { M1S[(size_t)r * D + cc] = sigmoidf_(PS[(size_t)r * 9216 + 7168 + cc] + bg[cc]) * v0; return 0.f; }); TSTOP(2);
        TSTART(2); sgemm<16, 1, 2048, 4>(c.lds, ABRS + 1024, 3072, (const bf16_t*)(ws + OFF_WBR) + 1024, 3072, D, nullptr, nullptr, rm_id,
            [=](int r, int cc, float v0, float, float) { MS[(size_t)r * D + cc] = f2bf(M1S[(size_t)r * D + cc] + sigmoidf_(PS[(size_t)r * 9216 + 8192 + cc] + bg[1024 + cc]) * v0); return 0.f; }); TSTOP(2);
    }
    SEAM(8);
    if (IN(9)) {
        pg8::Gemm g{XN, D, (const bf16_t*)(ws + OFF_WOUT), D, T, D, D}; pg8::StaticOrder S; S.init(T, D, G, bid);
        TSTART(16); pg8::gemm_phase(c.lds, g, S, EpiResid{nullptr, XB, nullptr, XB, SSQ, 1.0f}); TSTOP(16);
        const bf16_t* MS = (const bf16_t*)(ws + OFF_MS);
        TSTART(2); sgemm<16, 1, D, 4>(c.lds, MS, D, (const bf16_t*)(ws + OFF_WOUT), D, D, nullptr, SSQS + 8192, rm_id,
            [=](int r, int cc, float v0, float, float) { const float x = YS[(size_t)r * D + cc] + v0; YS[(size_t)r * D + cc] = x; XNS[(size_t)r * D + cc] = f2bf(x); return x; }); TSTOP(2);
    }
    SEAM(9);
    if (IN(10)) {
        pg8::Gemm g{XB, D, (const bf16_t*)(ws + OFF_WUP2), D, T, 2 * FF, D}; pg8::StaticOrder S; S.init(T, 2 * FF, G, bid);
        LAS const float* linv = fill_inv(c.lds, SSQ);
        TSTART(17); pg8::gemm_phase(c.lds, g, S, EpiSwiglu{PP, linv}); TSTOP(17);
        TSTART(2); sgemm<16, 2, D>(c.lds, XNS, D, (const bf16_t*)(ws + OFF_WUP2), D, FF, SSQS + 8192, nullptr, rm_up,
            [=](int r, int cc, float v0, float v1, float inv) { HS[(size_t)r * FF + cc] = f2bf(siluf_(v0 * inv) * (v1 * inv)); return 0.f; }, G / 2); TSTOP(2);
    }
    SEAM(10);
    if (IN(11)) {
        pg8::Gemm g{PP, FF, (const bf16_t*)(ws + OFF_WDN2), FF, T, D, FF}; pg8::StaticOrder S; S.init(T, D, G, bid);
        TSTART(18); pg8::gemm_phase(c.lds, g, S, EpiResid{nullptr, XB, out + O_YP, nullptr, SSQ, 0.5f}); TSTOP(18);
        TSTART(2); sgemm<16, 1, FF, 2>(c.lds, HS, FF, (const bf16_t*)(ws + OFF_WDN2), FF, D, nullptr, nullptr, rm_id,
            [=](int r, int cc, float v0, float, float) { YS[(size_t)r * D + cc] += 0.5f * v0; return 0.f; }); TSTOP(2);
    }
    SEAM(11);
    if (IN(12)) {
        TSTART(7); rmsnorm_rows_f32(out + O_YP, T + TS, prm.in[31]); TSTOP(7);
    }
#ifdef TIMER_ID
    if (hi == 13) { ++nbar; grid_barrier(barctr, nbar * (unsigned)G);
        if (bid == TIMER_BLOCK) { const float us = (float)tacc_ * 0.0001f; for (int e = tid; e < TS * D; e += 512) YS[e] = us; } }
#endif
#undef IN
#undef SEAM
}

#ifndef N_LAUNCH_MODE
#define N_LAUNCH_MODE 1
#endif
extern "C" void kernel_launch(void* const* d_in, const int* in_sizes, int n_in, void* d_out, int out_size, void* d_ws, size_t ws_size, hipStream_t stream) {
    static int grid = 0;
    if (grid == 0) {
        if (n_in != 32 || ws_size < OFF_XBAR + XCD_BAR_WORDS * 4) { fprintf(stderr, "kernel_launch: unexpected n_in %d or ws_size %zu (< %zu)\n", n_in, ws_size, (size_t)WS_END); grid = -1; return; }
        int dev = 0, cus = 0, per_cu = 0;
        hipGetDevice(&dev); hipDeviceGetAttribute(&cus, hipDeviceAttributeMultiprocessorCount, dev);
        if (hipFuncSetAttribute((const void*)fwd_kernel, hipFuncAttributeMaxDynamicSharedMemorySize, LDS_BYTES) != hipSuccess) { fprintf(stderr, "kernel_launch: hipFuncSetAttribute failed\n"); grid = -1; return; }
        hipOccupancyMaxActiveBlocksPerMultiprocessor(&per_cu, (const void*)fwd_kernel, 512, LDS_BYTES);
        if (per_cu < 1) { fprintf(stderr, "kernel_launch: occupancy query says %d blocks per CU\n", per_cu); per_cu = 1; }
        grid = cus * 1;
        (void)hipGetLastError();
    }
    if (grid < 0) return;
    Params p{};
    for (int i = 0; i < 32; ++i) p.in[i] = (const float*)d_in[i];
    p.out = (float*)d_out; p.ws = (unsigned char*)d_ws;
#if N_LAUNCH_MODE == 0
    for (int ph = 0; ph < 13; ++ph) { p.ph_lo = ph; p.ph_hi = ph + 1; hipLaunchKernelGGL(fwd_kernel, dim3(grid), dim3(512), LDS_BYTES, stream, p);
#ifdef DIAG
        int st = -1; if (ph == 2) st = 0; if (ph == 3) st = 1; if (ph == 6) st = 8; if (ph == 7) st = 3; if (ph == 8) st = 5; if (ph == 9) st = 6; if (ph == 11) st = 7; if (ph == 12) st = 20;
        if (st >= 0) { p.ph_lo = 100 + st; p.ph_hi = 0; hipLaunchKernelGGL(fwd_kernel, dim3(grid), dim3(512), LDS_BYTES, stream, p); }
#endif
    }
#else
    p.ph_lo = 0; p.ph_hi = 13;
    hipMemsetAsync((char*)d_ws + OFF_XBAR, 0, XCD_BAR_WORDS * 4, stream);
    void* args[] = {&p};
    hipError_t e = hipLaunchCooperativeKernel((const void*)fwd_kernel, dim3(grid), dim3(512), args, LDS_BYTES, stream);
    if (e != hipSuccess) fprintf(stderr, "cooperative launch failed: %s (grid %d)\n", hipGetErrorString(e), grid);
#endif
}
```

```cpp
#include <hip/hip_runtime.h>
#include <hip/hip_cooperative_groups.h>
#include <cstdio>
namespace cg = cooperative_groups;

#define LAS __attribute__((address_space(3)))
typedef unsigned short bf16_t;
typedef short bf16x8 __attribute__((ext_vector_type(8)));
typedef float f32x4 __attribute__((ext_vector_type(4)));
typedef unsigned u32x4 __attribute__((ext_vector_type(4)));

constexpr int T = 16384, TS = 128, D = 1024, FF = 2816, NPP = 4096, SEQ = 2048, NCH = 32;
constexpr float EPS = 1e-6f;
constexpr size_t OFF_WUP1 = 0, OFF_WDN1 = 11534336;
constexpr size_t OFF_DT = 0, OFF_SUMM = 2097152, OFF_HALO = 4194304, OFF_GSSQ = 5767168, OFF_PS = 7864320,
                 OFF_DTS = 12582912, OFF_YGS = 12599296, OFF_ABRS = 13647872, OFF_M1S = 14434304, OFF_MS = 14958592;
constexpr size_t OFF_WIN = 17301504, OFF_WDT = 36175872, OFF_WBR = 36241408, OFF_WOUT = 42532864, OFF_WUP2 = 44630016,
                 OFF_WDN2 = 56164352, OFF_WRG = 61931520, OFF_WIG = 62193664, OFF_XB = 62455808, OFF_XN = 96010240,
                 OFF_PP = 129564672, OFF_SSQ = 263782400, OFF_XNS = 264830976, OFF_HS = 265093120, WS_END = 265814016;
constexpr size_t O_YP = 0, O_YS = 16777216, O_LCP = 16908288, O_LHP = 16932864, O_SCP = 16941056, O_SHP = 17014784,
                 O_LCS = 19111936, O_LHS = 19136512, O_SCS = 19144704, O_SHS = 19218432;
constexpr int LDS_BYTES = 143360;
constexpr int LDS_INV = 131072;

struct Params { const float* in[32]; float* out; unsigned char* ws; int ph_lo, ph_hi; };

#ifdef DIAG
#define SZ(x) 0.0f
#ifndef DIAG_TOL
#define DIAG_TOL 0.01f
#endif
#else
#define SZ(x) (x)
#endif
#define A256(base, row, chunk) ((base) + (row) * 256 + 16 * ((chunk) ^ ((row) & 15)))
#define A128(base, row, chunk) ((base) + (row) * 128 + 16 * ((chunk) ^ ((((row) >> 1) ^ ((row) >> 3)) & 7)))
__device__ __forceinline__ int otid() { int t = threadIdx.x; asm volatile("" : "+v"(t)); return t; }
__device__ __forceinline__ unsigned cvt_pk_bf16(float lo, float hi) { unsigned r; asm volatile("v_cvt_pk_bf16_f32 %0, %1, %2" : "=v"(r) : "v"(lo), "v"(hi)); return r; }
__device__ __forceinline__ bf16_t f2bf(float f) { return (bf16_t)(cvt_pk_bf16(f, 0.f) & 0xffffu); }
__device__ __forceinline__ float bf2f(bf16_t b) { return __uint_as_float(((unsigned)b) << 16); }
__device__ __forceinline__ float bflo(unsigned w) { return __uint_as_float(w << 16); }
__device__ __forceinline__ float bfhi(unsigned w) { return __uint_as_float(w & 0xffff0000u); }
__device__ __forceinline__ float sigmoidf_(float x) { return __builtin_amdgcn_rcpf(1.0f + __expf(-x)); }
__device__ __forceinline__ float siluf_(float x) { return x * sigmoidf_(x); }
__device__ __forceinline__ float gelu_tanh(float x) { const float u = 0.7978845608028654f * (x + 0.044715f * x * x * x); return x * sigmoidf_(2.0f * u); }
__device__ __forceinline__ float softplusf_(float x) { return x > 20.f ? x : log1pf(__expf(x)); }
__device__ __forceinline__ u32x4 pack8(const f32x4 a, const f32x4 b) { u32x4 w; w.x = cvt_pk_bf16(a[0], a[1]); w.y = cvt_pk_bf16(a[2], a[3]); w.z = cvt_pk_bf16(b[0], b[1]); w.w = cvt_pk_bf16(b[2], b[3]); return w; }
__device__ __forceinline__ void unpack8(const u32x4 w, f32x4& a, f32x4& b) { a[0] = bflo(w.x); a[1] = bfhi(w.x); a[2] = bflo(w.y); a[3] = bfhi(w.y); b[0] = bflo(w.z); b[1] = bfhi(w.z); b[2] = bflo(w.w); b[3] = bfhi(w.w); }
__device__ __forceinline__ float rowinv16(const float* ssq, int row) {
    const f32x4* p = (const f32x4*)(ssq + (size_t)row * 16); const f32x4 a = p[0], b = p[1], c = p[2], d = p[3];
    const float s = ((a[0] + a[1]) + (a[2] + a[3])) + ((b[0] + b[1]) + (b[2] + b[3])) + ((c[0] + c[1]) + (c[2] + c[3])) + ((d[0] + d[1]) + (d[2] + d[3]));
    return rsqrtf(s * (1.0f / 1024.0f) + EPS);
}

namespace pg8 {
constexpr int BM = 256, BK = 64, HALF = 128, HTB = HALF * BK * 2, STAGE_BYTES = 8 * HTB, NXCD = 8, WGM = 8;
__device__ __forceinline__ int lds_byte(int r, int c) { const int st = (r >> 4) * 2 + (c >> 5), rr = r & 15, cc = c & 31, ob = rr * 64 + cc * 2; return st * 1024 + (ob ^ (((ob >> 9) & 1) << 5)); }
__device__ __forceinline__ void stage_rc(int b, int& R, int& C) { const int st = b / 1024, sb = b % 1024, swz = sb ^ (((sb >> 9) & 1) << 5); R = (st >> 1) * 16 + swz / 64; C = (st & 1) * 32 + (swz % 64) / 2; }
__device__ __forceinline__ int perm32(int rho) { const int n = rho >> 4, i = rho & 15; return 8 * (i >> 2) + 4 * n + (i & 3); }
struct Unit { int pm, pn; };
struct Gemm { const bf16_t* A; int lda; const bf16_t* Bt; int ldb; int M, N, K; };
struct StaticOrder {
    int nM, nN, nwg, G, c;
    __device__ __forceinline__ void init(int M, int N, int G_, int c_) { nM = M / BM; nN = N / BM; nwg = nM * nN; G = G_; c = c_; }
    __device__ __forceinline__ bool next(int i, Unit& u) const {
        const long L = (long)i * G + c; if (L >= nwg) return false;
        int wgid = (int)L; { const int q = nwg / NXCD, r = nwg % NXCD, xcd = wgid % NXCD, off = wgid / NXCD; wgid = (xcd < r ? xcd * (q + 1) : r * (q + 1) + (xcd - r) * q) + off; }
        const int nig = WGM * nN, gid = wgid / nig, fm = gid * WGM, gsz = (nM - fm) < WGM ? (nM - fm) : WGM;
        u.pm = fm + ((wgid % nig) % gsz); u.pn = (wgid % nig) / gsz; return true;
    }
};
template <class Epi>
__device__ __forceinline__ void gemm_phase(LAS unsigned char* lds, const Gemm g, const StaticOrder& S, const Epi& E) {
    const int tid = otid(), wid = __builtin_amdgcn_readfirstlane(tid >> 6), lane = tid & 63, wr = wid >> 2, wc = wid & 3, fr = lane & 15, fq = lane >> 4;
    const int K = g.K, nt = K / BK;
    unsigned voffA[2], voffB[2];
#pragma unroll
    for (int i = 0; i < 2; ++i) { int R, C; stage_rc(tid * 16 + i * 8192, R, C); const int Rb = (R & ~31) + perm32(R & 31);
        voffA[i] = (unsigned)(R * g.lda + C) * 2u; voffB[i] = (unsigned)(Rb * g.ldb + C) * 2u; }
    const size_t kstep = (size_t)(BK * 2);
    const size_t hstepA = (size_t)HALF * g.lda * 2, hstepB = (size_t)HALF * g.ldb * 2;
    const size_t tstepA = 2 * hstepA, tstepB = 2 * hstepB;
    const unsigned ldsw = (unsigned)wid * 1024u;
    const int aoff = lds_byte(wr * 64 + fr, fq * 8), boff = lds_byte(wc * 32 + fr, fq * 8);
#define PG8_SA(b, h) (((b) * 2 + (h)) * HTB)
#define PG8_SB(b, h) ((4 + (b) * 2 + (h)) * HTB)
#define PG8_STAGE(bufoff, gbase, voff) do { _Pragma("unroll") for (int _i = 0; _i < 2; ++_i) \
        __builtin_amdgcn_global_load_lds((const unsigned*)((const char*)(gbase) + (voff)[_i]), (LAS unsigned*)(lds + (bufoff) + ldsw + _i * 8192), 16, 0, 0); } while (0)
#define PG8_LDA(dst, b, h) do { _Pragma("unroll") for (int m = 0; m < 4; ++m) _Pragma("unroll") for (int k = 0; k < 2; ++k) dst[m][k] = *(const LAS bf16x8*)(lds + PG8_SA(b, h) + aoff + m * 2048 + k * 1024); } while (0)
#define PG8_LDB(dst, b, h) do { _Pragma("unroll") for (int n = 0; n < 2; ++n) _Pragma("unroll") for (int k = 0; k < 2; ++k) dst[n][k] = *(const LAS bf16x8*)(lds + PG8_SB(b, h) + boff + n * 2048 + k * 1024); } while (0)
#define PG8_MMA(ai, bj, At, Bt) do { __builtin_amdgcn_s_setprio(1); _Pragma("unroll") for (int m = 0; m < 4; ++m) _Pragma("unroll") for (int n = 0; n < 2; ++n) _Pragma("unroll") for (int k = 0; k < 2; ++k) \
        acc[ai][bj][m][n] = __builtin_amdgcn_mfma_f32_16x16x32_bf16(Bt[n][k], At[m][k], acc[ai][bj][m][n], 0, 0, 0); __builtin_amdgcn_s_setprio(0); } while (0)
#define PG8_WAIT_V(n) asm volatile("s_waitcnt vmcnt(" #n ")" ::: "memory")
#define PG8_WAIT_L(n) asm volatile("s_waitcnt lgkmcnt(" #n ")" ::: "memory")
#define PG8_BAR __builtin_amdgcn_s_barrier()
#define PG8_SCHED __builtin_amdgcn_sched_barrier(0)
    Unit cur, nxt; int ui = 0;
    if (!S.next(0, cur)) return;
    f32x4 acc[2][2][4][2];
#pragma unroll
    for (int a = 0; a < 2; ++a)
#pragma unroll
        for (int b = 0; b < 2; ++b)
#pragma unroll
            for (int m = 0; m < 4; ++m)
#pragma unroll
                for (int n = 0; n < 2; ++n) acc[a][b][m][n] = (f32x4){0.f, 0.f, 0.f, 0.f};
    bf16x8 At[4][2], B0[2][2], B1[2][2];
    const char* cA = (const char*)g.A + (size_t)cur.pm * tstepA; const char* cB = (const char*)g.Bt + (size_t)cur.pn * tstepB;
    PG8_STAGE(PG8_SB(0, 0), cB, voffB); PG8_STAGE(PG8_SA(0, 0), cA, voffA); PG8_STAGE(PG8_SB(0, 1), cB + hstepB, voffB); PG8_STAGE(PG8_SA(0, 1), cA + hstepA, voffA);
    if (wr == 1) PG8_BAR;
    PG8_WAIT_V(4); PG8_BAR;
    PG8_STAGE(PG8_SB(1, 0), cB + kstep, voffB); PG8_STAGE(PG8_SA(1, 0), cA + kstep, voffA); PG8_STAGE(PG8_SB(1, 1), cB + hstepB + kstep, voffB);
    PG8_WAIT_V(6); PG8_BAR;
    for (;;) {
        const bool has_next = S.next(ui + 1, nxt);
        const char* nA = has_next ? (const char*)g.A + (size_t)nxt.pm * tstepA : cA; const char* nB = has_next ? (const char*)g.Bt + (size_t)nxt.pn * tstepB : cB;
        for (int t = 0; t < nt; t += 2) {
            const bool last = (t == nt - 2);
            const char* a1 = cA + (size_t)(t + 1) * kstep;
            const char* a2 = last ? nA : cA + (size_t)(t + 2) * kstep; const char* b2 = last ? nB : cB + (size_t)(t + 2) * kstep;
            const char* a3 = a2 + kstep; const char* b3 = b2 + kstep;
            PG8_LDB(B0, 0, 0); PG8_SCHED; PG8_LDA(At, 0, 0); PG8_STAGE(PG8_SA(1, 1), a1 + hstepA, voffA);
            PG8_WAIT_L(8); PG8_BAR; PG8_WAIT_L(0); PG8_MMA(0, 0, At, B0); PG8_BAR; PG8_SCHED;
            PG8_LDB(B1, 0, 1); PG8_STAGE(PG8_SB(0, 0), b2, voffB);
            PG8_BAR; PG8_WAIT_L(0); PG8_MMA(0, 1, At, B1); PG8_BAR;
            PG8_LDA(At, 0, 1); PG8_STAGE(PG8_SA(0, 0), a2, voffA);
            PG8_BAR; PG8_WAIT_L(0); PG8_MMA(1, 0, At, B0); PG8_BAR; PG8_SCHED;
            PG8_STAGE(PG8_SB(0, 1), b2 + hstepB, voffB);
            PG8_WAIT_V(6); PG8_BAR; PG8_MMA(1, 1, At, B1); PG8_BAR;
            PG8_LDB(B0, 1, 0); PG8_SCHED; PG8_LDA(At, 1, 0); PG8_STAGE(PG8_SA(0, 1), a2 + hstepA, voffA);
            PG8_WAIT_L(8); PG8_BAR; PG8_WAIT_L(0); PG8_MMA(0, 0, At, B0); PG8_BAR; PG8_SCHED;
            PG8_LDB(B1, 1, 1); PG8_STAGE(PG8_SB(1, 0), b3, voffB);
            PG8_BAR; PG8_WAIT_L(0); PG8_MMA(0, 1, At, B1); PG8_BAR;
            PG8_LDA(At, 1, 1); PG8_STAGE(PG8_SA(1, 0), a3, voffA);
            PG8_BAR; PG8_WAIT_L(0); PG8_MMA(1, 0, At, B0); PG8_BAR; PG8_SCHED;
            PG8_STAGE(PG8_SB(1, 1), b3 + hstepB, voffB);
            PG8_WAIT_V(6); PG8_BAR; PG8_MMA(1, 1, At, B1); PG8_BAR;
        }
        E(acc, cur, wr, wc, fr, fq);
        if (!has_next) break;
#pragma unroll
        for (int a = 0; a < 2; ++a)
#pragma unroll
            for (int b = 0; b < 2; ++b)
#pragma unroll
                for (int m = 0; m < 4; ++m)
#pragma unroll
                    for (int n = 0; n < 2; ++n) acc[a][b][m][n] = (f32x4){0.f, 0.f, 0.f, 0.f};
        cur = nxt; cA = nA; cB = nB; ++ui;
    }
    PG8_WAIT_V(0);
    if (wr == 0) PG8_BAR;
    PG8_BAR;
#undef PG8_SA
#undef PG8_SB
#undef PG8_STAGE
#undef PG8_LDA
#undef PG8_LDB
#undef PG8_MMA
#undef PG8_WAIT_V
#undef PG8_WAIT_L
#undef PG8_BAR
#undef PG8_SCHED
}
}
typedef f32x4 Acc[2][2][4][2];

__device__ __forceinline__ LAS const float* fill_inv(LAS unsigned char* lds, const float* ssq) {
    LAS float* t = (LAS float*)(lds + LDS_INV); const int base = 2048 * (blockIdx.x & 7);
    for (int r = otid(); r < 2048; r += 512) t[r] = rowinv16(ssq, base + r);
    __syncthreads();
    return t;
}
struct EpiSwiglu {
    bf16_t* H; LAS const float* linv;
    __device__ __forceinline__ void operator()(const Acc& acc, const pg8::Unit& u, int wr, int wc, int fr, int fq) const {
        const int row0 = u.pm * 256 + wr * 64 + fr, col = u.pn * 128 + wc * 32 + 8 * fq;
#pragma unroll
        for (int ai = 0; ai < 2; ++ai)
#pragma unroll
            for (int m = 0; m < 4; ++m) {
                const int row = row0 + ai * 128 + m * 16; const float inv = linv ? linv[row & 2047] : 1.0f;
                f32x4 h0, h1;
#pragma unroll
                for (int j = 0; j < 4; ++j) { h0[j] = siluf_(acc[ai][0][m][0][j] * inv) * (acc[ai][1][m][0][j] * inv); h1[j] = siluf_(acc[ai][0][m][1][j] * inv) * (acc[ai][1][m][1][j] * inv); }
                *(u32x4*)(H + (size_t)row * FF + col) = pack8(h0, h1);
            }
    }
};
struct EpiResid {
    const float* xin; const bf16_t* xin_b; float* xout; bf16_t* xb; float* ssq; float alpha;
    __device__ __forceinline__ void operator()(const Acc& acc, const pg8::Unit& u, int wr, int wc, int fr, int fq) const {
        const int row0 = u.pm * 256 + wr * 64 + fr, col0 = u.pn * 256 + wc * 32 + 8 * fq;
#pragma unroll
        for (int ai = 0; ai < 2; ++ai) {
            f32x4 xv[4][2][2];
#pragma unroll
            for (int m = 0; m < 4; ++m)
#pragma unroll
                for (int bj = 0; bj < 2; ++bj) { const size_t o = (size_t)(row0 + ai * 128 + m * 16) * D + col0 + bj * 128;
                    if (xin_b) unpack8(*(const u32x4*)(xin_b + o), xv[m][bj][0], xv[m][bj][1]);
                    else { xv[m][bj][0] = *(const f32x4*)(xin + o); xv[m][bj][1] = *(const f32x4*)(xin + o + 4); } }
#pragma unroll
            for (int m = 0; m < 4; ++m) {
                const int row = row0 + ai * 128 + m * 16; float ss = 0.f;
#pragma unroll
                for (int bj = 0; bj < 2; ++bj) {
                    const size_t o = (size_t)row * D + col0 + bj * 128;
                    const f32x4 v0 = xv[m][bj][0] + alpha * acc[ai][bj][m][0], v1 = xv[m][bj][1] + alpha * acc[ai][bj][m][1];
                    if (xout) { *(f32x4*)(xout + o) = v0; *(f32x4*)(xout + o + 4) = v1; }
                    ss += (v0[0] * v0[0] + v0[1] * v0[1]) + (v0[2] * v0[2] + v0[3] * v0[3]) + (v1[0] * v1[0] + v1[1] * v1[1]) + (v1[2] * v1[2] + v1[3] * v1[3]);
                    if (xb) *(u32x4*)(xb + o) = pack8(v0, v1);
                }
                ss += __shfl_xor(ss, 16); ss += __shfl_xor(ss, 32);
                if (fq == 0) ssq[(size_t)row * 16 + u.pn * 4 + wc] = ss;
            }
        }
    }
};
struct EpiScaleBf16 {
    bf16_t* O; LAS const float* linv;
    __device__ __forceinline__ void operator()(const Acc& acc, const pg8::Unit& u, int wr, int wc, int fr, int fq) const {
        const int row0 = u.pm * 256 + wr * 64 + fr, col0 = u.pn * 256 + wc * 32 + 8 * fq;
#pragma unroll
        for (int ai = 0; ai < 2; ++ai)
#pragma unroll
            for (int m = 0; m < 4; ++m) {
                const int row = row0 + ai * 128 + m * 16; const float inv = linv[row & 2047];
#pragma unroll
                for (int bj = 0; bj < 2; ++bj) *(u32x4*)(O + (size_t)row * NPP + col0 + bj * 128) = pack8(acc[ai][bj][m][0] * inv, acc[ai][bj][m][1] * inv);
            }
    }
};
struct EpiGatesA {
    bf16_t* PP; LAS const float* linv; float* gssq;
    __device__ __forceinline__ void operator()(const Acc& acc, const pg8::Unit& u, int wr, int wc, int fr, int fq) const {
        const int row0 = u.pm * 256 + wr * 64 + fr, cw = wc * 32 + 8 * fq; const int pn = u.pn;
#pragma unroll
        for (int ai = 0; ai < 2; ++ai) {
            u32x4 sv[4][2];
#pragma unroll
            for (int m = 0; m < 4; ++m)
#pragma unroll
                for (int bj = 0; bj < 2; ++bj) sv[m][bj] = *(const u32x4*)(PP + (size_t)(row0 + ai * 128 + m * 16) * NPP + pn * 256 + bj * 128 + cw);
#pragma unroll
            for (int m = 0; m < 4; ++m) {
                const int row = row0 + ai * 128 + m * 16; const float inv = linv[row & 2047]; float ss = 0.f;
#pragma unroll
                for (int bj = 0; bj < 2; ++bj) {
                    const f32x4 a0 = acc[ai][bj][m][0] * inv, a1 = acc[ai][bj][m][1] * inv; f32x4 o0, o1;
                    bf16_t* p = PP + (size_t)row * NPP + pn * 256 + bj * 128 + cw; f32x4 s0, s1; unpack8(sv[m][bj], s0, s1);
                    if (pn < 4) {
#pragma unroll
                        for (int j = 0; j < 4; ++j) { o0[j] = gelu_tanh(a0[j]) * s0[j]; o1[j] = gelu_tanh(a1[j]) * s1[j]; }
                    } else {
#pragma unroll
                        for (int j = 0; j < 4; ++j) { o0[j] = siluf_(a0[j]) * s0[j]; o1[j] = siluf_(a1[j]) * s1[j]; ss += o0[j] * o0[j] + o1[j] * o1[j]; }
                    }
                    *(u32x4*)p = pack8(o0, o1);
                }
                if (pn >= 4) { ss += __shfl_xor(ss, 16); ss += __shfl_xor(ss, 32); if (fq == 0) gssq[(size_t)row * 32 + (pn - 4) * 4 + wc] = ss; }
            }
        }
    }
};
struct EpiSigmoid {
    bf16_t* O; int ldo; LAS const float* linv; const float* bias;
    __device__ __forceinline__ void operator()(const Acc& acc, const pg8::Unit& u, int wr, int wc, int fr, int fq) const {
        const int row0 = u.pm * 256 + wr * 64 + fr, col0 = u.pn * 256 + wc * 32 + 8 * fq;
#pragma unroll
        for (int ai = 0; ai < 2; ++ai)
#pragma unroll
            for (int m = 0; m < 4; ++m) {
                const int row = row0 + ai * 128 + m * 16; const float inv = linv[row & 2047];
#pragma unroll
                for (int bj = 0; bj < 2; ++bj) {
                    const int gc = col0 + bj * 128;
                    const f32x4 a0 = acc[ai][bj][m][0] * inv, a1 = acc[ai][bj][m][1] * inv; f32x4 o0, o1;
                    const f32x4 b0 = *(const f32x4*)(bias + gc), b1 = *(const f32x4*)(bias + gc + 4);
#pragma unroll
                    for (int j = 0; j < 4; ++j) { o0[j] = sigmoidf_(a0[j] + b0[j]); o1[j] = sigmoidf_(a1[j] + b1[j]); }
                    *(u32x4*)(O + (size_t)row * ldo + gc) = pack8(o0, o1);
                }
            }
    }
};
struct EpiBr {
    bf16_t* GA; const bf16_t* PP; int mode;
    __device__ __forceinline__ void operator()(const Acc& acc, const pg8::Unit& u, int wr, int wc, int fr, int fq) const {
        const int row0 = u.pm * 256 + wr * 64 + fr, col0 = u.pn * 256 + wc * 32 + 8 * fq;
#pragma unroll
        for (int ai = 0; ai < 2; ++ai) {
            u32x4 gv[4][2], hv[4][2];
#pragma unroll
            for (int m = 0; m < 4; ++m)
#pragma unroll
                for (int bj = 0; bj < 2; ++bj) { const int row = row0 + ai * 128 + m * 16; gv[m][bj] = *(const u32x4*)(GA + (size_t)row * D + col0 + bj * 128);
                    hv[m][bj] = (mode == 0) ? (u32x4){0u, 0u, 0u, 0u} : *(const u32x4*)(PP + (size_t)row * NPP + 3072 + col0 + bj * 128); }
#pragma unroll
            for (int m = 0; m < 4; ++m) {
                const int row = row0 + ai * 128 + m * 16;
#pragma unroll
                for (int bj = 0; bj < 2; ++bj) {
                    bf16_t* p = GA + (size_t)row * D + col0 + bj * 128; f32x4 g0, g1; unpack8(gv[m][bj], g0, g1);
                    if (mode == 0) { *(u32x4*)p = pack8(g0 * acc[ai][bj][m][0], g1 * acc[ai][bj][m][1]); }
                    else { f32x4 h0, h1; unpack8(hv[m][bj], h0, h1); *(u32x4*)p = pack8(g0 + h0 * acc[ai][bj][m][0], g1 + h1 * acc[ai][bj][m][1]); }
                }
            }
        }
    }
};

template <int NC, int NB, int K, class RM, class F>
__device__ __forceinline__ void small_gemm(LAS unsigned char* lds, const bf16_t* A, int lda, int M, const bf16_t* Bt, int ldb, int N,
                                           const float* rs_src, int rs_mode, RM rm, F f) {
    const int tid = otid(), wid = tid >> 6, lane = tid & 63, lr = lane & 15, kg = lane >> 4;
    LAS float* red = (LAS float*)lds;
    LAS float* invs = (LAS float*)(lds + 131072);
    const int nct = N / NC, items = (M / 16) * nct; constexpr int kw = K / 8;
    constexpr int CT = NC / 16;
    const int nrt = M / 16; const bool hoist = (rs_mode == 1) && (gridDim.x % nrt == 0); const int bix = gridDim.x - 1 - blockIdx.x;
    for (int it = bix; it < items; it += gridDim.x) {
        const int rt = it % nrt, ct = it / nrt, row0 = rt * 16, col0 = ct * NC;
        if (rs_mode == 1) { if (!(hoist && it != bix)) { const int r = tid >> 5, q = tid & 31; const float* p = rs_src + (size_t)(row0 + r) * D + q * 32; float s = 0.f;
            for (int j = 0; j < 32; j += 4) { const f32x4 v = *(const f32x4*)(p + j); s += v[0] * v[0] + v[1] * v[1] + v[2] * v[2] + v[3] * v[3]; }
            s += __shfl_xor(s, 1); s += __shfl_xor(s, 2); s += __shfl_xor(s, 4); s += __shfl_xor(s, 8); s += __shfl_xor(s, 16);
            if (q == 0) invs[r] = rsqrtf(s * (1.0f / 1024.0f) + EPS); } }
        else if (rs_mode == 2) { if (tid < 16) invs[tid] = rowinv16(rs_src, row0 + tid); }
        else { if (tid < 16) invs[tid] = 1.0f; }
        f32x4 acc[NB][CT];
#pragma unroll
        for (int p = 0; p < NB; ++p)
#pragma unroll
            for (int c = 0; c < CT; ++c) acc[p][c] = (f32x4){0.f, 0.f, 0.f, 0.f};
        const bf16_t* ap = A + (size_t)(row0 + lr) * lda + wid * kw + 8 * kg;
        const bf16_t* bp0 = Bt + (size_t)(rm(col0, 0) + lr) * ldb + wid * kw + 8 * kg;
        const bf16_t* bp1 = NB > 1 ? Bt + (size_t)(rm(col0, 1) + lr) * ldb + wid * kw + 8 * kg : bp0;
#pragma unroll
        for (int k = 0; k < kw; k += 32) {
            const bf16x8 a = *(const bf16x8*)(ap + k);
#pragma unroll
            for (int c = 0; c < CT; ++c) {
                const bf16x8 b = *(const bf16x8*)(bp0 + (size_t)c * 16 * ldb + k);
                acc[0][c] = __builtin_amdgcn_mfma_f32_16x16x32_bf16(a, b, acc[0][c], 0, 0, 0);
                if (NB > 1) { const bf16x8 b1 = *(const bf16x8*)(bp1 + (size_t)c * 16 * ldb + k); acc[NB - 1][c] = __builtin_amdgcn_mfma_f32_16x16x32_bf16(a, b1, acc[NB - 1][c], 0, 0, 0); }
            }
        }
#pragma unroll
        for (int p = 0; p < NB; ++p)
#pragma unroll
            for (int c = 0; c < CT; ++c)
#pragma unroll
                for (int r = 0; r < 4; ++r) red[((wid * NB + p) * 16 + 4 * kg + r) * NC + 16 * c + lr] = acc[p][c][r];
        __syncthreads();
        for (int e = tid; e < 16 * NC; e += 512) {
            float v0 = 0.f, v1 = 0.f;
#pragma unroll
            for (int w = 0; w < 8; ++w) { v0 += red[(w * NB) * 16 * NC + e]; if (NB > 1) v1 += red[(w * NB + 1) * 16 * NC + e]; }
            const int r = e / NC, c = e % NC;
            f(row0 + r, col0 + c, v0, v1, invs[r]);
        }
        __syncthreads();
    }
}

template <int NC, int NB, int K, int RT = 8, class RM, class F>
__device__ __forceinline__ void sgemm(LAS unsigned char* lds, const bf16_t* A, int lda, const bf16_t* Bt, int ldb, int N, const float* ssq_src, float* ssq_out, RM rm, F f, int nblk = 0) {
    const int tid = otid(), wid = tid >> 6, lane = tid & 63, lr = lane & 15, kg = lane >> 4;
    constexpr int CT = NC / 16, KW = K / 8;
    LAS float* red = (LAS float*)lds;
    constexpr int RH = 8 / RT; const int items = (N / NC) * RH, bix = gridDim.x - 1 - blockIdx.x; if (nblk == 0) nblk = gridDim.x;
    LAS float* invs = (LAS float*)(lds + LDS_INV);
    if (bix < items && bix < nblk) {
        if (ssq_src) { const int row = tid >> 2, q = tid & 3; float sm = 0.f;
#pragma unroll
            for (int j = 0; j < 16; j += 4) { const f32x4 v = *(const f32x4*)(ssq_src + row * 64 + q * 16 + j); sm += (v[0] + v[1]) + (v[2] + v[3]); }
            sm += __shfl_xor(sm, 1); sm += __shfl_xor(sm, 2);
            if (q == 0) invs[row] = rsqrtf(sm * (1.0f / 1024.0f) + EPS); }
        else if (tid < 128) invs[tid] = 1.0f;
        __syncthreads();
    }
    for (int it = bix; it < items && bix < nblk; it += nblk) {
        const int ci = it / RH, col0 = ci * NC, rowb = (it % RH) * RT * 16;
        f32x4 acc[RT][NB][CT];
#pragma unroll
        for (int t = 0; t < RT; ++t)
#pragma unroll
            for (int p = 0; p < NB; ++p)
#pragma unroll
                for (int c = 0; c < CT; ++c) acc[t][p][c] = (f32x4){0.f, 0.f, 0.f, 0.f};
        const bf16_t* ap = A + (size_t)(rowb + lr) * lda + wid * KW + 8 * kg;
        const bf16_t* bp0 = Bt + (size_t)(rm(col0, 0) + lr) * ldb + wid * KW + 8 * kg;
        const bf16_t* bp1 = NB > 1 ? Bt + (size_t)(rm(col0, 1) + lr) * ldb + wid * KW + 8 * kg : bp0;
#pragma unroll (RT == 8 ? 4 : (RT == 4 ? (KW / 32 <= 8 ? 8 : 6) : 16))
        for (int k = 0; k < KW; k += 32) {
            bf16x8 bf[NB][CT];
#pragma unroll
            for (int c = 0; c < CT; ++c) { bf[0][c] = *(const bf16x8*)(bp0 + (size_t)c * 16 * ldb + k); if (NB > 1) bf[NB - 1][c] = *(const bf16x8*)(bp1 + (size_t)c * 16 * ldb + k); }
#pragma unroll
            for (int t = 0; t < RT; ++t) { const bf16x8 a = *(const bf16x8*)(ap + (size_t)t * 16 * lda + k);
#pragma unroll
                for (int p = 0; p < NB; ++p)
#pragma unroll
                    for (int c = 0; c < CT; ++c) acc[t][p][c] = __builtin_amdgcn_mfma_f32_16x16x32_bf16(a, bf[p][c], acc[t][p][c], 0, 0, 0); }
        }
#pragma unroll
        for (int t = 0; t < RT; ++t)
#pragma unroll
            for (int p = 0; p < NB; ++p)
#pragma unroll
                for (int c = 0; c < CT; ++c)
#pragma unroll
                    for (int r = 0; r < 4; ++r) red[((((wid * RT + t) * NB + p) * CT + c) * 16 + 4 * kg + r) * 16 + lr] = acc[t][p][c][r];
        __syncthreads();
        for (int e = tid; e < RT * 16 * NC; e += 512) {
            const int rl = e / NC, row = rowb + rl, col = e % NC, t = rl >> 4, rr = rl & 15, c = col >> 4, cl = col & 15;
            float v0 = 0.f, v1 = 0.f;
#pragma unroll
            for (int w = 0; w < 8; ++w) { v0 += red[((((w * RT + t) * NB + 0) * CT + c) * 16 + rr) * 16 + cl]; if (NB > 1) v1 += red[((((w * RT + t) * NB + (NB - 1)) * CT + c) * 16 + rr) * 16 + cl]; }
            float sq = f(row, col0 + col, v0, v1, invs[row]);
            if (ssq_out) { sq *= sq; sq += __shfl_xor(sq, 1); sq += __shfl_xor(sq, 2); sq += __shfl_xor(sq, 4); sq += __shfl_xor(sq, 8); if (NC > 16) sq += __shfl_xor(sq, 16);
                if ((col & (NC - 1)) == 0) ssq_out[row * 64 + ci] = sq; }
        }
        __syncthreads();
    }
}

template <int CT, int NB, int K, class RM, class F>
__device__ __forceinline__ void wave_gemm(LAS unsigned char* lds, const bf16_t* A, int lda, const bf16_t* Bt, int ldb, int N, const float* rs_src, RM rm, F f) {
    const int tid = otid(), wid = tid >> 6, lane = tid & 63, lr = lane & 15, kg = lane >> 4;
    const int bix = gridDim.x - 1 - blockIdx.x, rt = bix & 7, row0 = rt * 16, nct = N / (16 * CT);
    LAS float* invs = (LAS float*)(lds + LDS_INV);
    if (rs_src) { const int r = tid >> 5, q = tid & 31; const float* p = rs_src + (size_t)(row0 + r) * D + q * 32; float s = 0.f;
        for (int j = 0; j < 32; j += 4) { const f32x4 v = *(const f32x4*)(p + j); s += v[0] * v[0] + v[1] * v[1] + v[2] * v[2] + v[3] * v[3]; }
        s += __shfl_xor(s, 1); s += __shfl_xor(s, 2); s += __shfl_xor(s, 4); s += __shfl_xor(s, 8); s += __shfl_xor(s, 16);
        if (q == 0) invs[r] = rsqrtf(s * (1.0f / 1024.0f) + EPS); }
    else if (tid < 16) invs[tid] = 1.0f;
    __syncthreads();
    for (int ct = (bix >> 3) * 8 + wid; ct < nct; ct += (gridDim.x >> 3) * 8) {
        const int col0 = ct * 16 * CT;
        f32x4 acc[NB][CT];
#pragma unroll
        for (int p = 0; p < NB; ++p)
#pragma unroll
            for (int c = 0; c < CT; ++c) acc[p][c] = (f32x4){0.f, 0.f, 0.f, 0.f};
        const bf16_t* ap = A + (size_t)(row0 + lr) * lda + 8 * kg;
        const bf16_t* bp0 = Bt + (size_t)(rm(col0, 0) + lr) * ldb + 8 * kg;
        const bf16_t* bp1 = NB > 1 ? Bt + (size_t)(rm(col0, 1) + lr) * ldb + 8 * kg : bp0;
#pragma unroll 4
        for (int k = 0; k < K; k += 32) {
            const bf16x8 a = *(const bf16x8*)(ap + k);
#pragma unroll
            for (int c = 0; c < CT; ++c) {
                const bf16x8 b = *(const bf16x8*)(bp0 + (size_t)c * 16 * ldb + k);
                acc[0][c] = __builtin_amdgcn_mfma_f32_16x16x32_bf16(a, b, acc[0][c], 0, 0, 0);
                if (NB > 1) { const bf16x8 b1 = *(const bf16x8*)(bp1 + (size_t)c * 16 * ldb + k); acc[NB - 1][c] = __builtin_amdgcn_mfma_f32_16x16x32_bf16(a, b1, acc[NB - 1][c], 0, 0, 0); }
            }
        }
#pragma unroll
        for (int c = 0; c < CT; ++c)
#pragma unroll
            for (int r = 0; r < 4; ++r) f(row0 + 4 * kg + r, col0 + 16 * c + lr, acc[0][c][r], NB > 1 ? acc[NB - 1][c][r] : 0.f, invs[4 * kg + r]);
    }
    __syncthreads();
}

struct Ctx { const float* const* in; float* out; unsigned char* ws; LAS unsigned char* lds; };

__device__ __forceinline__ void tp_tile(LAS float* tile, const float* src, int sld, int sc0, int k0, bf16_t* dst, int dld, int dr0, int dk0, const float* scale, int ncv) {
    const int lane = otid() & 63;
    float v[64];
    const float* sp = src + (size_t)k0 * sld + sc0 + lane;
#pragma unroll
    for (int kk = 0; kk < 64; ++kk) v[kk] = (lane < ncv) ? sp[(size_t)kk * sld] : 0.f;
    if (scale) {
#pragma unroll
        for (int kk = 0; kk < 64; ++kk) v[kk] *= scale[k0 + kk];
    }
#pragma unroll
    for (int kk = 0; kk < 64; ++kk) tile[kk * 65 + lane] = v[kk];
    const int j = lane & 7;
#pragma unroll
    for (int ps = 0; ps < 8; ++ps) { const int cc = (lane >> 3) + 8 * ps;
        float x[8];
#pragma unroll
        for (int i = 0; i < 8; ++i) x[i] = tile[(8 * j + i) * 65 + cc];
        u32x4 w; w.x = cvt_pk_bf16(x[0], x[1]); w.y = cvt_pk_bf16(x[2], x[3]); w.z = cvt_pk_bf16(x[4], x[5]); w.w = cvt_pk_bf16(x[6], x[7]);
        if (cc < ncv) *(u32x4*)(dst + (size_t)(dr0 + cc) * dld + dk0 + 8 * j) = w; }
}
__device__ __forceinline__ void prep_weights(const Ctx& c) {
    const int wv_ = __builtin_amdgcn_readfirstlane(otid() >> 6); LAS float* tile = (LAS float*)c.lds + wv_ * (64 * 65); unsigned char* ws = c.ws;
    constexpr int N_UP = 1408, N_DN = 704, N_IN = 2304, N_DT = 16, N_BRL = 256, N_BRS = 512, N_OUT = 256, N_RG = 32;
    constexpr int TOT = 2 * N_UP + 2 * N_DN + N_IN + N_DT + N_BRL + N_BRS + N_OUT + 2 * N_RG;
    for (int ti0 = blockIdx.x * 8 + wv_; ti0 < TOT; ti0 += gridDim.x * 8) {
        int ti = ti0;
        if (ti < 2 * N_UP) { const int l = ti >= N_UP; if (l) ti -= N_UP;
            const int j = ti >> 5, r = ti & 31, pn = j >> 1, panel = j & 1, ct = r >> 4, kt = r & 15;
            tp_tile(tile, c.in[l ? 29 : 7], 2 * FF, panel * FF + 128 * pn + 64 * ct, 64 * kt, (bf16_t*)(ws + (l ? OFF_WUP2 : OFF_WUP1)), D, 256 * pn + 128 * panel + 64 * ct, 64 * kt, l ? c.in[28] : nullptr, 64);
            continue; }
        ti -= 2 * N_UP;
        if (ti < 2 * N_DN) { const int l = ti >= N_DN; if (l) ti -= N_DN;
            const int nt = ti / 44, kt = ti % 44;
            tp_tile(tile, c.in[l ? 30 : 8], D, 64 * nt, 64 * kt, (bf16_t*)(ws + (l ? OFF_WDN2 : OFF_WDN1)), FF, 64 * nt, 64 * kt, nullptr, 64);
            continue; }
        ti -= 2 * N_DN;
        if (ti < N_IN) { const int nt = ti >> 4, kt = ti & 15, n0 = 64 * nt;
            const int sc = n0 < 1024 ? n0 : (n0 < 4096 ? n0 + 3072 : (n0 < 7168 ? n0 - 3072 : n0 + 32));
            tp_tile(tile, c.in[10], 9248, sc, 64 * kt, (bf16_t*)(ws + OFF_WIN), D, n0, 64 * kt, c.in[9], 64);
            continue; }
        ti -= N_IN;
        if (ti < N_DT) { tp_tile(tile, c.in[10], 9248, 7168, 64 * ti, (bf16_t*)(ws + OFF_WDT), D, 0, 64 * ti, c.in[9], 32); continue; }
        ti -= N_DT;
        if (ti < N_BRL) { const int nt = ti >> 4, kt = ti & 15; tp_tile(tile, c.in[25], D, 64 * nt, 64 * kt, (bf16_t*)(ws + OFF_WBR), 3072, 64 * nt, 64 * kt, nullptr, 64); continue; }
        ti -= N_BRL;
        if (ti < N_BRS) { const int nt = ti >> 5, kt = ti & 31; tp_tile(tile, c.in[26], D, 64 * nt, 64 * kt, (bf16_t*)(ws + OFF_WBR), 3072, 64 * nt, 1024 + 64 * kt, c.in[24], 64); continue; }
        ti -= N_BRS;
        if (ti < N_OUT) { const int nt = ti >> 4, kt = ti & 15; tp_tile(tile, c.in[27], D, 64 * nt, 64 * kt, (bf16_t*)(ws + OFF_WOUT), D, 64 * nt, 64 * kt, nullptr, 64); continue; }
        ti -= N_OUT;
        { const int l = ti >= N_RG; if (l) ti -= N_RG; const int h = ti >> 2, nt = (ti >> 1) & 1, kt = ti & 1;
          tp_tile(tile, c.in[l ? 16 : 14] + h * 16384, 128, 64 * nt, 64 * kt, (bf16_t*)(ws + (l ? OFF_WIG : OFF_WRG)) + h * 16384, 128, 64 * nt, 64 * kt, nullptr, 64); }
    }
}
__device__ __forceinline__ void rmsnorm_rows_bf16(const float* x, int nrows, const float* g, bf16_t* dst) {
    const int t_ = otid(), lane = t_ & 63, gw = blockIdx.x * 8 + (t_ >> 6), nw = gridDim.x * 8;
    f32x4 gg[4];
#pragma unroll
    for (int i = 0; i < 4; ++i) gg[i] = *(const f32x4*)(g + (i * 64 + lane) * 4);
    for (int r = gw; r < nrows; r += 2 * nw) {
        const int r2 = r + nw; const bool two = r2 < nrows;
        const float* p = x + (size_t)r * D; const float* p2 = x + (size_t)(two ? r2 : r) * D; f32x4 v[4], w[4]; float s = 0.f, s2 = 0.f;
#pragma unroll
        for (int i = 0; i < 4; ++i) { v[i] = *(const f32x4*)(p + (i * 64 + lane) * 4); w[i] = *(const f32x4*)(p2 + (i * 64 + lane) * 4); }
#pragma unroll
        for (int i = 0; i < 4; ++i) { s += v[i][0] * v[i][0] + v[i][1] * v[i][1] + v[i][2] * v[i][2] + v[i][3] * v[i][3]; s2 += w[i][0] * w[i][0] + w[i][1] * w[i][1] + w[i][2] * w[i][2] + w[i][3] * w[i][3]; }
#pragma unroll
        for (int o = 1; o < 64; o <<= 1) { s += __shfl_xor(s, o); s2 += __shfl_xor(s2, o); }
        const float inv = rsqrtf(s * (1.0f / 1024.0f) + EPS), inv2 = rsqrtf(s2 * (1.0f / 1024.0f) + EPS);
#pragma unroll
        for (int i = 0; i < 4; ++i) { const int cc = (i * 64 + lane) * 4; const f32x4 o = v[i] * inv * gg[i];
            unsigned* q = (unsigned*)(dst + (size_t)r * D + cc); q[0] = cvt_pk_bf16(o[0], o[1]); q[1] = cvt_pk_bf16(o[2], o[3]);
            if (two) { const f32x4 o2 = w[i] * inv2 * gg[i]; unsigned* q2 = (unsigned*)(dst + (size_t)r2 * D + cc); q2[0] = cvt_pk_bf16(o2[0], o2[1]); q2[1] = cvt_pk_bf16(o2[2], o2[3]); } }
    }
}
__device__ __forceinline__ void rmsnorm_rows_f32(float* x, int nrows, const float* g) {
    const int t_ = otid(), lane = t_ & 63, gw = blockIdx.x * 8 + (t_ >> 6), nw = gridDim.x * 8;
    f32x4 gg[4];
#pragma unroll
    for (int i = 0; i < 4; ++i) gg[i] = *(const f32x4*)(g + (i * 64 + lane) * 4);
    for (int r = gw; r < nrows; r += 2 * nw) {
        const int r2 = r + nw; const bool two = r2 < nrows;
        float* p = x + (size_t)r * D; float* p2 = x + (size_t)(two ? r2 : r) * D; f32x4 v[4], w[4]; float s = 0.f, s2 = 0.f;
#pragma unroll
        for (int i = 0; i < 4; ++i) { v[i] = *(const f32x4*)(p + (i * 64 + lane) * 4); w[i] = *(const f32x4*)(p2 + (i * 64 + lane) * 4); }
#pragma unroll
        for (int i = 0; i < 4; ++i) { s += v[i][0] * v[i][0] + v[i][1] * v[i][1] + v[i][2] * v[i][2] + v[i][3] * v[i][3]; s2 += w[i][0] * w[i][0] + w[i][1] * w[i][1] + w[i][2] * w[i][2] + w[i][3] * w[i][3]; }
#pragma unroll
        for (int o = 1; o < 64; o <<= 1) { s += __shfl_xor(s, o); s2 += __shfl_xor(s2, o); }
        const float inv = rsqrtf(s * (1.0f / 1024.0f) + EPS), inv2 = rsqrtf(s2 * (1.0f / 1024.0f) + EPS);
#pragma unroll
        for (int i = 0; i < 4; ++i) { const int cc = (i * 64 + lane) * 4; *(f32x4*)(p + cc) = v[i] * inv * gg[i]; if (two) *(f32x4*)(p2 + cc) = w[i] * inv2 * gg[i]; }
    }
}

template <bool FINAL>
__device__ __forceinline__ void lru_chunk(const Ctx& c, int b, int ch, bool dry = false) {
    const int tid = otid(), wid = tid >> 6, lane = tid & 63, lr = lane & 15, kg = lane >> 4;
    LAS float* XC = (LAS float*)c.lds; LAS float* AA = (LAS float*)(c.lds + 32768); LAS float* UU = (LAS float*)(c.lds + 65536); LAS unsigned char* XCb = c.lds + 98304;
    bf16_t* PP = (bf16_t*)(c.ws + OFF_PP); bf16_t* HALO = (bf16_t*)(c.ws + OFF_HALO); float* SUMM = (float*)(c.ws + OFF_SUMM);
    const bf16_t* WRG = (const bf16_t*)(c.ws + OFF_WRG); const bf16_t* WIG = (const bf16_t*)(c.ws + OFF_WIG);
    const float* cw = c.in[12]; const float* cb = c.in[13]; const float* brg = c.in[15]; const float* big = c.in[17]; const float* lam = c.in[18];
    const int t0 = b * SEQ + 64 * ch;
    LAS float* CARRY = (LAS float*)(c.lds + 115712);
    if (FINAL) {
        float h0 = 0.f, h1 = 0.f;
        for (int cp = 0; cp < ch; cp += 8) {
            float a0[8], b0[8], a1[8], b1[8];
#pragma unroll
            for (int i = 0; i < 8; ++i) { a0[i] = 1.f; b0[i] = 0.f; a1[i] = 1.f; b1[i] = 0.f;
                if (cp + i < ch) { const float* sp = SUMM + ((size_t)(b * NCH + cp + i) * D + tid) * 2; a0[i] = sp[0]; b0[i] = sp[1]; a1[i] = sp[1024]; b1[i] = sp[1025]; } }
#pragma unroll
            for (int i = 0; i < 8; ++i) { h0 = a0[i] * h0 + b0[i]; h1 = a1[i] * h1 + b1[i]; }
        }
        CARRY[tid] = h0; CARRY[tid + 512] = h1;
    }
    const int cg8 = tid & 15, tk = (tid >> 4) * 2;
    u32x4 rawp[5]; f32x4 wk[4][2], bb[2]; bf16x8 wrf[4], wif[4]; float pb1 = 0.f, pb2 = 0.f, plam = 0.f;
#define LRU_FETCH(hd) do { const int cc0_ = 128 * (hd) + 8 * cg8; \
        _Pragma("unroll") for (int i = 0; i < 5; ++i) { const int tt = tk - 3 + i; rawp[i] = (u32x4){0u, 0u, 0u, 0u}; \
            if (tt >= 0) rawp[i] = *(const u32x4*)(PP + (size_t)(t0 + tt) * NPP + cc0_); \
            else if (ch > 0) rawp[i] = *(const u32x4*)(HALO + ((size_t)((b * NCH + ch - 1) * 3 + (tt + 3))) * D + cc0_); } \
        _Pragma("unroll") for (int k = 0; k < 4; ++k) { wk[k][0] = *(const f32x4*)(cw + k * D + cc0_); wk[k][1] = *(const f32x4*)(cw + k * D + cc0_ + 4); } \
        bb[0] = *(const f32x4*)(cb + cc0_); bb[1] = *(const f32x4*)(cb + cc0_ + 4); } while (0)
#define LRU_FETCHW(hd) do { \
        { const int cgl_ = 128 * (hd) + 16 * wid + lr; const bf16_t* wr__ = WRG + (size_t)cgl_ * 128 + 8 * kg; const bf16_t* wi__ = WIG + (size_t)cgl_ * 128 + 8 * kg; \
          _Pragma("unroll") for (int ks = 0; ks < 4; ++ks) { wrf[ks] = *(const bf16x8*)(wr__ + 32 * ks); wif[ks] = *(const bf16x8*)(wi__ + 32 * ks); } \
          pb1 = brg[cgl_]; pb2 = big[cgl_]; plam = lam[cgl_]; } } while (0)
    LRU_FETCH(0); LRU_FETCHW(0);
    for (int head = 0; head < 8; ++head) {
        const int ch0 = 128 * head;
        {
            f32x4 raw[5][2];
#pragma unroll
            for (int i = 0; i < 5; ++i) unpack8(rawp[i], raw[i][0], raw[i][1]);
#pragma unroll
            for (int q = 0; q < 2; ++q) { f32x4 o0 = bb[0], o1 = bb[1];
#pragma unroll
                for (int k = 0; k < 4; ++k) { o0 += wk[k][0] * raw[q + k][0]; o1 += wk[k][1] * raw[q + k][1]; }
                *(LAS f32x4*)(XC + (tk + q) * 128 + 8 * cg8) = o0; *(LAS f32x4*)(XC + (tk + q) * 128 + 8 * cg8 + 4) = o1;
                *(LAS u32x4*)A256(XCb, tk + q, cg8) = pack8(o0, o1); }
            if (head < 7) LRU_FETCH(head + 1);
        }
        __syncthreads();
        {
            f32x4 ar[4], ai_[4];
#pragma unroll
            for (int m = 0; m < 4; ++m) { ar[m] = (f32x4){0.f, 0.f, 0.f, 0.f}; ai_[m] = (f32x4){0.f, 0.f, 0.f, 0.f}; }
#pragma unroll
            for (int ks = 0; ks < 4; ++ks) { const bf16x8 br = wrf[ks], bi = wif[ks];
#pragma unroll
                for (int m = 0; m < 4; ++m) { const bf16x8 a = *(const LAS bf16x8*)A256(XCb, 16 * m + lr, 4 * ks + kg);
                    ar[m] = __builtin_amdgcn_mfma_f32_16x16x32_bf16(a, br, ar[m], 0, 0, 0); ai_[m] = __builtin_amdgcn_mfma_f32_16x16x32_bf16(a, bi, ai_[m], 0, 0, 0); } }
            const int cl = 16 * wid + lr; const float b1 = pb1, b2 = pb2, sp = softplusf_(-plam);
            if (head < 7) LRU_FETCHW(head + 1);
#pragma unroll
            for (int m = 0; m < 4; ++m)
#pragma unroll
                for (int r = 0; r < 4; ++r) { const int tk = 16 * m + 4 * kg + r; const float rg = sigmoidf_(ar[m][r] + b1), ig = sigmoidf_(ai_[m][r] + b2);
                    const float la = -8.0f * rg * sp, a_ = __expf(la); const float u = __builtin_amdgcn_sqrtf(fmaxf(1.0f - a_ * a_, 0.0f)) * ig * XC[tk * 128 + cl];
                    AA[tk * 128 + cl] = la; UU[tk * 128 + cl] = u; }
        }
        __syncthreads();
        if (!FINAL) {
            const int cg8s = tid & 15, tks = (tid >> 4) * 2;
#pragma unroll
            for (int q = 0; q < 2; ++q) { const f32x4 o0 = *(const LAS f32x4*)(UU + (tks + q) * 128 + 8 * cg8s), o1 = *(const LAS f32x4*)(UU + (tks + q) * 128 + 8 * cg8s + 4);
                const f32x4 l0 = *(const LAS f32x4*)(AA + (tks + q) * 128 + 8 * cg8s), l1 = *(const LAS f32x4*)(AA + (tks + q) * 128 + 8 * cg8s + 4);
                *(u32x4*)(PP + (size_t)(t0 + tks + q) * NPP + ch0 + 8 * cg8s) = pack8(o0, o1); *(u32x4*)(PP + (size_t)(t0 + tks + q) * NPP + 3072 + ch0 + 8 * cg8s) = pack8(l0, l1); } }
        if (tid < 128) { const int cgl = ch0 + tid;
            if (!FINAL) { float A = 1.f, H = 0.f;
                for (int t8 = 0; t8 < 64; t8 += 16) { float av[16], uv[16];
#pragma unroll
                    for (int i = 0; i < 16; ++i) { av[i] = AA[(t8 + i) * 128 + tid]; uv[i] = UU[(t8 + i) * 128 + tid]; }
#pragma unroll
                    for (int i = 0; i < 16; ++i) { const float a_ = __expf(av[i]); H = a_ * H + uv[i]; A *= a_; } }
                float* s = SUMM + ((size_t)(b * NCH + ch) * D + cgl) * 2; s[0] = A; s[1] = H; }
            else { float h = CARRY[cgl];
                for (int t8 = 0; t8 < 64; t8 += 16) { float av[16], uv[16];
#pragma unroll
                    for (int i = 0; i < 16; ++i) { av[i] = AA[(t8 + i) * 128 + tid]; uv[i] = UU[(t8 + i) * 128 + tid]; }
#pragma unroll
                    for (int i = 0; i < 16; ++i) { h = av[i] * h + uv[i]; UU[(t8 + i) * 128 + tid] = h; } }
                if (ch == NCH - 1) c.out[O_LHP + b * D + cgl] = h; } }
        __syncthreads();
        if (FINAL) { const int cg8 = tid & 15, tk = (tid >> 4) * 2;
#pragma unroll
            for (int q = 0; q < 2; ++q) { const f32x4 o0 = *(const LAS f32x4*)(UU + (tk + q) * 128 + 8 * cg8), o1 = *(const LAS f32x4*)(UU + (tk + q) * 128 + 8 * cg8 + 4);
                if (!dry) *(u32x4*)(PP + (size_t)(t0 + tk + q) * NPP + ch0 + 8 * cg8) = pack8(o0, o1); }
            __syncthreads(); }
    }
}

__device__ __forceinline__ void lru_final(const Ctx& c, int b, int ch) {
    const int tid = otid(); bf16_t* PP = (bf16_t*)(c.ws + OFF_PP); const float* SUMM = (const float*)(c.ws + OFF_SUMM);
    const int t0 = b * SEQ + 64 * ch, c2 = 2 * tid;
    float h0 = 0.f, h1 = 0.f;
    for (int cp = 0; cp < ch; cp += 8) {
        f32x4 sv[8];
#pragma unroll
        for (int i = 0; i < 8; ++i) { sv[i] = (f32x4){1.f, 0.f, 1.f, 0.f}; if (cp + i < ch) sv[i] = *(const f32x4*)(SUMM + ((size_t)(b * NCH + cp + i) * D + c2) * 2); }
#pragma unroll
        for (int i = 0; i < 8; ++i) { h0 = sv[i][0] * h0 + sv[i][1]; h1 = sv[i][2] * h1 + sv[i][3]; }
    }
    for (int t8 = 0; t8 < 64; t8 += 16) {
        unsigned uu[16], ll[16];
#pragma unroll
        for (int i = 0; i < 16; ++i) { const bf16_t* p = PP + (size_t)(t0 + t8 + i) * NPP + c2; uu[i] = *(const unsigned*)p; ll[i] = *(const unsigned*)(p + 3072); }
#pragma unroll
        for (int i = 0; i < 16; ++i) { h0 = __expf(bflo(ll[i])) * h0 + bflo(uu[i]); h1 = __expf(bfhi(ll[i])) * h1 + bfhi(uu[i]);
            *(unsigned*)(PP + (size_t)(t0 + t8 + i) * NPP + c2) = cvt_pk_bf16(h0, h1); }
    }
    if (ch == NCH - 1) { c.out[O_LHP + b * D + c2] = h0; c.out[O_LHP + b * D + c2 + 1] = h1; }
}

__device__ __forceinline__ void bc_conv(const Ctx& c, int b, int ch) {
    const int tid = otid(); const bf16_t* PP = (const bf16_t*)(c.ws + OFF_PP); bf16_t* BCc = (bf16_t*)(c.ws + OFF_XN);
    const float* cw = c.in[19]; const float* cb = c.in[20]; const int t0 = b * SEQ + 64 * ch;
    if (tid < 384) { const int row = tid >> 7, cg8 = tid & 127;
        *(u32x4*)((bf16_t*)(c.ws + OFF_HALO) + ((size_t)((b * NCH + ch) * 3 + row)) * D + 8 * cg8) = *(const u32x4*)(PP + (size_t)(t0 + 61 + row) * NPP + 8 * cg8); }
#pragma unroll 1
    for (int item = tid; item < 1024; item += 512) {
        const int cgq = item & 127, st = item >> 7, gcol = 3072 + 8 * cgq, ccol = 2048 + 8 * cgq;
        u32x4 raw[11];
#pragma unroll
        for (int i = 0; i < 11; ++i) { const int tt = 8 * st - 3 + i; raw[i] = (u32x4){0u, 0u, 0u, 0u}; if (tt >= 0 || ch > 0) raw[i] = *(const u32x4*)(PP + (size_t)(t0 + tt) * NPP + gcol); }
#pragma unroll
        for (int hf = 0; hf < 2; ++hf) {
            f32x4 wk[4]; const f32x4 bb = *(const f32x4*)(cb + ccol + 4 * hf);
#pragma unroll
            for (int k = 0; k < 4; ++k) wk[k] = *(const f32x4*)(cw + k * 3072 + ccol + 4 * hf);
#pragma unroll
            for (int q = 0; q < 8; ++q) { f32x4 o = bb;
#pragma unroll
                for (int k = 0; k < 4; ++k) { const unsigned w0 = raw[q + k][2 * hf], w1 = raw[q + k][2 * hf + 1]; const f32x4 r = (f32x4){bflo(w0), bfhi(w0), bflo(w1), bfhi(w1)}; o += wk[k] * r; }
#pragma unroll
                for (int j = 0; j < 4; ++j) o[j] = siluf_(o[j]);
                unsigned* op = (unsigned*)(BCc + (size_t)(t0 + 8 * st + q) * 1024 + 8 * cgq + 4 * hf); op[0] = cvt_pk_bf16(o[0], o[1]); op[1] = cvt_pk_bf16(o[2], o[3]); }
        }
    }
}

__device__ __forceinline__ void ssd_seq(const Ctx& c, int b, int h, bool dry = false) {
    const int tid = otid(), wid = tid >> 6, lane = tid & 63, lr = lane & 15, kg = lane >> 4;
    LAS unsigned char* L = c.lds;
    LAS unsigned char* Cm = L; LAS unsigned char* Bm = L + 16384; LAS unsigned char* BdT = L + 32768; LAS unsigned char* Sb = L + 49152;
    LAS unsigned char* XdT = L + 65536; LAS unsigned char* Xr = L + 73728; LAS unsigned char* Mm = L + 82944;
    LAS float* dts = (LAS float*)(L + 91136); LAS float* css = (LAS float*)(L + 91392); LAS float* dec = (LAS float*)(L + 91648); LAS bf16_t* halo = (LAS bf16_t*)(L + 91904);
    bf16_t* PP = (bf16_t*)(c.ws + OFF_PP); const float* DT = (const float*)(c.ws + OFF_DT);
    const float* cw = c.in[19]; const float* cb = c.in[20];
    const int g = h >> 3;
    const float Ah = -__expf(c.in[22][h]), Dh = c.in[23][h], dtb = c.in[21][h];
    f32x4 accS[4];
#pragma unroll
    for (int m = 0; m < 4; ++m) accS[m] = (f32x4){0.f, 0.f, 0.f, 0.f};
    for (int e = tid; e < 64 * 128; e += 512) ((LAS bf16_t*)Sb)[e] = 0;
    const bf16_t* BCc = (const bf16_t*)(c.ws + OFF_XN);
    const int role = tid >> 7, rt = tid & 127;
    const int xg = rt & 7, xst = rt >> 3;
    const int bg8 = rt & 15, bst = rt >> 4;
    const int gcol = 1024 + 64 * h + 8 * xg, ccol = 64 * h + 8 * xg;
    const int bcol = (role == 2 ? 512 : 0) + 128 * g + 8 * bg8;
    u32x4 raw[8]; float dtv = 0.f;
    f32x4 wkk[2][4], bbb[2];
#pragma unroll
    for (int hf = 0; hf < 2; ++hf) { bbb[hf] = *(const f32x4*)(cb + ccol + 4 * hf);
#pragma unroll
        for (int k = 0; k < 4; ++k) wkk[hf][k] = *(const f32x4*)(cw + k * 3072 + ccol + 4 * hf); }
    {
        const int t0 = b * SEQ;
        if (role == 0) {
#pragma unroll
            for (int i = 0; i < 7; ++i) { const int tt = 4 * xst - 3 + i; raw[i] = (u32x4){0u, 0u, 0u, 0u}; if (tt >= 0) raw[i] = *(const u32x4*)(PP + (size_t)(t0 + tt) * NPP + gcol); } }
        else if (role < 3) {
#pragma unroll
            for (int i = 0; i < 8; ++i) raw[i] = *(const u32x4*)(BCc + (size_t)(t0 + 8 * bst + i) * 1024 + bcol); }
        if (wid == 0) dtv = DT[(size_t)(t0 + lane) * 32 + h];
    }
    for (int ch = 0; ch < NCH; ++ch) {
        const int t0 = b * SEQ + 64 * ch;
        if (wid == 0) {
            const float d = softplusf_(dtv + dtb); float sc = d * Ah;
#pragma unroll
            for (int o = 1; o < 64; o <<= 1) { const float v = __shfl_up(sc, o); if (lane >= o) sc += v; }
            const float ce = __shfl(sc, 63);
            dts[lane] = d; css[lane] = sc; dec[lane] = __expf(ce - sc);
        }
        __syncthreads();
        if (role == 0) {
            if (xst == 0 && ch > 0) {
#pragma unroll
                for (int i = 0; i < 3; ++i) raw[i] = *(const LAS u32x4*)(halo + ((ch - 1) & 1) * 192 + i * 64 + 8 * xg); }
            if (xst == 15) {
#pragma unroll
                for (int i = 0; i < 3; ++i) *(LAS u32x4*)(halo + (ch & 1) * 192 + i * 64 + 8 * xg) = raw[4 + i];
                if (ch == NCH - 1 && !dry) {
#pragma unroll
                    for (int r = 0; r < 3; ++r) { f32x4 v0, v1; unpack8(raw[4 + r], v0, v1); float* o = c.out + O_SCP + (size_t)(b * 3 + r) * 3072 + ccol; *(f32x4*)o = v0; *(f32x4*)(o + 4) = v1; } } }
            const int chunk = (xst >> 1) ^ xg;
#pragma unroll
            for (int hf = 0; hf < 2; ++hf) {
                unsigned tq[4][2];
#pragma unroll
                for (int q = 0; q < 4; ++q) { f32x4 o = bbb[hf];
#pragma unroll
                    for (int k = 0; k < 4; ++k) { const unsigned w0 = raw[q + k][2 * hf], w1 = raw[q + k][2 * hf + 1]; const f32x4 r = (f32x4){bflo(w0), bfhi(w0), bflo(w1), bfhi(w1)}; o += wkk[hf][k] * r; }
#pragma unroll
                    for (int j = 0; j < 4; ++j) o[j] = siluf_(o[j]);
                    const int l = 4 * xst + q;
                    LAS unsigned* rp = (LAS unsigned*)(Xr + l * 144 + 16 * xg + 8 * hf); rp[0] = cvt_pk_bf16(o[0], o[1]); rp[1] = cvt_pk_bf16(o[2], o[3]);
                    const float d = dts[l]; tq[q][0] = cvt_pk_bf16(o[0] * d, o[1] * d); tq[q][1] = cvt_pk_bf16(o[2] * d, o[3] * d);
                }
#pragma unroll
                for (int j2 = 0; j2 < 2; ++j2) {
                    unsigned lo[2], hi[2];
#pragma unroll
                    for (int i = 0; i < 2; ++i) { const unsigned a = tq[2 * i][j2], bq = tq[2 * i + 1][j2]; lo[i] = (a & 0xffffu) | (bq << 16); hi[i] = (a >> 16) | (bq & 0xffff0000u); }
                    LAS unsigned* p0 = (LAS unsigned*)(A128(XdT, 8 * xg + 4 * hf + 2 * j2, xst >> 1) + 8 * (xst & 1)); p0[0] = lo[0]; p0[1] = lo[1];
                    LAS unsigned* p1 = (LAS unsigned*)(A128(XdT, 8 * xg + 4 * hf + 2 * j2 + 1, xst >> 1) + 8 * (xst & 1)); p1[0] = hi[0]; p1[1] = hi[1]; }
            }
        } else if (role == 1) {
            const int chunk = bst ^ (bg8 & 7);
            unsigned tq[8][4];
#pragma unroll
            for (int q = 0; q < 8; ++q) { const int l = 8 * bst + q; *(LAS u32x4*)A256(Bm, l, bg8) = raw[q]; const float d = dec[l]; f32x4 v0, v1; unpack8(raw[q], v0, v1);
                tq[q][0] = cvt_pk_bf16(v0[0] * d, v0[1] * d); tq[q][1] = cvt_pk_bf16(v0[2] * d, v0[3] * d); tq[q][2] = cvt_pk_bf16(v1[0] * d, v1[1] * d); tq[q][3] = cvt_pk_bf16(v1[2] * d, v1[3] * d); }
#pragma unroll
            for (int j2 = 0; j2 < 4; ++j2) { u32x4 lo, hi;
#pragma unroll
                for (int i = 0; i < 4; ++i) { const unsigned a = tq[2 * i][j2], bq = tq[2 * i + 1][j2]; lo[i] = (a & 0xffffu) | (bq << 16); hi[i] = (a >> 16) | (bq & 0xffff0000u); }
                *(LAS u32x4*)A128(BdT, 8 * bg8 + 2 * j2, bst) = lo; *(LAS u32x4*)A128(BdT, 8 * bg8 + 2 * j2 + 1, bst) = hi; }
        } else if (role == 2) {
#pragma unroll
            for (int q = 0; q < 8; ++q) *(LAS u32x4*)A256(Cm, 8 * bst + q, bg8) = raw[q];
        }
        if (ch + 1 < NCH) {
            if (role == 0) {
#pragma unroll
                for (int i = 0; i < 7; ++i) { const int tt = 4 * xst - 3 + i; if (tt >= 0) raw[i] = *(const u32x4*)(PP + (size_t)(t0 + 64 + tt) * NPP + gcol); } }
            else if (role < 3) {
#pragma unroll
                for (int i = 0; i < 8; ++i) raw[i] = *(const u32x4*)(BCc + (size_t)(t0 + 64 + 8 * bst + i) * 1024 + bcol); }
            if (wid == 0) dtv = DT[(size_t)(t0 + 64 + lane) * 32 + h];
        }
        __syncthreads();
#pragma unroll
        for (int q = 0; q < 2; ++q) { const int ti = 2 * wid + q, lt = ti >> 2, stl = ti & 3; f32x4 a4 = (f32x4){0.f, 0.f, 0.f, 0.f};
            if (stl <= lt) {
#pragma unroll
                for (int ks = 0; ks < 4; ++ks) { const bf16x8 a = *(const LAS bf16x8*)A256(Bm, 16 * stl + lr, 4 * ks + kg), bq = *(const LAS bf16x8*)A256(Cm, 16 * lt + lr, 4 * ks + kg);
                    a4 = __builtin_amdgcn_mfma_f32_16x16x32_bf16(a, bq, a4, 0, 0, 0); } }
            const int l = 16 * lt + lr; const float cl = css[l]; f32x4 v;
#pragma unroll
            for (int r = 0; r < 4; ++r) { const int sI = 16 * stl + 4 * kg + r; v[r] = (sI <= l) ? a4[r] * __expf(cl - css[sI]) : 0.f; }
            unsigned* dummy = nullptr; (void)dummy;
            LAS unsigned* mp = (LAS unsigned*)(A128(Mm, l, 2 * stl + (kg >> 1)) + 8 * (kg & 1)); mp[0] = cvt_pk_bf16(v[0], v[1]); mp[1] = cvt_pk_bf16(v[2], v[3]); }
        __syncthreads();
#pragma unroll
        for (int q = 0; q < 2; ++q) { const int ti = 2 * wid + q, pt = ti >> 2, lt = ti & 3; f32x4 a4 = (f32x4){0.f, 0.f, 0.f, 0.f};
#pragma unroll
            for (int ks = 0; ks < 4; ++ks) { const bf16x8 a = *(const LAS bf16x8*)A256(Sb, 16 * pt + lr, 4 * ks + kg), bq = *(const LAS bf16x8*)A256(Cm, 16 * lt + lr, 4 * ks + kg);
                a4 = __builtin_amdgcn_mfma_f32_16x16x32_bf16(a, bq, a4, 0, 0, 0); }
            const int l = 16 * lt + lr; const float el = __expf(css[l]);
#pragma unroll
            for (int r = 0; r < 4; ++r) a4[r] *= el;
            const int prow_ = 16 * pt + lr, sw = (2 * pt + (lr >> 3)) & 7;
#pragma unroll
            for (int ks = 0; ks < 2; ++ks) { const bf16x8 a = *(const LAS bf16x8*)A128(XdT, prow_, 4 * ks + kg), bq = *(const LAS bf16x8*)A128(Mm, 16 * lt + lr, 4 * ks + kg);
                a4 = __builtin_amdgcn_mfma_f32_16x16x32_bf16(a, bq, a4, 0, 0, 0); }
            const int p0 = 16 * pt + 4 * kg; const LAS unsigned* xp = (const LAS unsigned*)(Xr + l * 144 + 2 * p0); const unsigned x01 = xp[0], x23 = xp[1];
            const float y0 = a4[0] + Dh * bflo(x01), y1 = a4[1] + Dh * bfhi(x01), y2 = a4[2] + Dh * bflo(x23), y3 = a4[3] + Dh * bfhi(x23);
            if (!dry) { unsigned* yp = (unsigned*)(PP + (size_t)(t0 + l) * NPP + 1024 + 64 * h + p0); yp[0] = cvt_pk_bf16(y0, y1); yp[1] = cvt_pk_bf16(y2, y3); } }
        { const float ce = __expf(css[63]); const int nrow = 16 * wid + lr, swn = (2 * wid + (lr >> 3)) & 7;
#pragma unroll
          for (int m = 0; m < 4; ++m) { accS[m] *= ce; const int prow_ = 16 * m + lr, swp = (2 * m + (lr >> 3)) & 7;
#pragma unroll
            for (int ks = 0; ks < 2; ++ks) { const bf16x8 a = *(const LAS bf16x8*)A128(BdT, nrow, 4 * ks + kg), bq = *(const LAS bf16x8*)A128(XdT, prow_, 4 * ks + kg);
                accS[m] = __builtin_amdgcn_mfma_f32_16x16x32_bf16(a, bq, accS[m], 0, 0, 0); } } }
        __syncthreads();
#pragma unroll
        for (int m = 0; m < 4; ++m) { LAS unsigned* sp = (LAS unsigned*)(A256(Sb, 16 * m + lr, 2 * wid + (kg >> 1)) + 8 * (kg & 1)); sp[0] = cvt_pk_bf16(accS[m][0], accS[m][1]); sp[1] = cvt_pk_bf16(accS[m][2], accS[m][3]); }
    }
    if (!dry) {
#pragma unroll
        for (int m = 0; m < 4; ++m) *(f32x4*)(c.out + O_SHP + ((size_t)(b * 32 + h) * 64 + 16 * m + lr) * 128 + 16 * wid + 4 * kg) = accS[m];
    }
    __syncthreads();
}

__device__ __forceinline__ void lru_sample(const Ctx& c, int b, int head) {
    const int tid = otid(); LAS float* XC = (LAS float*)c.lds; LAS float* RG = XC + 2048; LAS float* IG = RG + 2048;
    const float* PS = (const float*)(c.ws + OFF_PS); bf16_t* ABRS = (bf16_t*)(c.ws + OFF_ABRS);
    const float* cw = c.in[12]; const float* cb = c.in[13]; const int ch0 = 128 * head;
    for (int e = tid; e < 2048; e += 512) { const int tk = e >> 7, cl = e & 127, cgl = ch0 + cl; float o = cb[cgl];
#pragma unroll
        for (int k = 0; k < 4; ++k) { const int tt = tk - 3 + k; const float v = tt >= 0 ? PS[(size_t)(b * 16 + tt) * 9216 + cgl] : SZ(c.in[2][(size_t)(b * 3 + tt + 3) * D + cgl]); o += cw[k * D + cgl] * v; }
        XC[e] = o; }
    if (tid < 384) { const int r = tid >> 7, cl = tid & 127; c.out[O_LCS + (size_t)(b * 3 + r) * D + ch0 + cl] = PS[(size_t)(b * 16 + 13 + r) * 9216 + ch0 + cl]; }
    __syncthreads();
    {
        LAS unsigned char* XCb = c.lds + 32768; const int wid = tid >> 6, lane = tid & 63, lr = lane & 15, kg = lane >> 4;
        for (int e = tid; e < 2048; e += 512) *(LAS bf16_t*)(XCb + (e >> 7) * 272 + 2 * (e & 127)) = f2bf(XC[e]);
        __syncthreads();
        const bf16_t* wr_ = (const bf16_t*)(c.ws + OFF_WRG) + (size_t)(ch0 + 16 * wid + lr) * 128 + 8 * kg; const bf16_t* wi_ = (const bf16_t*)(c.ws + OFF_WIG) + (size_t)(ch0 + 16 * wid + lr) * 128 + 8 * kg;
        f32x4 ar = (f32x4){0.f, 0.f, 0.f, 0.f}, ai_ = ar;
#pragma unroll
        for (int ks = 0; ks < 4; ++ks) { const bf16x8 br = *(const bf16x8*)(wr_ + 32 * ks), bi = *(const bf16x8*)(wi_ + 32 * ks), a = *(const LAS bf16x8*)(XCb + lr * 272 + (32 * ks + 8 * kg) * 2);
            ar = __builtin_amdgcn_mfma_f32_16x16x32_bf16(a, br, ar, 0, 0, 0); ai_ = __builtin_amdgcn_mfma_f32_16x16x32_bf16(a, bi, ai_, 0, 0, 0); }
        const int cl = 16 * wid + lr; const float b1 = c.in[15][ch0 + cl], b2 = c.in[17][ch0 + cl];
#pragma unroll
        for (int r = 0; r < 4; ++r) { const int tk = 4 * kg + r; RG[tk * 128 + cl] = sigmoidf_(ar[r] + b1); IG[tk * 128 + cl] = sigmoidf_(ai_[r] + b2); }
    }
    __syncthreads();
    if (tid < 128) { const int cgl = ch0 + tid; const float sp = softplusf_(-c.in[18][cgl]); float h = SZ(c.in[3][b * D + cgl]);
        for (int tk = 0; tk < 16; ++tk) { const float la = -8.0f * RG[tk * 128 + tid] * sp, a = __expf(la), u = sqrtf(-expm1f(2.0f * la)) * IG[tk * 128 + tid] * XC[tk * 128 + tid];
            h = a * h + u; ABRS[(size_t)(b * 16 + tk) * 3072 + cgl] = f2bf(gelu_tanh(PS[(size_t)(b * 16 + tk) * 9216 + 4096 + cgl]) * h); }
        c.out[O_LHS + b * D + cgl] = h; }
    __syncthreads();
}
__device__ __forceinline__ void ssd_sample(const Ctx& c, int b, int h) {
    const int tid = otid(); LAS float* XS = (LAS float*)c.lds; LAS float* BS = XS + 1024; LAS float* CS = BS + 2048; LAS float* DTL = CS + 2048;
    const float* PS = (const float*)(c.ws + OFF_PS); const float* DTS = (const float*)(c.ws + OFF_DTS); float* YGS = (float*)(c.ws + OFF_YGS);
    const float* cw = c.in[19]; const float* cb = c.in[20]; const int g = h >> 3;
    for (int e = tid; e < 16 * 320; e += 512) { const int tk = e / 320, q = e % 320; int cc; LAS float* dst;
        if (q < 64) { cc = 64 * h + q; dst = XS + tk * 64 + q; } else if (q < 192) { cc = 2048 + 128 * g + (q - 64); dst = BS + tk * 128 + (q - 64); } else { cc = 2560 + 128 * g + (q - 192); dst = CS + tk * 128 + (q - 192); }
        float o = cb[cc];
#pragma unroll
        for (int k = 0; k < 4; ++k) { const int tt = tk - 3 + k; const float v = tt >= 0 ? PS[(size_t)(b * 16 + tt) * 9216 + 1024 + cc] : SZ(c.in[4][(size_t)(b * 3 + tt + 3) * 3072 + cc]); o += cw[k * 3072 + cc] * v; }
        *dst = siluf_(o);
        if (tk >= 13 && (q < 64 || (h & 7) == 0)) c.out[O_SCS + (size_t)(b * 3 + tk - 13) * 3072 + cc] = PS[(size_t)(b * 16 + tk) * 9216 + 1024 + cc]; }
    if (tid < 16) DTL[tid] = softplusf_(DTS[(b * 16 + tid) * 32 + h] + c.in[21][h]);
    __syncthreads();
    const float Ah = -__expf(c.in[22][h]), Dh = c.in[23][h];
    const int p = tid >> 3, n0 = (tid & 7) * 16; float hs[16];
    const float* h0 = c.in[5] + ((size_t)(b * 32 + h) * 64 + p) * 128 + n0;
#pragma unroll
    for (int j = 0; j < 16; ++j) hs[j] = SZ(h0[j]);
    float zv[16];
#pragma unroll
    for (int tk = 0; tk < 16; ++tk) zv[tk] = PS[(size_t)(b * 16 + tk) * 9216 + 5120 + 64 * h + p];
#pragma unroll
    for (int tk = 0; tk < 16; ++tk) { const float d = DTL[tk], ea = __expf(d * Ah), xv = XS[tk * 64 + p], dx = d * xv; float y = 0.f;
#pragma unroll
        for (int j = 0; j < 16; ++j) { hs[j] = ea * hs[j] + dx * BS[tk * 128 + n0 + j]; y += CS[tk * 128 + n0 + j] * hs[j]; }
        y += __shfl_xor(y, 1); y += __shfl_xor(y, 2); y += __shfl_xor(y, 4);
        if ((tid & 7) == 0) { const int row = b * 16 + tk; YGS[(size_t)row * 2048 + 64 * h + p] = (y + Dh * xv) * siluf_(zv[tk]); } }
    float* ho = c.out + O_SHS + ((size_t)(b * 32 + h) * 64 + p) * 128 + n0;
#pragma unroll
    for (int j = 0; j < 16; ++j) ho[j] = hs[j];
    __syncthreads();
}

#ifdef DIAG
constexpr size_t OFF_DIAG = 266338304;
__device__ __forceinline__ int prow(int r) { return (r >> 4) * SEQ + (r & 15); }
template <class FA, class FB>
__device__ __forceinline__ void diag_rel(LAS float* red, float* dst, int ncols, FA fa, FB fb) {
    const int tid = threadIdx.x; float num = 0.f, den = 0.f;
    for (int e = tid; e < TS * ncols; e += 512) { const int r = e / ncols, cc = e % ncols; const float a = fa(r, cc), b = fb(r, cc); num += (a - b) * (a - b); den += b * b; }
    red[tid] = num; red[512 + tid] = den; __syncthreads();
    if (tid == 0) { float n = 0.f, d = 0.f; for (int i = 0; i < 512; ++i) { n += red[i]; d += red[512 + i]; } *dst = n / (d + 1e-30f); }
    __syncthreads();
}
#endif
constexpr size_t OFF_BAR = 266338304 + 4096, OFF_SSQS = OFF_BAR + 4096;
__device__ __forceinline__ void grid_barrier(unsigned* ctr, unsigned target) {
    asm volatile("s_waitcnt vmcnt(0) lgkmcnt(0)" ::: "memory");
    __syncthreads();
    if (threadIdx.x == 0) {
        __builtin_amdgcn_fence(__ATOMIC_RELEASE, "agent");
        asm volatile("s_waitcnt vmcnt(0)" ::: "memory");
        __hip_atomic_fetch_add(ctr, 1u, __ATOMIC_RELAXED, __HIP_MEMORY_SCOPE_AGENT);
        while (__hip_atomic_load(ctr, __ATOMIC_RELAXED, __HIP_MEMORY_SCOPE_AGENT) < target) __builtin_amdgcn_s_sleep(1);
        __builtin_amdgcn_fence(__ATOMIC_ACQUIRE, "agent");
        asm volatile("s_waitcnt vmcnt(0)" ::: "memory");
    }
    __syncthreads();
}
#define XB_TMO      128
#define XB_XCNT(j)  (256  + 64 * (j))
#define XB_XSUB(j)  (1280 + 64 * (j))
#define XB_XGEN(j)  (2304 + 64 * (j))
#define XB_TOP      3328
#define XB_TOPGEN   3392
#define XCD_BAR_WORDS 3456
#define XB_SPIN_CAP (1u << 18)
constexpr size_t OFF_XBAR = 266338304 + 4096 + 4096 + 65536;
__device__ __forceinline__ unsigned xb_ld(unsigned* p)              { return __hip_atomic_load(p, __ATOMIC_RELAXED, __HIP_MEMORY_SCOPE_AGENT); }
__device__ __forceinline__ unsigned xb_add(unsigned* p, unsigned v) { return __hip_atomic_fetch_add(p, v, __ATOMIC_RELAXED, __HIP_MEMORY_SCOPE_AGENT); }
__device__ __forceinline__ unsigned xb_xcc_id() { return (unsigned)__builtin_amdgcn_s_getreg((3 << 11) | 20) & 0xFu; }
#define XB_SPIN(cond, bar) do { unsigned _sp = 0; while (cond) { __builtin_amdgcn_s_sleep(1); \
    if ((++_sp & 255u) == 0u) { if (xb_ld(&(bar)[XB_TMO])) break; if (_sp > XB_SPIN_CAP) { atomicAdd(&(bar)[XB_TMO], 1u); break; } } } } while (0)
struct XcdBarrier { unsigned* bar; unsigned x; volatile LAS unsigned* st; };
__device__ __forceinline__ XcdBarrier xcd_barrier_post(unsigned* bar, volatile LAS unsigned* st) {
    XcdBarrier b; b.bar = bar; b.x = xb_xcc_id(); b.st = st;
    if (threadIdx.x == 0) (void)xb_add(&bar[XB_XCNT(b.x)], 1u);
    return b;
}
__device__ __forceinline__ void xcd_barrier_complete(unsigned* bar, unsigned x, unsigned& nloc, unsigned& nx) {
    const unsigned G = gridDim.x * gridDim.y * gridDim.z;
    unsigned sum, cnt, mine, sp = 0u;
    for (;;) {
        sum = 0u; cnt = 0u; mine = 0u;
#pragma unroll
        for (unsigned j = 0; j < 16; ++j) { const unsigned c = xb_ld(&bar[XB_XCNT(j)]); sum += c; cnt += (c > 0u) ? 1u : 0u; mine = (j == x) ? c : mine; }
        if (sum == G) break;
        __builtin_amdgcn_s_sleep(1);
        if ((++sp & 255u) == 0u) { if (xb_ld(&bar[XB_TMO])) break; if (sp > XB_SPIN_CAP) { atomicAdd(&bar[XB_TMO], 1u); break; } }
    }
    nloc = mine > 0u ? mine : 1u; nx = cnt > 0u ? cnt : 1u;
}
__device__ __forceinline__ void xcd_barrier(const XcdBarrier& b) {
    asm volatile("s_waitcnt vmcnt(0)" ::: "memory");
    __syncthreads();
    if (threadIdx.x == 0) {
        unsigned* bar = b.bar;
        __builtin_amdgcn_s_waitcnt(0);
        unsigned nloc = b.st[0], nx = b.st[1];
        if (nloc == 0u) { xcd_barrier_complete(bar, b.x, nloc, nx); b.st[0] = nloc; b.st[1] = nx; }
        const unsigned old = xb_add(&bar[XB_XSUB(b.x)], 1u);
        const unsigned gen = old / nloc;
        if (old + 1u == (gen + 1u) * nloc) {
            __builtin_amdgcn_fence(__ATOMIC_RELEASE, "agent");
            asm volatile("s_waitcnt vmcnt(0)" ::: "memory");
            const unsigned og = xb_add(&bar[XB_TOP], 1u);
            const unsigned tg = og / nx;
            if (og + 1u == (tg + 1u) * nx) xb_add(&bar[XB_TOPGEN], 1u);
            else XB_SPIN(xb_ld(&bar[XB_TOPGEN]) == tg, bar);
            __builtin_amdgcn_fence(__ATOMIC_ACQUIRE, "agent");
            xb_add(&bar[XB_XGEN(b.x)], 1u);
            asm volatile("s_waitcnt vmcnt(0)" ::: "memory");
        } else {
            XB_SPIN(xb_ld(&bar[XB_XGEN(b.x)]) == gen, bar);
            __builtin_amdgcn_fence(__ATOMIC_ACQUIRE, "agent");
            asm volatile("s_waitcnt vmcnt(0)" ::: "memory");
        }
    }
    __syncthreads();
}
#ifndef DUPX
#define DUPX 0
#endif
#ifdef TIMER_ID
#define TSTART(id) do { if ((id) == TIMER_ID) t0_ = __builtin_amdgcn_s_memrealtime(); } while (0)
#define TSTOP(id) do { if ((id) == TIMER_ID) tacc_ += __builtin_amdgcn_s_memrealtime() - t0_; } while (0)
#else
#define TSTART(id)
#define TSTOP(id)
#endif
__global__ void __launch_bounds__(512, 2) fwd_kernel(Params prm) {
    extern __shared__ __attribute__((aligned(16))) unsigned char lds_raw[];
    Ctx c; c.in = prm.in; c.out = prm.out; c.ws = prm.ws; c.lds = (LAS unsigned char*)lds_raw;
    unsigned char* ws = prm.ws; float* out = prm.out;
    const int tid = threadIdx.x, G = gridDim.x, bid = blockIdx.x;
    bf16_t* XB = (bf16_t*)(ws + OFF_XB); bf16_t* XN = (bf16_t*)(ws + OFF_XN); bf16_t* PP = (bf16_t*)(ws + OFF_PP); float* SSQ = (float*)(ws + OFF_SSQ);
    bf16_t* XNS = (bf16_t*)(ws + OFF_XNS); bf16_t* HS = (bf16_t*)(ws + OFF_HS); float* PS = (float*)(ws + OFF_PS); float* GSSQ = (float*)(ws + OFF_GSSQ);
    float* YS = out + O_YS; float* SSQS = (float*)(ws + OFF_SSQS);
    const int lo = prm.ph_lo, hi = prm.ph_hi;
#ifdef DIAG
    if (lo >= 100) {
        if (bid != 0) return;
        float* DG = (float*)(ws + OFF_DIAG); LAS float* red = (LAS float*)c.lds; const int st = lo - 100;
        const float* DTp = (const float*)(ws + OFF_DT); const float* DTs = (const float*)(ws + OFF_DTS); const bf16_t* ABRS = (const bf16_t*)(ws + OFF_ABRS); const bf16_t* MS = (const bf16_t*)(ws + OFF_MS); const float* bg = prm.in[11];
        if (st == 0 || st == 6 || st == 7) diag_rel(red, DG + st, D, [=](int r, int cc) { return out[O_YP + (size_t)prow(r) * D + cc]; }, [=](int r, int cc) { return YS[(size_t)r * D + cc]; });
        if (st == 1) { diag_rel(red, DG + 1, NPP, [=](int r, int cc) { return bf2f(PP[(size_t)prow(r) * NPP + cc]); }, [=](int r, int cc) { return PS[(size_t)r * 9216 + cc]; });
                       diag_rel(red, DG + 2, 32, [=](int r, int cc) { return DTp[(size_t)prow(r) * 32 + cc]; }, [=](int r, int cc) { return DTs[(size_t)r * 32 + cc]; }); }
        if (st == 8) { diag_rel(red, DG + 8, D, [=](int r, int cc) { return bf2f(XN[(size_t)prow(r) * D + cc]); }, [=](int r, int cc) { return sigmoidf_(PS[(size_t)r * 9216 + 7168 + cc] + bg[cc]); });
                       diag_rel(red, DG + 9, D, [=](int r, int cc) { return bf2f(PP[(size_t)prow(r) * NPP + 3072 + cc]); }, [=](int r, int cc) { return sigmoidf_(PS[(size_t)r * 9216 + 8192 + cc] + bg[1024 + cc]); }); }
        if (st == 3) { diag_rel(red, DG + 3, D, [=](int r, int cc) { return bf2f(PP[(size_t)prow(r) * NPP + cc]); }, [=](int r, int cc) { return bf2f(ABRS[(size_t)r * 3072 + cc]); });
                       diag_rel(red, DG + 4, 2048, [=](int r, int cc) { return bf2f(PP[(size_t)prow(r) * NPP + 1024 + cc]); }, [=](int r, int cc) { return bf2f(ABRS[(size_t)r * 3072 + 1024 + cc]); }); }
        if (st == 5) diag_rel(red, DG + 5, D, [=](int r, int cc) { return bf2f(XN[(size_t)prow(r) * D + cc]); }, [=](int r, int cc) { return bf2f(MS[(size_t)r * D + cc]); });
        if (st == 20) {
            int mask = 0; if (!(DG[8] < DIAG_TOL)) mask |= 1; if (!(DG[9] < DIAG_TOL)) mask |= 2; if (!(DG[3] < DIAG_TOL)) mask |= 4; if (!(DG[4] < DIAG_TOL)) mask |= 8; if (!(DG[5] < DIAG_TOL)) mask |= 16;
            if (mask == 0) { if (!(DG[6] < DIAG_TOL)) mask |= 32; if (!(DG[7] < DIAG_TOL)) mask |= 64; }
            float code = mask ? 100.f * (1 + mask) : 0.f;
            if (code > 0.f) for (int e = tid; e < TS * D; e += 512) YS[e] = code;
        }
        return;
    }
#endif
#ifndef PHMASK
#define PHMASK 0x1fff
#endif
#define IN(k) (((PHMASK >> (k)) & 1) && lo <= (k) && (k) < hi)
    unsigned* barctr = (unsigned*)(ws + OFF_BAR); unsigned nbar = 0; (void)barctr;
    volatile LAS unsigned* xbst = (volatile LAS unsigned*)(c.lds + LDS_BYTES - 16);
    if (tid < 4) xbst[tid] = 0u;
    __syncthreads();
    XcdBarrier xbar; xbar.bar = (unsigned*)(ws + OFF_XBAR); xbar.x = 0; xbar.st = xbst;
    if (hi - lo > 1) xbar = xcd_barrier_post((unsigned*)(ws + OFF_XBAR), xbst);
    unsigned long long t0_ = 0, tacc_ = 0; (void)t0_; (void)tacc_;
#define SEAM(k) do { if (IN(k) && IN((k) + 1)) { TSTART(12); ++nbar; xcd_barrier(xbar); TSTOP(12); } } while (0)
    auto rm_id = [](int col0, int) { return col0; };
    auto rm_up = [](int col0, int panel) { return (col0 >> 7) * 256 + panel * 128 + (col0 & 127); };

    if (IN(0)) {
        TSTART(0); prep_weights(c);
#if DUPX == 1
        prep_weights(c);
#endif
        rmsnorm_rows_bf16(prm.in[0], T, prm.in[6], XN); TSTOP(0);
#ifdef DIAG
        { const int t_ = otid(), lane = t_ & 63; for (int r = bid * 8 + (t_ >> 6); r < TS; r += G * 8) { const float* p = prm.in[0] + (size_t)prow(r) * D; float v[16]; float s = 0.f;
            for (int i = 0; i < 16; ++i) { v[i] = p[lane + 64 * i]; s += v[i] * v[i]; }
            for (int o = 1; o < 64; o <<= 1) s += __shfl_xor(s, o);
            const float inv = rsqrtf(s * (1.0f / 1024.0f) + EPS);
            for (int i = 0; i < 16; ++i) XNS[(size_t)r * D + lane + 64 * i] = f2bf(v[i] * inv * prm.in[6][lane + 64 * i]); } }
#else
        rmsnorm_rows_bf16(prm.in[1], TS, prm.in[6], XNS);
#endif
    }
    SEAM(0);
    if (IN(1)) {
        pg8::Gemm g{XN, D, (const bf16_t*)(ws + OFF_WUP1), D, T, 2 * FF, D}; pg8::StaticOrder S; S.init(T, 2 * FF, G, bid);

#if DUPX == 5
        pg8::gemm_phase(c.lds, g, S, EpiSwiglu{PP, (LAS const float*)nullptr});
#endif
        TSTART(1); pg8::gemm_phase(c.lds, g, S, EpiSwiglu{PP, (LAS const float*)nullptr}); TSTOP(1);
        TSTART(2); sgemm<16, 2, D>(c.lds, XNS, D, (const bf16_t*)(ws + OFF_WUP1), D, FF, nullptr, nullptr, rm_up,
            [=](int r, int cc, float v0, float v1, float) { HS[(size_t)r * FF + cc] = f2bf(siluf_(v0) * v1); return 0.f; }, G / 2); TSTOP(2);
    }
    SEAM(1);
    if (IN(2)) {
        pg8::Gemm g{PP, FF, (const bf16_t*)(ws + OFF_WDN1), FF, T, D, FF}; pg8::StaticOrder S; S.init(T, D, G, bid);
        TSTART(10); pg8::gemm_phase(c.lds, g, S, EpiResid{prm.in[0], nullptr, nullptr, XB, SSQ, 0.5f}); TSTOP(10);
        const float* xs_in = prm.in[1];
        TSTART(2); sgemm<16, 1, FF, 2>(c.lds, HS, FF, (const bf16_t*)(ws + OFF_WDN1), FF, D, nullptr, SSQS, rm_id,
            [=](int r, int cc, float v0, float, float) {
#ifdef DIAG
            const float x = prm.in[0][(size_t)prow(r) * D + cc] + 0.5f * v0;
#else
            const float x = xs_in[(size_t)r * D + cc] + 0.5f * v0;
#endif
            YS[(size_t)r * D + cc] = x; XNS[(size_t)r * D + cc] = f2bf(x); return x; }); TSTOP(2);
    }
    SEAM(2);
    if (IN(3)) {
        pg8::Gemm g{XB, D, (const bf16_t*)(ws + OFF_WIN), D, T, NPP, D}; pg8::StaticOrder S; S.init(T, NPP, G, bid);

#if DUPX == 6
        pg8::gemm_phase(c.lds, g, S, EpiScaleBf16{PP, SSQ});
#endif
        LAS const float* linv = fill_inv(c.lds, SSQ); TSTART(11); pg8::gemm_phase(c.lds, g, S, EpiScaleBf16{PP, linv}); TSTOP(11);
        float* DTp = (float*)(ws + OFF_DT); float* DTs = (float*)(ws + OFF_DTS);
        TSTART(2);
        {
            const int t_ = otid(), wv = t_ >> 6, ln = t_ & 63, lr = ln & 15, kg = ln >> 4; const bf16_t* WDT = (const bf16_t*)(ws + OFF_WDT);
            for (int wt = bid * 8 + wv; wt < T / 16; wt += G * 8) {
                f32x4 a0 = (f32x4){0.f, 0.f, 0.f, 0.f}, a1 = a0; f32x4 sq[4][4];
#pragma unroll
                for (int r = 0; r < 4; ++r)
#pragma unroll
                    for (int i = 0; i < 4; ++i) sq[r][i] = *(const f32x4*)(SSQ + (size_t)(16 * wt + 4 * kg + r) * 16 + 4 * i);
                const bf16_t* ap = XB + (size_t)(16 * wt + lr) * D + 8 * kg; const bf16_t* bp = WDT + (size_t)lr * D + 8 * kg;
#pragma unroll 8
                for (int k = 0; k < D; k += 32) { const bf16x8 a = *(const bf16x8*)(ap + k), b0 = *(const bf16x8*)(bp + k), b1 = *(const bf16x8*)(bp + 16 * D + k);
                    a0 = __builtin_amdgcn_mfma_f32_16x16x32_bf16(a, b0, a0, 0, 0, 0); a1 = __builtin_amdgcn_mfma_f32_16x16x32_bf16(a, b1, a1, 0, 0, 0); }
#pragma unroll
                for (int r = 0; r < 4; ++r) { const int row = 16 * wt + 4 * kg + r; const f32x4 sm = (sq[r][0] + sq[r][1]) + (sq[r][2] + sq[r][3]); const float inv = rsqrtf(((sm[0] + sm[1]) + (sm[2] + sm[3])) * (1.0f / 1024.0f) + EPS); DTp[(size_t)row * 32 + lr] = a0[r] * inv; DTp[(size_t)row * 32 + 16 + lr] = a1[r] * inv; }
            }
        }
        TSTOP(2);
        TSTART(2); sgemm<32, 1, D>(c.lds, XNS, D, (const bf16_t*)(ws + OFF_WIN), D, 9216, SSQS, nullptr, rm_id,
            [=](int r, int cc, float v0, float, float inv) { PS[(size_t)r * 9216 + cc] = v0 * inv; return 0.f; }); TSTOP(2);
        TSTART(2); sgemm<32, 1, D>(c.lds, XNS, D, (const bf16_t*)(ws + OFF_WDT), D, 32, SSQS, nullptr, rm_id,
            [=](int r, int cc, float v0, float, float inv) { DTs[(size_t)r * 32 + cc] = v0 * inv; return 0.f; }); TSTOP(2);
    }
    SEAM(3);
    if (IN(4)) {
        for (int e = bid * 512 + tid; e < 8 * 3 * 2048; e += G * 512) {
            const int cc = e & 2047, r = (e >> 11) % 3, b = e / (3 * 2048); const size_t row = (size_t)b * SEQ + 2045 + r;
            if (cc < 1024) out[O_LCP + (size_t)(b * 3 + r) * D + cc] = bf2f(PP[row * NPP + cc]);
            else out[O_SCP + (size_t)(b * 3 + r) * 3072 + 2048 + (cc - 1024)] = bf2f(PP[row * NPP + 3072 + (cc - 1024)]); }

#if DUPX == 4
        for (int it = bid; it < 256; it += G) lru_chunk<false>(c, it >> 5, it & 31);
#endif
        TSTART(19); for (int it = bid; it < 256; it += G) bc_conv(c, it >> 5, it & 31); TSTOP(19);
        if (hi - lo > 1) xcd_barrier(xbar);
        TSTART(3); for (int it = bid; it < 256; it += G) lru_chunk<false>(c, it >> 5, it & 31); TSTOP(3);

#if DUPX == 3
        for (int it = bid; it < 256; it += G) ssd_seq(c, it >> 5, it & 31, prm.ph_lo == 0);
#endif


    }
    SEAM(4);
    if (IN(5)) {

#if DUPX == 2
        for (int it = bid; it < 256; it += G) lru_chunk<true>(c, it >> 5, it & 31, prm.ph_lo == 0);
#endif
        TSTART(4); for (int it = bid; it < 256; it += G) ssd_seq(c, it & 7, it >> 3); TSTOP(4);
        TSTART(5); for (int it = bid; it < 256; it += G) lru_final(c, it >> 5, it & 31); TSTOP(5);
        TSTART(2); for (int it = bid; it < 64; it += G) lru_sample(c, it >> 3, it & 7); TSTOP(2);
        TSTART(2); for (int it = bid; it < 256; it += G) ssd_sample(c, it >> 5, it & 31); TSTOP(2);
    }
    SEAM(5);
    if (IN(6)) { TSTART(8);
        {
        const float* YGS = (const float*)(ws + OFF_YGS); bf16_t* ABRS = (bf16_t*)(ws + OFF_ABRS);
        const int lane = tid & 63;
        for (int w = bid * 8 + (tid >> 6); w < TS * 4; w += G * 8) { const int r = w >> 2, gq = w & 3; const float* p = YGS + (size_t)r * 2048 + 512 * gq; float v[8]; float s = 0.f;
#pragma unroll
            for (int j = 0; j < 8; ++j) { v[j] = p[lane + 64 * j]; s += v[j] * v[j]; }
#pragma unroll
            for (int o = 1; o < 64; o <<= 1) s += __shfl_xor(s, o);
            const float inv = rsqrtf(s * (1.0f / 512.0f) + EPS);
#pragma unroll
            for (int j = 0; j < 8; ++j) ABRS[(size_t)r * 3072 + 1024 + 512 * gq + lane + 64 * j] = f2bf(v[j] * inv); }
        }
        LAS const float* linv = fill_inv(c.lds, SSQ);
        { pg8::Gemm g{XB, D, (const bf16_t*)(ws + OFF_WIN) + (size_t)4096 * D, D, T, 3072, D}; pg8::StaticOrder S; S.init(T, 3072, G, bid);
          pg8::gemm_phase(c.lds, g, S, EpiGatesA{PP, linv, GSSQ}); }
        { pg8::Gemm g{XB, D, (const bf16_t*)(ws + OFF_WIN) + (size_t)7168 * D, D, T, D, D}; pg8::StaticOrder S; S.init(T, D, G, bid);
          pg8::gemm_phase(c.lds, g, S, EpiSigmoid{XN, D, linv, prm.in[11]}); }
        { pg8::Gemm g{XB, D, (const bf16_t*)(ws + OFF_WIN) + (size_t)8192 * D, D, T, D, D}; pg8::StaticOrder S; S.init(T, D, G, bid);
          pg8::gemm_phase(c.lds, g, S, EpiSigmoid{PP + 3072, NPP, linv, prm.in[11] + 1024}); } TSTOP(8);
    }
    SEAM(6);
    if (IN(7)) { TSTART(6);
        const int lane = tid & 63;
        for (int r = bid * 8 + (tid >> 6); r < T; r += G * 8) {
            float s = (lane < 32) ? GSSQ[(size_t)r * 32 + lane] : 0.f;
            s += __shfl_xor(s, 1); s += __shfl_xor(s, 2); s += __shfl_xor(s, 4);
            const float i0 = rsqrtf(__shfl(s, 0) * (1.0f / 512.0f) + EPS), i1 = rsqrtf(__shfl(s, 8) * (1.0f / 512.0f) + EPS), i2 = rsqrtf(__shfl(s, 16) * (1.0f / 512.0f) + EPS), i3 = rsqrtf(__shfl(s, 24) * (1.0f / 512.0f) + EPS);
#pragma unroll
            for (int i = 0; i < 4; ++i) { const float inv = i == 0 ? i0 : (i == 1 ? i1 : (i == 2 ? i2 : i3));
                bf16_t* p = PP + (size_t)r * NPP + 1024 + 512 * i + 8 * lane; f32x4 a, bq; unpack8(*(const u32x4*)p, a, bq); *(u32x4*)p = pack8(a * inv, bq * inv); }
        }
    }
    TSTOP(6); SEAM(7);
    if (IN(8)) {
        TSTART(9); { pg8::Gemm g{PP, NPP, (const bf16_t*)(ws + OFF_WBR), 3072, T, D, D}; pg8::StaticOrder S; S.init(T, D, G, bid); pg8::gemm_phase(c.lds, g, S, EpiBr{XN, PP, 0}); }
        { pg8::Gemm g{PP + 1024, NPP, (const bf16_t*)(ws + OFF_WBR) + 1024, 3072, T, D, 2048}; pg8::StaticOrder S; S.init(T, D, G, bid); pg8::gemm_phase(c.lds, g, S, EpiBr{XN, PP, 1}); } TSTOP(9);
        const bf16_t* ABRS = (const bf16_t*)(ws + OFF_ABRS); float* M1S = (float*)(ws + OFF_M1S); bf16_t* MS = (bf16_t*)(ws + OFF_MS); const float* bg = prm.in[11];
        TSTART(2); sgemm<16, 1, D, 2>(c.lds, ABRS, 3072, (const bf16_t*)(ws + OFF_WBR), 3072, D, nullptr, nullptr, rm_id,
            [=](int r, int cc, float v0, float, float) { M1S[(size_t)r * D + cc] = sigmoidf_(PS[(size_t)r * 9216 + 7168 + cc] + bg[cc]) * v0; return 0.f; }); TSTOP(2);
        TSTART(2); sgemm<16, 1, 2048, 2>(c.lds, ABRS + 1024, 3072, (const bf16_t*)(ws + OFF_WBR) + 1024, 3072, D, nullptr, nullptr, rm_id,
            [=](int r, int cc, float v0, float, float) { MS[(size_t)r * D + cc] = f2bf(M1S[(size_t)r * D + cc] + sigmoidf_(PS[(size_t)r * 9216 + 8192 + cc] + bg[1024 + cc]) * v0); return 0.f; }); TSTOP(2);
    }
    SEAM(8);
    if (IN(9)) {
        pg8::Gemm g{XN, D, (const bf16_t*)(ws + OFF_WOUT), D, T, D, D}; pg8::StaticOrder S; S.init(T, D, G, bid);
        TSTART(16); pg8::gemm_phase(c.lds, g, S, EpiResid{nullptr, XB, nullptr, XB, SSQ, 1.0f}); TSTOP(16);
        const bf16_t* MS = (const bf16_t*)(ws + OFF_MS);
        TSTART(2); sgemm<16, 1, D, 2>(c.lds, MS, D, (const bf16_t*)(ws + OFF_WOUT), D, D, nullptr, SSQS + 8192, rm_id,
            [=](int r, int cc, float v0, float, float) { const float x = YS[(size_t)r * D + cc] + v0; YS[(size_t)r * D + cc] = x; XNS[(size_t)r * D + cc] = f2bf(x); return x; }); TSTOP(2);
    }
    SEAM(9);
    if (IN(10)) {
        pg8::Gemm g{XB, D, (const bf16_t*)(ws + OFF_WUP2), D, T, 2 * FF, D}; pg8::StaticOrder S; S.init(T, 2 * FF, G, bid);
        LAS const float* linv = fill_inv(c.lds, SSQ);
        TSTART(17); pg8::gemm_phase(c.lds, g, S, EpiSwiglu{PP, linv}); TSTOP(17);
        TSTART(2); sgemm<16, 2, D>(c.lds, XNS, D, (const bf16_t*)(ws + OFF_WUP2), D, FF, SSQS + 8192, nullptr, rm_up,
            [=](int r, int cc, float v0, float v1, float inv) { HS[(size_t)r * FF + cc] = f2bf(siluf_(v0 * inv) * (v1 * inv)); return 0.f; }, G / 2); TSTOP(2);
    }
    SEAM(10);
    if (IN(11)) {
        pg8::Gemm g{PP, FF, (const bf16_t*)(ws + OFF_WDN2), FF, T, D, FF}; pg8::StaticOrder S; S.init(T, D, G, bid);
        TSTART(18); pg8::gemm_phase(c.lds, g, S, EpiResid{nullptr, XB, out + O_YP, nullptr, SSQ, 0.5f}); TSTOP(18);
        TSTART(2); sgemm<16, 1, FF, 2>(c.lds, HS, FF, (const bf16_t*)(ws + OFF_WDN2), FF, D, nullptr, nullptr, rm_id,
            [=](int r, int cc, float v0, float, float) { YS[(size_t)r * D + cc] += 0.5f * v0; return 0.f; }); TSTOP(2);
    }
    SEAM(11);
    if (IN(12)) {
        TSTART(7); rmsnorm_rows_f32(out + O_YP, T + TS, prm.in[31]); TSTOP(7);
    }
#ifdef TIMER_ID
    if (hi == 13) { ++nbar; grid_barrier(barctr, nbar * (unsigned)G);
        if (bid == TIMER_BLOCK) { const float us = (float)tacc_ * 0.0001f; for (int e = tid; e < TS * D; e += 512) YS[e] = us; } }
#endif
#undef IN
#undef SEAM
}

#ifndef N_LAUNCH_MODE
#define N_LAUNCH_MODE 1
#endif
extern "C" void kernel_launch(void* const* d_in, const int* in_sizes, int n_in, void* d_out, int out_size, void* d_ws, size_t ws_size, hipStream_t stream) {
    static int grid = 0;
    if (grid == 0) {
        if (n_in != 32 || ws_size < OFF_XBAR + XCD_BAR_WORDS * 4) { fprintf(stderr, "kernel_launch: unexpected n_in %d or ws_size %zu (< %zu)\n", n_in, ws_size, (size_t)WS_END); grid = -1; return; }
        int dev = 0, cus = 0, per_cu = 0;
        hipGetDevice(&dev); hipDeviceGetAttribute(&cus, hipDeviceAttributeMultiprocessorCount, dev);
        if (hipFuncSetAttribute((const void*)fwd_kernel, hipFuncAttributeMaxDynamicSharedMemorySize, LDS_BYTES) != hipSuccess) { fprintf(stderr, "kernel_launch: hipFuncSetAttribute failed\n"); grid = -1; return; }
        hipOccupancyMaxActiveBlocksPerMultiprocessor(&per_cu, (const void*)fwd_kernel, 512, LDS_BYTES);
        if (per_cu < 1) { fprintf(stderr, "kernel_launch: occupancy query says %d blocks per CU\n", per_cu); per_cu = 1; }
        grid = cus * 1;
        (void)hipGetLastError();
    }
    if (grid < 0) return;
    Params p{};
    for (int i = 0; i < 32; ++i) p.in[i] = (const float*)d_in[i];
    p.out = (float*)d_out; p.ws = (unsigned char*)d_ws;
#if N_LAUNCH_MODE == 0
    for (int ph = 0; ph < 13; ++ph) { p.ph_lo = ph; p.ph_hi = ph + 1; hipLaunchKernelGGL(fwd_kernel, dim3(grid), dim3(512), LDS_BYTES, stream, p);
#ifdef DIAG
        int st = -1; if (ph == 2) st = 0; if (ph == 3) st = 1; if (ph == 6) st = 8; if (ph == 7) st = 3; if (ph == 8) st = 5; if (ph == 9) st = 6; if (ph == 11) st = 7; if (ph == 12) st = 20;
        if (st >= 0) { p.ph_lo = 100 + st; p.ph_hi = 0; hipLaunchKernelGGL(fwd_kernel, dim3(grid), dim3(512), LDS_BYTES, stream, p); }
#endif
    }
#else
    p.ph_lo = 0; p.ph_hi = 13;
    hipMemsetAsync((char*)d_ws + OFF_XBAR, 0, XCD_BAR_WORDS * 4, stream);
    void* args[] = {&p};
    hipError_t e = hipLaunchCooperativeKernel((const void*)fwd_kernel, dim3(grid), dim3(512), args, LDS_BYTES, stream);
    if (e != hipSuccess) fprintf(stderr, "cooperative launch failed: %s (grid %d)\n", hipGetErrorString(e), grid);
#endif
}
```
